# Optimizing an MI355X kernel written in HIP

```python
import math
import jax, jax.numpy as jnp
from jax import lax
import numpy as np

D_MODEL = 1024
BATCH = 2
SEQ = 16384
DEPTH = 4

A_HEADS = 4
A_HEAD_DIM = 64
A_V_DIM = 2 * A_HEAD_DIM
B_HEADS = 4
B_HEAD_DIM = 128
CONV_WIDTH = 4
DELTA_CHUNK = 64
C_HEADS = 16
C_HEAD_DIM = 64
T5_BUCKETS = 32
T5_MAX_DISTANCE = 2048
Q_BLOCK = 128
N_EXPERTS = 32
TOP_K = 4
D_FF = D_MODEL
SWIGLU_LIMIT = 7.0
SWIGLU_ALPHA = 1.702
MOE_BLOCK = 256
DEEPNORM_ALPHA = (2 * DEPTH) ** 0.25
DEEPNORM_BETA = (8 * DEPTH) ** -0.25
LN_EPS = 1e-5
RMS_EPS = 1e-6
N_EVEN = (DEPTH + 1) // 2
N_ODD = DEPTH // 2

A_Q = A_HEADS * 2 * A_HEAD_DIM
A_K = A_HEADS * 2 * A_HEAD_DIM
A_V = A_HEADS * A_V_DIM
B_W = B_HEADS * B_HEAD_DIM
EVEN_SPLITS = [A_Q, A_Q + A_K, A_Q + A_K + A_V, A_Q + A_K + A_V + 3 * B_W,
               A_Q + A_K + A_V + 4 * B_W, A_Q + A_K + A_V + 4 * B_W + B_HEADS]
EVEN_IN = A_Q + A_K + A_V + 4 * B_W + 2 * B_HEADS
EVEN_OUT = A_V + B_W
C_W = C_HEADS * C_HEAD_DIM
ODD_SPLITS = [C_W, 2 * C_W, 3 * C_W, 4 * C_W]
ODD_IN = 4 * C_W + C_HEADS
ODD_OUT = C_W

kernel_name = "hybrid_diffattn_gdn_fox_moe_deepnorm"


def layer_norm(x, g, b):
    xf = x.astype(jnp.float32)
    mu = jnp.mean(xf, -1, keepdims=True)
    var = jnp.mean(jnp.square(xf - mu), -1, keepdims=True)
    return ((xf - mu) * lax.rsqrt(var + LN_EPS) * g.astype(jnp.float32) + b.astype(jnp.float32)).astype(x.dtype)


def rms_norm(x, w):
    xf = x.astype(jnp.float32)
    return (xf * lax.rsqrt(jnp.mean(xf * xf, -1, keepdims=True) + RMS_EPS) * w.astype(jnp.float32)).astype(x.dtype)


def l2_norm(x):
    xf = x.astype(jnp.float32)
    return (xf * lax.rsqrt(jnp.sum(xf * xf, -1, keepdims=True) + RMS_EPS)).astype(x.dtype)


def t5_bucket(rel):
    n = jnp.maximum(rel, 0)
    max_exact = T5_BUCKETS // 2
    nf = jnp.maximum(n, 1).astype(jnp.float32)
    large = max_exact + (jnp.log(nf / max_exact) / math.log(T5_MAX_DISTANCE / max_exact)
                         * (T5_BUCKETS - max_exact)).astype(jnp.int32)
    large = jnp.minimum(large, T5_BUCKETS - 1)
    return jnp.where(n < max_exact, n, large)


def diff_attention(q, k, v, lam, bias_table):
    Bsz, H, _, T, d = q.shape
    scale = d ** -0.5
    k_pos = jnp.arange(T)
    table = bias_table.astype(jnp.float32).T

    def block(i):
        start = i * Q_BLOCK
        qb = lax.dynamic_slice_in_dim(q, start, Q_BLOCK, axis=3)
        rel = (start + jnp.arange(Q_BLOCK))[:, None] - k_pos[None, :]
        bias = table[:, t5_bucket(rel)]
        s = jnp.einsum('bhmqd,bhmkd->bhmqk', qb, k).astype(jnp.float32) * scale + bias[None, :, None]
        p = jax.nn.softmax(jnp.where(rel >= 0, s, -jnp.inf), axis=-1)
        a = p[:, :, 0] - lam * p[:, :, 1]
        return jnp.einsum('bhqk,bhkd->bhqd', a.astype(v.dtype), v)

    out = lax.map(block, jnp.arange(T // Q_BLOCK))
    return out.transpose(1, 2, 0, 3, 4).reshape(Bsz, H, T, v.shape[-1])


def forgetting_attention(q, k, v, logf):
    Bsz, H, T, d = q.shape
    scale = d ** -0.5
    cum = jnp.cumsum(logf.astype(jnp.float32), axis=-1)
    k_pos = jnp.arange(T)

    def block(i):
        start = i * Q_BLOCK
        qb = lax.dynamic_slice_in_dim(q, start, Q_BLOCK, axis=2)
        cq = lax.dynamic_slice_in_dim(cum, start, Q_BLOCK, axis=2)
        causal = (start + jnp.arange(Q_BLOCK))[:, None] >= k_pos[None, :]
        s = jnp.einsum('bhqd,bhkd->bhqk', qb, k).astype(jnp.float32) * scale + cq[..., :, None] - cum[..., None, :]
        p = jax.nn.softmax(jnp.where(causal, s, -jnp.inf), axis=-1)
        return jnp.einsum('bhqk,bhkd->bhqd', p.astype(v.dtype), v)

    out = lax.map(block, jnp.arange(T // Q_BLOCK))
    return out.transpose(1, 2, 0, 3, 4).reshape(Bsz, H, T, d)


def gated_delta_rule(q, k, v, g, beta):
    f32 = jnp.float32
    Bsz, H, T, dk = q.shape
    dv = v.shape[-1]
    C = DELTA_CHUNK
    N = T // C
    q = (q.astype(f32) * dk ** -0.5).reshape(Bsz, H, N, C, dk)
    k = k.astype(f32).reshape(Bsz, H, N, C, dk)
    v = v.astype(f32).reshape(Bsz, H, N, C, dv)
    beta = beta.astype(f32).reshape(Bsz, H, N, C, 1)
    gc = jnp.cumsum(g.astype(f32).reshape(Bsz, H, N, C), axis=-1)
    idx = jnp.arange(C)
    incl = idx[:, None] >= idx[None, :]
    strict = (idx[:, None] > idx[None, :]).astype(f32)
    decay = jnp.exp(jnp.where(incl, gc[..., :, None] - gc[..., None, :], -jnp.inf))
    kb = k * beta
    lower = jnp.einsum('bhncd,bhnmd->bhncm', kb, k) * decay * strict
    rhs = jnp.concatenate([v * beta, kb * jnp.exp(gc)[..., None]], axis=-1)
    sol = lax.linalg.triangular_solve(jnp.eye(C, dtype=f32) + lower, rhs,
                                      left_side=True, lower=True, unit_diagonal=True)
    u, w = sol[..., :dv], sol[..., dv:]
    qk_intra = jnp.einsum('bhncd,bhnmd->bhncm', q, k) * decay
    q_dec = q * jnp.exp(gc)[..., None]
    k_dec = k * jnp.exp(gc[..., -1:] - gc)[..., None]
    g_last = jnp.exp(gc[..., -1])

    def step(S, xs):
        u_n, w_n, qk_n, qd_n, kd_n, gl_n = xs
        v_new = u_n - jnp.einsum('bhck,bhkv->bhcv', w_n, S)
        o_n = jnp.einsum('bhck,bhkv->bhcv', qd_n, S) + jnp.einsum('bhcm,bhmv->bhcv', qk_n, v_new)
        S = S * gl_n[..., None, None] + jnp.einsum('bhck,bhcv->bhkv', kd_n, v_new)
        return S, o_n

    xs = tuple(jnp.moveaxis(a, 2, 0) for a in (u, w, qk_intra, q_dec, k_dec, g_last))
    _, o = lax.scan(step, jnp.zeros((Bsz, H, dk, dv), f32), xs)
    return jnp.moveaxis(o, 0, 2).reshape(Bsz, H, T, dv)


def causal_conv_silu(x, w):
    K, C = w.shape
    y = lax.conv_general_dilated(x, w[:, None, :].astype(x.dtype), window_strides=(1,),
                                 padding=[(K - 1, 0)], dimension_numbers=('NWC', 'WIO', 'NWC'),
                                 feature_group_count=C)
    return jax.nn.silu(y)


def even_mixer(x, w_in, w_out, lam_params, subln_w, conv_w, a_log, dt_bias, gdn_norm_w, t5_bias, lam_init):
    Bsz, T, _ = x.shape
    proj = x @ w_in
    aq, ak, av, bqkv, bz, bb, ba = jnp.split(proj, EVEN_SPLITS, axis=-1)
    aq = aq.reshape(Bsz, T, A_HEADS, 2, A_HEAD_DIM).transpose(0, 2, 3, 1, 4)
    ak = ak.reshape(Bsz, T, A_HEADS, 2, A_HEAD_DIM).transpose(0, 2, 3, 1, 4)
    av = av.reshape(Bsz, T, A_HEADS, A_V_DIM).transpose(0, 2, 1, 3)
    lp = lam_params.astype(jnp.float32)
    lam = jnp.exp(jnp.sum(lp[0] * lp[1])) - jnp.exp(jnp.sum(lp[2] * lp[3])) + lam_init
    ao = diff_attention(aq, ak, av, lam, t5_bias)
    ao = rms_norm(ao, subln_w) * (1.0 - lam_init)
    ao = ao.transpose(0, 2, 1, 3).reshape(Bsz, T, A_V)
    bqkv = causal_conv_silu(bqkv, conv_w)
    bq, bk, bv = jnp.split(bqkv, 3, axis=-1)
    heads = lambda t: t.reshape(Bsz, T, B_HEADS, B_HEAD_DIM).transpose(0, 2, 1, 3)
    bq, bk, bv = l2_norm(heads(bq)), l2_norm(heads(bk)), heads(bv)
    beta = jax.nn.sigmoid(bb.astype(jnp.float32)).transpose(0, 2, 1)
    g = (-jnp.exp(a_log.astype(jnp.float32))
         * jax.nn.softplus(ba.astype(jnp.float32) + dt_bias.astype(jnp.float32))).transpose(0, 2, 1)
    bo = gated_delta_rule(bq, bk, bv, g, beta).astype(x.dtype)
    bo = rms_norm(bo, gdn_norm_w) * jax.nn.silu(heads(bz))
    bo = bo.transpose(0, 2, 1, 3).reshape(Bsz, T, B_W)
    return jnp.concatenate([ao, bo], axis=-1) @ w_out


def odd_mixer(x, w_in, w_out, qk_norm_w, forget_b):
    Bsz, T, _ = x.shape
    proj = x @ w_in
    q, k, v, gate, f = jnp.split(proj, ODD_SPLITS, axis=-1)
    heads = lambda t: t.reshape(Bsz, T, C_HEADS, C_HEAD_DIM).transpose(0, 2, 1, 3)
    q = rms_norm(heads(q), qk_norm_w[0])
    k = rms_norm(heads(k), qk_norm_w[1])
    logf = jax.nn.log_sigmoid(f.astype(jnp.float32) + forget_b.astype(jnp.float32)).transpose(0, 2, 1)
    o = forgetting_attention(q, k, heads(v), logf)
    o = o.transpose(0, 2, 1, 3).reshape(Bsz, T, C_W) * jax.nn.sigmoid(gate)
    return o @ w_out


def moe_ffn(x, router_w, router_b, w_gu, b_gu, w_down, b_down):
    Bsz, T, D = x.shape
    xt = x.reshape(-1, D)
    n_tok = xt.shape[0]
    logits = (xt @ router_w + router_b).astype(jnp.float32)
    top_val, top_idx = lax.top_k(logits, TOP_K)
    gates = jax.nn.softmax(top_val, axis=-1)
    n_assign = n_tok * TOP_K
    flat_e = top_idx.reshape(-1)
    flat_tok = jnp.repeat(jnp.arange(n_tok, dtype=jnp.int32), TOP_K)
    order = jnp.argsort(flat_e)
    e_sorted, tok_sorted, gate_sorted = flat_e[order], flat_tok[order], gates.reshape(-1)[order]
    counts = jnp.bincount(flat_e, length=N_EXPERTS)
    padded = (counts + MOE_BLOCK - 1) // MOE_BLOCK * MOE_BLOCK
    start = jnp.cumsum(counts) - counts
    pad_end = jnp.cumsum(padded)
    pad_start = pad_end - padded
    dest = pad_start[e_sorted] + jnp.arange(n_assign) - start[e_sorted]
    n_blocks = -(-n_assign // MOE_BLOCK) + N_EXPERTS
    n_rows = n_blocks * MOE_BLOCK
    row_tok = jnp.full((n_rows,), n_tok, jnp.int32).at[dest].set(tok_sorted)
    block_expert = jnp.minimum(jnp.searchsorted(pad_end, jnp.arange(n_blocks) * MOE_BLOCK, side='right'),
                               N_EXPERTS - 1)
    x_pad = jnp.concatenate([xt, jnp.zeros((1, D), xt.dtype)], axis=0)
    xb = x_pad[row_tok].reshape(n_blocks, MOE_BLOCK, D)

    def expert_block(args):
        xblk, e = args
        h = xblk @ w_gu[e] + b_gu[e]
        g, u = jnp.split(h, 2, axis=-1)
        g = jnp.minimum(g, SWIGLU_LIMIT)
        u = jnp.clip(u, -SWIGLU_LIMIT, SWIGLU_LIMIT)
        act = g * jax.nn.sigmoid(SWIGLU_ALPHA * g) * (u + 1.0)
        return act @ w_down[e] + b_down[e]

    yb = lax.map(expert_block, (xb, block_expert)).reshape(n_rows, D)
    y_assign = yb[dest] * gate_sorted[:, None].astype(yb.dtype)
    out = jnp.zeros_like(xt).at[tok_sorted].add(y_assign)
    return out.reshape(Bsz, T, D)


def setup_inputs(seed: int = 0) -> dict:
    key = jax.random.key(seed)
    ks = jax.random.split(key, 24)
    f32 = jnp.float32
    nrm = lambda k, shape, s: jax.random.normal(k, shape, f32) * s
    even_scale = jnp.ones((EVEN_IN,), f32)
    even_scale = even_scale.at[A_Q + A_K:A_Q + A_K + A_V].set(DEEPNORM_BETA)
    bv0 = A_Q + A_K + A_V + 2 * B_W
    even_scale = even_scale.at[bv0:bv0 + B_W].set(DEEPNORM_BETA)
    odd_scale = jnp.ones((ODD_IN,), f32).at[2 * C_W:3 * C_W].set(DEEPNORM_BETA)
    dt = jnp.exp(jax.random.uniform(ks[8], (N_EVEN, B_HEADS), f32, math.log(1e-3), math.log(1e-1)))
    return {
        'x': jax.random.normal(ks[0], (BATCH, SEQ, D_MODEL), f32),
        't5_bias': nrm(ks[1], (T5_BUCKETS, A_HEADS), 0.5),
        'even_w_in': nrm(ks[2], (N_EVEN, D_MODEL, EVEN_IN), D_MODEL ** -0.5) * even_scale,
        'even_w_out': nrm(ks[3], (N_EVEN, EVEN_OUT, D_MODEL), EVEN_OUT ** -0.5 * DEEPNORM_BETA),
        'diff_lambda': nrm(ks[4], (N_EVEN, 4, A_HEAD_DIM), 0.1),
        'diff_subln_w': 1.0 + nrm(ks[5], (N_EVEN, A_V_DIM), 0.02),
        'gdn_conv_w': nrm(ks[6], (N_EVEN, CONV_WIDTH, 3 * B_W), CONV_WIDTH ** -0.5),
        'gdn_a_log': jnp.log(jax.random.uniform(ks[7], (N_EVEN, B_HEADS), f32, 1.0, 16.0)),
        'gdn_dt_bias': dt + jnp.log(-jnp.expm1(-dt)),
        'gdn_norm_w': 1.0 + nrm(ks[9], (N_EVEN, B_HEAD_DIM), 0.02),
        'odd_w_in': nrm(ks[10], (N_ODD, D_MODEL, ODD_IN), D_MODEL ** -0.5) * odd_scale,
        'odd_w_out': nrm(ks[11], (N_ODD, ODD_OUT, D_MODEL), ODD_OUT ** -0.5 * DEEPNORM_BETA),
        'fox_qk_norm_w': 1.0 + nrm(ks[12], (N_ODD, 2, C_HEAD_DIM), 0.02),
        'fox_forget_b': 2.0 + nrm(ks[13], (N_ODD, C_HEADS), 0.1),
        'router_w': nrm(ks[14], (DEPTH, D_MODEL, N_EXPERTS), D_MODEL ** -0.5),
        'router_b': nrm(ks[15], (DEPTH, N_EXPERTS), 0.01),
        'moe_w_gate_up': nrm(ks[16], (DEPTH, N_EXPERTS, D_MODEL, 2 * D_FF), D_MODEL ** -0.5),
        'moe_b_gate_up': nrm(ks[17], (DEPTH, N_EXPERTS, 2 * D_FF), 0.01),
        'moe_w_down': nrm(ks[18], (DEPTH, N_EXPERTS, D_FF, D_MODEL), D_FF ** -0.5 * DEEPNORM_BETA),
        'moe_b_down': nrm(ks[19], (DEPTH, N_EXPERTS, D_MODEL), 0.01),
        'ln_mix_g': 1.0 + nrm(ks[20], (DEPTH, D_MODEL), 0.02),
        'ln_mix_b': nrm(ks[21], (DEPTH, D_MODEL), 0.02),
        'ln_ffn_g': 1.0 + nrm(ks[22], (DEPTH, D_MODEL), 0.02),
        'ln_ffn_b': nrm(ks[23], (DEPTH, D_MODEL), 0.02),
    }


def reference(x, t5_bias, even_w_in, even_w_out, diff_lambda, diff_subln_w, gdn_conv_w, gdn_a_log,
              gdn_dt_bias, gdn_norm_w, odd_w_in, odd_w_out, fox_qk_norm_w, fox_forget_b,
              router_w, router_b, moe_w_gate_up, moe_b_gate_up, moe_w_down, moe_b_down,
              ln_mix_g, ln_mix_b, ln_ffn_g, ln_ffn_b):
    for layer in range(DEPTH):
        i = layer // 2
        if layer % 2 == 0:
            lam_init = 0.8 - 0.6 * math.exp(-0.3 * layer)
            h = even_mixer(x, even_w_in[i], even_w_out[i], diff_lambda[i], diff_subln_w[i],
                           gdn_conv_w[i], gdn_a_log[i], gdn_dt_bias[i], gdn_norm_w[i], t5_bias, lam_init)
        else:
            h = odd_mixer(x, odd_w_in[i], odd_w_out[i], fox_qk_norm_w[i], fox_forget_b[i])
        x = layer_norm(DEEPNORM_ALPHA * x + h, ln_mix_g[layer], ln_mix_b[layer])
        h = moe_ffn(x, router_w[layer], router_b[layer], moe_w_gate_up[layer], moe_b_gate_up[layer],
                    moe_w_down[layer], moe_b_down[layer])
        x = layer_norm(DEEPNORM_ALPHA * x + h, ln_ffn_g[layer], ln_ffn_b[layer])
    return x
```

```cpp
#include <hip/hip_runtime.h>
#include <cstdint>
#include <cstdio>

namespace cfg {
constexpr int B = 2, T = 16384, D = 1024, NTOK = B * T;
constexpr int EVEN_IN = 3592, ODD_IN = 4112;
constexpr int NE = 32, TOPK = 4, DFF = 1024;
constexpr float ALPHA = 1.681792830507429f;
constexpr float LN_EPS = 1e-5f, RMS_EPS = 1e-6f;
}
using namespace cfg;

namespace nv {

__device__ __forceinline__ float sigmoidf_(float x) { return 1.f / (1.f + __expf(-x)); }
__device__ __forceinline__ float softplusf_(float x) { return x > 20.f ? x : log1pf(expf(x)); }

struct GemmArgs {
    const float* A; const float* Bm; const float* bias; float* C; const int* cnt; const int* off; const int* list;
    int lda, ldb, ldc, M, N, K;
};
template <int MODE>
__global__ void __launch_bounds__(256) gemm(GemmArgs g) {
    __shared__ float As[16][128 + 4];
    __shared__ float Bs[16][128 + 4];
    const int tid = threadIdx.x, tx = tid & 15, ty = tid >> 4;
    const int m0 = blockIdx.y * 128, n0 = blockIdx.x * 128;
    int M = g.M; const float* Bm = g.Bm; const float* bias = g.bias; int rowbase = 0; const int* lst = nullptr;
    if (MODE != 0) {
        const int e = blockIdx.z; M = g.cnt[e]; if (m0 >= M) return;
        rowbase = g.off[e]; lst = g.list + (size_t)e * NTOK;
        Bm += (size_t)e * g.K * g.ldb; if (bias) bias += (size_t)e * g.N;
    }
    const float* arow[2]; bool aval[2];
#pragma unroll
    for (int i = 0; i < 2; ++i) {
        const int r = m0 + (tid >> 2) + 64 * i; aval[i] = r < M;
        if (MODE == 0) arow[i] = g.A + (size_t)r * g.lda;
        else if (MODE == 1) { const int tok = aval[i] ? (lst[r] >> 2) : 0; arow[i] = g.A + (size_t)tok * g.lda; }
        else arow[i] = g.A + (size_t)(rowbase + r) * g.lda;
    }
    float acc[8][8];
#pragma unroll
    for (int i = 0; i < 8; ++i)
#pragma unroll
        for (int j = 0; j < 8; ++j) acc[i][j] = 0.f;
    for (int k0 = 0; k0 < g.K; k0 += 16) {
#pragma unroll
        for (int i = 0; i < 2; ++i) {
            const int r = (tid >> 2) + 64 * i, c = (tid & 3) * 4;
            float4 v = make_float4(0.f, 0.f, 0.f, 0.f);
            if (aval[i]) {
                v = *(const float4*)(arow[i] + k0 + c);
                if (MODE == 2) {
                    const float4 u = *(const float4*)(arow[i] + 1024 + k0 + c);
                    float gg[4] = {v.x, v.y, v.z, v.w}, uu[4] = {u.x, u.y, u.z, u.w}, o[4];
#pragma unroll
                    for (int q = 0; q < 4; ++q) { const float a = fminf(gg[q], 7.f), b = fminf(fmaxf(uu[q], -7.f), 7.f); o[q] = a * sigmoidf_(1.702f * a) * (b + 1.f); }
                    v = make_float4(o[0], o[1], o[2], o[3]);
                }
            }
            As[c][r] = v.x; As[c + 1][r] = v.y; As[c + 2][r] = v.z; As[c + 3][r] = v.w;
        }
#pragma unroll
        for (int i = 0; i < 2; ++i) {
            const int r = (tid >> 5) + 8 * i, c = (tid & 31) * 4;
            const float* bp = Bm + (size_t)(k0 + r) * g.ldb + n0 + c;
            float4 v;
            if (n0 + c + 3 < g.N) v = *(const float4*)bp;
            else { v.x = (n0 + c < g.N) ? bp[0] : 0.f; v.y = (n0 + c + 1 < g.N) ? bp[1] : 0.f; v.z = (n0 + c + 2 < g.N) ? bp[2] : 0.f; v.w = 0.f; }
            *(float4*)&Bs[r][c] = v;
        }
        __syncthreads();
#pragma unroll
        for (int kk = 0; kk < 16; ++kk) {
            const float4 a0 = *(const float4*)&As[kk][ty * 8], a1 = *(const float4*)&As[kk][ty * 8 + 4];
            const float4 b0 = *(const float4*)&Bs[kk][tx * 8], b1 = *(const float4*)&Bs[kk][tx * 8 + 4];
            const float a[8] = {a0.x, a0.y, a0.z, a0.w, a1.x, a1.y, a1.z, a1.w};
            const float b[8] = {b0.x, b0.y, b0.z, b0.w, b1.x, b1.y, b1.z, b1.w};
#pragma unroll
            for (int i = 0; i < 8; ++i)
#pragma unroll
                for (int j = 0; j < 8; ++j) acc[i][j] = fmaf(a[i], b[j], acc[i][j]);
        }
        __syncthreads();
    }
#pragma unroll
    for (int i = 0; i < 8; ++i) {
        const int r = m0 + ty * 8 + i; if (r >= M) continue;
        float* crow = g.C + (size_t)(rowbase + r) * g.ldc;
#pragma unroll
        for (int j = 0; j < 8; ++j) { const int c = n0 + tx * 8 + j; if (c < g.N) crow[c] = acc[i][j] + (bias ? bias[c] : 0.f); }
    }
}

__device__ __forceinline__ float block_sum_256(float v, float* red) {
#pragma unroll
    for (int o = 32; o > 0; o >>= 1) v += __shfl_xor(v, o);
    __syncthreads();
    if ((threadIdx.x & 63) == 0) red[threadIdx.x >> 6] = v;
    __syncthreads();
    return red[0] + red[1] + red[2] + red[3];
}
__global__ void __launch_bounds__(256) ln_res(float* X, const float* H, const float* gam, const float* bet, float* Xout) {
    __shared__ float red[4];
    const size_t row = blockIdx.x; const int c = threadIdx.x * 4;
    const float4 x = *(const float4*)(X + row * D + c), h = *(const float4*)(H + row * D + c);
    float v[4] = {ALPHA * x.x + h.x, ALPHA * x.y + h.y, ALPHA * x.z + h.z, ALPHA * x.w + h.w};
    const float mean = block_sum_256(v[0] + v[1] + v[2] + v[3], red) * (1.f / D);
    float q = 0.f;
#pragma unroll
    for (int i = 0; i < 4; ++i) { v[i] -= mean; q += v[i] * v[i]; }
    const float rstd = rsqrtf(block_sum_256(q, red) * (1.f / D) + LN_EPS);
    const float4 gg = *(const float4*)(gam + c), bb = *(const float4*)(bet + c);
    const float4 o = make_float4(v[0] * rstd * gg.x + bb.x, v[1] * rstd * gg.y + bb.y, v[2] * rstd * gg.z + bb.z, v[3] * rstd * gg.w + bb.w);
    *(float4*)(Xout + row * D + c) = o;
}

template <int MODE>
__global__ void __launch_bounds__(256) attn(const float* P, float* O, const float* tab  , const float* cum  , int ldp) {
    __shared__ float Ks[64][64];
    __shared__ float Vs[64][64];
    __shared__ float ck[64];
    __shared__ float tb[MODE == 0 ? 2048 : 1];
    const int tid = threadIdx.x, qb = gridDim.x - 1 - blockIdx.x, b = blockIdx.y >> 4, vh = blockIdx.y & 15;
    int qcol, kcol, vcol, ocol, h;
    if (MODE == 0) { h = vh >> 2; const int m = (vh >> 1) & 1, half = vh & 1; qcol = h * 128 + m * 64; kcol = 512 + h * 128 + m * 64; vcol = 1024 + h * 128 + half * 64; ocol = (h * 2 + m) * 128 + half * 64; }
    else { h = vh; qcol = h * 64; kcol = 1024 + h * 64; vcol = 2048 + h * 64; ocol = h * 64; }
    if (MODE == 0) { for (int i = tid; i < 2048; i += 256) tb[i] = tab[h * 2048 + i]; }
    const int i_row = qb * 256 + tid; const size_t tok = (size_t)b * T + i_row;
    float q[64], o[64];
#pragma unroll
    for (int d = 0; d < 64; d += 4) { const float4 v = *(const float4*)(P + tok * ldp + qcol + d); q[d] = v.x * 0.125f; q[d + 1] = v.y * 0.125f; q[d + 2] = v.z * 0.125f; q[d + 3] = v.w * 0.125f; }
#pragma unroll
    for (int d = 0; d < 64; ++d) o[d] = 0.f;
    float m_run = -INFINITY, l_run = 0.f;
    float cq = 0.f; const float* cumrow = nullptr;
    if (MODE == 1) { cumrow = cum + (size_t)(b * 16 + h) * T; cq = cumrow[i_row]; }
    const float far_bias = (MODE == 0) ? tab[h * 2048 + 2047] : 0.f;
    const int ntile = 4 * qb + 4;
    for (int kt = 0; kt < ntile; ++kt) {
        __syncthreads();
        {
            const int r = tid >> 2, c0 = (tid & 3) * 16; const size_t ktok = (size_t)b * T + kt * 64 + r;
#pragma unroll
            for (int c = 0; c < 16; c += 4) { *(float4*)&Ks[r][c0 + c] = *(const float4*)(P + ktok * ldp + kcol + c0 + c); *(float4*)&Vs[r][c0 + c] = *(const float4*)(P + ktok * ldp + vcol + c0 + c); }
            if (MODE == 1 && tid < 64) ck[tid] = cumrow[kt * 64 + tid];
        }
        __syncthreads();
        if (kt * 64 > i_row) continue;
#pragma unroll 1
        for (int jj = 0; jj < 64; ++jj) {
            const int j = kt * 64 + jj; const int dist = i_row - j;
            if (dist < 0) break;
            float dot = 0.f;
#pragma unroll
            for (int d = 0; d < 64; d += 4) { const float4 kv = *(const float4*)&Ks[jj][d]; dot = fmaf(q[d], kv.x, dot); dot = fmaf(q[d + 1], kv.y, dot); dot = fmaf(q[d + 2], kv.z, dot); dot = fmaf(q[d + 3], kv.w, dot); }
            float bias;
            if (MODE == 0) bias = dist < 2048 ? tb[dist] : far_bias;
            else bias = cq - ck[jj];
            const float sc = dot + bias;
            if (sc > m_run) { const float f = __expf(m_run - sc); l_run *= f;
#pragma unroll
                for (int d = 0; d < 64; ++d) o[d] *= f;
                m_run = sc; }
            const float p = __expf(sc - m_run); l_run += p;
#pragma unroll
            for (int d = 0; d < 64; d += 4) { const float4 vv = *(const float4*)&Vs[jj][d]; o[d] = fmaf(p, vv.x, o[d]); o[d + 1] = fmaf(p, vv.y, o[d + 1]); o[d + 2] = fmaf(p, vv.z, o[d + 2]); o[d + 3] = fmaf(p, vv.w, o[d + 3]); }
        }
    }
    const float inv = 1.f / l_run;
#pragma unroll
    for (int d = 0; d < 64; d += 4) *(float4*)(O + tok * D + ocol + d) = make_float4(o[d] * inv, o[d + 1] * inv, o[d + 2] * inv, o[d + 3] * inv);
}

__global__ void t5tab(const float* t5, float* tab) {
    const int i = blockIdx.x * blockDim.x + threadIdx.x; if (i >= 4 * 2048) return;
    const int h = i >> 11, n = i & 2047; int bk;
    if (n < 16) bk = n; else { bk = 16 + (int)(log((double)n / 16.0) / log(128.0) * 16.0); if (bk > 31) bk = 31; }
    tab[i] = t5[bk * 4 + h];
}

__global__ void conv_silu(const float* P  , const float* w  , float* CQ  ) {
    const size_t i = (size_t)blockIdx.x * blockDim.x + threadIdx.x; if (i >= (size_t)NTOK * 1536) return;
    const int c = (int)(i % 1536); const size_t tok = i / 1536; const int t = (int)(tok % T);
    float y = 0.f;
#pragma unroll
    for (int j = 0; j < 4; ++j) { const int tt = t - 3 + j; if (tt >= 0) y = fmaf(w[j * 1536 + c], P[(tok - 3 + j) * EVEN_IN + 1536 + c], y); }
    CQ[i] = y * sigmoidf_(y);
}
__global__ void gdn_norm(const float* P, float* CQ, const float* a_log, const float* dt_bias, float* BETA, float* G) {
    const int i = blockIdx.x * blockDim.x + threadIdx.x; if (i >= NTOK * 8) return;
    const int which = i & 1, h = (i >> 1) & 3; const size_t tok = i >> 3;
    float* p = CQ + tok * 1536 + which * 512 + h * 128; float ss = 0.f;
    for (int d = 0; d < 128; ++d) ss = fmaf(p[d], p[d], ss);
    const float r = rsqrtf(ss + RMS_EPS);
    for (int d = 0; d < 128; ++d) p[d] *= r;
    if (which == 0) {
        BETA[tok * 4 + h] = sigmoidf_(P[tok * EVEN_IN + 3584 + h]);
        G[tok * 4 + h] = -expf(a_log[h]) * softplusf_(P[tok * EVEN_IN + 3588 + h] + dt_bias[h]);
    }
}
__global__ void __launch_bounds__(128) gdn_rec(const float* CQ, const float* BETA, const float* G, float* GO  ) {
    __shared__ float ks[2][128], qs[2][128];
    const int b = blockIdx.x >> 2, h = blockIdx.x & 3, c = threadIdx.x;
    float S[128];
#pragma unroll
    for (int d = 0; d < 128; ++d) S[d] = 0.f;
    const float scale = 0.08838834764831845f;
    for (int t = 0; t < T; ++t) {
        const size_t tok = (size_t)b * T + t; const int bf = t & 1;
        ks[bf][c] = CQ[tok * 1536 + 512 + h * 128 + c]; qs[bf][c] = CQ[tok * 1536 + h * 128 + c];
        const float v = CQ[tok * 1536 + 1024 + h * 128 + c], beta = BETA[tok * 4 + h], alpha = __expf(G[tok * 4 + h]);
        __syncthreads();
        float ksum = 0.f;
#pragma unroll
        for (int d = 0; d < 128; d += 4) { const float4 k4 = *(const float4*)&ks[bf][d]; ksum = fmaf(k4.x, S[d], ksum); ksum = fmaf(k4.y, S[d + 1], ksum); ksum = fmaf(k4.z, S[d + 2], ksum); ksum = fmaf(k4.w, S[d + 3], ksum); }
        const float vnew = beta * (v - alpha * ksum);
        float o = 0.f;
#pragma unroll
        for (int d = 0; d < 128; d += 4) { const float4 k4 = *(const float4*)&ks[bf][d]; const float4 q4 = *(const float4*)&qs[bf][d];
            S[d] = fmaf(alpha, S[d], k4.x * vnew); S[d + 1] = fmaf(alpha, S[d + 1], k4.y * vnew); S[d + 2] = fmaf(alpha, S[d + 2], k4.z * vnew); S[d + 3] = fmaf(alpha, S[d + 3], k4.w * vnew);
            o = fmaf(q4.x, S[d], o); o = fmaf(q4.y, S[d + 1], o); o = fmaf(q4.z, S[d + 2], o); o = fmaf(q4.w, S[d + 3], o); }
        GO[tok * 512 + h * 128 + c] = o * scale;
    }
}
__global__ void __launch_bounds__(128) even_combine(const float* ATT  , const float* GO, const float* P, const float* lamp  ,
                                                    const float* subln_w, const float* gdn_w, float* MIX, float lam_init) {
    __shared__ float red[2]; __shared__ float lam_s;
    const size_t tok = blockIdx.x; const int d = threadIdx.x;
    if (d < 64) {
        float a = lamp[d] * lamp[64 + d], bb = lamp[128 + d] * lamp[192 + d];
#pragma unroll
        for (int o = 32; o > 0; o >>= 1) { a += __shfl_xor(a, o); bb += __shfl_xor(bb, o); }
        if (d == 0) lam_s = expf(a) - expf(bb) + lam_init;
    }
    __syncthreads();
    const float lam = lam_s;
    for (int grp = 0; grp < 8; ++grp) {
        float v;
        if (grp < 4) v = ATT[tok * D + (grp * 2) * 128 + d] - lam * ATT[tok * D + (grp * 2 + 1) * 128 + d];
        else v = GO[tok * 512 + (grp - 4) * 128 + d];
        float ss = v * v;
#pragma unroll
        for (int o = 32; o > 0; o >>= 1) ss += __shfl_xor(ss, o);
        __syncthreads();
        if ((d & 63) == 0) red[d >> 6] = ss;
        __syncthreads();
        const float r = rsqrtf((red[0] + red[1]) * (1.f / 128.f) + RMS_EPS);
        float outv;
        if (grp < 4) outv = v * r * subln_w[d] * (1.f - lam_init);
        else { const float z = P[tok * EVEN_IN + 3072 + (grp - 4) * 128 + d]; outv = v * r * gdn_w[d] * (z * sigmoidf_(z)); }
        MIX[tok * D + grp * 128 + d] = outv;
    }
}

__global__ void qknorm(float* P  , const float* w  ) {
    const int i = blockIdx.x * blockDim.x + threadIdx.x; if (i >= NTOK * 32) return;
    const int which = i & 1, h = (i >> 1) & 15; const size_t tok = i >> 5;
    float* p = P + tok * ODD_IN + which * 1024 + h * 64; float ss = 0.f;
    for (int d = 0; d < 64; ++d) ss = fmaf(p[d], p[d], ss);
    const float r = rsqrtf(ss * (1.f / 64.f) + RMS_EPS);
    for (int d = 0; d < 64; ++d) p[d] = p[d] * r * w[which * 64 + d];
}
__global__ void logf_k(const float* P, const float* fb, float* LF  ) {
    const int i = blockIdx.x * blockDim.x + threadIdx.x; if (i >= NTOK * 16) return;
    const int h = i & 15; const size_t tok = i >> 4; const int b = (int)(tok / T), t = (int)(tok % T);
    const float x = P[tok * ODD_IN + 4096 + h] + fb[h];
    LF[(size_t)(b * 16 + h) * T + t] = -softplusf_(-x);
}
__global__ void __launch_bounds__(1024) cumsum16k(float* LF) {
    __shared__ float part[1024];
    float* p = LF + (size_t)blockIdx.x * T + threadIdx.x * 16; float v[16]; float s = 0.f;
#pragma unroll
    for (int i = 0; i < 16; ++i) { s += p[i]; v[i] = s; }
    part[threadIdx.x] = s; __syncthreads();
    for (int o = 1; o < 1024; o <<= 1) { float a = threadIdx.x >= o ? part[threadIdx.x - o] : 0.f; __syncthreads(); part[threadIdx.x] += a; __syncthreads(); }
    const float base = threadIdx.x ? part[threadIdx.x - 1] : 0.f;
#pragma unroll
    for (int i = 0; i < 16; ++i) p[i] = v[i] + base;
}
__global__ void gate_k(const float* ATT, const float* P, float* MIX) {
    const size_t i = (size_t)blockIdx.x * blockDim.x + threadIdx.x; if (i >= (size_t)NTOK * D) return;
    const size_t tok = i >> 10; const int c = (int)(i & 1023);
    MIX[i] = ATT[i] * sigmoidf_(P[tok * ODD_IN + 3072 + c]);
}

__global__ void __launch_bounds__(256) router(const float* X, const float* rw  , const float* rb, int* cnt, int* list, int* sel_e, int* sel_slot, float* gate) {
    __shared__ float lg[8][32];
    const int tk = threadIdx.x >> 5, e = threadIdx.x & 31; const size_t tok = (size_t)blockIdx.x * 8 + tk;
    const float* x = X + tok * D; float acc = 0.f;
    for (int k = 0; k < D; ++k) acc = fmaf(x[k], rw[k * 32 + e], acc);
    lg[tk][e] = acc + rb[e];
    __syncthreads();
    if (e == 0) {
        float v[4]; int id[4]; unsigned used = 0u;
#pragma unroll
        for (int k = 0; k < 4; ++k) { float best = -INFINITY; int bi = 0; for (int j = 0; j < 32; ++j) { const float z = lg[tk][j]; if (!((used >> j) & 1u) && z > best) { best = z; bi = j; } } used |= 1u << bi; v[k] = best; id[k] = bi; }
        float s = 0.f, p[4];
#pragma unroll
        for (int k = 0; k < 4; ++k) { p[k] = __expf(v[k] - v[0]); s += p[k]; }
#pragma unroll
        for (int k = 0; k < 4; ++k) {
            const int slot = atomicAdd(&cnt[id[k]], 1);
            list[(size_t)id[k] * NTOK + slot] = (int)(tok * 4 + k);
            sel_e[tok * 4 + k] = id[k]; sel_slot[tok * 4 + k] = slot; gate[tok * 4 + k] = p[k] / s;
        }
    }
}
__global__ void offsets(const int* cnt, int* off) { if (threadIdx.x == 0) { int s = 0; for (int e = 0; e < NE; ++e) { off[e] = s; s += cnt[e]; } } }
__global__ void __launch_bounds__(256) combine_ln(float* X, const float* Y, const int* off, const int* sel_e, const int* sel_slot, const float* gate, const float* gam, const float* bet, float* Xout) {
    __shared__ float red[4];
    const size_t row = blockIdx.x; const int c = threadIdx.x * 4;
    const float4 x = *(const float4*)(X + row * D + c);
    float v[4] = {ALPHA * x.x, ALPHA * x.y, ALPHA * x.z, ALPHA * x.w};
#pragma unroll
    for (int k = 0; k < 4; ++k) { const size_t pos = (size_t)off[sel_e[row * 4 + k]] + sel_slot[row * 4 + k]; const float gt = gate[row * 4 + k]; const float4 y = *(const float4*)(Y + pos * D + c);
        v[0] = fmaf(gt, y.x, v[0]); v[1] = fmaf(gt, y.y, v[1]); v[2] = fmaf(gt, y.z, v[2]); v[3] = fmaf(gt, y.w, v[3]); }
    const float mean = block_sum_256(v[0] + v[1] + v[2] + v[3], red) * (1.f / D);
    float q = 0.f;
#pragma unroll
    for (int i = 0; i < 4; ++i) { v[i] -= mean; q += v[i] * v[i]; }
    const float rstd = rsqrtf(block_sum_256(q, red) * (1.f / D) + LN_EPS);
    const float4 gg = *(const float4*)(gam + c), bb = *(const float4*)(bet + c);
    *(float4*)(Xout + row * D + c) = make_float4(v[0] * rstd * gg.x + bb.x, v[1] * rstd * gg.y + bb.y, v[2] * rstd * gg.z + bb.z, v[3] * rstd * gg.w + bb.w);
}

constexpr size_t MiB = 1u << 20;
constexpr size_t O_X = 0;
constexpr size_t O_H = 128 * MiB;
constexpr size_t O_MIX = 256 * MiB;
constexpr size_t O_ATT = 384 * MiB;
constexpr size_t O_PROJ = 512 * MiB;
constexpr size_t O_CQ = 1032 * MiB;
constexpr size_t O_GO = 1224 * MiB;
constexpr size_t O_HB = 512 * MiB;
constexpr size_t O_Y = 1536 * MiB;
constexpr size_t O_SMALL = 2048 * MiB;
constexpr size_t O_END = 2064 * MiB;
constexpr size_t S_TAB = 0, S_BETA = 64 * 1024, S_G = S_BETA + 512 * 1024, S_CUM = S_G + 512 * 1024  , S_CNT = S_CUM + 2 * MiB, S_OFF = S_CNT + 256,
                 S_SELE = S_CNT + 4096, S_SLOT = S_SELE + 512 * 1024, S_GATE = S_SLOT + 512 * 1024, S_LIST = S_GATE + 512 * 1024  ;
static_assert(S_LIST + 4 * MiB <= 16 * MiB, "small region");

struct In { const float* p[24]; };
static_assert(sizeof(GemmArgs) == 80, "GemmArgs has padding");

static void forward(const In& in, unsigned char* ws, float* out, float* const* chk  , hipStream_t st) {
    float* X = (float*)(ws + O_X); float* H = (float*)(ws + O_H); float* MIX = (float*)(ws + O_MIX); float* ATT = (float*)(ws + O_ATT);
    float* PROJ = (float*)(ws + O_PROJ); float* CQ = (float*)(ws + O_CQ); float* GO = (float*)(ws + O_GO); float* HB = (float*)(ws + O_HB); float* Y = (float*)(ws + O_Y);
    unsigned char* sm = ws + O_SMALL;
    float* TAB = (float*)(sm + S_TAB); float* BETA = (float*)(sm + S_BETA); float* G = (float*)(sm + S_G); float* CUM = (float*)(sm + S_CUM);
    int* CNT = (int*)(sm + S_CNT); int* OFF = (int*)(sm + S_OFF); int* SELE = (int*)(sm + S_SELE); int* SLOT = (int*)(sm + S_SLOT); float* GATE = (float*)(sm + S_GATE); int* LIST = (int*)(sm + S_LIST);
    (void)hipMemcpyAsync(X, in.p[0], (size_t)NTOK * D * 4, hipMemcpyDeviceToDevice, st);
    t5tab<<<32, 256, 0, st>>>(in.p[1], TAB);
    for (int layer = 0; layer < 4; ++layer) {
        const int i = layer >> 1;
        if ((layer & 1) == 0) {
            GemmArgs g{X, in.p[2] + (size_t)i * D * EVEN_IN, nullptr, PROJ, nullptr, nullptr, nullptr, D, EVEN_IN, EVEN_IN, NTOK, EVEN_IN, D};
            gemm<0><<<dim3((EVEN_IN + 127) / 128, NTOK / 128), 256, 0, st>>>(g);
            conv_silu<<<(unsigned)(((size_t)NTOK * 1536 + 255) / 256), 256, 0, st>>>(PROJ, in.p[6] + (size_t)i * 4 * 1536, CQ);
            gdn_norm<<<NTOK * 8 / 256, 256, 0, st>>>(PROJ, CQ, in.p[7] + i * 4, in.p[8] + i * 4, BETA, G);
            gdn_rec<<<8, 128, 0, st>>>(CQ, BETA, G, GO);
            attn<0><<<dim3(T / 256, B * 16), 256, 0, st>>>(PROJ, ATT, TAB, nullptr, EVEN_IN);
            const float lam_init = 0.8f - 0.6f * expf(-0.3f * (float)layer);
            even_combine<<<NTOK, 128, 0, st>>>(ATT, GO, PROJ, in.p[4] + i * 256, in.p[5] + i * 128, in.p[9] + i * 128, MIX, lam_init);
            GemmArgs g2{MIX, in.p[3] + (size_t)i * D * D, nullptr, H, nullptr, nullptr, nullptr, D, D, D, NTOK, D, D};
            gemm<0><<<dim3(D / 128, NTOK / 128), 256, 0, st>>>(g2);
        } else {
            GemmArgs g{X, in.p[10] + (size_t)i * D * ODD_IN, nullptr, PROJ, nullptr, nullptr, nullptr, D, ODD_IN, ODD_IN, NTOK, ODD_IN, D};
            gemm<0><<<dim3((ODD_IN + 127) / 128, NTOK / 128), 256, 0, st>>>(g);
            qknorm<<<NTOK * 32 / 256, 256, 0, st>>>(PROJ, in.p[12] + i * 128);
            logf_k<<<NTOK * 16 / 256, 256, 0, st>>>(PROJ, in.p[13] + i * 16, CUM);
            cumsum16k<<<B * 16, 1024, 0, st>>>(CUM);
            attn<1><<<dim3(T / 256, B * 16), 256, 0, st>>>(PROJ, ATT, nullptr, CUM, ODD_IN);
            gate_k<<<(unsigned)((size_t)NTOK * D / 256), 256, 0, st>>>(ATT, PROJ, MIX);
            GemmArgs g2{MIX, in.p[11] + (size_t)i * D * D, nullptr, H, nullptr, nullptr, nullptr, D, D, D, NTOK, D, D};
            gemm<0><<<dim3(D / 128, NTOK / 128), 256, 0, st>>>(g2);
        }
        ln_res<<<NTOK, 256, 0, st>>>(X, H, in.p[20] + layer * D, in.p[21] + layer * D, X);
        if (chk) (void)hipMemcpyAsync(chk[2 * layer], X, (size_t)NTOK * D * 4, hipMemcpyDeviceToDevice, st);
        (void)hipMemsetAsync(CNT, 0, 128, st);
        router<<<NTOK / 8, 256, 0, st>>>(X, in.p[14] + (size_t)layer * D * NE, in.p[15] + layer * NE, CNT, LIST, SELE, SLOT, GATE);
        offsets<<<1, 64, 0, st>>>(CNT, OFF);
        GemmArgs m1{X, in.p[16] + (size_t)layer * NE * D * 2048, in.p[17] + (size_t)layer * NE * 2048, HB, CNT, OFF, LIST, D, 2048, 2048, 0, 2048, D};
        gemm<1><<<dim3(2048 / 128, NTOK / 128, NE), 256, 0, st>>>(m1);
        GemmArgs m2{HB, in.p[18] + (size_t)layer * NE * DFF * D, in.p[19] + (size_t)layer * NE * D, Y, CNT, OFF, LIST, 2048, D, D, 0, D, DFF};
        gemm<2><<<dim3(D / 128, NTOK / 128, NE), 256, 0, st>>>(m2);
        float* dst = (layer == 3) ? out : X;
        combine_ln<<<NTOK, 256, 0, st>>>(X, Y, OFF, SELE, SLOT, GATE, in.p[22] + layer * D, in.p[23] + layer * D, dst);
        if (chk) (void)hipMemcpyAsync(chk[2 * layer + 1], dst, (size_t)NTOK * D * 4, hipMemcpyDeviceToDevice, st);
    }
}
}

extern "C" void kernel_launch(void* const* d_in, const int* in_sizes, int n_in, void* d_out, int out_size, void* d_ws, size_t ws_size, hipStream_t stream) {
    if (n_in != 24 || ws_size < nv::O_END) { fprintf(stderr, "kernel_launch: unexpected n_in %d / ws %zu\n", n_in, ws_size); return; }
    nv::In in; for (int i = 0; i < 24; ++i) in.p[i] = (const float*)d_in[i];
    nv::forward(in, (unsigned char*)d_ws, (float*)d_out, nullptr, stream);
}
```

```cpp
#ifndef MK_DEBUG
#define MK_DEBUG 0
#endif
#include <hip/hip_runtime.h>
#include <cstdint>
#include <cstdio>

namespace cfg {
constexpr int B = 2, T = 16384, D = 1024, NTOK = B * T;
constexpr int EVEN_IN = 3592, ODD_IN = 4112;
constexpr int NE = 32, TOPK = 4, DFF = 1024;
constexpr float ALPHA = 1.681792830507429f;
constexpr float LN_EPS = 1e-5f, RMS_EPS = 1e-6f;
}
using namespace cfg;

#if MK_DEBUG
namespace nv {

__device__ __forceinline__ float sigmoidf_(float x) { return 1.f / (1.f + __expf(-x)); }
__device__ __forceinline__ float softplusf_(float x) { return x > 20.f ? x : log1pf(expf(x)); }

struct GemmArgs {
    const float* A; const float* Bm; const float* bias; float* C; const int* cnt; const int* off; const int* list;
    int lda, ldb, ldc, M, N, K;
};
template <int MODE>
__global__ void __launch_bounds__(256) gemm(GemmArgs g) {
    __shared__ float As[16][128 + 4];
    __shared__ float Bs[16][128 + 4];
    const int tid = threadIdx.x, tx = tid & 15, ty = tid >> 4;
    const int m0 = blockIdx.y * 128, n0 = blockIdx.x * 128;
    int M = g.M; const float* Bm = g.Bm; const float* bias = g.bias; int rowbase = 0; const int* lst = nullptr;
    if (MODE != 0) {
        const int e = blockIdx.z; M = g.cnt[e]; if (m0 >= M) return;
        rowbase = g.off[e]; lst = g.list + (size_t)e * NTOK;
        Bm += (size_t)e * g.K * g.ldb; if (bias) bias += (size_t)e * g.N;
    }
    const float* arow[2]; bool aval[2];
#pragma unroll
    for (int i = 0; i < 2; ++i) {
        const int r = m0 + (tid >> 2) + 64 * i; aval[i] = r < M;
        if (MODE == 0) arow[i] = g.A + (size_t)r * g.lda;
        else if (MODE == 1) { const int tok = aval[i] ? (lst[r] >> 2) : 0; arow[i] = g.A + (size_t)tok * g.lda; }
        else arow[i] = g.A + (size_t)(rowbase + r) * g.lda;
    }
    float acc[8][8];
#pragma unroll
    for (int i = 0; i < 8; ++i)
#pragma unroll
        for (int j = 0; j < 8; ++j) acc[i][j] = 0.f;
    for (int k0 = 0; k0 < g.K; k0 += 16) {
#pragma unroll
        for (int i = 0; i < 2; ++i) {
            const int r = (tid >> 2) + 64 * i, c = (tid & 3) * 4;
            float4 v = make_float4(0.f, 0.f, 0.f, 0.f);
            if (aval[i]) {
                v = *(const float4*)(arow[i] + k0 + c);
                if (MODE == 2) {
                    const float4 u = *(const float4*)(arow[i] + 1024 + k0 + c);
                    float gg[4] = {v.x, v.y, v.z, v.w}, uu[4] = {u.x, u.y, u.z, u.w}, o[4];
#pragma unroll
                    for (int q = 0; q < 4; ++q) { const float a = fminf(gg[q], 7.f), b = fminf(fmaxf(uu[q], -7.f), 7.f); o[q] = a * sigmoidf_(1.702f * a) * (b + 1.f); }
                    v = make_float4(o[0], o[1], o[2], o[3]);
                }
            }
            As[c][r] = v.x; As[c + 1][r] = v.y; As[c + 2][r] = v.z; As[c + 3][r] = v.w;
        }
#pragma unroll
        for (int i = 0; i < 2; ++i) {
            const int r = (tid >> 5) + 8 * i, c = (tid & 31) * 4;
            const float* bp = Bm + (size_t)(k0 + r) * g.ldb + n0 + c;
            float4 v;
            if (n0 + c + 3 < g.N) v = *(const float4*)bp;
            else { v.x = (n0 + c < g.N) ? bp[0] : 0.f; v.y = (n0 + c + 1 < g.N) ? bp[1] : 0.f; v.z = (n0 + c + 2 < g.N) ? bp[2] : 0.f; v.w = 0.f; }
            *(float4*)&Bs[r][c] = v;
        }
        __syncthreads();
#pragma unroll
        for (int kk = 0; kk < 16; ++kk) {
            const float4 a0 = *(const float4*)&As[kk][ty * 8], a1 = *(const float4*)&As[kk][ty * 8 + 4];
            const float4 b0 = *(const float4*)&Bs[kk][tx * 8], b1 = *(const float4*)&Bs[kk][tx * 8 + 4];
            const float a[8] = {a0.x, a0.y, a0.z, a0.w, a1.x, a1.y, a1.z, a1.w};
            const float b[8] = {b0.x, b0.y, b0.z, b0.w, b1.x, b1.y, b1.z, b1.w};
#pragma unroll
            for (int i = 0; i < 8; ++i)
#pragma unroll
                for (int j = 0; j < 8; ++j) acc[i][j] = fmaf(a[i], b[j], acc[i][j]);
        }
        __syncthreads();
    }
#pragma unroll
    for (int i = 0; i < 8; ++i) {
        const int r = m0 + ty * 8 + i; if (r >= M) continue;
        float* crow = g.C + (size_t)(rowbase + r) * g.ldc;
#pragma unroll
        for (int j = 0; j < 8; ++j) { const int c = n0 + tx * 8 + j; if (c < g.N) crow[c] = acc[i][j] + (bias ? bias[c] : 0.f); }
    }
}

__device__ __forceinline__ float block_sum_256(float v, float* red) {
#pragma unroll
    for (int o = 32; o > 0; o >>= 1) v += __shfl_xor(v, o);
    __syncthreads();
    if ((threadIdx.x & 63) == 0) red[threadIdx.x >> 6] = v;
    __syncthreads();
    return red[0] + red[1] + red[2] + red[3];
}
__global__ void __launch_bounds__(256) ln_res(float* X, const float* H, const float* gam, const float* bet, float* Xout) {
    __shared__ float red[4];
    const size_t row = blockIdx.x; const int c = threadIdx.x * 4;
    const float4 x = *(const float4*)(X + row * D + c), h = *(const float4*)(H + row * D + c);
    float v[4] = {ALPHA * x.x + h.x, ALPHA * x.y + h.y, ALPHA * x.z + h.z, ALPHA * x.w + h.w};
    const float mean = block_sum_256(v[0] + v[1] + v[2] + v[3], red) * (1.f / D);
    float q = 0.f;
#pragma unroll
    for (int i = 0; i < 4; ++i) { v[i] -= mean; q += v[i] * v[i]; }
    const float rstd = rsqrtf(block_sum_256(q, red) * (1.f / D) + LN_EPS);
    const float4 gg = *(const float4*)(gam + c), bb = *(const float4*)(bet + c);
    const float4 o = make_float4(v[0] * rstd * gg.x + bb.x, v[1] * rstd * gg.y + bb.y, v[2] * rstd * gg.z + bb.z, v[3] * rstd * gg.w + bb.w);
    *(float4*)(Xout + row * D + c) = o;
}

template <int MODE>
__global__ void __launch_bounds__(256) attn(const float* P, float* O, const float* tab  , const float* cum  , int ldp) {
    __shared__ float Ks[64][64];
    __shared__ float Vs[64][64];
    __shared__ float ck[64];
    __shared__ float tb[MODE == 0 ? 2048 : 1];
    const int tid = threadIdx.x, qb = gridDim.x - 1 - blockIdx.x, b = blockIdx.y >> 4, vh = blockIdx.y & 15;
    int qcol, kcol, vcol, ocol, h;
    if (MODE == 0) { h = vh >> 2; const int m = (vh >> 1) & 1, half = vh & 1; qcol = h * 128 + m * 64; kcol = 512 + h * 128 + m * 64; vcol = 1024 + h * 128 + half * 64; ocol = (h * 2 + m) * 128 + half * 64; }
    else { h = vh; qcol = h * 64; kcol = 1024 + h * 64; vcol = 2048 + h * 64; ocol = h * 64; }
    if (MODE == 0) { for (int i = tid; i < 2048; i += 256) tb[i] = tab[h * 2048 + i]; }
    const int i_row = qb * 256 + tid; const size_t tok = (size_t)b * T + i_row;
    float q[64], o[64];
#pragma unroll
    for (int d = 0; d < 64; d += 4) { const float4 v = *(const float4*)(P + tok * ldp + qcol + d); q[d] = v.x * 0.125f; q[d + 1] = v.y * 0.125f; q[d + 2] = v.z * 0.125f; q[d + 3] = v.w * 0.125f; }
#pragma unroll
    for (int d = 0; d < 64; ++d) o[d] = 0.f;
    float m_run = -INFINITY, l_run = 0.f;
    float cq = 0.f; const float* cumrow = nullptr;
    if (MODE == 1) { cumrow = cum + (size_t)(b * 16 + h) * T; cq = cumrow[i_row]; }
    const float far_bias = (MODE == 0) ? tab[h * 2048 + 2047] : 0.f;
    const int ntile = 4 * qb + 4;
    for (int kt = 0; kt < ntile; ++kt) {
        __syncthreads();
        {
            const int r = tid >> 2, c0 = (tid & 3) * 16; const size_t ktok = (size_t)b * T + kt * 64 + r;
#pragma unroll
            for (int c = 0; c < 16; c += 4) { *(float4*)&Ks[r][c0 + c] = *(const float4*)(P + ktok * ldp + kcol + c0 + c); *(float4*)&Vs[r][c0 + c] = *(const float4*)(P + ktok * ldp + vcol + c0 + c); }
            if (MODE == 1 && tid < 64) ck[tid] = cumrow[kt * 64 + tid];
        }
        __syncthreads();
        if (kt * 64 > i_row) continue;
#pragma unroll 1
        for (int jj = 0; jj < 64; ++jj) {
            const int j = kt * 64 + jj; const int dist = i_row - j;
            if (dist < 0) break;
            float dot = 0.f;
#pragma unroll
            for (int d = 0; d < 64; d += 4) { const float4 kv = *(const float4*)&Ks[jj][d]; dot = fmaf(q[d], kv.x, dot); dot = fmaf(q[d + 1], kv.y, dot); dot = fmaf(q[d + 2], kv.z, dot); dot = fmaf(q[d + 3], kv.w, dot); }
            float bias;
            if (MODE == 0) bias = dist < 2048 ? tb[dist] : far_bias;
            else bias = cq - ck[jj];
            const float sc = dot + bias;
            if (sc > m_run) { const float f = __expf(m_run - sc); l_run *= f;
#pragma unroll
                for (int d = 0; d < 64; ++d) o[d] *= f;
                m_run = sc; }
            const float p = __expf(sc - m_run); l_run += p;
#pragma unroll
            for (int d = 0; d < 64; d += 4) { const float4 vv = *(const float4*)&Vs[jj][d]; o[d] = fmaf(p, vv.x, o[d]); o[d + 1] = fmaf(p, vv.y, o[d + 1]); o[d + 2] = fmaf(p, vv.z, o[d + 2]); o[d + 3] = fmaf(p, vv.w, o[d + 3]); }
        }
    }
    const float inv = 1.f / l_run;
#pragma unroll
    for (int d = 0; d < 64; d += 4) *(float4*)(O + tok * D + ocol + d) = make_float4(o[d] * inv, o[d + 1] * inv, o[d + 2] * inv, o[d + 3] * inv);
}

__global__ void t5tab(const float* t5, float* tab) {
    const int i = blockIdx.x * blockDim.x + threadIdx.x; if (i >= 4 * 2048) return;
    const int h = i >> 11, n = i & 2047; int bk;
    if (n < 16) bk = n; else { bk = 16 + (int)(log((double)n / 16.0) / log(128.0) * 16.0); if (bk > 31) bk = 31; }
    tab[i] = t5[bk * 4 + h];
}

__global__ void conv_silu(const float* P  , const float* w  , float* CQ  ) {
    const size_t i = (size_t)blockIdx.x * blockDim.x + threadIdx.x; if (i >= (size_t)NTOK * 1536) return;
    const int c = (int)(i % 1536); const size_t tok = i / 1536; const int t = (int)(tok % T);
    float y = 0.f;
#pragma unroll
    for (int j = 0; j < 4; ++j) { const int tt = t - 3 + j; if (tt >= 0) y = fmaf(w[j * 1536 + c], P[(tok - 3 + j) * EVEN_IN + 1536 + c], y); }
    CQ[i] = y * sigmoidf_(y);
}
__global__ void gdn_norm(const float* P, float* CQ, const float* a_log, const float* dt_bias, float* BETA, float* G) {
    const int i = blockIdx.x * blockDim.x + threadIdx.x; if (i >= NTOK * 8) return;
    const int which = i & 1, h = (i >> 1) & 3; const size_t tok = i >> 3;
    float* p = CQ + tok * 1536 + which * 512 + h * 128; float ss = 0.f;
    for (int d = 0; d < 128; ++d) ss = fmaf(p[d], p[d], ss);
    const float r = rsqrtf(ss + RMS_EPS);
    for (int d = 0; d < 128; ++d) p[d] *= r;
    if (which == 0) {
        BETA[tok * 4 + h] = sigmoidf_(P[tok * EVEN_IN + 3584 + h]);
        G[tok * 4 + h] = -expf(a_log[h]) * softplusf_(P[tok * EVEN_IN + 3588 + h] + dt_bias[h]);
    }
}
__global__ void __launch_bounds__(128) gdn_rec(const float* CQ, const float* BETA, const float* G, float* GO  ) {
    __shared__ float ks[2][128], qs[2][128];
    const int b = blockIdx.x >> 2, h = blockIdx.x & 3, c = threadIdx.x;
    float S[128];
#pragma unroll
    for (int d = 0; d < 128; ++d) S[d] = 0.f;
    const float scale = 0.08838834764831845f;
    for (int t = 0; t < T; ++t) {
        const size_t tok = (size_t)b * T + t; const int bf = t & 1;
        ks[bf][c] = CQ[tok * 1536 + 512 + h * 128 + c]; qs[bf][c] = CQ[tok * 1536 + h * 128 + c];
        const float v = CQ[tok * 1536 + 1024 + h * 128 + c], beta = BETA[tok * 4 + h], alpha = __expf(G[tok * 4 + h]);
        __syncthreads();
        float ksum = 0.f;
#pragma unroll
        for (int d = 0; d < 128; d += 4) { const float4 k4 = *(const float4*)&ks[bf][d]; ksum = fmaf(k4.x, S[d], ksum); ksum = fmaf(k4.y, S[d + 1], ksum); ksum = fmaf(k4.z, S[d + 2], ksum); ksum = fmaf(k4.w, S[d + 3], ksum); }
        const float vnew = beta * (v - alpha * ksum);
        float o = 0.f;
#pragma unroll
        for (int d = 0; d < 128; d += 4) { const float4 k4 = *(const float4*)&ks[bf][d]; const float4 q4 = *(const float4*)&qs[bf][d];
            S[d] = fmaf(alpha, S[d], k4.x * vnew); S[d + 1] = fmaf(alpha, S[d + 1], k4.y * vnew); S[d + 2] = fmaf(alpha, S[d + 2], k4.z * vnew); S[d + 3] = fmaf(alpha, S[d + 3], k4.w * vnew);
            o = fmaf(q4.x, S[d], o); o = fmaf(q4.y, S[d + 1], o); o = fmaf(q4.z, S[d + 2], o); o = fmaf(q4.w, S[d + 3], o); }
        GO[tok * 512 + h * 128 + c] = o * scale;
    }
}
__global__ void __launch_bounds__(128) even_combine(const float* ATT  , const float* GO, const float* P, const float* lamp  ,
                                                    const float* subln_w, const float* gdn_w, float* MIX, float lam_init) {
    __shared__ float red[2]; __shared__ float lam_s;
    const size_t tok = blockIdx.x; const int d = threadIdx.x;
    if (d < 64) {
        float a = lamp[d] * lamp[64 + d], bb = lamp[128 + d] * lamp[192 + d];
#pragma unroll
        for (int o = 32; o > 0; o >>= 1) { a += __shfl_xor(a, o); bb += __shfl_xor(bb, o); }
        if (d == 0) lam_s = expf(a) - expf(bb) + lam_init;
    }
    __syncthreads();
    const float lam = lam_s;
    for (int grp = 0; grp < 8; ++grp) {
        float v;
        if (grp < 4) v = ATT[tok * D + (grp * 2) * 128 + d] - lam * ATT[tok * D + (grp * 2 + 1) * 128 + d];
        else v = GO[tok * 512 + (grp - 4) * 128 + d];
        float ss = v * v;
#pragma unroll
        for (int o = 32; o > 0; o >>= 1) ss += __shfl_xor(ss, o);
        __syncthreads();
        if ((d & 63) == 0) red[d >> 6] = ss;
        __syncthreads();
        const float r = rsqrtf((red[0] + red[1]) * (1.f / 128.f) + RMS_EPS);
        float outv;
        if (grp < 4) outv = v * r * subln_w[d] * (1.f - lam_init);
        else { const float z = P[tok * EVEN_IN + 3072 + (grp - 4) * 128 + d]; outv = v * r * gdn_w[d] * (z * sigmoidf_(z)); }
        MIX[tok * D + grp * 128 + d] = outv;
    }
}

__global__ void qknorm(float* P  , const float* w  ) {
    const int i = blockIdx.x * blockDim.x + threadIdx.x; if (i >= NTOK * 32) return;
    const int which = i & 1, h = (i >> 1) & 15; const size_t tok = i >> 5;
    float* p = P + tok * ODD_IN + which * 1024 + h * 64; float ss = 0.f;
    for (int d = 0; d < 64; ++d) ss = fmaf(p[d], p[d], ss);
    const float r = rsqrtf(ss * (1.f / 64.f) + RMS_EPS);
    for (int d = 0; d < 64; ++d) p[d] = p[d] * r * w[which * 64 + d];
}
__global__ void logf_k(const float* P, const float* fb, float* LF  ) {
    const int i = blockIdx.x * blockDim.x + threadIdx.x; if (i >= NTOK * 16) return;
    const int h = i & 15; const size_t tok = i >> 4; const int b = (int)(tok / T), t = (int)(tok % T);
    const float x = P[tok * ODD_IN + 4096 + h] + fb[h];
    LF[(size_t)(b * 16 + h) * T + t] = -softplusf_(-x);
}
__global__ void __launch_bounds__(1024) cumsum16k(float* LF) {
    __shared__ float part[1024];
    float* p = LF + (size_t)blockIdx.x * T + threadIdx.x * 16; float v[16]; float s = 0.f;
#pragma unroll
    for (int i = 0; i < 16; ++i) { s += p[i]; v[i] = s; }
    part[threadIdx.x] = s; __syncthreads();
    for (int o = 1; o < 1024; o <<= 1) { float a = threadIdx.x >= o ? part[threadIdx.x - o] : 0.f; __syncthreads(); part[threadIdx.x] += a; __syncthreads(); }
    const float base = threadIdx.x ? part[threadIdx.x - 1] : 0.f;
#pragma unroll
    for (int i = 0; i < 16; ++i) p[i] = v[i] + base;
}
__global__ void gate_k(const float* ATT, const float* P, float* MIX) {
    const size_t i = (size_t)blockIdx.x * blockDim.x + threadIdx.x; if (i >= (size_t)NTOK * D) return;
    const size_t tok = i >> 10; const int c = (int)(i & 1023);
    MIX[i] = ATT[i] * sigmoidf_(P[tok * ODD_IN + 3072 + c]);
}

__global__ void __launch_bounds__(256) router(const float* X, const float* rw  , const float* rb, int* cnt, int* list, int* sel_e, int* sel_slot, float* gate) {
    __shared__ float lg[8][32];
    const int tk = threadIdx.x >> 5, e = threadIdx.x & 31; const size_t tok = (size_t)blockIdx.x * 8 + tk;
    const float* x = X + tok * D; float acc = 0.f;
    for (int k = 0; k < D; ++k) acc = fmaf(x[k], rw[k * 32 + e], acc);
    lg[tk][e] = acc + rb[e];
    __syncthreads();
    if (e == 0) {
        float v[4]; int id[4]; unsigned used = 0u;
#pragma unroll
        for (int k = 0; k < 4; ++k) { float best = -INFINITY; int bi = 0; for (int j = 0; j < 32; ++j) { const float z = lg[tk][j]; if (!((used >> j) & 1u) && z > best) { best = z; bi = j; } } used |= 1u << bi; v[k] = best; id[k] = bi; }
        float s = 0.f, p[4];
#pragma unroll
        for (int k = 0; k < 4; ++k) { p[k] = __expf(v[k] - v[0]); s += p[k]; }
#pragma unroll
        for (int k = 0; k < 4; ++k) {
            const int slot = atomicAdd(&cnt[id[k]], 1);
            list[(size_t)id[k] * NTOK + slot] = (int)(tok * 4 + k);
            sel_e[tok * 4 + k] = id[k]; sel_slot[tok * 4 + k] = slot; gate[tok * 4 + k] = p[k] / s;
        }
    }
}
__global__ void offsets(const int* cnt, int* off) { if (threadIdx.x == 0) { int s = 0; for (int e = 0; e < NE; ++e) { off[e] = s; s += cnt[e]; } } }
__global__ void __launch_bounds__(256) combine_ln(float* X, const float* Y, const int* off, const int* sel_e, const int* sel_slot, const float* gate, const float* gam, const float* bet, float* Xout) {
    __shared__ float red[4];
    const size_t row = blockIdx.x; const int c = threadIdx.x * 4;
    const float4 x = *(const float4*)(X + row * D + c);
    float v[4] = {ALPHA * x.x, ALPHA * x.y, ALPHA * x.z, ALPHA * x.w};
#pragma unroll
    for (int k = 0; k < 4; ++k) { const size_t pos = (size_t)off[sel_e[row * 4 + k]] + sel_slot[row * 4 + k]; const float gt = gate[row * 4 + k]; const float4 y = *(const float4*)(Y + pos * D + c);
        v[0] = fmaf(gt, y.x, v[0]); v[1] = fmaf(gt, y.y, v[1]); v[2] = fmaf(gt, y.z, v[2]); v[3] = fmaf(gt, y.w, v[3]); }
    const float mean = block_sum_256(v[0] + v[1] + v[2] + v[3], red) * (1.f / D);
    float q = 0.f;
#pragma unroll
    for (int i = 0; i < 4; ++i) { v[i] -= mean; q += v[i] * v[i]; }
    const float rstd = rsqrtf(block_sum_256(q, red) * (1.f / D) + LN_EPS);
    const float4 gg = *(const float4*)(gam + c), bb = *(const float4*)(bet + c);
    *(float4*)(Xout + row * D + c) = make_float4(v[0] * rstd * gg.x + bb.x, v[1] * rstd * gg.y + bb.y, v[2] * rstd * gg.z + bb.z, v[3] * rstd * gg.w + bb.w);
}

constexpr size_t MiB = 1u << 20;
constexpr size_t O_X = 0;
constexpr size_t O_H = 128 * MiB;
constexpr size_t O_MIX = 256 * MiB;
constexpr size_t O_ATT = 384 * MiB;
constexpr size_t O_PROJ = 512 * MiB;
constexpr size_t O_CQ = 1032 * MiB;
constexpr size_t O_GO = 1224 * MiB;
constexpr size_t O_HB = 512 * MiB;
constexpr size_t O_Y = 1536 * MiB;
constexpr size_t O_SMALL = 2048 * MiB;
constexpr size_t O_END = 2064 * MiB;
constexpr size_t S_TAB = 0, S_BETA = 64 * 1024, S_G = S_BETA + 512 * 1024, S_CUM = S_G + 512 * 1024  , S_CNT = S_CUM + 2 * MiB, S_OFF = S_CNT + 256,
                 S_SELE = S_CNT + 4096, S_SLOT = S_SELE + 512 * 1024, S_GATE = S_SLOT + 512 * 1024, S_LIST = S_GATE + 512 * 1024  ;
static_assert(S_LIST + 4 * MiB <= 16 * MiB, "small region");

struct In { const float* p[24]; };
static_assert(sizeof(GemmArgs) == 80, "GemmArgs has padding");

struct Save { int layer, stage; void* dst; };
enum { ST_PROJ = 0, ST_CQ, ST_GO, ST_ATT, ST_MIX, ST_H, ST_XMIX, ST_XOUT, ST_CUM, ST_BETA, ST_G, ST_Y };
static void forward(const In& in, unsigned char* ws, float* out, const Save* sv, int nsv, hipStream_t st) {
    auto save = [&](int layer, int stage, const void* src, size_t bytes) { for (int k = 0; k < nsv; ++k) if (sv[k].layer == layer && sv[k].stage == stage) (void)hipMemcpyAsync(sv[k].dst, src, bytes, hipMemcpyDeviceToDevice, st); };
    float* X = (float*)(ws + O_X); float* H = (float*)(ws + O_H); float* MIX = (float*)(ws + O_MIX); float* ATT = (float*)(ws + O_ATT);
    float* PROJ = (float*)(ws + O_PROJ); float* CQ = (float*)(ws + O_CQ); float* GO = (float*)(ws + O_GO); float* HB = (float*)(ws + O_HB); float* Y = (float*)(ws + O_Y);
    unsigned char* sm = ws + O_SMALL;
    float* TAB = (float*)(sm + S_TAB); float* BETA = (float*)(sm + S_BETA); float* G = (float*)(sm + S_G); float* CUM = (float*)(sm + S_CUM);
    int* CNT = (int*)(sm + S_CNT); int* OFF = (int*)(sm + S_OFF); int* SELE = (int*)(sm + S_SELE); int* SLOT = (int*)(sm + S_SLOT); float* GATE = (float*)(sm + S_GATE); int* LIST = (int*)(sm + S_LIST);
    (void)hipMemcpyAsync(X, in.p[0], (size_t)NTOK * D * 4, hipMemcpyDeviceToDevice, st);
    t5tab<<<32, 256, 0, st>>>(in.p[1], TAB);
    for (int layer = 0; layer < 4; ++layer) {
        const int i = layer >> 1;
        if ((layer & 1) == 0) {
            GemmArgs g{X, in.p[2] + (size_t)i * D * EVEN_IN, nullptr, PROJ, nullptr, nullptr, nullptr, D, EVEN_IN, EVEN_IN, NTOK, EVEN_IN, D};
            gemm<0><<<dim3((EVEN_IN + 127) / 128, NTOK / 128), 256, 0, st>>>(g);
            conv_silu<<<(unsigned)(((size_t)NTOK * 1536 + 255) / 256), 256, 0, st>>>(PROJ, in.p[6] + (size_t)i * 4 * 1536, CQ);
            gdn_norm<<<NTOK * 8 / 256, 256, 0, st>>>(PROJ, CQ, in.p[7] + i * 4, in.p[8] + i * 4, BETA, G);
            save(layer, ST_CQ, CQ, (size_t)NTOK * 1536 * 4); save(layer, ST_BETA, BETA, (size_t)NTOK * 16); save(layer, ST_G, G, (size_t)NTOK * 16);
            gdn_rec<<<8, 128, 0, st>>>(CQ, BETA, G, GO);
            save(layer, ST_GO, GO, (size_t)NTOK * 512 * 4);
            save(layer, ST_PROJ, PROJ, (size_t)NTOK * EVEN_IN * 4);
            attn<0><<<dim3(T / 256, B * 16), 256, 0, st>>>(PROJ, ATT, TAB, nullptr, EVEN_IN);
            save(layer, ST_ATT, ATT, (size_t)NTOK * D * 4);
            const float lam_init = 0.8f - 0.6f * expf(-0.3f * (float)layer);
            even_combine<<<NTOK, 128, 0, st>>>(ATT, GO, PROJ, in.p[4] + i * 256, in.p[5] + i * 128, in.p[9] + i * 128, MIX, lam_init);
            GemmArgs g2{MIX, in.p[3] + (size_t)i * D * D, nullptr, H, nullptr, nullptr, nullptr, D, D, D, NTOK, D, D};
            gemm<0><<<dim3(D / 128, NTOK / 128), 256, 0, st>>>(g2);
        } else {
            GemmArgs g{X, in.p[10] + (size_t)i * D * ODD_IN, nullptr, PROJ, nullptr, nullptr, nullptr, D, ODD_IN, ODD_IN, NTOK, ODD_IN, D};
            gemm<0><<<dim3((ODD_IN + 127) / 128, NTOK / 128), 256, 0, st>>>(g);
            qknorm<<<NTOK * 32 / 256, 256, 0, st>>>(PROJ, in.p[12] + i * 128);
            logf_k<<<NTOK * 16 / 256, 256, 0, st>>>(PROJ, in.p[13] + i * 16, CUM);
            cumsum16k<<<B * 16, 1024, 0, st>>>(CUM);
            save(layer, ST_PROJ, PROJ, (size_t)NTOK * ODD_IN * 4); save(layer, ST_CUM, CUM, (size_t)32 * T * 4);
            attn<1><<<dim3(T / 256, B * 16), 256, 0, st>>>(PROJ, ATT, nullptr, CUM, ODD_IN);
            save(layer, ST_ATT, ATT, (size_t)NTOK * D * 4);
            gate_k<<<(unsigned)((size_t)NTOK * D / 256), 256, 0, st>>>(ATT, PROJ, MIX);
            GemmArgs g2{MIX, in.p[11] + (size_t)i * D * D, nullptr, H, nullptr, nullptr, nullptr, D, D, D, NTOK, D, D};
            gemm<0><<<dim3(D / 128, NTOK / 128), 256, 0, st>>>(g2);
        }
        save(layer, ST_MIX, MIX, (size_t)NTOK * D * 4); save(layer, ST_H, H, (size_t)NTOK * D * 4);
        ln_res<<<NTOK, 256, 0, st>>>(X, H, in.p[20] + layer * D, in.p[21] + layer * D, X);
        save(layer, ST_XMIX, X, (size_t)NTOK * D * 4);
        (void)hipMemsetAsync(CNT, 0, 128, st);
        router<<<NTOK / 8, 256, 0, st>>>(X, in.p[14] + (size_t)layer * D * NE, in.p[15] + layer * NE, CNT, LIST, SELE, SLOT, GATE);
        offsets<<<1, 64, 0, st>>>(CNT, OFF);
        GemmArgs m1{X, in.p[16] + (size_t)layer * NE * D * 2048, in.p[17] + (size_t)layer * NE * 2048, HB, CNT, OFF, LIST, D, 2048, 2048, 0, 2048, D};
        gemm<1><<<dim3(2048 / 128, NTOK / 128, NE), 256, 0, st>>>(m1);
        GemmArgs m2{HB, in.p[18] + (size_t)layer * NE * DFF * D, in.p[19] + (size_t)layer * NE * D, Y, CNT, OFF, LIST, 2048, D, D, 0, D, DFF};
        gemm<2><<<dim3(D / 128, NTOK / 128, NE), 256, 0, st>>>(m2);
        float* dst = (layer == 3) ? out : X;
        combine_ln<<<NTOK, 256, 0, st>>>(X, Y, OFF, SELE, SLOT, GATE, in.p[22] + layer * D, in.p[23] + layer * D, dst);
        save(layer, ST_XOUT, dst, (size_t)NTOK * D * 4);
    }
}
}

#endif
namespace fk {
#define LAS __attribute__((address_space(3)))
#define GAS __attribute__((address_space(1)))
typedef unsigned short bf16_t;
typedef short bf16x8 __attribute__((ext_vector_type(8)));
typedef short s16x4 __attribute__((ext_vector_type(4)));
typedef float f32x2 __attribute__((ext_vector_type(2)));
typedef float f32x4 __attribute__((ext_vector_type(4)));
typedef float f32x16 __attribute__((ext_vector_type(16)));
typedef unsigned u32x2 __attribute__((ext_vector_type(2)));
typedef unsigned u32x4 __attribute__((ext_vector_type(4)));
typedef GAS unsigned gu32;

constexpr int NWAVES = 8, NTHR = 512;
constexpr int PITCH = 4096;
constexpr float LOG2E = 1.4426950408889634f;
constexpr float C2 = 0.125f * LOG2E;
constexpr int NPAD = NTOK * 4 + NE * 256;
constexpr int T5PAD = 256, T5N = 2048 + T5PAD;

constexpr size_t MiB = 1u << 20;
constexpr size_t WS_CTL = 0, CTL_BYTES = 1 * MiB;
constexpr size_t WS_WINE = 2 * MiB;
constexpr size_t WS_WINO = 16 * MiB;
constexpr size_t WS_WOUTE = 32 * MiB, WS_WOUTO = 36 * MiB;
constexpr size_t WS_RW = 40 * MiB;
constexpr size_t WS_SWE = WS_RW + 512 * 1024;
constexpr size_t WS_SWO = WS_SWE + 128 * 1024;
constexpr size_t WS_T5 = 41 * MiB;
constexpr size_t WS_WGU = 64 * MiB;
constexpr size_t WS_WD = 576 * MiB;
constexpr size_t WS_X = 832 * MiB;
constexpr size_t WS_XB = 960 * MiB;
constexpr size_t WS_PROJ = 1024 * MiB;
constexpr size_t WS_ATT = 1280 * MiB;
constexpr size_t WS_MIX = 1344 * MiB;
constexpr size_t WS_H = 1408 * MiB;
constexpr size_t WS_GW = 1536 * MiB, WS_GQD = 1570 * MiB, WS_GQK = 1604 * MiB, WS_GKD = 1622 * MiB, WS_GU = 1658 * MiB;
constexpr size_t WS_GO = 1722 * MiB;
constexpr size_t WS_ACT = 1792 * MiB;
constexpr size_t WS_Y = 2064 * MiB;
constexpr size_t WS_PB = 2336 * MiB;
constexpr size_t WS_CUM = 2338 * MiB;
constexpr size_t WS_KB8 = 2340 * MiB;
constexpr size_t WS_SELE = 2348 * MiB, WS_SLOT = WS_SELE + 512 * 1024, WS_GATE = WS_SLOT + 512 * 1024, WS_TSUM = WS_GATE + 512 * 1024;
constexpr size_t WS_LIST = 2350 * MiB;
constexpr size_t WS_GL = 2354 * MiB;
constexpr size_t WS_FAST_END = 2356 * MiB;
constexpr int CW_TMO = 0, CW_BAR = 4096, CW_CNT = 8192  , CW_QUEUE = 12288  ;

constexpr int RING_BYTES = 131072;
constexpr int MISC_OFF = RING_BYTES + 320;
constexpr int LDS_BYTES = 147456;

#define LDS_WAIT() asm volatile("s_waitcnt lgkmcnt(0)" ::: "memory")
#define VM_WAIT() asm volatile("s_waitcnt vmcnt(0)" ::: "memory")
#define RLX_AGENT __ATOMIC_RELAXED, __HIP_MEMORY_SCOPE_AGENT

__device__ __forceinline__ unsigned f2bf(float f) { unsigned u = __builtin_bit_cast(unsigned, f); return (u + 0x7fffu + ((u >> 16) & 1u)) >> 16; }
__device__ __forceinline__ unsigned pk2(float lo, float hi) { return f2bf(lo) | (f2bf(hi) << 16); }
__device__ __forceinline__ float bf2f(unsigned short h) { return __builtin_bit_cast(float, (unsigned)h << 16); }
__device__ __forceinline__ float bflo(unsigned w) { return __builtin_bit_cast(float, w << 16); }
__device__ __forceinline__ float bfhi(unsigned w) { return __builtin_bit_cast(float, w & 0xffff0000u); }
__device__ __forceinline__ unsigned cvt_pk_bf16(float lo, float hi) { unsigned r; asm volatile("v_cvt_pk_bf16_f32 %0, %1, %2" : "=v"(r) : "v"(lo), "v"(hi)); return r; }
__device__ __forceinline__ float sigmoid_f(float x) { return 1.f / (1.f + __expf(-x)); }
__device__ __forceinline__ float softplus_f(float x) { const float e = __expf(-fabsf(x)); const float l = e < 1e-3f ? e * (1.f - 0.5f * e) : __logf(1.f + e); return fmaxf(x, 0.f) + l; }

#define XB_TMO      128
#define XB_XCNT(j)  (256  + 64 * (j))
#define XB_XSUB(j)  (1280 + 64 * (j))
#define XB_XGEN(j)  (2304 + 64 * (j))
#define XB_TOP      3328
#define XB_TOPGEN   3392
#define XCD_BAR_WORDS 3456
#define XB_SPIN_CAP (1u << 18)
__device__ __forceinline__ unsigned xb_ld(unsigned* p)              { return __hip_atomic_load(p, __ATOMIC_RELAXED, __HIP_MEMORY_SCOPE_AGENT); }
__device__ __forceinline__ unsigned xb_add(unsigned* p, unsigned v) { return __hip_atomic_fetch_add(p, v, __ATOMIC_RELAXED, __HIP_MEMORY_SCOPE_AGENT); }
__device__ __forceinline__ unsigned xb_xcc_id() { return (unsigned)__builtin_amdgcn_s_getreg((3 << 11) | 20) & 0xFu; }
#define XB_SPIN(cond, bar) do { unsigned _sp = 0; while (cond) { __builtin_amdgcn_s_sleep(1); \
    if ((++_sp & 255u) == 0u) { if (xb_ld(&(bar)[XB_TMO])) break; if (_sp > XB_SPIN_CAP) { atomicAdd(&(bar)[XB_TMO], 1u); break; } } } } while (0)
struct XcdBarrier { unsigned* bar; unsigned x; volatile LAS unsigned* st; };
__device__ __forceinline__ XcdBarrier xcd_barrier_post(unsigned* bar, volatile LAS unsigned* st) {
    XcdBarrier b; b.bar = bar; b.x = xb_xcc_id(); b.st = st;
    if (threadIdx.x == 0) (void)xb_add(&bar[XB_XCNT(b.x)], 1u);
    return b;
}
__device__ __forceinline__ void xcd_barrier_complete(unsigned* bar, unsigned x, unsigned& nloc, unsigned& nx) {
    const unsigned G = gridDim.x * gridDim.y * gridDim.z;
    unsigned sum, cnt, mine, sp = 0u;
    for (;;) {
        sum = 0u; cnt = 0u;
#pragma unroll
        for (unsigned j = 0; j < 16; ++j) { const unsigned c = xb_ld(&bar[XB_XCNT(j)]); sum += c; cnt += (c > 0u) ? 1u : 0u; }
        mine = xb_ld(&bar[XB_XCNT(x)]);
        if (sum == G) break;
        __builtin_amdgcn_s_sleep(1);
        if ((++sp & 255u) == 0u) { if (xb_ld(&bar[XB_TMO])) break; if (sp > XB_SPIN_CAP) { atomicAdd(&bar[XB_TMO], 1u); break; } }
    }
    nloc = mine > 0u ? mine : 1u; nx = cnt > 0u ? cnt : 1u;
}
__device__ __forceinline__ void xcd_barrier(const XcdBarrier& b) {
    asm volatile("s_waitcnt vmcnt(0)" ::: "memory");
    __syncthreads();
    if (threadIdx.x == 0) {
        unsigned* bar = b.bar; const unsigned bx = b.x;
        __builtin_amdgcn_s_waitcnt(0);
        unsigned nloc = b.st[0], nx = b.st[1];
        if (nloc == 0u) { xcd_barrier_complete(bar, bx, nloc, nx); b.st[0] = nloc; b.st[1] = nx; }
        const unsigned old = xb_add(&bar[XB_XSUB(bx)], 1u);
        const unsigned gen = old / nloc;
        if (old + 1u == (gen + 1u) * nloc) {
            __builtin_amdgcn_fence(__ATOMIC_RELEASE, "agent");
            asm volatile("s_waitcnt vmcnt(0)" ::: "memory");
            const unsigned og = xb_add(&bar[XB_TOP], 1u);
            const unsigned tg = og / nx;
            if (og + 1u == (tg + 1u) * nx) xb_add(&bar[XB_TOPGEN], 1u);
            else XB_SPIN(xb_ld(&bar[XB_TOPGEN]) == tg, bar);
            __builtin_amdgcn_fence(__ATOMIC_ACQUIRE, "agent");
            xb_add(&bar[XB_XGEN(bx)], 1u);
            asm volatile("s_waitcnt vmcnt(0)" ::: "memory");
        } else {
            XB_SPIN(xb_ld(&bar[XB_XGEN(bx)]) == gen, bar);
            __builtin_amdgcn_fence(__ATOMIC_ACQUIRE, "agent");
            asm volatile("s_waitcnt vmcnt(0)" ::: "memory");
        }
    }
    __syncthreads();
}

namespace pg8 {
constexpr int BM = 256, BK = 64, HALF = 128, HTB = HALF * BK * 2, STAGE_BYTES = 8 * HTB;
__host__ __device__ __forceinline__ int lds_byte(int r, int c) { const int st = (r >> 4) * 2 + (c >> 5), rr = r & 15, cc = c & 31, ob = rr * 64 + cc * 2; return st * 1024 + (ob ^ (((ob >> 9) & 1) << 5)); }
__host__ __device__ __forceinline__ void stage_rc(int b, int& R, int& C) { const int st = b / 1024, sb = b % 1024, swz = sb ^ (((sb >> 9) & 1) << 5); R = (st >> 1) * 16 + swz / 64; C = (st & 1) * 32 + (swz % 64) / 2; }
__host__ __device__ __forceinline__ int perm32(int rho) { const int n = rho >> 4, i = rho & 15; return 8 * (i >> 2) + 4 * n + (i & 3); }

struct Unit { const char* A; const char* B; const int* rows; int nvalid; int row0; int col0; int aux; };

template <class Epi, class Sched, bool GATHER>
__device__ __forceinline__ void gemm_phase(LAS unsigned char* lds, const int K, const Sched& S, const Epi& E, const int tid) {
    const int wid = __builtin_amdgcn_readfirstlane(tid >> 6), lane = tid & 63, wr = wid >> 2, wc = wid & 3, fr = lane & 15, fq = lane >> 4;
    const int nt = K / BK;
    int Rr[2], Cc[2]; unsigned voffB[2]; unsigned offA[2][2], noffA[2][2];
#pragma unroll
    for (int i = 0; i < 2; ++i) { stage_rc(tid * 16 + i * 8192, Rr[i], Cc[i]); const int Rb = Epi::PERM ? ((Rr[i] & ~31) + perm32(Rr[i] & 31)) : Rr[i];
        voffB[i] = (unsigned)(Rb * K + Cc[i]) * 2u;
#pragma unroll
        for (int h = 0; h < 2; ++h) { offA[h][i] = (unsigned)((Rr[i] + HALF * h) * K + Cc[i]) * 2u; noffA[h][i] = offA[h][i]; } }
    const size_t kstep = (size_t)(BK * 2);
    const size_t hstep = (size_t)HALF * K * 2;
    const unsigned ldsw = (unsigned)wid * 1024u;
    const int aoff = lds_byte(wr * 64 + fr, fq * 8), boff = lds_byte(wc * 32 + fr, fq * 8);
#define PG8_SA(b, h) (((b) * 2 + (h)) * HTB)
#define PG8_SB(b, h) ((4 + (b) * 2 + (h)) * HTB)
#define PG8_STAGE_B(bufoff, gbase) do { _Pragma("unroll") for (int _i = 0; _i < 2; ++_i) \
        __builtin_amdgcn_global_load_lds((const unsigned*)((const char*)(gbase) + voffB[_i]), (LAS unsigned*)(lds + (bufoff) + ldsw + _i * 8192), 16, 0, 0); } while (0)
#define PG8_STAGE_A(bufoff, gbase, off, h) do { _Pragma("unroll") for (int _i = 0; _i < 2; ++_i) \
        __builtin_amdgcn_global_load_lds((const unsigned*)((const char*)(gbase) + (off)[h][_i]), (LAS unsigned*)(lds + (bufoff) + ldsw + _i * 8192), 16, 0, 0); } while (0)
#define PG8_LDA(dst, b, h) do { _Pragma("unroll") for (int m = 0; m < 4; ++m) _Pragma("unroll") for (int k = 0; k < 2; ++k) dst[m][k] = *(const LAS bf16x8*)(lds + PG8_SA(b, h) + aoff + m * 2048 + k * 1024); } while (0)
#define PG8_LDB(dst, b, h) do { _Pragma("unroll") for (int n = 0; n < 2; ++n) _Pragma("unroll") for (int k = 0; k < 2; ++k) dst[n][k] = *(const LAS bf16x8*)(lds + PG8_SB(b, h) + boff + n * 2048 + k * 1024); } while (0)
#define PG8_MMA(ai, bj, At, Bt) do { __builtin_amdgcn_s_setprio(1); _Pragma("unroll") for (int m = 0; m < 4; ++m) _Pragma("unroll") for (int n = 0; n < 2; ++n) _Pragma("unroll") for (int k = 0; k < 2; ++k) \
        acc[ai][bj][m][n] = __builtin_amdgcn_mfma_f32_16x16x32_bf16(Bt[n][k], At[m][k], acc[ai][bj][m][n], 0, 0, 0); __builtin_amdgcn_s_setprio(0); } while (0)
#define PG8_WAIT_V(n) asm volatile("s_waitcnt vmcnt(" #n ")" ::: "memory")
#define PG8_WAIT_L(n) asm volatile("s_waitcnt lgkmcnt(" #n ")" ::: "memory")
#define PG8_BAR __builtin_amdgcn_s_barrier()
#define PG8_SCHED __builtin_amdgcn_sched_barrier(0)
#define PG8_ROWS(dst, u) do { if constexpr (GATHER) { _Pragma("unroll") for (int h = 0; h < 2; ++h) _Pragma("unroll") for (int i = 0; i < 2; ++i) { \
        int rr_ = Rr[i] + HALF * h; rr_ = rr_ < (u).nvalid ? rr_ : (u).nvalid - 1; const int tok_ = (u).rows[rr_] >> 2; dst[h][i] = (unsigned)(tok_ * K + Cc[i]) * 2u; } } } while (0)
    Unit cur, nxt; int ui = 0;
    if (!S.next(0, cur)) return;
    f32x4 acc[2][2][4][2];
#pragma unroll
    for (int a = 0; a < 2; ++a)
#pragma unroll
        for (int b = 0; b < 2; ++b)
#pragma unroll
            for (int m = 0; m < 4; ++m)
#pragma unroll
                for (int n = 0; n < 2; ++n) acc[a][b][m][n] = (f32x4){0.f, 0.f, 0.f, 0.f};
    bf16x8 At[4][2], B0[2][2], B1[2][2];
    const char* cA = cur.A; const char* cB = cur.B;
    PG8_ROWS(offA, cur);
    PG8_STAGE_B(PG8_SB(0, 0), cB); PG8_STAGE_B(PG8_SB(0, 1), cB + hstep); PG8_STAGE_A(PG8_SA(0, 0), cA, offA, 0); PG8_STAGE_A(PG8_SA(0, 1), cA, offA, 1);
    if (wr == 1) PG8_BAR;
    PG8_WAIT_V(2); PG8_BAR;
    PG8_STAGE_B(PG8_SB(1, 0), cB + kstep); PG8_STAGE_A(PG8_SA(1, 0), cA + kstep, offA, 0); PG8_STAGE_B(PG8_SB(1, 1), cB + hstep + kstep);
    PG8_WAIT_V(6); PG8_BAR;
    for (;;) {
        const bool has_next = S.next(ui + 1, nxt);
        const char* nA = has_next ? nxt.A : cA; const char* nB = has_next ? nxt.B : cB;
        if constexpr (GATHER) { if (has_next) { PG8_ROWS(noffA, nxt); } else {
#pragma unroll
            for (int h = 0; h < 2; ++h)
#pragma unroll
                for (int i = 0; i < 2; ++i) noffA[h][i] = offA[h][i]; } }
        for (int t = 0; t < nt; t += 2) {
            const bool last = (t == nt - 2);
            const char* a1 = cA + (size_t)(t + 1) * kstep;
            const char* a2 = last ? nA : cA + (size_t)(t + 2) * kstep; const char* b2 = last ? nB : cB + (size_t)(t + 2) * kstep;
            const char* a3 = a2 + kstep; const char* b3 = b2 + kstep;
            PG8_LDB(B0, 0, 0); PG8_LDB(B1, 0, 1); PG8_SCHED; PG8_LDA(At, 0, 0); PG8_STAGE_A(PG8_SA(1, 1), a1, offA, 1);
            if (GATHER && last) { asm volatile("" ::: "memory");
#pragma unroll
                for (int h = 0; h < 2; ++h)
#pragma unroll
                    for (int i = 0; i < 2; ++i) offA[h][i] = noffA[h][i]; }
            PG8_WAIT_V(8); PG8_WAIT_L(0); PG8_BAR; PG8_MMA(0, 0, At, B0); PG8_MMA(0, 1, At, B1); PG8_BAR; PG8_SCHED;
            PG8_LDA(At, 0, 1); PG8_STAGE_B(PG8_SB(0, 0), b2); PG8_STAGE_B(PG8_SB(0, 1), b2 + hstep); PG8_STAGE_A(PG8_SA(0, 0), a2, offA, 0);
            PG8_WAIT_V(8); PG8_WAIT_L(0); PG8_BAR; PG8_MMA(1, 0, At, B0); PG8_MMA(1, 1, At, B1); PG8_BAR; PG8_SCHED;
            PG8_LDB(B0, 1, 0); PG8_LDB(B1, 1, 1); PG8_SCHED; PG8_LDA(At, 1, 0); PG8_STAGE_A(PG8_SA(0, 1), a2, offA, 1);
            PG8_WAIT_V(8); PG8_WAIT_L(0); PG8_BAR; PG8_MMA(0, 0, At, B0); PG8_MMA(0, 1, At, B1); PG8_BAR; PG8_SCHED;
            PG8_LDA(At, 1, 1); PG8_STAGE_B(PG8_SB(1, 0), b3); PG8_STAGE_B(PG8_SB(1, 1), b3 + hstep); PG8_STAGE_A(PG8_SA(1, 0), a3, offA, 0);
            PG8_WAIT_V(8); PG8_WAIT_L(0); PG8_BAR; PG8_MMA(1, 0, At, B0); PG8_MMA(1, 1, At, B1); PG8_BAR; PG8_SCHED;
        }
        if (wr == 0) PG8_BAR;
        E(acc, cur, wr, wc, fr, fq);
        if (!has_next) break;
#pragma unroll
        for (int a = 0; a < 2; ++a)
#pragma unroll
            for (int b = 0; b < 2; ++b)
#pragma unroll
                for (int m = 0; m < 4; ++m)
#pragma unroll
                    for (int n = 0; n < 2; ++n) acc[a][b][m][n] = (f32x4){0.f, 0.f, 0.f, 0.f};
        cur = nxt; cA = nA; cB = nB; ++ui;
        if (wr == 1) PG8_BAR;
    }
    PG8_WAIT_V(0);
    PG8_BAR;
#undef PG8_SA
#undef PG8_SB
#undef PG8_STAGE_A
#undef PG8_STAGE_B
#undef PG8_LDA
#undef PG8_LDB
#undef PG8_MMA
#undef PG8_WAIT_V
#undef PG8_WAIT_L
#undef PG8_BAR
#undef PG8_SCHED
#undef PG8_ROWS
}

struct DenseOrder {
    const char* A; const char* Bt; int K; int nM, nN, nwg, G, c;
    __device__ __forceinline__ bool next(int i, Unit& u) const {
        const long L = (long)i * G + c; if (L >= nwg) return false;
        int wgid = (int)L; { const int q = nwg / 8, r = nwg % 8, xcd = wgid % 8, off = wgid / 8; wgid = (xcd < r ? xcd * (q + 1) : r * (q + 1) + (xcd - r) * q) + off; }
        const int nig = 8 * nN, gid = wgid / nig, fm = gid * 8, gsz = (nM - fm) < 8 ? (nM - fm) : 8;
        const int pm = fm + ((wgid % nig) % gsz), pn = (wgid % nig) / gsz;
        u.A = A + (size_t)pm * BM * K * 2; u.B = Bt + (size_t)pn * BM * K * 2; u.rows = nullptr; u.nvalid = BM; u.row0 = pm * BM; u.col0 = pn * BM; u.aux = 0; return true;
    }
};
struct MoeOrder {
    const char* A; const char* W; const int* list; const LAS int* cnt; const LAS int* offp;
    int npn; size_t wstride; int K; bool gather; int G, c;
    __device__ __forceinline__ bool next(int i, Unit& u) const {
        const int x = c & 7, j = c >> 3, W8 = G >> 3; int q = j + i * W8;
#pragma unroll
        for (int s = 0; s < 4; ++s) { const int e = x + 8 * s; const int n = cnt[e]; const int ntile = (n + 255) >> 8; const int ne = ntile * npn;
            if (q < ne) { const int ti = q / npn, pn = q % npn;
                u.B = W + (size_t)e * wstride + (size_t)pn * BM * K * 2; u.row0 = offp[e] + ti * BM; u.col0 = pn * BM; u.aux = e;
                u.nvalid = (n - ti * BM) < BM ? (n - ti * BM) : BM;
                if (gather) { u.A = A; u.rows = list + (size_t)e * NTOK + ti * BM; } else { u.A = A + (size_t)u.row0 * K * 2; u.rows = nullptr; }
                return true; }
            q -= ne; }
        return false;
    }
};

struct EpiProj {
    static constexpr bool PERM = true;
    bf16_t* O; int ldc; int qcols; float qscale;
    __device__ __forceinline__ void operator()(const f32x4 (&acc)[2][2][4][2], const Unit& u, int wr, int wc, int fr, int fq) const {
        const int row0 = u.row0 + wr * 64 + fr, col0 = u.col0 + wc * 32 + 8 * fq;
        const float sc = (u.col0 < qcols) ? qscale : 1.f;
#pragma unroll
        for (int ai = 0; ai < 2; ++ai)
#pragma unroll
            for (int m = 0; m < 4; ++m) { bf16_t* rowp = O + (size_t)(row0 + ai * HALF + m * 16) * ldc + col0;
#pragma unroll
                for (int bj = 0; bj < 2; ++bj) { const f32x4 v0 = acc[ai][bj][m][0] * sc, v1 = acc[ai][bj][m][1] * sc;
                    u32x4 w; w.x = cvt_pk_bf16(v0[0], v0[1]); w.y = cvt_pk_bf16(v0[2], v0[3]); w.z = cvt_pk_bf16(v1[0], v1[1]); w.w = cvt_pk_bf16(v1[2], v1[3]);
                    *(u32x4*)(rowp + bj * HALF) = w; } }
    }
};
struct EpiF32 {
    static constexpr bool PERM = false;
    float* C; int ldc;
    __device__ __forceinline__ void operator()(const f32x4 (&acc)[2][2][4][2], const Unit& u, int wr, int wc, int fr, int fq) const {
        const int row0 = u.row0 + wr * 64 + fr, col0 = u.col0 + wc * 32 + 4 * fq;
#pragma unroll
        for (int ai = 0; ai < 2; ++ai)
#pragma unroll
            for (int m = 0; m < 4; ++m) { float* rowp = C + (size_t)(row0 + ai * HALF + m * 16) * ldc + col0;
#pragma unroll
                for (int bj = 0; bj < 2; ++bj)
#pragma unroll
                    for (int n = 0; n < 2; ++n) *(f32x4*)(rowp + bj * HALF + n * 16) = acc[ai][bj][m][n]; }
    }
};
struct EpiSwiglu {
    static constexpr bool PERM = true;
    bf16_t* O; const float* bias;
    __device__ __forceinline__ void operator()(const f32x4 (&acc)[2][2][4][2], const Unit& u, int wr, int wc, int fr, int fq) const {
        const int row0 = u.row0 + wr * 64 + fr, ac0 = (u.col0 >> 1) + wc * 32 + 8 * fq;
        const float* bg = bias + (size_t)u.aux * 2048 + ac0; const float* bu = bg + 1024;
        f32x4 bgv[2], buv[2];
#pragma unroll
        for (int n = 0; n < 2; ++n) { bgv[n] = *(const f32x4*)(bg + 4 * n); buv[n] = *(const f32x4*)(bu + 4 * n); }
#pragma unroll
        for (int ai = 0; ai < 2; ++ai)
#pragma unroll
            for (int m = 0; m < 4; ++m) { bf16_t* rowp = O + (size_t)(row0 + ai * HALF + m * 16) * 1024 + ac0; float o[8];
#pragma unroll
                for (int n = 0; n < 2; ++n) { const f32x4 g = acc[ai][0][m][n] + bgv[n], uu = acc[ai][1][m][n] + buv[n];
#pragma unroll
                    for (int j = 0; j < 4; ++j) { const float a = fminf(g[j], 7.f), b = fminf(fmaxf(uu[j], -7.f), 7.f);
                        o[4 * n + j] = a * __builtin_amdgcn_rcpf(1.f + __builtin_amdgcn_exp2f(-1.702f * LOG2E * a)) * (b + 1.f); } }
                u32x4 w; w.x = cvt_pk_bf16(o[0], o[1]); w.y = cvt_pk_bf16(o[2], o[3]); w.z = cvt_pk_bf16(o[4], o[5]); w.w = cvt_pk_bf16(o[6], o[7]);
                *(u32x4*)rowp = w; }
    }
};
struct EpiDown {
    static constexpr bool PERM = true;
    bf16_t* O; const float* bias;
    __device__ __forceinline__ void operator()(const f32x4 (&acc)[2][2][4][2], const Unit& u, int wr, int wc, int fr, int fq) const {
        const int row0 = u.row0 + wr * 64 + fr, col0 = u.col0 + wc * 32 + 8 * fq;
        const float* bb = bias + (size_t)u.aux * 1024 + col0;
        f32x4 bv[2][2];
#pragma unroll
        for (int bj = 0; bj < 2; ++bj)
#pragma unroll
            for (int n = 0; n < 2; ++n) bv[bj][n] = *(const f32x4*)(bb + bj * HALF + 4 * n);
#pragma unroll
        for (int ai = 0; ai < 2; ++ai)
#pragma unroll
            for (int m = 0; m < 4; ++m) { bf16_t* rowp = O + (size_t)(row0 + ai * HALF + m * 16) * 1024 + col0;
#pragma unroll
                for (int bj = 0; bj < 2; ++bj) { const f32x4 v0 = acc[ai][bj][m][0] + bv[bj][0], v1 = acc[ai][bj][m][1] + bv[bj][1];
                    u32x4 w; w.x = cvt_pk_bf16(v0[0], v0[1]); w.y = cvt_pk_bf16(v0[2], v0[3]); w.z = cvt_pk_bf16(v1[0], v1[1]); w.w = cvt_pk_bf16(v1[2], v1[3]);
                    *(u32x4*)(rowp + bj * HALF) = w; } }
    }
};
}
namespace attn_body {
constexpr int D = 64, NW = 8, QBLK = 32, QB = QBLK * NW, KVBLK = 64, NQB = T / QB;
constexpr int NSLOT = 3, SLOTB = 9216;
constexpr int LDS_K = 0, LDS_V = NSLOT * SLOTB, LDS_WS = 2 * NSLOT * SLOTB, LDS_OST = LDS_WS + NW * 64 * 4, LDS_TB = LDS_OST + NW * 4096, LDS_UNIT = LDS_TB + T5N * 4, LDS_BYTES = LDS_UNIT + 16;
static_assert(LDS_BYTES <= RING_BYTES, "attention LDS");
__device__ __forceinline__ int crow(int r, int hi) { return (r & 3) + 8 * (r >> 2) + 4 * hi; }
#define SBAR() __builtin_amdgcn_sched_barrier(0)
__device__ __forceinline__ void cmask(f32x16& p0, f32x16& p1, int jb, int qrel, int hi) {
    const float NEG = -INFINITY; const int lim = qrel - 64 * jb - 4 * hi;
#pragma unroll
    for (int r = 0; r < 16; ++r) { const int c = (r & 3) + 8 * (r >> 2); if (c > lim) p0[r] = NEG; if (c + 32 > lim) p1[r] = NEG; }
}
__device__ __forceinline__ void glds16(const void* sbase, unsigned voff, unsigned lds_dst) { unsigned keep;
    asm volatile("s_mov_b32 %0, m0\n\ts_mov_b32 m0, %3\n\ts_nop 0\n\tglobal_load_lds_dwordx4 %1, %2\n\ts_mov_b32 m0, %0" : "=&s"(keep) : "v"(voff), "s"(sbase), "s"(lds_dst) : "memory"); }
__device__ __forceinline__ float max3f(float a, float b, float c) { float r; asm("v_max3_f32 %0, %1, %2, %3" : "=v"(r) : "v"(a), "v"(b), "v"(c)); return r; }
__device__ __forceinline__ float max2f(float a, float b) { float r; asm("v_max_f32_e32 %0, %1, %2" : "=v"(r) : "v"(a), "v"(b)); return r; }
__device__ __forceinline__ float fadd_s(float a, float b) { float r; asm("v_add_f32_e32 %0, %1, %2" : "=v"(r) : "v"(a), "v"(b)); return r; }
__device__ __forceinline__ float fsub_s(float a, float b) { float r; asm("v_sub_f32_e32 %0, %1, %2" : "=v"(r) : "v"(a), "v"(b)); return r; }
typedef __bf16 bf16x2_t __attribute__((ext_vector_type(2)));
__device__ __forceinline__ unsigned cvtpk_s(float lo, float hi) { f32x2 v = {lo, hi}; bf16x2_t b = __builtin_convertvector(v, bf16x2_t); return __builtin_bit_cast(unsigned, b); }
#define WAIT_BAR(N) asm volatile("s_waitcnt vmcnt(" #N ") lgkmcnt(0)\n\ts_barrier" ::: "memory")
typedef LAS const char* lds_cptr;
typedef short v4i16_t __attribute__((ext_vector_type(4)));
__device__ __forceinline__ void kload2(bf16x8* kf, lds_cptr kp, int j) { kf[2 * j] = *(const LAS bf16x8*)(kp + j * 2048); kf[2 * j + 1] = *(const LAS bf16x8*)(kp + j * 2048 + 512); }
__device__ __forceinline__ s16x4 vtr(lds_cptr p) { return __builtin_bit_cast(s16x4, __builtin_amdgcn_ds_read_tr16_b64_v4i16((LAS v4i16_t*)p)); }
__device__ __forceinline__ float rowmax(const f32x16& p0, const f32x16& p1) {
    float a = max3f(p0[0], p0[1], p1[0]), b = max3f(p0[2], p0[3], p1[1]); a = max3f(a, p1[2], p1[3]);
#pragma unroll
    for (int r = 4; r < 16; r += 4) { a = max3f(a, p0[r], p0[r + 1]); b = max3f(b, p0[r + 2], p0[r + 3]); a = max3f(a, p1[r], p1[r + 1]); b = max3f(b, p1[r + 2], p1[r + 3]); }
    const float m = max2f(a, b);
    auto rr = __builtin_amdgcn_permlane32_swap(__float_as_uint(m), __float_as_uint(m), false, false);
    return max2f(__uint_as_float(rr[0]), __uint_as_float(rr[1]));
}
__device__ __forceinline__ void pv(f32x16* o, int vb, bf16x8 pa0, bf16x8 pa1, bf16x8 pa2, bf16x8 pa3) {
#pragma unroll
    for (int d0 = 0; d0 < 2; ++d0) { s16x4 lo[4], hi[4];
#pragma unroll
        for (int ks = 0; ks < 4; ++ks) {
            asm volatile("ds_read_b64_tr_b16 %0,%1 offset:%c2" : "=&v"(lo[ks]) : "v"(vb), "i"(d0 * 4096 + ks * 1024) : "memory");
            asm volatile("ds_read_b64_tr_b16 %0,%1 offset:%c2" : "=&v"(hi[ks]) : "v"(vb), "i"(d0 * 4096 + ks * 1024 + 512) : "memory"); }
        asm volatile("s_waitcnt lgkmcnt(0)" ::: "memory"); SBAR();
#define PK(k) (bf16x8){lo[k][0], lo[k][1], lo[k][2], lo[k][3], hi[k][0], hi[k][1], hi[k][2], hi[k][3]}
        o[d0] = __builtin_amdgcn_mfma_f32_32x32x16_bf16(pa0, PK(0), o[d0], 0, 0, 0);
        o[d0] = __builtin_amdgcn_mfma_f32_32x32x16_bf16(pa1, PK(1), o[d0], 0, 0, 0);
        o[d0] = __builtin_amdgcn_mfma_f32_32x32x16_bf16(pa2, PK(2), o[d0], 0, 0, 0);
        o[d0] = __builtin_amdgcn_mfma_f32_32x32x16_bf16(pa3, PK(3), o[d0], 0, 0, 0);
#undef PK
    }
}
struct AttnP {
    const bf16_t* proj;
    bf16_t* out;
    const float* t5tab;
    const float* cum2;
    const bf16_t* kb8;
};

template <int MODE, int THRL>
__device__ __forceinline__ void attn_unit(const AttnP& P, int b, int vh, int qb, char* shm, const int tid) {
    const int lane = tid & 63, r32 = lane & 31, hi = lane >> 5; const int wid = __builtin_amdgcn_readfirstlane(tid >> 6);
    int h, qcol, kcol, vcol, ocol;
    if (MODE == 0) { h = vh >> 2; const int m = (vh >> 1) & 1, half = vh & 1; qcol = h * 128 + m * 64; kcol = 512 + h * 128 + m * 64; vcol = 1024 + h * 128 + half * 64; ocol = (h * 2 + m) * 128 + half * 64; }
    else { h = vh; qcol = h * 64; kcol = 1024 + h * 64; vcol = 2048 + h * 64; ocol = h * 64; }
    const long rowbase = (long)b * T; const int q0 = qb * QB;
    const bf16_t* Qw = P.proj + (rowbase + q0 + wid * QBLK) * PITCH + qcol;
    const bf16_t* Kh = P.proj + rowbase * PITCH + kcol; const bf16_t* Vh = P.proj + rowbase * PITCH + vcol;
    const unsigned lds0 = (unsigned)(uintptr_t)shm;
    float* wsf = (float*)(shm + LDS_WS) + wid * 64;
    const unsigned kvoff = (unsigned)(lane * PITCH + wid * 8) * 2u;
    const unsigned vvoff = (unsigned)((16 * (wid & 3) + (lane >> 2)) * PITCH + (wid >> 2) * 32 + (lane & 3) * 8) * 2u;
    const bf16_t* k8h = (MODE == 1) ? P.kb8 + (long)(b * 16 + h) * T * 8 : nullptr; const unsigned k8voff = (unsigned)lane * 16u;
    const unsigned kdst = lds0 + LDS_K + wid * 1024, vdst = lds0 + LDS_V + wid * 1024, k8dst = lds0 + LDS_K + 8192;
#define DMA_K(t, slot) do { glds16(Kh + (long)(t) * KVBLK * PITCH, kvoff, (unsigned)__builtin_amdgcn_readfirstlane(kdst + (slot))); \
        if (MODE == 1 && wid == 0) glds16(k8h + (long)(t) * KVBLK * 8, k8voff, (unsigned)__builtin_amdgcn_readfirstlane(k8dst + (slot))); } while (0)
#define DMA_V(t, slot) glds16(Vh + (long)(t) * KVBLK * PITCH, vvoff, (unsigned)__builtin_amdgcn_readfirstlane(vdst + (slot)))
#define WAIT2(N0, N1) do { if (MODE == 1 && wid == 0) { WAIT_BAR(N1); } else { WAIT_BAR(N0); } } while (0)
    const int vb0 = (int)(lds0 + LDS_V) + ((lane >> 4) & 1) * 32 + (lane & 3) * 8 + (4 * hi + ((lane & 15) >> 2)) * 64;
    constexpr int NKF = (MODE == 1) ? 10 : 8;
    bf16x8 kf[NKF];
    const lds_cptr shm3 = (lds_cptr)shm; const lds_cptr kp0 = shm3 + LDS_K + hi * 1024 + r32 * 16; const lds_cptr kp8 = shm3 + LDS_K + 8192 + r32 * 16;
    const lds_cptr vp0 = shm3 + LDS_V + ((lane >> 4) & 1) * 32 + (lane & 3) * 8 + (4 * hi + ((lane & 15) >> 2)) * 64;
    const int NT = (q0 + QB) / KVBLK;
    DMA_K(0, 0); DMA_V(0, 0); DMA_K(1, SLOTB);
    constexpr int NQR = (MODE == 1) ? 5 : 4;
    bf16x8 qr[NQR];
#pragma unroll
    for (int d0 = 0; d0 < 4; ++d0) qr[d0] = *reinterpret_cast<const bf16x8*>(&Qw[(long)r32 * PITCH + d0 * 16 + hi * 8]);
    const int qrel = wid * QBLK + r32;
    if (MODE == 1) {
        const float c = P.cum2[(long)(b * 16 + h) * T + q0 + qrel];
        const unsigned ch = f2bf(c); const float r1 = c - __builtin_bit_cast(float, ch << 16); const unsigned cm = f2bf(r1); const float r2 = r1 - __builtin_bit_cast(float, cm << 16); const unsigned cl = f2bf(r2);
        u32x4 w; w.x = ch | (cm << 16); w.y = cl | (0x3f80u << 16); w.z = 0x3f80u | (0x3f80u << 16); w.w = 0u;
        if (hi) w = (u32x4){0u, 0u, 0u, 0u};
        qr[NQR - 1] = __builtin_bit_cast(bf16x8, w);
    }
    float mhat = 0.f, l_reg = 0.f; f32x16 o[2]; o[0] = f32x16{}; o[1] = f32x16{}; const f32x16 zero16 = f32x16{}; f32x2 mh2 = {0.f, 0.f};
    const float* tblo = (const float*)(shm + LDS_TB) + (q0 + qrel - 4 * hi - 63 + T5PAD);
#define CMASK(P0, P1, t) do { int jb_ = (t) - (NT - 4); if (jb_ >= 0) cmask(P0, P1, jb_, qrel, hi); } while (0)
#ifndef MK_NOBIAS
#define MK_NOBIAS 0
#endif
#define BIAS(P0, P1, t) do { if (MODE == 0 && !MK_NOBIAS) { const float* tb_ = tblo - 64 * (t); \
        _Pragma("unroll") for (int r = 0; r < 16; ++r) { const int kv0_ = (r & 3) + 8 * (r >> 2); P0[r] += tb_[63 - kv0_]; P1[r] += tb_[31 - kv0_]; } } } while (0)
    bool resc = false;
#define RESC() do { if (resc) { asm volatile("s_waitcnt lgkmcnt(0)" ::: "memory"); \
      _Pragma("unroll") for (int d_ = 0; d_ < 2; ++d_) _Pragma("unroll") for (int r = 0; r < 16; ++r) o[d_][r] *= wsf[crow(r, hi)]; } } while (0)
    f32x16 cA, cB;
    u32x4 pwa0, pwa1, pwa2, pwa3, pwb0, pwb1, pwb2, pwb3;
    int sl_prev = 0, sl_cur = 0, sl_next = SLOTB;
#define ROT() do { sl_prev = sl_cur; sl_cur = sl_next; sl_next = (sl_next == (NSLOT - 1) * SLOTB) ? 0 : sl_next + SLOTB; } while (0)
    DMA_K(2, 2 * SLOTB);
    WAIT2(3, 5);
    { const char* kb = shm + LDS_K + hi * 1024 + r32 * 16;
#pragma unroll
      for (int d0 = 0; d0 < 4; ++d0) {
          const bf16x8 b0 = *reinterpret_cast<const bf16x8*>(kb + d0 * 2048);
          const bf16x8 b1 = *reinterpret_cast<const bf16x8*>(kb + d0 * 2048 + 512);
          if (d0 == 0) { cA = __builtin_amdgcn_mfma_f32_32x32x16_bf16(b0, qr[0], zero16, 0, 0, 0); cB = __builtin_amdgcn_mfma_f32_32x32x16_bf16(b1, qr[0], zero16, 0, 0, 0); }
          else { cA = __builtin_amdgcn_mfma_f32_32x32x16_bf16(b0, qr[d0], cA, 0, 0, 0); cB = __builtin_amdgcn_mfma_f32_32x32x16_bf16(b1, qr[d0], cB, 0, 0, 0); } }
      if (MODE == 1) { const char* k8 = shm + LDS_K + 8192 + r32 * 16;
          const bf16x8 b0 = *reinterpret_cast<const bf16x8*>(k8); const bf16x8 b1 = *reinterpret_cast<const bf16x8*>(k8 + 512);
          cA = __builtin_amdgcn_mfma_f32_32x32x16_bf16(b0, qr[NQR - 1], cA, 0, 0, 0); cB = __builtin_amdgcn_mfma_f32_32x32x16_bf16(b1, qr[NQR - 1], cB, 0, 0, 0); } }
    asm volatile("s_nop 15\n\ts_nop 7" : "+v"(cA), "+v"(cB));
#ifndef MK_NOBIAS0
#define MK_NOBIAS0 0
#endif
    if (MODE == 0 && NT <= 28 && !MK_NOBIAS0) BIAS(cA, cB, 0);
    CMASK(cA, cB, 0);
#define PKW(P, B) cvtpk_s(P[B], P[B + 1])
    { mhat = rowmax(cA, cB); mh2 = (f32x2){mhat, mhat}; float sacc = 0.f;
      _Pragma("unroll") for (int r = 0; r < 16; ++r) { cA[r] = __builtin_amdgcn_exp2f(fsub_s(cA[r], mhat)); cB[r] = __builtin_amdgcn_exp2f(fsub_s(cB[r], mhat)); }
      _Pragma("unroll") for (int r = 0; r < 16; ++r) sacc += cA[r] + cB[r];
      l_reg = sacc;
      pwa0 = (u32x4){PKW(cA, 0), PKW(cA, 2), PKW(cA, 4), PKW(cA, 6)}; pwa1 = (u32x4){PKW(cA, 8), PKW(cA, 10), PKW(cA, 12), PKW(cA, 14)};
      pwa2 = (u32x4){PKW(cB, 0), PKW(cB, 2), PKW(cB, 4), PKW(cB, 6)}; pwa3 = (u32x4){PKW(cB, 8), PKW(cB, 10), PKW(cB, 12), PKW(cB, 14)}; }
    WAIT_BAR(0);
    DMA_K(3, 0); DMA_V(1, SLOTB);
    ROT();
#pragma unroll
    for (int j = 0; j < 4; ++j) kload2(kf, kp0 + sl_cur, j);
    if (MODE == 1) { kf[8] = *(const LAS bf16x8*)(kp8 + sl_cur); kf[9] = *(const LAS bf16x8*)(kp8 + sl_cur + 512); }
    WAIT2(2, 3);
    s16x4 vlo[8], vhi[8];
#define PAF(PW, k) __builtin_bit_cast(bf16x8, PW##k)
#define VFR(i) (bf16x8){vlo[i][0], vlo[i][1], vlo[i][2], vlo[i][3], vhi[i][0], vhi[i][1], vhi[i][2], vhi[i][3]}
#define PIN(x) asm volatile("" : "+v"(x))
#define MX3(a, b, c) __builtin_fmaxf(__builtin_fmaxf((a), (b)), (c))
#define GAPA(MF) do { MF; SBAR(); } while (0)
#define EX(v) __builtin_amdgcn_exp2f(v)
#define GAPB(MF, X, B, PW, I) do { MF; { f32x2 a_ = {X[B], X[B + 1]}, b_ = {X[B + 2], X[B + 3]}; a_ -= mh2; b_ -= mh2; const float e0_ = EX(a_.x), e1_ = EX(a_.y), e2_ = EX(b_.x), e3_ = EX(b_.y); \
        sacc += e0_; sacc += e1_; sacc += e2_; sacc += e3_; PW[I] = cvtpk_s(e0_, e1_); PW[I + 1] = cvtpk_s(e2_, e3_); } PIN(PW); PIN(sacc); SBAR(); } while (0)
#define VRD(i) do { vlo[i] = vtr(vp_ + (((i) >> 2) * 4096 + ((i) & 3) * 1024)); vhi[i] = vtr(vp_ + (((i) >> 2) * 4096 + ((i) & 3) * 1024 + 512)); } while (0)
#define KRD(G, j) do { if (G) { kload2(kf, kp0 + sl_next, j); SBAR(); } } while (0)
#define KRD8(G) do { if (MODE == 1 && (G)) { kf[NKF - 2] = *(const LAS bf16x8*)(kp8 + sl_next); kf[NKF - 1] = *(const LAS bf16x8*)(kp8 + sl_next + 512); SBAR(); } } while (0)
#define STEP(PWC, PWN, t, GK, GV, GL, GBIAS) do { SBAR(); \
    const lds_cptr vp_ = vp0 + sl_prev; \
    VRD(0); SBAR(); GAPA(cA = __builtin_amdgcn_mfma_f32_32x32x16_bf16(kf[0], qr[0], zero16, 0, 0, 0)); \
    VRD(4); SBAR(); GAPA(cB = __builtin_amdgcn_mfma_f32_32x32x16_bf16(kf[1], qr[0], zero16, 0, 0, 0)); \
    VRD(1); SBAR(); GAPA(cA = __builtin_amdgcn_mfma_f32_32x32x16_bf16(kf[2], qr[1], cA, 0, 0, 0)); \
    VRD(5); SBAR(); GAPA(cB = __builtin_amdgcn_mfma_f32_32x32x16_bf16(kf[3], qr[1], cB, 0, 0, 0)); \
    VRD(2); SBAR(); GAPA(cA = __builtin_amdgcn_mfma_f32_32x32x16_bf16(kf[4], qr[2], cA, 0, 0, 0)); \
    VRD(6); SBAR(); GAPA(cB = __builtin_amdgcn_mfma_f32_32x32x16_bf16(kf[5], qr[2], cB, 0, 0, 0)); \
    VRD(3); SBAR(); GAPA(cA = __builtin_amdgcn_mfma_f32_32x32x16_bf16(kf[6], qr[3], cA, 0, 0, 0)); \
    VRD(7); SBAR(); GAPA(cB = __builtin_amdgcn_mfma_f32_32x32x16_bf16(kf[7], qr[3], cB, 0, 0, 0)); \
    if (MODE == 1) { cA = __builtin_amdgcn_mfma_f32_32x32x16_bf16(kf[NKF - 2], qr[NQR - 1], cA, 0, 0, 0); cB = __builtin_amdgcn_mfma_f32_32x32x16_bf16(kf[NKF - 1], qr[NQR - 1], cB, 0, 0, 0); SBAR(); } \
    if (GK) { DMA_K((t) + 3, sl_cur); } if (GV) { DMA_V((t) + 1, sl_next); } \
    if (GBIAS) { BIAS(cA, cB, t); } \
    CMASK(cA, cB, t); \
    { float a = MX3(cA[0], cA[1], cB[0]), b = MX3(cA[2], cA[3], cB[1]); a = MX3(a, cB[2], cB[3]); \
      _Pragma("unroll") for (int r = 4; r < 16; r += 4) { a = MX3(a, cA[r], cA[r + 1]); b = MX3(b, cA[r + 2], cA[r + 3]); a = MX3(a, cB[r], cB[r + 1]); b = MX3(b, cB[r + 2], cB[r + 3]); } \
      float rm = __builtin_fmaxf(a, b); { auto rr = __builtin_amdgcn_permlane32_swap(__float_as_uint(rm), __float_as_uint(rm), false, false); rm = __builtin_fmaxf(__uint_as_float(rr[0]), __uint_as_float(rr[1])); } \
      rm -= mhat; resc = false; \
      if (__builtin_expect(__any(rm > (float)THRL), 0)) { const float dl = __builtin_fmaxf(rm, 0.f); mhat += dl; mh2 = (f32x2){mhat, mhat}; \
        const float f = __builtin_amdgcn_exp2f(-dl); l_reg *= f; if (hi == 0) wsf[r32] = f; resc = true; } } \
    SBAR(); \
    float sacc = 0.f; \
    GAPB(o[0] = __builtin_amdgcn_mfma_f32_32x32x16_bf16(PAF(PWC, 0), VFR(0), o[0], 0, 0, 0), cA, 0, PWN##0, 0); \
    GAPB(o[1] = __builtin_amdgcn_mfma_f32_32x32x16_bf16(PAF(PWC, 0), VFR(4), o[1], 0, 0, 0), cA, 4, PWN##0, 2); \
    KRD(GL, 0); GAPB(o[0] = __builtin_amdgcn_mfma_f32_32x32x16_bf16(PAF(PWC, 1), VFR(1), o[0], 0, 0, 0), cA, 8, PWN##1, 0); \
    KRD(GL, 1); GAPB(o[1] = __builtin_amdgcn_mfma_f32_32x32x16_bf16(PAF(PWC, 1), VFR(5), o[1], 0, 0, 0), cA, 12, PWN##1, 2); \
    KRD(GL, 2); GAPB(o[0] = __builtin_amdgcn_mfma_f32_32x32x16_bf16(PAF(PWC, 2), VFR(2), o[0], 0, 0, 0), cB, 0, PWN##2, 0); \
    KRD(GL, 3); GAPB(o[1] = __builtin_amdgcn_mfma_f32_32x32x16_bf16(PAF(PWC, 2), VFR(6), o[1], 0, 0, 0), cB, 4, PWN##2, 2); \
    KRD8(GL); GAPB(o[0] = __builtin_amdgcn_mfma_f32_32x32x16_bf16(PAF(PWC, 3), VFR(3), o[0], 0, 0, 0), cB, 8, PWN##3, 0); \
    GAPB(o[1] = __builtin_amdgcn_mfma_f32_32x32x16_bf16(PAF(PWC, 3), VFR(7), o[1], 0, 0, 0), cB, 12, PWN##3, 2); \
    l_reg += sacc; \
    } while (0)
    int t = 1;
#undef CMASK
#define CMASK(P0, P1, t) do { } while (0)
    for (; t + 5 < NT && (MODE != 0 || NT > 28); t += 2) {
        STEP(pwa, pwb, t, true, true, true, (MODE == 0 && t + 28 >= NT));     WAIT2(2, 3); RESC(); ROT();
        STEP(pwb, pwa, t + 1, true, true, true, (MODE == 0 && t + 29 >= NT)); WAIT2(2, 3); RESC(); ROT();
    }
#undef CMASK
#define CMASK(P0, P1, t) do { int jb_ = (t) - (NT - 4); if (jb_ >= 0) cmask(P0, P1, jb_, qrel, hi); } while (0)
#define ENDW(tt) do { if ((tt) + 3 < NT) { WAIT2(2, 3); } else if ((tt) + 2 < NT) { WAIT_BAR(1); } else { WAIT_BAR(0); } } while (0)
    for (; t + 1 < NT; t += 2) {
        STEP(pwa, pwb, t, (t + 3 < NT), (t + 1 < NT), (t + 1 < NT), (MODE == 0));         ENDW(t);     RESC(); ROT();
        STEP(pwb, pwa, t + 1, (t + 4 < NT), (t + 2 < NT), (t + 2 < NT), (MODE == 0));     ENDW(t + 1); RESC(); ROT();
    }
    STEP(pwa, pwb, NT - 1, false, false, false, (MODE == 0)); RESC();
    SBAR(); pv(o, vb0 + sl_cur, PAF(pwb, 0), PAF(pwb, 1), PAF(pwb, 2), PAF(pwb, 3));
#undef PKW
#undef PAF
#undef VFR
#undef PIN
#undef MX3
#undef GAPA
#undef GAPB
#undef EX
#undef VRD
#undef KRD
#undef KRD8
#undef STEP
#undef ENDW
    { auto rr = __builtin_amdgcn_permlane32_swap(__float_as_uint(l_reg), __float_as_uint(l_reg), false, false); l_reg = __uint_as_float(rr[0]) + __uint_as_float(rr[1]); }
    if (hi == 0) wsf[32 + r32] = l_reg; asm volatile("s_waitcnt lgkmcnt(0)" ::: "memory");
    float rli[16];
#pragma unroll
    for (int r = 0; r < 16; ++r) rli[r] = __builtin_amdgcn_rcpf(wsf[32 + crow(r, hi)]);
    bf16_t* Ow = P.out + (rowbase + q0 + wid * QBLK) * 1024 + ocol;
    { bf16_t* stg = (bf16_t*)(shm + LDS_OST) + wid * 2048;
#pragma unroll
      for (int r = 0; r < 16; ++r) { const int orow = crow(r, hi);
#pragma unroll
          for (int d0 = 0; d0 < 2; ++d0) stg[orow * 64 + d0 * 32 + r32] = (bf16_t)f2bf(o[d0][r] * rli[r]); }
      asm volatile("s_waitcnt lgkmcnt(0)" ::: "memory");
#pragma unroll
      for (int i = 0; i < 4; ++i) { const int row = i * 8 + (lane >> 3), ch = lane & 7; u32x4 v = *(const u32x4*)(stg + row * 64 + ch * 8);
          if (MODE == 1) {
              const u32x4 g = *(const u32x4*)(P.proj + (rowbase + q0 + wid * QBLK + row) * PITCH + 3072 + h * 64 + ch * 8);
              u32x4 w;
#pragma unroll
              for (int j = 0; j < 4; ++j) { const float a0 = bflo(v[j]) * sigmoid_f(bflo(g[j])), a1 = bfhi(v[j]) * sigmoid_f(bfhi(g[j])); w[j] = pk2(a0, a1); }
              v = w; }
          *(u32x4*)(Ow + (long)row * 1024 + ch * 8) = v; } }
    asm volatile("s_waitcnt lgkmcnt(0)\n\ts_barrier" ::: "memory");
#undef DMA_K
#undef DMA_V
#undef WAIT2
#undef CMASK
#undef BIAS
#undef RESC
#undef ROT
}

#ifndef MK_THRL
#define MK_THRL 8
#endif
template <int MODE>
__device__ __forceinline__ void attn_phase(char* lds, const AttnP& P, unsigned* queues  , unsigned xcc, const int tid) {
    volatile LAS int* uw = (volatile LAS int*)(LAS char*)(lds + LDS_UNIT); int cur_h = -1;
    for (int k = 0; k < 8; ++k) {
#if defined(MK_STATIC_Q)
        const int qx = (int)((blockIdx.x + (unsigned)k) & 7u); int it_ = 0;
#else
        const int qx = (int)((xcc + (unsigned)k) & 7u);
#endif
        for (;;) {
#if defined(MK_STATIC_Q)
            if (tid == 0) { uw[0] = (k == 0 && (int)blockIdx.x / 8 + 32 * it_ < 4 * NQB && qx == (int)(blockIdx.x & 7)) ? (int)blockIdx.x / 8 + 32 * it_ : 4 * NQB; } ++it_;
#else
            if (tid == 0) uw[0] = (int)__hip_atomic_fetch_add(queues + 64 * qx, 1u, RLX_AGENT);
#endif
            __syncthreads();
            const int e = __builtin_amdgcn_readfirstlane(uw[0]);
            __syncthreads();
            if (e >= 4 * NQB) break;
            const int bvh = 4 * qx + (e & 3), qb = NQB - 1 - (e >> 2);
#ifndef MK_T5RELOAD
#define MK_T5RELOAD 0
#endif
            if (MODE == 0 && (MK_T5RELOAD || ((bvh & 15) >> 2) != cur_h)) {
                cur_h = (bvh & 15) >> 2;
                LAS float* tb = (LAS float*)(LAS char*)(lds + LDS_TB) + tid; const GAS float* src = (const GAS float*)P.t5tab + (size_t)cur_h * T5N + tid; asm volatile("" : "+v"(tb), "+v"(src));
#pragma unroll
                for (int it = 0; it < (T5N + NTHR - 1) / NTHR; ++it) if (tid + NTHR * it < T5N) tb[NTHR * it] = src[NTHR * it];
                __syncthreads();
            }
            attn_unit<MODE, MK_THRL>(P, bvh >> 4, bvh & 15, qb, lds, tid);
        }
    }
}
#undef SBAR
#undef WAIT_BAR
}
struct Args { const float* in[24]; float* out; unsigned char* ws; const float* dbg_src; int lo, hi, bar_region, dbg_layer0; };
static_assert(sizeof(Args) == 27 * 8 + 16, "Args has padding");
template <int K_> __device__ __forceinline__ const float* inptr() {
#if defined(__HIP_DEVICE_COMPILE__)
    auto ka = __builtin_amdgcn_kernarg_segment_ptr(); const GAS float* p;
    asm volatile("s_load_dwordx2 %0, %1, %2\n\ts_waitcnt lgkmcnt(0)" : "=s"(p) : "s"(ka), "i"(K_ * 8)); return (const float*)p;
#else
    return nullptr;
#endif
}
#define INP(k) inptr<k>()
struct Frame {
    LAS unsigned char* lds; char* ldsg;
    gu32* ctl; unsigned char* ws;
    int tid, lane, wave, G, gw, NGW;
    float* out;
};
__device__ __forceinline__ float wave_sum(float v) {
#pragma unroll
    for (int o = 1; o < 64; o <<= 1) v += __shfl_xor(v, o);
    return v;
}
__device__ __forceinline__ float rowmax16(float v) {
    v = fmaxf(v, __builtin_bit_cast(float, __builtin_amdgcn_update_dpp(0, __builtin_bit_cast(int, v), 0xB1, 0xF, 0xF, false)));
    v = fmaxf(v, __builtin_bit_cast(float, __builtin_amdgcn_update_dpp(0, __builtin_bit_cast(int, v), 0x4E, 0xF, 0xF, false)));
    v = fmaxf(v, __builtin_bit_cast(float, __builtin_amdgcn_update_dpp(0, __builtin_bit_cast(int, v), 0x141, 0xF, 0xF, false)));
    v = fmaxf(v, __builtin_bit_cast(float, __builtin_amdgcn_update_dpp(0, __builtin_bit_cast(int, v), 0x140, 0xF, 0xF, false)));
    return v;
}
__device__ __forceinline__ float rowsum16(float v) {
    v += __builtin_bit_cast(float, __builtin_amdgcn_update_dpp(0, __builtin_bit_cast(int, v), 0xB1, 0xF, 0xF, false));
    v += __builtin_bit_cast(float, __builtin_amdgcn_update_dpp(0, __builtin_bit_cast(int, v), 0x4E, 0xF, 0xF, false));
    v += __builtin_bit_cast(float, __builtin_amdgcn_update_dpp(0, __builtin_bit_cast(int, v), 0x141, 0xF, 0xF, false));
    v += __builtin_bit_cast(float, __builtin_amdgcn_update_dpp(0, __builtin_bit_cast(int, v), 0x140, 0xF, 0xF, false));
    return v;
}

__device__ __forceinline__ void p0_transpose_item(const float* W, int ldn, int K, bf16_t* WT, int k0, int n_src0, int n_dst0, LAS float* scr, int lane) {
#pragma unroll 8
    for (int i = 0; i < 32; ++i) { const int kk = 2 * i + (lane >> 5); scr[kk * 33 + (lane & 31)] = W[(size_t)(k0 + kk) * ldn + n_src0 + (lane & 31)]; }
    LDS_WAIT(); asm volatile("" ::: "memory");
    const int c = lane & 7;
#pragma unroll
    for (int j = 0; j < 4; ++j) { const int n = (lane >> 3) + 8 * j; const LAS float* s = scr + (8 * c) * 33 + n;
        u32x4 o; o.x = pk2(s[0 * 33], s[1 * 33]); o.y = pk2(s[2 * 33], s[3 * 33]); o.z = pk2(s[4 * 33], s[5 * 33]); o.w = pk2(s[6 * 33], s[7 * 33]);
        *(GAS u32x4*)(WT + (size_t)(n_dst0 + n) * K + k0 + 8 * c) = o; }
    LDS_WAIT(); asm volatile("" ::: "memory");
}
__device__ __forceinline__ void p0a_convert(Frame& F) {
    LAS float* scr = (LAS float*)(F.lds + F.wave * 16384);
    unsigned char* ws = F.ws;
    constexpr int I_INE = 16 * 112, I_INO = 16 * 128, I_OUT = 16 * 32, I_GU = 16 * 64, I_D = 16 * 32;
    constexpr int N_DENSE = 2 * (I_INE + I_INO + 2 * I_OUT);
    constexpr long N_MOE = 128L * (I_GU + I_D);
    for (long it = F.gw; it < N_DENSE + N_MOE; it += F.NGW) {
        long r = it;
        if (r < N_DENSE) {
            const int i = (int)(r / (N_DENSE / 2)); int q = (int)(r % (N_DENSE / 2));
            if (q < I_INE) { p0_transpose_item(INP(2) + (size_t)i * D * EVEN_IN, EVEN_IN, D, (bf16_t*)(ws + WS_WINE) + (size_t)i * 3584 * D, 64 * (q / 112), 32 * (q % 112), 32 * (q % 112), scr, F.lane); continue; } q -= I_INE;
            if (q < I_INO) { p0_transpose_item(INP(10) + (size_t)i * D * ODD_IN, ODD_IN, D, (bf16_t*)(ws + WS_WINO) + (size_t)i * 4096 * D, 64 * (q / 128), 32 * (q % 128), 32 * (q % 128), scr, F.lane); continue; } q -= I_INO;
            if (q < I_OUT) { p0_transpose_item(INP(3) + (size_t)i * D * D, D, D, (bf16_t*)(ws + WS_WOUTE) + (size_t)i * D * D, 64 * (q / 32), 32 * (q % 32), 32 * (q % 32), scr, F.lane); continue; } q -= I_OUT;
            p0_transpose_item(INP(11) + (size_t)i * D * D, D, D, (bf16_t*)(ws + WS_WOUTO) + (size_t)i * D * D, 64 * (q / 32), 32 * (q % 32), 32 * (q % 32), scr, F.lane); continue;
        }
        r -= N_DENSE;
        const int le = (int)(r / (I_GU + I_D)); int q = (int)(r % (I_GU + I_D));
        if (q < I_GU) { const int nb = q % 64, n_src = 32 * nb;
            const int cc = n_src & 1023, n_dst = (cc >> 7) * 256 + (n_src >= 1024 ? 128 : 0) + (cc & 127);
            p0_transpose_item(INP(16) + (size_t)le * D * 2048, 2048, D, (bf16_t*)(ws + WS_WGU) + (size_t)le * 2048 * D, 64 * (q / 64), n_src, n_dst, scr, F.lane); }
        else { q -= I_GU; p0_transpose_item(INP(18) + (size_t)le * DFF * D, D, DFF, (bf16_t*)(ws + WS_WD) + (size_t)le * D * DFF, 64 * (q / 32), 32 * (q % 32), 32 * (q % 32), scr, F.lane); }
    }
    for (int it = F.gw; it < 128 + 32 + 32; it += F.NGW) {
        const float* src; int ld, col; bf16_t* hi; bool zero = false;
        if (it < 128) { const int l = it >> 5, e = it & 31; src = INP(14) + (size_t)l * D * NE; ld = NE; col = e; hi = (bf16_t*)(ws + WS_RW) + ((size_t)l * 2 * 32 + e) * 1024; }
        else if (it < 160) { const int i = (it - 128) >> 4, n = (it - 128) & 15; src = INP(2) + (size_t)i * D * EVEN_IN; ld = EVEN_IN; col = 3584 + n; zero = n >= 8; hi = (bf16_t*)(ws + WS_SWE) + ((size_t)i * 2 * 16 + n) * 1024; }
        else { const int i = (it - 160) >> 4, n = (it - 160) & 15; src = INP(10) + (size_t)i * D * ODD_IN; ld = ODD_IN; col = 4096 + n; hi = (bf16_t*)(ws + WS_SWO) + ((size_t)i * 2 * 16 + n) * 1024; }
        bf16_t* lo = hi + (it < 128 ? 32 : 16) * 1024;
        for (int k = F.lane; k < D; k += 64) { const float w = zero ? 0.f : src[(size_t)k * ld + col]; const unsigned h = f2bf(w); hi[k] = (bf16_t)h; lo[k] = (bf16_t)f2bf(w - __builtin_bit_cast(float, h << 16)); }
    }
    for (int i = F.gw * 64 + F.lane; i < 4 * T5N; i += F.NGW * 64) {
        const int h = i / T5N, p = i % T5N; float v = 0.f;
        if (p >= T5PAD) { const int n = p - T5PAD; int bk = n;
            if (n >= 16) { bk = 16 + (n >= 22) + (n >= 30) + (n >= 40) + (n >= 54) + (n >= 73) + (n >= 99) + (n >= 134) + (n >= 182) + (n >= 246) + (n >= 332) + (n >= 450) + (n >= 609) + (n >= 825) + (n >= 1117) + (n >= 1513); }
            v = (INP(1)[bk * 4 + h] - INP(1)[31 * 4 + h]) * LOG2E; }
#ifdef MK_ZEROT5
        v = 0.f;
#endif
#ifdef MK_SAMET5
        if (p >= T5PAD) { const int n = p - T5PAD; int bk = n; if (n >= 16) { bk = 16 + (n >= 22) + (n >= 30) + (n >= 40) + (n >= 54) + (n >= 73) + (n >= 99) + (n >= 134) + (n >= 182) + (n >= 246) + (n >= 332) + (n >= 450) + (n >= 609) + (n >= 825) + (n >= 1117) + (n >= 1513); } v = (INP(1)[bk * 4] - INP(1)[31 * 4]) * LOG2E; }
#endif
        ((float*)(ws + WS_T5))[i] = v;
    }
}

struct Ln16 {
    const float* X; const float* H; const bf16_t* Y; float* Xout; bf16_t* XB; const float* gam; const float* bet;
    const bf16_t* Whi; const bf16_t* Wlo;
};
template <int SRC, int NS, bool WRITE_XB>
__device__ __forceinline__ void ln16_tile(const Ln16& P, int tile, int lane, const int (&pos)[4], const float (&gt)[4], f32x4 (&acc)[NS > 0 ? NS : 1]) {
    const int r = lane & 15, q = lane >> 4; const size_t m = (size_t)tile * 16 + r;
    const float* xr = P.X + m * D + 8 * q; const float* hr = (SRC == 1) ? P.H + m * D + 8 * q : nullptr;
    const bf16_t* yr[4];
    if (SRC == 2) {
#pragma unroll
        for (int k = 0; k < 4; ++k) yr[k] = P.Y + (size_t)pos[k] * D + 8 * q; }
#define LN16_LOAD(v, ks) do { const f32x4 a0 = *(const f32x4*)(xr + 32 * (ks)), a1 = *(const f32x4*)(xr + 32 * (ks) + 4); \
        if (SRC == 0) { _Pragma("unroll") for (int j = 0; j < 4; ++j) { v[j] = a0[j]; v[4 + j] = a1[j]; } } \
        else if (SRC == 1) { const f32x4 h0 = *(const f32x4*)(hr + 32 * (ks)), h1 = *(const f32x4*)(hr + 32 * (ks) + 4); _Pragma("unroll") for (int j = 0; j < 4; ++j) { v[j] = ALPHA * a0[j] + h0[j]; v[4 + j] = ALPHA * a1[j] + h1[j]; } } \
        else { _Pragma("unroll") for (int j = 0; j < 4; ++j) { v[j] = ALPHA * a0[j]; v[4 + j] = ALPHA * a1[j]; } \
            _Pragma("unroll") for (int k = 0; k < 4; ++k) { const u32x4 y = *(const u32x4*)(yr[k] + 32 * (ks)); _Pragma("unroll") for (int j = 0; j < 4; ++j) { v[2 * j] = fmaf(gt[k], bflo(y[j]), v[2 * j]); v[2 * j + 1] = fmaf(gt[k], bfhi(y[j]), v[2 * j + 1]); } } } } while (0)
    float mean = 0.f, rstd = 1.f;
    if (SRC != 0) {
        float s = 0.f, ss = 0.f;
#pragma unroll 4
        for (int ks = 0; ks < 32; ++ks) { float v[8]; LN16_LOAD(v, ks);
#pragma unroll
            for (int j = 0; j < 8; ++j) { s += v[j]; ss = fmaf(v[j], v[j], ss); } }
        s += __shfl_xor(s, 16); s += __shfl_xor(s, 32); ss += __shfl_xor(ss, 16); ss += __shfl_xor(ss, 32);
        mean = s * (1.f / D); const float var = fmaxf(ss * (1.f / D) - mean * mean, 0.f); rstd = rsqrtf(var + LN_EPS);
    }
#pragma unroll
    for (int n = 0; n < (NS > 0 ? NS : 1); ++n) acc[n] = (f32x4){0.f, 0.f, 0.f, 0.f};
#pragma unroll 2
    for (int ks = 0; ks < 32; ++ks) {
        float v[8]; LN16_LOAD(v, ks);
        if (SRC != 0) { const f32x4 g0 = *(const f32x4*)(P.gam + 32 * ks + 8 * q), g1 = *(const f32x4*)(P.gam + 32 * ks + 8 * q + 4), b0 = *(const f32x4*)(P.bet + 32 * ks + 8 * q), b1 = *(const f32x4*)(P.bet + 32 * ks + 8 * q + 4);
#pragma unroll
            for (int j = 0; j < 4; ++j) { v[j] = (v[j] - mean) * rstd * g0[j] + b0[j]; v[4 + j] = (v[4 + j] - mean) * rstd * g1[j] + b1[j]; } }
        float* xo = P.Xout + m * D + 32 * ks + 8 * q;
        *(f32x4*)xo = (f32x4){v[0], v[1], v[2], v[3]}; *(f32x4*)(xo + 4) = (f32x4){v[4], v[5], v[6], v[7]};
        u32x4 hi; hi.x = pk2(v[0], v[1]); hi.y = pk2(v[2], v[3]); hi.z = pk2(v[4], v[5]); hi.w = pk2(v[6], v[7]);
        if (WRITE_XB) *(u32x4*)(P.XB + m * D + 32 * ks + 8 * q) = hi;
        if (NS > 0) {
            u32x4 lo;
#pragma unroll
            for (int j = 0; j < 4; ++j) lo[j] = pk2(v[2 * j] - bflo(hi[j]), v[2 * j + 1] - bfhi(hi[j]));
            const bf16x8 ah = __builtin_bit_cast(bf16x8, hi), al = __builtin_bit_cast(bf16x8, lo);
#pragma unroll
            for (int n = 0; n < NS; ++n) {
                const bf16x8 bh = *(const bf16x8*)(P.Whi + (size_t)(16 * n + r) * D + 32 * ks + 8 * q), bl = *(const bf16x8*)(P.Wlo + (size_t)(16 * n + r) * D + 32 * ks + 8 * q);
                acc[n] = __builtin_amdgcn_mfma_f32_16x16x32_bf16(ah, bh, acc[n], 0, 0, 0);
                acc[n] = __builtin_amdgcn_mfma_f32_16x16x32_bf16(al, bh, acc[n], 0, 0, 0);
                acc[n] = __builtin_amdgcn_mfma_f32_16x16x32_bf16(ah, bl, acc[n], 0, 0, 0); }
        }
    }
#undef LN16_LOAD
}
__device__ __forceinline__ void smallproj_store(Frame& F, const f32x4& acc, int tile, bool next_even, const float* fb) {
    const int r = F.lane & 15, q = F.lane >> 4;
    if (next_even) {
        float* pb = (float*)(F.ws + WS_PB);
#pragma unroll
        for (int i = 0; i < 4; ++i) pb[(size_t)(tile * 16 + 4 * q + i) * 16 + r] = acc[i];
    } else {
        float* cum = (float*)(F.ws + WS_CUM); float* tsum = (float*)(F.ws + WS_TSUM);
        const int tok0 = tile * 16, b = tok0 / T, t0 = tok0 % T; const float bias = fb[r]; float s = 0.f;
#pragma unroll
        for (int i = 0; i < 4; ++i) { const float lf = -softplus_f(-(acc[i] + bias)); cum[(size_t)(b * 16 + r) * T + t0 + 4 * q + i] = lf; s += lf; }
        s += __shfl_xor(s, 16); s += __shfl_xor(s, 32);
        if (q == 0) tsum[(size_t)(b * 16 + r) * 1024 + (t0 >> 4)] = s;
    }
}

__device__ __forceinline__ void p0b_input(Frame& F) {
    Ln16 P{INP(0), nullptr, nullptr, (float*)(F.ws + WS_X), (bf16_t*)(F.ws + WS_XB), nullptr, nullptr, (const bf16_t*)(F.ws + WS_SWE), (const bf16_t*)(F.ws + WS_SWE) + 16 * 1024};
    const int pos[4] = {0, 0, 0, 0}; const float gt[4] = {0.f, 0.f, 0.f, 0.f};
    for (int tile = F.gw; tile < NTOK / 16; tile += F.NGW) { f32x4 acc[1]; ln16_tile<0, 1, true>(P, tile, F.lane, pos, gt, acc); smallproj_store(F, acc[0], tile, true, nullptr); }
}

__device__ __forceinline__ void ln_router_phase(Frame& F, int layer) {
    volatile LAS int* wcnt = (volatile LAS int*)(F.lds + 0); volatile LAS int* gbase = (volatile LAS int*)(F.lds + 128);
    Ln16 P{(const float*)(F.ws + WS_X), (const float*)(F.ws + WS_H), nullptr, (float*)(F.ws + WS_X), (bf16_t*)(F.ws + WS_XB), INP(20) + layer * D, INP(21) + layer * D,
           (const bf16_t*)(F.ws + WS_RW) + (size_t)layer * 2 * 32 * 1024, (const bf16_t*)(F.ws + WS_RW) + (size_t)layer * 2 * 32 * 1024 + 32 * 1024};
    const float* rb = INP(15) + layer * NE;
    int* sele = (int*)(F.ws + WS_SELE); int* slot_o = (int*)(F.ws + WS_SLOT); float* gate_o = (float*)(F.ws + WS_GATE); int* list = (int*)(F.ws + WS_LIST);
    unsigned* gcnt = (unsigned*)(F.ctl + CW_CNT + layer * NE);
    const int pos[4] = {0, 0, 0, 0}; const float gt[4] = {0.f, 0.f, 0.f, 0.f};
    const int r = F.lane & 15, q = F.lane >> 4;
    for (int wt = blockIdx.x; wt < NTOK / 128; wt += F.G) {
        if (F.tid < 32) wcnt[F.tid] = 0;
        __syncthreads();
        const int tile = wt * 8 + F.wave;
        f32x4 acc[2]; ln16_tile<1, 2, true>(P, tile, F.lane, pos, gt, acc);
        const float b0 = rb[r], b1 = rb[16 + r];
        float top[4][4];
#pragma unroll
        for (int i = 0; i < 4; ++i) {
            float a = __builtin_bit_cast(float, (__builtin_bit_cast(unsigned, acc[0][i] + b0) & ~31u) | (unsigned)r);
            float b = __builtin_bit_cast(float, (__builtin_bit_cast(unsigned, acc[1][i] + b1) & ~31u) | (unsigned)(16 + r));
#pragma unroll
            for (int k = 0; k < 4; ++k) { const float mx = rowmax16(fmaxf(a, b)); top[i][k] = mx; if (a == mx) a = -INFINITY; if (b == mx) b = -INFINITY; }
        }
        float tv[4];
#pragma unroll
        for (int k = 0; k < 4; ++k) { const int i = r >> 2; tv[k] = i == 0 ? top[0][k] : i == 1 ? top[1][k] : i == 2 ? top[2][k] : top[3][k]; }
        float w[4], ws_ = 0.f;
#pragma unroll
        for (int k = 0; k < 4; ++k) { w[k] = __expf(tv[k] - tv[0]); ws_ += w[k]; }
        const int kk = r & 3; const float mine = kk == 0 ? tv[0] : kk == 1 ? tv[1] : kk == 2 ? tv[2] : tv[3]; const float gmine = (kk == 0 ? w[0] : kk == 1 ? w[1] : kk == 2 ? w[2] : w[3]) / ws_;
        const int e = (int)(__builtin_bit_cast(unsigned, mine) & 31u);
        const int local = __hip_atomic_fetch_add((LAS int*)(wcnt + e), 1, __ATOMIC_RELAXED, __HIP_MEMORY_SCOPE_WORKGROUP);
        __syncthreads();
        if (F.tid < 32) gbase[F.tid] = (int)__hip_atomic_fetch_add(gcnt + F.tid, (unsigned)wcnt[F.tid], RLX_AGENT);
        __syncthreads();
        const int tok = tile * 16 + 4 * q + (r >> 2); const int sl = gbase[e] + local;
        sele[tok * 4 + kk] = e; slot_o[tok * 4 + kk] = sl; gate_o[tok * 4 + kk] = gmine; list[(size_t)e * NTOK + sl] = tok * 4 + kk;
        __syncthreads();
    }
}

__device__ __forceinline__ void moe_tables(Frame& F, int layer) {
    volatile LAS int* cnt = (volatile LAS int*)(F.lds + RING_BYTES); volatile LAS int* offp = cnt + 32;
    if (F.tid < 64) {
        const int c = F.lane < 32 ? (int)__hip_atomic_load((unsigned*)(F.ctl + CW_CNT + layer * NE + (F.lane & 31)), RLX_AGENT) : 0;
        int p = ((c + 255) >> 8) << 8;
#pragma unroll
        for (int o = 1; o < 32; o <<= 1) { const int n = __shfl_up(p, o); if ((F.lane & 31) >= o) p += n; }
        if (F.lane < 32) { cnt[F.lane] = c; offp[F.lane] = p - (((c + 255) >> 8) << 8); }
    }
    __syncthreads();
}

__device__ __forceinline__ void moe_out_phase(Frame& F, int layer) {
    volatile LAS int* offp = (volatile LAS int*)(F.lds + RING_BYTES) + 32;
    const bool lastl = layer == 3, next_even = (layer & 1) == 1; const int ni = (layer + 1) >> 1;
    const bf16_t* sw = next_even ? (const bf16_t*)(F.ws + WS_SWE) + (size_t)ni * 2 * 16 * 1024 : (const bf16_t*)(F.ws + WS_SWO) + (size_t)ni * 2 * 16 * 1024;
    Ln16 P{(const float*)(F.ws + WS_X), nullptr, (const bf16_t*)(F.ws + WS_Y), lastl ? F.out : (float*)(F.ws + WS_X), (bf16_t*)(F.ws + WS_XB), INP(22) + layer * D, INP(23) + layer * D, sw, sw + 16 * 1024};
    const int* sele = (const int*)(F.ws + WS_SELE); const int* slot = (const int*)(F.ws + WS_SLOT); const float* gate = (const float*)(F.ws + WS_GATE);
    const float* fb = INP(13) + (lastl ? 0 : ni * 16);
    for (int tile = F.gw; tile < NTOK / 16; tile += F.NGW) {
        const int m = tile * 16 + (F.lane & 15); int pos[4]; float gt[4];
#pragma unroll
        for (int k = 0; k < 4; ++k) { pos[k] = offp[sele[m * 4 + k]] + slot[m * 4 + k]; gt[k] = gate[m * 4 + k]; }
        f32x4 acc[1];
        if (lastl) ln16_tile<2, 0, false>(P, tile, F.lane, pos, gt, acc);
        else { ln16_tile<2, 1, true>(P, tile, F.lane, pos, gt, acc); smallproj_store(F, acc[0], tile, next_even, fb); }
    }
}

__device__ __forceinline__ void odd_prep_phase(Frame& F, int li) {
    float* cum = (float*)(F.ws + WS_CUM); const float* tsum = (const float*)(F.ws + WS_TSUM); bf16_t* kb8 = (bf16_t*)(F.ws + WS_KB8);
    for (int it = F.gw; it < 32 * 64; it += F.NGW) {
        const int bh = it >> 6, seg = it & 63;
        double base = 0.0;
        for (int j = F.lane; j < 16 * seg; j += 64) base += (double)tsum[(size_t)bh * 1024 + j];
#pragma unroll
        for (int o = 1; o < 64; o <<= 1) base += __shfl_xor(base, o);
        float* p = cum + (size_t)bh * T + seg * 256 + 4 * F.lane;
        const f32x4 lf = *(const f32x4*)p;
        float c0 = lf[0], c1 = c0 + lf[1], c2 = c1 + lf[2], c3 = c2 + lf[3];
        float incl = c3;
#pragma unroll
        for (int o = 1; o < 64; o <<= 1) { const float n = __shfl_up(incl, o); if (F.lane >= o) incl += n; }
        const float excl = incl - c3; const float bs = (float)base + excl;
        const float cc[4] = {(bs + c0) * LOG2E, (bs + c1) * LOG2E, (bs + c2) * LOG2E, (bs + c3) * LOG2E};
        *(f32x4*)p = (f32x4){cc[0], cc[1], cc[2], cc[3]};
#pragma unroll
        for (int j = 0; j < 4; ++j) { const float c = -cc[j];
            const unsigned ch = f2bf(c); const float r1 = c - __builtin_bit_cast(float, ch << 16); const unsigned cm = f2bf(r1); const float r2 = r1 - __builtin_bit_cast(float, cm << 16); const unsigned cl = f2bf(r2);
            u32x4 w; w.x = 0x3f80u | (0x3f80u << 16); w.y = 0x3f80u | (ch << 16); w.z = cm | (cl << 16); w.w = 0u;
            *(u32x4*)(kb8 + ((size_t)bh * T + seg * 256 + 4 * F.lane + j) * 8) = w; }
    }
    bf16_t* proj = (bf16_t*)(F.ws + WS_PROJ); const float* nw = INP(12) + li * 128;
    float wq[16], wk[16];
#pragma unroll
    for (int j = 0; j < 16; ++j) { wq[j] = nw[(F.lane & 3) * 16 + j] * C2; wk[j] = nw[64 + (F.lane & 3) * 16 + j]; }
    for (int tok = F.gw; tok < NTOK; tok += F.NGW) {
#pragma unroll
        for (int which = 0; which < 2; ++which) {
            bf16_t* p = proj + (size_t)tok * PITCH + which * 1024 + 16 * F.lane;
            const u32x4 a = *(const u32x4*)p, b = *(const u32x4*)(p + 8);
            float v[16];
#pragma unroll
            for (int j = 0; j < 4; ++j) { v[2 * j] = bflo(a[j]); v[2 * j + 1] = bfhi(a[j]); v[8 + 2 * j] = bflo(b[j]); v[8 + 2 * j + 1] = bfhi(b[j]); }
            float ss = 0.f;
#pragma unroll
            for (int j = 0; j < 16; ++j) ss = fmaf(v[j], v[j], ss);
            ss += __shfl_xor(ss, 1); ss += __shfl_xor(ss, 2);
            const float rr = rsqrtf(ss * (1.f / 64.f) + RMS_EPS);
            u32x4 oa, ob;
#pragma unroll
            for (int j = 0; j < 4; ++j) { oa[j] = pk2(v[2 * j] * rr * (which ? wk[2 * j] : wq[2 * j]), v[2 * j + 1] * rr * (which ? wk[2 * j + 1] : wq[2 * j + 1]));
                ob[j] = pk2(v[8 + 2 * j] * rr * (which ? wk[8 + 2 * j] : wq[8 + 2 * j]), v[8 + 2 * j + 1] * rr * (which ? wk[8 + 2 * j + 1] : wq[8 + 2 * j + 1])); }
            *(u32x4*)p = oa; *(u32x4*)(p + 8) = ob;
        }
    }
}

__device__ __forceinline__ void even_combine_phase(Frame& F, int li, float lam_init) {
    const float* lp = INP(4) + li * 256;
    float a = 0.f, bsum = 0.f; { const int l = F.lane; a = lp[l] * lp[64 + l]; bsum = lp[128 + l] * lp[192 + l]; }
    a = wave_sum(a); bsum = wave_sum(bsum);
    const float lam = __expf(a) - __expf(bsum) + lam_init;
    const bf16_t* att = (const bf16_t*)(F.ws + WS_ATT); const float* go = (const float*)(F.ws + WS_GO); const bf16_t* proj = (const bf16_t*)(F.ws + WS_PROJ); bf16_t* mix = (bf16_t*)(F.ws + WS_MIX);
    const int l = F.lane, hh = l >> 4, d0 = (l & 15) * 8;
    float sw[8], gw[8];
#pragma unroll
    for (int j = 0; j < 8; ++j) { sw[j] = INP(5)[li * 128 + d0 + j] * (1.f - lam_init); gw[j] = INP(9)[li * 128 + d0 + j]; }
    for (int tok = F.gw; tok < NTOK; tok += F.NGW) {
        const u32x4 o0 = *(const u32x4*)(att + (size_t)tok * D + (hh * 2) * 128 + d0), o1 = *(const u32x4*)(att + (size_t)tok * D + (hh * 2 + 1) * 128 + d0);
        float v[8]; float ss = 0.f;
#pragma unroll
        for (int j = 0; j < 4; ++j) { v[2 * j] = bflo(o0[j]) - lam * bflo(o1[j]); v[2 * j + 1] = bfhi(o0[j]) - lam * bfhi(o1[j]); }
#pragma unroll
        for (int j = 0; j < 8; ++j) ss = fmaf(v[j], v[j], ss);
        ss = rowsum16(ss);
        float rr = rsqrtf(ss * (1.f / 128.f) + RMS_EPS);
        u32x4 w;
#pragma unroll
        for (int j = 0; j < 4; ++j) w[j] = pk2(v[2 * j] * rr * sw[2 * j], v[2 * j + 1] * rr * sw[2 * j + 1]);
        *(u32x4*)(mix + (size_t)tok * D + hh * 128 + d0) = w;
        const f32x4 g0 = *(const f32x4*)(go + (size_t)tok * 512 + hh * 128 + d0), g1 = *(const f32x4*)(go + (size_t)tok * 512 + hh * 128 + d0 + 4);
        const u32x4 z = *(const u32x4*)(proj + (size_t)tok * PITCH + 3072 + hh * 128 + d0);
        float u[8] = {g0[0], g0[1], g0[2], g0[3], g1[0], g1[1], g1[2], g1[3]};
        ss = 0.f;
#pragma unroll
        for (int j = 0; j < 8; ++j) ss = fmaf(u[j], u[j], ss);
        ss = rowsum16(ss);
        rr = rsqrtf(ss * (1.f / 128.f) + RMS_EPS);
#pragma unroll
        for (int j = 0; j < 4; ++j) { const float z0 = bflo(z[j]), z1 = bfhi(z[j]); w[j] = pk2(u[2 * j] * rr * gw[2 * j] * (z0 * sigmoid_f(z0)), u[2 * j + 1] * rr * gw[2 * j + 1] * (z1 * sigmoid_f(z1))); }
        *(u32x4*)(mix + (size_t)tok * D + 512 + hh * 128 + d0) = w;
    }
}
constexpr int GP_W = 136, GP_K = 72;
constexpr int GB_W = 64 * GP_W * 2, GB_QK = 64 * GP_K * 2, GB_KD = 128 * GP_K * 2;
constexpr int GB_ITEM = 2 * GB_W + GB_QK + GB_KD;
__device__ __forceinline__ int P32(int x) { return (x & ~31) | (((x >> 2) & 3) << 3) | (((x >> 4) & 1) << 2) | (x & 3); }

__device__ __forceinline__ void gdn_prep_phase(Frame& F, int li) {
    LAS unsigned char* L = F.lds;
    LAS bf16_t* Kn = (LAS bf16_t*)(L + 0);
    LAS bf16_t* Qn = (LAS bf16_t*)(L + 17408);
    LAS float* R = (LAS float*)(L + 34816);
    LAS float* Lm = (LAS float*)(L + 100352);
    LAS float* sc = (LAS float*)(L + 116736);
    const bf16_t* proj = (const bf16_t*)(F.ws + WS_PROJ); const float* pb = (const float*)(F.ws + WS_PB);
    const float* cw = INP(6) + (size_t)li * 4 * 1536;
    const int tid = F.tid, lane = F.lane, wave = F.wave;
    for (int item = blockIdx.x; item < 2048; item += F.G) {
        const int n = item & 255, h = (item >> 8) & 3, b = item >> 10; const int t0 = n * 64; const size_t tok0 = (size_t)b * T + t0;
        if (wave == 0) {
            const float bb = pb[(tok0 + lane) * 16 + h], ba = pb[(tok0 + lane) * 16 + 4 + h];
            const float beta = sigmoid_f(bb); const float g = -__expf(INP(7)[li * 4 + h]) * softplus_f(ba + INP(8)[li * 4 + h]);
            float gc = g;
#pragma unroll
            for (int o = 1; o < 64; o <<= 1) { const float v = __shfl_up(gc, o); if (lane >= o) gc += v; }
            sc[lane] = beta; sc[64 + lane] = gc;
        }
        __syncthreads();
        const int c = tid & 127, seg = tid >> 7;
        float yq[16], yk[16];
        {
            float w[3][4];
#pragma unroll
            for (int g = 0; g < 3; ++g)
#pragma unroll
                for (int j = 0; j < 4; ++j) w[g][j] = cw[j * 1536 + g * 512 + h * 128 + c];
            float xw[3][3];
            const bf16_t* base = proj + (tok0 + 16 * seg) * PITCH + 1536 + h * 128 + c;
#pragma unroll
            for (int j = 0; j < 3; ++j) { const bool ok = (t0 + 16 * seg - 3 + j) >= 0;
#pragma unroll
                for (int g = 0; g < 3; ++g) xw[g][j] = ok ? bf2f(base[(long)(j - 3) * PITCH + g * 512]) : 0.f; }
#pragma unroll
            for (int j = 0; j < 16; ++j) {
                float x[3];
#pragma unroll
                for (int g = 0; g < 3; ++g) x[g] = bf2f(base[(long)j * PITCH + g * 512]);
                float y[3];
#pragma unroll
                for (int g = 0; g < 3; ++g) { y[g] = w[g][0] * xw[g][0] + w[g][1] * xw[g][1] + w[g][2] * xw[g][2] + w[g][3] * x[g]; y[g] = y[g] * sigmoid_f(y[g]); xw[g][0] = xw[g][1]; xw[g][1] = xw[g][2]; xw[g][2] = x[g]; }
                yq[j] = y[0]; yk[j] = y[1]; R[(16 * seg + j) * 256 + c] = y[2] * sc[16 * seg + j];
            }
#pragma unroll
            for (int j = 0; j < 16; ++j) { const float sq = wave_sum(yq[j] * yq[j]), sk = wave_sum(yk[j] * yk[j]); if (lane == 0) { sc[128 + (wave * 16 + j) * 2] = sq; sc[128 + (wave * 16 + j) * 2 + 1] = sk; } }
        }
        __syncthreads();
        {
            const int wp = wave ^ 1;
#pragma unroll
            for (int j = 0; j < 16; ++j) { const int tk = 16 * seg + j;
                const float rq = rsqrtf(sc[128 + (wave * 16 + j) * 2] + sc[128 + (wp * 16 + j) * 2] + RMS_EPS), rk = rsqrtf(sc[128 + (wave * 16 + j) * 2 + 1] + sc[128 + (wp * 16 + j) * 2 + 1] + RMS_EPS);
                const float bt = sc[tk]; Qn[tk * GP_W + c] = (bf16_t)f2bf(yq[j] * rq); Kn[tk * GP_W + c] = (bf16_t)f2bf(yk[j] * rk); R[tk * 256 + 128 + c] = yk[j] * rk * bt * __expf(sc[64 + tk]); }
        }
        __syncthreads();
        {
            const int pq = wave >> 2, ti = (wave >> 1) & 1, tj = wave & 1, r32 = lane & 31, hi = lane >> 5;
            const LAS bf16_t* Ap = (pq ? Qn : Kn) + (32 * ti + r32) * GP_W + 8 * hi; const LAS bf16_t* Bp = Kn + (32 * tj + r32) * GP_W + 8 * hi;
            f32x16 acc = f32x16{};
#pragma unroll
            for (int ks = 0; ks < 8; ++ks) acc = __builtin_amdgcn_mfma_f32_32x32x16_bf16(*(const LAS bf16x8*)(Ap + 16 * ks), *(const LAS bf16x8*)(Bp + 16 * ks), acc, 0, 0, 0);
            const int m = 32 * tj + r32; const float gcm = sc[64 + m];
            bf16_t* gqk = (bf16_t*)(F.ws + WS_GQK) + (size_t)item * (64 * GP_K);
#pragma unroll
            for (int r = 0; r < 16; ++r) { const int cc = 32 * ti + (r & 3) + 8 * (r >> 2) + 4 * hi;
                const float dec = __expf(fminf(sc[64 + cc] - gcm, 0.f));
                if (pq == 0) Lm[cc * 64 + m] = (m < cc) ? sc[cc] * acc[r] * dec : 0.f;
                else gqk[cc * GP_K + P32(m)] = (bf16_t)f2bf((m <= cc) ? 0.08838834764831845f * acc[r] * dec : 0.f); }
        }
        __syncthreads();
        if (wave < 4) {
            float sol[64];
            LAS float* Rc = R + tid; const LAS float* Lv = Lm; asm volatile("" : "+v"(Rc), "+v"(Lv));
#pragma unroll
            for (int i = 0; i < 64; ++i) sol[i] = Rc[i * 256];
            __builtin_amdgcn_sched_barrier(0);
#pragma unroll
            for (int i = 1; i < 64; ++i) {
                float s = sol[i];
#pragma unroll
                for (int kb = 0; kb < (i + 3) / 4; ++kb) { const f32x4 l4 = *(const LAS f32x4*)(Lv + i * 64 + 4 * kb);
#pragma unroll
                    for (int u = 0; u < 4; ++u) if (4 * kb + u < i) s = fmaf(-l4[u], sol[4 * kb + u], s); }
                sol[i] = s;
                Rc[i * 256] = s;
                __builtin_amdgcn_sched_barrier(0);
            }
        } else {
            const int t2 = tid - 256; const float gl = sc[64 + 63];
            bf16_t* gqd = (bf16_t*)(F.ws + WS_GQD) + (size_t)item * (64 * GP_W); bf16_t* gkd = (bf16_t*)(F.ws + WS_GKD) + (size_t)item * (128 * GP_K);
#pragma unroll 4
            for (int it = 0; it < 32; ++it) { const int e = t2 + 256 * it; const int cc = e >> 7, dk = e & 127; const float gcc = sc[64 + cc];
                gqd[cc * GP_W + P32(dk)] = (bf16_t)f2bf(bf2f(Qn[cc * GP_W + dk]) * 0.08838834764831845f * __expf(gcc));
                gkd[dk * GP_K + P32(cc)] = (bf16_t)f2bf(bf2f(Kn[cc * GP_W + dk]) * __expf(gl - gcc)); }
            if (t2 == 0) ((float*)(F.ws + WS_GL))[item] = __expf(gl);
        }
        __syncthreads();
        {
            f32x4* gu = (f32x4*)((float*)(F.ws + WS_GU) + (size_t)item * 8192);
#pragma unroll
            for (int it = 0; it < 4; ++it) { const int e = tid + NTHR * it; const int ln = e & 63, mt = (e >> 6) & 3, w = e >> 8; const int r = ln & 15, q = ln >> 4; const int dv = 16 * w + r, c0 = 16 * mt + 4 * q;
                gu[e] = (f32x4){R[(c0 + 0) * 256 + dv], R[(c0 + 1) * 256 + dv], R[(c0 + 2) * 256 + dv], R[(c0 + 3) * 256 + dv]}; }
            bf16_t* gw = (bf16_t*)(F.ws + WS_GW) + (size_t)item * (64 * GP_W);
#pragma unroll 4
            for (int it = 0; it < 16; ++it) { const int e = tid + NTHR * it; const int cc = e >> 7, dk = e & 127; gw[cc * GP_W + P32(dk)] = (bf16_t)f2bf(R[cc * 256 + 128 + dk]); }
        }
        __syncthreads();
    }
}

__device__ __forceinline__ void gdn_scan_phase(Frame& F, int li) {
    if (blockIdx.x >= 8) return;
    const int bh = blockIdx.x, b = bh >> 2, h = bh & 3, lane = F.lane, wave = F.wave, r = lane & 15, q = lane >> 4;
    const char* const g_w = (const char*)(F.ws + WS_GW); const char* const g_qd = (const char*)(F.ws + WS_GQD); const char* const g_qk = (const char*)(F.ws + WS_GQK); const char* const g_kd = (const char*)(F.ws + WS_GKD);
    const float* gu = (const float*)(F.ws + WS_GU); const float* glp = (const float*)(F.ws + WS_GL); float* go = (float*)(F.ws + WS_GO);
    const unsigned lds0 = (unsigned)(uintptr_t)F.ldsg;
#define GDN_DMA(item_, buf_) do { _Pragma("unroll") for (int p_ = 0; p_ < 8; ++p_) { const int p = wave + 8 * p_; if (p < 61) { \
        const int arr = p < 17 ? 0 : p < 34 ? 1 : p < 43 ? 2 : 3; const int pb_ = p < 17 ? 0 : p < 34 ? 17 : p < 43 ? 34 : 43; const size_t isz = arr < 2 ? GB_W : arr == 2 ? GB_QK : GB_KD; \
        attn_body::glds16((arr == 0 ? g_w : arr == 1 ? g_qd : arr == 2 ? g_qk : g_kd) + (size_t)(item_) * isz + (size_t)(p - pb_) * 1024, (unsigned)lane * 16u, (unsigned)__builtin_amdgcn_readfirstlane(lds0 + (buf_) * GB_ITEM + p * 1024)); } } } while (0)
    f32x4 S[8];
#pragma unroll
    for (int m = 0; m < 8; ++m) S[m] = (f32x4){0.f, 0.f, 0.f, 0.f};
    const int item0 = bh * 256;
    GDN_DMA(item0, 0);
    for (int n = 0; n < 256; ++n) {
        const int item = item0 + n, buf = n & 1;
        f32x4 U[4];
#pragma unroll
        for (int mt = 0; mt < 4; ++mt) U[mt] = *(const f32x4*)(gu + (size_t)item * 8192 + ((wave * 4 + mt) * 64 + lane) * 4);
        const float gl = glp[item];
        asm volatile("s_waitcnt vmcnt(0) lgkmcnt(0)\n\ts_barrier" ::: "memory");
        if (n + 1 < 256) GDN_DMA(item + 1, buf ^ 1);
        const LAS unsigned char* Lb = F.lds + buf * GB_ITEM;
        const LAS bf16_t* Wp = (const LAS bf16_t*)Lb + r * GP_W + 8 * q; const LAS bf16_t* QDp = (const LAS bf16_t*)(Lb + GB_W) + r * GP_W + 8 * q;
        const LAS bf16_t* QKp = (const LAS bf16_t*)(Lb + 2 * GB_W) + r * GP_K + 8 * q; const LAS bf16_t* KDp = (const LAS bf16_t*)(Lb + 2 * GB_W + GB_QK) + r * GP_K + 8 * q;
        bf16x8 Sb[4];
#pragma unroll
        for (int ks = 0; ks < 4; ++ks) { u32x4 w; w.x = cvt_pk_bf16(S[2 * ks][0], S[2 * ks][1]); w.y = cvt_pk_bf16(S[2 * ks][2], S[2 * ks][3]); w.z = cvt_pk_bf16(S[2 * ks + 1][0], S[2 * ks + 1][1]); w.w = cvt_pk_bf16(S[2 * ks + 1][2], S[2 * ks + 1][3]); Sb[ks] = __builtin_bit_cast(bf16x8, w); }
        f32x4 ws_[4], O[4];
#pragma unroll
        for (int mt = 0; mt < 4; ++mt) { ws_[mt] = (f32x4){0.f, 0.f, 0.f, 0.f}; O[mt] = (f32x4){0.f, 0.f, 0.f, 0.f}; }
#pragma unroll
        for (int ks = 0; ks < 4; ++ks)
#pragma unroll
            for (int mt = 0; mt < 4; ++mt) {
                ws_[mt] = __builtin_amdgcn_mfma_f32_16x16x32_bf16(*(const LAS bf16x8*)(Wp + 16 * mt * GP_W + 32 * ks), Sb[ks], ws_[mt], 0, 0, 0);
                O[mt] = __builtin_amdgcn_mfma_f32_16x16x32_bf16(*(const LAS bf16x8*)(QDp + 16 * mt * GP_W + 32 * ks), Sb[ks], O[mt], 0, 0, 0);
                if (mt == 3) __builtin_amdgcn_sched_barrier(0); }
        bf16x8 Vb[2];
#pragma unroll
        for (int kc = 0; kc < 2; ++kc) { const f32x4 v0 = U[2 * kc] - ws_[2 * kc], v1 = U[2 * kc + 1] - ws_[2 * kc + 1];
            u32x4 w; w.x = cvt_pk_bf16(v0[0], v0[1]); w.y = cvt_pk_bf16(v0[2], v0[3]); w.z = cvt_pk_bf16(v1[0], v1[1]); w.w = cvt_pk_bf16(v1[2], v1[3]); Vb[kc] = __builtin_bit_cast(bf16x8, w); }
#pragma unroll
        for (int kc = 0; kc < 2; ++kc)
#pragma unroll
            for (int mt = 0; mt < 4; ++mt) { O[mt] = __builtin_amdgcn_mfma_f32_16x16x32_bf16(*(const LAS bf16x8*)(QKp + 16 * mt * GP_K + 32 * kc), Vb[kc], O[mt], 0, 0, 0); if (mt == 3) __builtin_amdgcn_sched_barrier(0); }
#pragma unroll
        for (int m = 0; m < 8; ++m) S[m] = S[m] * gl;
#pragma unroll
        for (int kc = 0; kc < 2; ++kc)
#pragma unroll
            for (int m = 0; m < 8; ++m) { S[m] = __builtin_amdgcn_mfma_f32_16x16x32_bf16(*(const LAS bf16x8*)(KDp + 16 * m * GP_K + 32 * kc), Vb[kc], S[m], 0, 0, 0); if (m == 7) __builtin_amdgcn_sched_barrier(0); }
        float* gop = go + ((size_t)b * T + 64 * n + 4 * q) * 512 + h * 128 + 16 * wave + r;
#pragma unroll
        for (int mt = 0; mt < 4; ++mt)
#pragma unroll
            for (int i = 0; i < 4; ++i) gop[(size_t)(16 * mt + i) * 512] = O[mt][i];
    }
    asm volatile("s_waitcnt vmcnt(0) lgkmcnt(0)\n\ts_barrier" ::: "memory");
#undef GDN_DMA
}
constexpr int N_STEPS = 2 + 2 * (9 + 8);

__global__ void __launch_bounds__(NTHR, 2) mk(Args a) {
    extern __shared__ __attribute__((aligned(16))) unsigned char lds_raw[];
    volatile LAS unsigned* MISC = (volatile LAS unsigned*)((LAS unsigned char*)lds_raw + MISC_OFF);
    for (int u = threadIdx.x; u < (LDS_BYTES - RING_BYTES) / 4; u += NTHR) ((LAS unsigned*)((LAS unsigned char*)lds_raw + RING_BYTES))[u] = 0u;
    __syncthreads();
    gu32* const ctl0 = (gu32*)(a.ws + WS_CTL);
    const int lo = a.lo, hi = a.hi;
    XcdBarrier bar; bar.bar = (unsigned*)(ctl0 + CW_BAR) + a.bar_region * XCD_BAR_WORDS; bar.x = xb_xcc_id(); bar.st = MISC + 8;
    if (hi - lo > 1) bar = xcd_barrier_post((unsigned*)(ctl0 + CW_BAR) + a.bar_region * XCD_BAR_WORDS, MISC + 8);
    const unsigned xcc = bar.x;
    const int cblk = (int)blockIdx.x;
    int step = 0;
#ifndef MK_EN
#define MK_EN 0xFFFF
#endif
#define EN(k) ((MK_EN >> (k)) & 1)
#define PHASE_BEGIN if (step >= lo && step < hi) { Frame F; { int tid_ = threadIdx.x; GAS unsigned char* wsg_ = (GAS unsigned char*)a.ws; asm volatile("" : "+v"(tid_), "+s"(wsg_)); unsigned char* ws_ = (unsigned char*)wsg_;     \
        F.lds = (LAS unsigned char*)lds_raw; F.ldsg = (char*)lds_raw; F.tid = tid_; F.lane = tid_ & 63; F.wave = __builtin_amdgcn_readfirstlane(tid_ >> 6); \
        F.G = gridDim.x; F.gw = blockIdx.x * NWAVES + F.wave; F.NGW = F.G * NWAVES; F.ws = ws_; F.ctl = (gu32*)(ws_ + WS_CTL); F.out = a.out; }
#define PHASE_END   if (step + 1 < hi) xcd_barrier(bar); } ++step;

    PHASE_BEGIN if (EN(0)) p0a_convert(F); PHASE_END
    PHASE_BEGIN if (EN(1)) {
        if (a.dbg_src) {
            const bool ne = (a.dbg_layer0 & 1) == 0; const int ni = a.dbg_layer0 >> 1;
            const bf16_t* sw = ne ? (const bf16_t*)(F.ws + WS_SWE) + (size_t)ni * 2 * 16 * 1024 : (const bf16_t*)(F.ws + WS_SWO) + (size_t)ni * 2 * 16 * 1024;
            Ln16 P{a.dbg_src, nullptr, nullptr, (float*)(F.ws + WS_X), (bf16_t*)(F.ws + WS_XB), nullptr, nullptr, sw, sw + 16 * 1024};
            const int pos[4] = {0, 0, 0, 0}; const float gt[4] = {0.f, 0.f, 0.f, 0.f};
            for (int tile = F.gw; tile < NTOK / 16; tile += F.NGW) { f32x4 acc[1]; ln16_tile<0, 1, true>(P, tile, F.lane, pos, gt, acc); smallproj_store(F, acc[0], tile, ne, INP(13) + ni * 16); }
        } else p0b_input(F); }
    PHASE_END

    for (int layer = 0; layer < 4; ++layer) {
        const int li = layer >> 1; const bool even = (layer & 1) == 0;
        if (layer < a.dbg_layer0) { step += even ? 9 : 8; continue; }
        PHASE_BEGIN if (EN(2)) {
            const int N = even ? 3584 : 4096;
            pg8::DenseOrder S{(const char*)(F.ws + WS_XB), even ? (const char*)(F.ws + WS_WINE) + (size_t)li * 3584 * D * 2 : (const char*)(F.ws + WS_WINO) + (size_t)li * 4096 * D * 2, D, NTOK / 256, N / 256, (NTOK / 256) * (N / 256), F.G, cblk};
            pg8::EpiProj E{(bf16_t*)(F.ws + WS_PROJ), PITCH, even ? 512 : 0, C2};
            pg8::gemm_phase<pg8::EpiProj, pg8::DenseOrder, false>(F.lds, D, S, E, F.tid);
        } PHASE_END
        if (even) {
            PHASE_BEGIN if (EN(3)) gdn_prep_phase(F, li); PHASE_END
            PHASE_BEGIN if (EN(4)) {
                if (EN(12)) gdn_scan_phase(F, li);
                attn_body::AttnP P{(const bf16_t*)(F.ws + WS_PROJ), (bf16_t*)(F.ws + WS_ATT), (const float*)(F.ws + WS_T5), nullptr, nullptr};
                attn_body::attn_phase<0>(F.ldsg, P, (unsigned*)(F.ctl + CW_QUEUE + layer * 8 * 64), xcc, F.tid);
            } PHASE_END
            PHASE_BEGIN if (EN(5)) even_combine_phase(F, li, 0.8f - 0.6f * __expf(-0.3f * (float)layer)); PHASE_END
        } else {
            PHASE_BEGIN if (EN(6)) odd_prep_phase(F, li); PHASE_END
            PHASE_BEGIN if (EN(7)) {
                attn_body::AttnP P{(const bf16_t*)(F.ws + WS_PROJ), (bf16_t*)(F.ws + WS_MIX), nullptr, (const float*)(F.ws + WS_CUM), (const bf16_t*)(F.ws + WS_KB8)};
                attn_body::attn_phase<1>(F.ldsg, P, (unsigned*)(F.ctl + CW_QUEUE + layer * 8 * 64), xcc, F.tid);
            } PHASE_END
        }
        PHASE_BEGIN if (EN(8)) {
            pg8::DenseOrder S{(const char*)(F.ws + WS_MIX), even ? (const char*)(F.ws + WS_WOUTE) + (size_t)li * D * D * 2 : (const char*)(F.ws + WS_WOUTO) + (size_t)li * D * D * 2, D, NTOK / 256, D / 256, (NTOK / 256) * (D / 256), F.G, cblk};
            pg8::EpiF32 E{(float*)(F.ws + WS_H), D};
            pg8::gemm_phase<pg8::EpiF32, pg8::DenseOrder, false>(F.lds, D, S, E, F.tid);
        } PHASE_END
        PHASE_BEGIN if (EN(9)) ln_router_phase(F, layer); PHASE_END
        PHASE_BEGIN if (EN(10)) {
            moe_tables(F, layer);
            pg8::MoeOrder S{(const char*)(F.ws + WS_XB), (const char*)(F.ws + WS_WGU) + (size_t)layer * NE * 2048 * D * 2, (const int*)(F.ws + WS_LIST), (const LAS int*)(F.lds + RING_BYTES), (const LAS int*)(F.lds + RING_BYTES) + 32,
                            8, (size_t)2048 * D * 2, D, true, F.G, cblk};
            pg8::EpiSwiglu E{(bf16_t*)(F.ws + WS_ACT), INP(17) + (size_t)layer * NE * 2048};
            pg8::gemm_phase<pg8::EpiSwiglu, pg8::MoeOrder, true>(F.lds, D, S, E, F.tid);
        } PHASE_END
        PHASE_BEGIN if (EN(11)) {
            moe_tables(F, layer);
            pg8::MoeOrder S{(const char*)(F.ws + WS_ACT), (const char*)(F.ws + WS_WD) + (size_t)layer * NE * D * DFF * 2, nullptr, (const LAS int*)(F.lds + RING_BYTES), (const LAS int*)(F.lds + RING_BYTES) + 32,
                            4, (size_t)D * DFF * 2, DFF, false, F.G, cblk};
            pg8::EpiDown E{(bf16_t*)(F.ws + WS_Y), INP(19) + (size_t)layer * NE * D};
            pg8::gemm_phase<pg8::EpiDown, pg8::MoeOrder, false>(F.lds, DFF, S, E, F.tid);
        } PHASE_END
        PHASE_BEGIN if (EN(13)) { moe_tables(F, layer); moe_out_phase(F, layer); } PHASE_END
    }
#undef PHASE_BEGIN
#undef PHASE_END
}
}

#if MK_DEBUG
namespace dbg {
template <class TA, class TB> __device__ __forceinline__ float ldv(const TA* p);
__device__ __forceinline__ float ldf(const float* p) { return *p; }
__device__ __forceinline__ float ldf(const unsigned short* p) { return __builtin_bit_cast(float, (unsigned)*p << 16); }
template <class TA, class TB>
__global__ void cmp(const TA* a, long lda, const TB* b, long ldb, int rows, int cols, float bscale, double* acc) {
    double e = 0.0, n = 0.0;
    for (long i = (long)blockIdx.x * blockDim.x + threadIdx.x; i < (long)rows * cols; i += (long)gridDim.x * blockDim.x) {
        const long r = i / cols, c = i % cols; const float x = ldf(a + r * lda + c), y = ldf(b + r * ldb + c) * bscale;
        e += (double)(x - y) * (x - y); n += (double)x * x; }
    for (int o = 32; o > 0; o >>= 1) { e += __shfl_xor(e, o); n += __shfl_xor(n, o); }
    if ((threadIdx.x & 63) == 0) { atomicAdd(acc, e); atomicAdd(acc + 1, n); }
}
__global__ void finish(float* out, const float* ref, const double* acc, int nchk, float thr, int which, long n) {
    float code = 0.f;
    if (which >= 0) { code = (float)sqrt(acc[2 * which] / (acc[2 * which + 1] + 1e-300)); if (!(code == code)) code = 3.f; if (code > 3.f) code = 3.f; }
    else { for (int k = 0; k < nchk; ++k) { const double e = acc[2 * k] / (acc[2 * k + 1] + 1e-300); if (!(e <= (double)thr)) { code = 0.1f * (k + 1); break; } } }
    for (long i = (long)blockIdx.x * blockDim.x + threadIdx.x; i < n; i += (long)gridDim.x * blockDim.x) out[i] = ref[i] * (1.f + code);
}
__global__ void csum(const unsigned* p, size_t nwords, unsigned long long* out, size_t colw, size_t pitchw) {
    unsigned long long s = 0;
    for (size_t i = (size_t)blockIdx.x * blockDim.x + threadIdx.x; i < nwords; i += (size_t)gridDim.x * blockDim.x) s += p[(i / colw) * pitchw + (i % colw)];
    for (int o = 32; o > 0; o >>= 1) s += __shfl_xor(s, o);
    if ((threadIdx.x & 63) == 0) atomicAdd(out, s);
}
__global__ void finish2(float* out, const float* ref, const unsigned long long* cs, int n, long nel) {
    float code = 0.f;
    for (int k = 0; k < n; ++k) if (cs[k] != cs[64 + k]) { code = 0.1f * (k + 1); break; }
    for (long i = (long)blockIdx.x * blockDim.x + threadIdx.x; i < nel; i += (long)gridDim.x * blockDim.x) out[i] = ref[i] * (1.f + code);
}
__global__ void attdiff(const unsigned short* a, const unsigned short* b, unsigned* stat, int mode) {
    const int u = blockIdx.x, bvh = u >> 6, qb = u & 63, bb = bvh >> 4, vh = bvh & 15;
    int ocol; if (mode == 0) { const int h = vh >> 2, m = (vh >> 1) & 1, half = vh & 1; ocol = (h * 2 + m) * 128 + half * 64; } else ocol = vh * 64;
    __shared__ int any; if (threadIdx.x == 0) any = 0; __syncthreads();
    const size_t row = (size_t)bb * T + qb * 256 + threadIdx.x; int df = 0;
    for (int c = 0; c < 64; ++c) df |= a[row * D + ocol + c] != b[row * D + ocol + c];
    if (df) any = 1; __syncthreads();
    if (threadIdx.x == 0 && any) { atomicAdd(stat, 1u); if (qb < 8) atomicAdd(stat + 1, 1u); if (vh < 8) atomicAdd(stat + 2, 1u); if (qb <= 6) atomicAdd(stat + 3, 1u); if (qb == 7) atomicAdd(stat + 4, 1u); if (qb == 0) atomicAdd(stat + 5, 1u); }
    if (df) { atomicAdd(stat + 6, 1u); if (threadIdx.x < 32) atomicAdd(stat + 7, 1u); }
}
__global__ void finish3(float* out, const float* ref, const unsigned* stat, int which, float denom, long nel) {
    float code = 0.f; { unsigned c = stat[which]; if (denom > 0.f) code = (float)(c / 8) * 8.f / denom; else { int lg = 0; while (c) { ++lg; c >>= 1; } code = 0.1f * (float)lg; } }
    for (long i = (long)blockIdx.x * blockDim.x + threadIdx.x; i < nel; i += (long)gridDim.x * blockDim.x) out[i] = ref[i] * (1.f + code);
}
__global__ void finish4(float* out, const float* ref, const double* acc, long nel) {
    const double e = acc[0] / (acc[1] + 1e-300); float code = e > 0 ? 0.1f * (float)floor(-log10(e)) : 2.f; if (code < 0.f) code = 0.f;
    for (long i = (long)blockIdx.x * blockDim.x + threadIdx.x; i < nel; i += (long)gridDim.x * blockDim.x) out[i] = ref[i] * (1.f + code);
}
__global__ void att2out(float* out, const unsigned short* att, int qlo, int qhi) {
    for (long i = (long)blockIdx.x * blockDim.x + threadIdx.x; i < (long)NTOK * D; i += (long)gridDim.x * blockDim.x) {
        const int row = (int)(i >> 10), qb = (row % T) >> 8; out[i] = (qb >= qlo && qb <= qhi) ? __builtin_bit_cast(float, (unsigned)att[i] << 16) : 0.f; }
}
}
#endif
#ifndef MK_SINGLE
#define MK_SINGLE 0
#endif
static int mk_grid_init() {
    static int grid = 0;
    if (grid == 0) {
        int dev = 0, cus = 0;
        if (hipGetDevice(&dev) != hipSuccess || hipDeviceGetAttribute(&cus, hipDeviceAttributeMultiprocessorCount, dev) != hipSuccess) { grid = -1; return grid; }
        if (hipFuncSetAttribute((const void*)fk::mk, hipFuncAttributeMaxDynamicSharedMemorySize, fk::LDS_BYTES) != hipSuccess) { fprintf(stderr, "kernel_launch: hipFuncSetAttribute failed\n"); grid = -1; return grid; }
        int per_cu = 0;
        if (hipOccupancyMaxActiveBlocksPerMultiprocessor(&per_cu, (const void*)fk::mk, fk::NTHR, fk::LDS_BYTES) != hipSuccess || per_cu < 1) fprintf(stderr, "kernel_launch: occupancy query reports %d\n", per_cu);
        (void)hipGetLastError();
        grid = cus;
    }
    return grid;
}
static void fast_forward(void* const* d_in, float* out, unsigned char* ws, hipStream_t stream, int step_lo, int step_hi, bool single, const float* dbg_src, int dbg_layer0) {
    const int grid = mk_grid_init(); if (grid <= 0) return;
    fk::Args a{};
    for (int i = 0; i < 24; ++i) a.in[i] = (const float*)d_in[i];
    a.out = out; a.ws = ws; a.dbg_src = dbg_src; a.dbg_layer0 = dbg_layer0; a.bar_region = 0;
    if (single) { a.lo = step_lo; a.hi = step_hi; hipLaunchKernelGGL(fk::mk, dim3(grid), dim3(fk::NTHR), fk::LDS_BYTES, stream, a); }
    else for (int s = step_lo; s < step_hi; ++s) { a.lo = s; a.hi = s + 1; hipLaunchKernelGGL(fk::mk, dim3(grid), dim3(fk::NTHR), fk::LDS_BYTES, stream, a); }
}

#ifndef MK_DEBUG
#define MK_DEBUG 0
#endif
#if MK_DEBUG
#ifndef MK_DBG_CFG
#define MK_DBG_CFG 1
#endif
#ifndef MK_DBG_DENOM
#define MK_DBG_DENOM 0.f
#endif
#ifndef MK_DBG_WHICH
#define MK_DBG_WHICH -1
#endif
#endif

extern "C" void kernel_launch(void* const* d_in, const int* in_sizes, int n_in, void* d_out, int out_size, void* d_ws, size_t ws_size, hipStream_t stream) {
    if (n_in != 24 || ws_size < (size_t)4000 * (1u << 20)) { fprintf(stderr, "kernel_launch: unexpected n_in %d / ws %zu\n", n_in, ws_size); return; }
    unsigned char* ws = (unsigned char*)d_ws;
#if MK_DEBUG
    using namespace nv;
    constexpr size_t MiB = 1u << 20; unsigned char* keep = ws + 2400 * MiB;
    float* nout = (float*)(keep + 1536 * MiB); double* acc = (double*)(keep + 1664 * MiB);
    In in; for (int i = 0; i < 24; ++i) in.p[i] = (const float*)d_in[i];
    const float C2 = fk::C2;
#if MK_DBG_CFG == 1
    Save sv[] = {{0, ST_PROJ, keep}, {0, ST_ATT, keep + 512 * MiB}};
    forward(in, ws, nout, sv, 2, stream);
    (void)hipMemsetAsync(ws + fk::WS_CTL, 0, fk::CTL_BYTES, stream); (void)hipMemsetAsync(acc, 0, 1024, stream);
    fast_forward(d_in, (float*)d_out, ws, stream, 0, 5, false, nullptr, 0);
    const float* nproj = (const float*)keep; const unsigned short* fproj = (const unsigned short*)(ws + fk::WS_PROJ);
    dbg::cmp<float, unsigned short><<<1024, 256, 0, stream>>>(nproj, EVEN_IN, fproj, fk::PITCH, NTOK, 512, 1.f / C2, acc + 0);
    dbg::cmp<float, unsigned short><<<1024, 256, 0, stream>>>(nproj + 512, EVEN_IN, fproj + 512, fk::PITCH, NTOK, 3072, 1.f, acc + 2);
    dbg::cmp<float, float><<<1024, 256, 0, stream>>>(nproj + 3584, EVEN_IN, (const float*)(ws + fk::WS_PB), 16, NTOK, 8, 1.f, acc + 4);
    dbg::cmp<float, unsigned short><<<1024, 256, 0, stream>>>((const float*)(keep + 512 * MiB), D, (const unsigned short*)(ws + fk::WS_ATT), D, NTOK, D, 1.f, acc + 6);
    const int nchk = 4;
#elif MK_DBG_CFG == 2
    Save sv[] = {{0, ST_XOUT, keep}, {1, ST_PROJ, keep + 128 * MiB}, {1, ST_CUM, keep + 648 * MiB}, {1, ST_MIX, keep + 656 * MiB}, {1, ST_H, keep + 784 * MiB}, {1, ST_XMIX, keep + 912 * MiB}, {1, ST_XOUT, keep + 1040 * MiB}};
    forward(in, ws, nout, sv, 7, stream);
    (void)hipMemsetAsync(ws + fk::WS_CTL, 0, fk::CTL_BYTES, stream); (void)hipMemsetAsync(acc, 0, 1024, stream);
    fast_forward(d_in, (float*)d_out, ws, stream, 0, 2, false, (const float*)keep, 1);
    const int s0 = 2 + 9;
    const float* nproj = (const float*)(keep + 128 * MiB); const unsigned short* fproj = (const unsigned short*)(ws + fk::WS_PROJ);
    fast_forward(d_in, (float*)d_out, ws, stream, s0, s0 + 2, false, (const float*)keep, 1);
    dbg::cmp<float, unsigned short><<<1024, 256, 0, stream>>>(nproj, ODD_IN, fproj, fk::PITCH, NTOK, 1024, 1.f / C2, acc + 0);
    dbg::cmp<float, unsigned short><<<1024, 256, 0, stream>>>(nproj + 1024, ODD_IN, fproj + 1024, fk::PITCH, NTOK, 3072, 1.f, acc + 2);
    dbg::cmp<float, float><<<1024, 256, 0, stream>>>((const float*)(keep + 648 * MiB), T, (const float*)(ws + fk::WS_CUM), T, 32, T, 1.f / fk::LOG2E, acc + 4);
    fast_forward(d_in, (float*)d_out, ws, stream, s0 + 2, s0 + 3, false, (const float*)keep, 1);
    dbg::cmp<float, unsigned short><<<1024, 256, 0, stream>>>((const float*)(keep + 656 * MiB), D, (const unsigned short*)(ws + fk::WS_MIX), D, NTOK, D, 1.f, acc + 6);
    fast_forward(d_in, (float*)d_out, ws, stream, s0 + 3, s0 + 4, false, (const float*)keep, 1);
    dbg::cmp<float, float><<<1024, 256, 0, stream>>>((const float*)(keep + 784 * MiB), D, (const float*)(ws + fk::WS_H), D, NTOK, D, 1.f, acc + 8);
    fast_forward(d_in, (float*)d_out, ws, stream, s0 + 4, s0 + 5, false, (const float*)keep, 1);
    dbg::cmp<float, float><<<1024, 256, 0, stream>>>((const float*)(keep + 912 * MiB), D, (const float*)(ws + fk::WS_X), D, NTOK, D, 1.f, acc + 10);
    fast_forward(d_in, (float*)d_out, ws, stream, s0 + 5, s0 + 8, false, (const float*)keep, 1);
    dbg::cmp<float, float><<<1024, 256, 0, stream>>>((const float*)(keep + 1040 * MiB), D, (const float*)(ws + fk::WS_X), D, NTOK, D, 1.f, acc + 12);
    const int nchk = 7;
#elif MK_DBG_CFG == 3
    Save sv[] = {{0, ST_ATT, keep}, {0, ST_GO, keep + 128 * MiB}, {0, ST_MIX, keep + 192 * MiB}, {0, ST_H, keep + 320 * MiB}, {0, ST_XMIX, keep + 448 * MiB}, {0, ST_XOUT, keep + 576 * MiB}};
    forward(in, ws, nout, sv, 6, stream);
    (void)hipMemsetAsync(ws + fk::WS_CTL, 0, fk::CTL_BYTES, stream); (void)hipMemsetAsync(acc, 0, 1024, stream);
    fast_forward(d_in, (float*)d_out, ws, stream, 0, 5, false, nullptr, 0);
    dbg::cmp<float, unsigned short><<<1024, 256, 0, stream>>>((const float*)keep, D, (const unsigned short*)(ws + fk::WS_ATT), D, NTOK, D, 1.f, acc + 0);
    dbg::cmp<float, float><<<1024, 256, 0, stream>>>((const float*)(keep + 128 * MiB), 512, (const float*)(ws + fk::WS_GO), 512, NTOK, 512, 1.f, acc + 2);
    fast_forward(d_in, (float*)d_out, ws, stream, 5, 6, false, nullptr, 0);
    dbg::cmp<float, unsigned short><<<1024, 256, 0, stream>>>((const float*)(keep + 192 * MiB), D, (const unsigned short*)(ws + fk::WS_MIX), D, NTOK, D, 1.f, acc + 4);
    fast_forward(d_in, (float*)d_out, ws, stream, 6, 7, false, nullptr, 0);
    dbg::cmp<float, float><<<1024, 256, 0, stream>>>((const float*)(keep + 320 * MiB), D, (const float*)(ws + fk::WS_H), D, NTOK, D, 1.f, acc + 6);
    fast_forward(d_in, (float*)d_out, ws, stream, 7, 8, false, nullptr, 0);
    dbg::cmp<float, float><<<1024, 256, 0, stream>>>((const float*)(keep + 448 * MiB), D, (const float*)(ws + fk::WS_X), D, NTOK, D, 1.f, acc + 8);
    fast_forward(d_in, (float*)d_out, ws, stream, 8, 11, false, nullptr, 0);
    dbg::cmp<float, float><<<1024, 256, 0, stream>>>((const float*)(keep + 576 * MiB), D, (const float*)(ws + fk::WS_X), D, NTOK, D, 1.f, acc + 10);
    const int nchk = 6;
#elif MK_DBG_CFG == 6
#ifndef MK_QLO
#define MK_QLO 0
#define MK_QHI 63
#endif
    (void)hipMemsetAsync(ws + fk::WS_CTL, 0, fk::CTL_BYTES, stream);
    fast_forward(d_in, (float*)d_out, ws, stream, 0, 5, false, nullptr, 0);
    dbg::att2out<<<1024, 256, 0, stream>>>((float*)d_out, (const unsigned short*)(ws + fk::WS_ATT), MK_QLO, MK_QHI);
    (void)nout; (void)acc; (void)in; (void)C2;
    const int nchk = 0; if (nchk == 0) return;
#elif MK_DBG_CFG == 5
    forward(in, ws, nout, nullptr, 0, stream);
    float* fout = (float*)(keep + 1024 * MiB); unsigned* stat = (unsigned*)acc; (void)hipMemsetAsync(stat, 0, 64, stream);
    for (int run = 0; run < 2; ++run) {
        (void)hipMemsetAsync(ws + fk::WS_CTL, 0, fk::CTL_BYTES, stream);
        fast_forward(d_in, fout, ws, stream, 0, 5, false, nullptr, 0);
        if (run == 0) (void)hipMemcpyAsync(keep, ws + fk::WS_ATT, (size_t)64 * MiB, hipMemcpyDeviceToDevice, stream);
    }
    dbg::attdiff<<<2048, 256, 0, stream>>>((const unsigned short*)keep, (const unsigned short*)(ws + fk::WS_ATT), stat, 0);
#if MK_DBG_WHICH == 9
    (void)hipMemsetAsync(acc + 16, 0, 64, stream);
    dbg::cmp<unsigned short, unsigned short><<<1024, 256, 0, stream>>>((const unsigned short*)keep, D, (const unsigned short*)(ws + fk::WS_ATT), D, NTOK, D, 1.f, acc + 16);
    dbg::finish4<<<1024, 256, 0, stream>>>((float*)d_out, nout, acc + 16, (long)NTOK * D);
#else
    dbg::finish3<<<1024, 256, 0, stream>>>((float*)d_out, nout, stat, MK_DBG_WHICH < 0 ? 0 : MK_DBG_WHICH, MK_DBG_DENOM, (long)NTOK * D);
#endif
    const int nchk = 0; if (nchk == 0) return;
#elif MK_DBG_CFG == 4
    forward(in, ws, nout, nullptr, 0, stream);
    float* fout = (float*)(keep + 1024 * MiB);
    unsigned long long* cs = (unsigned long long*)acc; (void)hipMemsetAsync(cs, 0, 2048, stream);
#ifndef MK_DBG_S0
#define MK_DBG_S0 0
#endif
    int nslot = 0;
    for (int run = 0; run < 2; ++run) {
        (void)hipMemsetAsync(ws + fk::WS_CTL, 0, fk::CTL_BYTES, stream);
        int slot = 0;
        auto CS2 = [&](size_t off, size_t rows, size_t colw, size_t pitchw) { if (slot >= MK_DBG_S0 && slot < MK_DBG_S0 + 9) dbg::csum<<<1024, 256, 0, stream>>>((const unsigned*)(ws + off), rows * colw, cs + 64 * run + (slot - MK_DBG_S0), colw, pitchw); ++slot; };
        auto CS = [&](size_t off, size_t bytes) { CS2(off, 1, bytes / 4, bytes / 4); };
        int st = 0;
        auto RUN = [&](int n) { fast_forward(d_in, fout, ws, stream, st, st + n, false, nullptr, 0); st += n; };
        RUN(1); CS(fk::WS_WINE, fk::WS_X - fk::WS_WINE);
        RUN(1); CS(fk::WS_X, (size_t)192 * MiB); CS(fk::WS_PB, 2 * MiB);
        for (int layer = 0; layer < 4; ++layer) {
            RUN(1); CS2(fk::WS_PROJ, NTOK, (layer & 1) ? 2048 : 1792, 2048);
            if ((layer & 1) == 0) { RUN(1); CS(fk::WS_GU, (size_t)64 * MiB); CS(fk::WS_GL, 8192); RUN(1); CS(fk::WS_ATT, (size_t)64 * MiB); CS(fk::WS_GO, (size_t)64 * MiB); RUN(1); CS(fk::WS_MIX, (size_t)64 * MiB); }
            else { RUN(1); CS2(fk::WS_PROJ, NTOK, 2048, 2048); CS(fk::WS_CUM, 2 * MiB); CS(fk::WS_KB8, 8 * MiB); RUN(1); CS(fk::WS_MIX, (size_t)64 * MiB); }
            RUN(1); CS(fk::WS_H, (size_t)128 * MiB);
            RUN(1); CS(fk::WS_X, (size_t)192 * MiB); CS(fk::WS_SELE, 512 * 1024); CS(fk::WS_GATE, 512 * 1024);
            RUN(3); if (layer < 3) CS(fk::WS_X, (size_t)192 * MiB);
        }
        nslot = slot;
    }
    (void)nslot;
    dbg::finish2<<<1024, 256, 0, stream>>>((float*)d_out, nout, cs, 9, (long)NTOK * D);
    const int nchk = 0; if (nchk == 0) return;
#endif
    dbg::finish<<<1024, 256, 0, stream>>>((float*)d_out, nout, acc, nchk, 1e-3f, MK_DBG_WHICH, (long)NTOK * D);
#else
    (void)hipMemsetAsync(ws + fk::WS_CTL, 0, fk::CTL_BYTES, stream);
    fast_forward(d_in, (float*)d_out, ws, stream, 0, fk::N_STEPS, MK_SINGLE != 0, nullptr, 0);
#endif
}
```

```cpp
#define MK_SINGLE 1
#ifndef MK_DEBUG
#define MK_DEBUG 0
#endif
#include <hip/hip_runtime.h>
#include <cstdint>
#include <cstdio>

namespace cfg {
constexpr int B = 2, T = 16384, D = 1024, NTOK = B * T;
constexpr int EVEN_IN = 3592, ODD_IN = 4112;
constexpr int NE = 32, TOPK = 4, DFF = 1024;
constexpr float ALPHA = 1.681792830507429f;
constexpr float LN_EPS = 1e-5f, RMS_EPS = 1e-6f;
}
using namespace cfg;

#if MK_DEBUG
namespace nv {

__device__ __forceinline__ float sigmoidf_(float x) { return 1.f / (1.f + __expf(-x)); }
__device__ __forceinline__ float softplusf_(float x) { return x > 20.f ? x : log1pf(expf(x)); }

struct GemmArgs {
    const float* A; const float* Bm; const float* bias; float* C; const int* cnt; const int* off; const int* list;
    int lda, ldb, ldc, M, N, K;
};
template <int MODE>
__global__ void __launch_bounds__(256) gemm(GemmArgs g) {
    __shared__ float As[16][128 + 4];
    __shared__ float Bs[16][128 + 4];
    const int tid = threadIdx.x, tx = tid & 15, ty = tid >> 4;
    const int m0 = blockIdx.y * 128, n0 = blockIdx.x * 128;
    int M = g.M; const float* Bm = g.Bm; const float* bias = g.bias; int rowbase = 0; const int* lst = nullptr;
    if (MODE != 0) {
        const int e = blockIdx.z; M = g.cnt[e]; if (m0 >= M) return;
        rowbase = g.off[e]; lst = g.list + (size_t)e * NTOK;
        Bm += (size_t)e * g.K * g.ldb; if (bias) bias += (size_t)e * g.N;
    }
    const float* arow[2]; bool aval[2];
#pragma unroll
    for (int i = 0; i < 2; ++i) {
        const int r = m0 + (tid >> 2) + 64 * i; aval[i] = r < M;
        if (MODE == 0) arow[i] = g.A + (size_t)r * g.lda;
        else if (MODE == 1) { const int tok = aval[i] ? (lst[r] >> 2) : 0; arow[i] = g.A + (size_t)tok * g.lda; }
        else arow[i] = g.A + (size_t)(rowbase + r) * g.lda;
    }
    float acc[8][8];
#pragma unroll
    for (int i = 0; i < 8; ++i)
#pragma unroll
        for (int j = 0; j < 8; ++j) acc[i][j] = 0.f;
    for (int k0 = 0; k0 < g.K; k0 += 16) {
#pragma unroll
        for (int i = 0; i < 2; ++i) {
            const int r = (tid >> 2) + 64 * i, c = (tid & 3) * 4;
            float4 v = make_float4(0.f, 0.f, 0.f, 0.f);
            if (aval[i]) {
                v = *(const float4*)(arow[i] + k0 + c);
                if (MODE == 2) {
                    const float4 u = *(const float4*)(arow[i] + 1024 + k0 + c);
                    float gg[4] = {v.x, v.y, v.z, v.w}, uu[4] = {u.x, u.y, u.z, u.w}, o[4];
#pragma unroll
                    for (int q = 0; q < 4; ++q) { const float a = fminf(gg[q], 7.f), b = fminf(fmaxf(uu[q], -7.f), 7.f); o[q] = a * sigmoidf_(1.702f * a) * (b + 1.f); }
                    v = make_float4(o[0], o[1], o[2], o[3]);
                }
            }
            As[c][r] = v.x; As[c + 1][r] = v.y; As[c + 2][r] = v.z; As[c + 3][r] = v.w;
        }
#pragma unroll
        for (int i = 0; i < 2; ++i) {
            const int r = (tid >> 5) + 8 * i, c = (tid & 31) * 4;
            const float* bp = Bm + (size_t)(k0 + r) * g.ldb + n0 + c;
            float4 v;
            if (n0 + c + 3 < g.N) v = *(const float4*)bp;
            else { v.x = (n0 + c < g.N) ? bp[0] : 0.f; v.y = (n0 + c + 1 < g.N) ? bp[1] : 0.f; v.z = (n0 + c + 2 < g.N) ? bp[2] : 0.f; v.w = 0.f; }
            *(float4*)&Bs[r][c] = v;
        }
        __syncthreads();
#pragma unroll
        for (int kk = 0; kk < 16; ++kk) {
            const float4 a0 = *(const float4*)&As[kk][ty * 8], a1 = *(const float4*)&As[kk][ty * 8 + 4];
            const float4 b0 = *(const float4*)&Bs[kk][tx * 8], b1 = *(const float4*)&Bs[kk][tx * 8 + 4];
            const float a[8] = {a0.x, a0.y, a0.z, a0.w, a1.x, a1.y, a1.z, a1.w};
            const float b[8] = {b0.x, b0.y, b0.z, b0.w, b1.x, b1.y, b1.z, b1.w};
#pragma unroll
            for (int i = 0; i < 8; ++i)
#pragma unroll
                for (int j = 0; j < 8; ++j) acc[i][j] = fmaf(a[i], b[j], acc[i][j]);
        }
        __syncthreads();
    }
#pragma unroll
    for (int i = 0; i < 8; ++i) {
        const int r = m0 + ty * 8 + i; if (r >= M) continue;
        float* crow = g.C + (size_t)(rowbase + r) * g.ldc;
#pragma unroll
        for (int j = 0; j < 8; ++j) { const int c = n0 + tx * 8 + j; if (c < g.N) crow[c] = acc[i][j] + (bias ? bias[c] : 0.f); }
    }
}

__device__ __forceinline__ float block_sum_256(float v, float* red) {
#pragma unroll
    for (int o = 32; o > 0; o >>= 1) v += __shfl_xor(v, o);
    __syncthreads();
    if ((threadIdx.x & 63) == 0) red[threadIdx.x >> 6] = v;
    __syncthreads();
    return red[0] + red[1] + red[2] + red[3];
}
__global__ void __launch_bounds__(256) ln_res(float* X, const float* H, const float* gam, const float* bet, float* Xout) {
    __shared__ float red[4];
    const size_t row = blockIdx.x; const int c = threadIdx.x * 4;
    const float4 x = *(const float4*)(X + row * D + c), h = *(const float4*)(H + row * D + c);
    float v[4] = {ALPHA * x.x + h.x, ALPHA * x.y + h.y, ALPHA * x.z + h.z, ALPHA * x.w + h.w};
    const float mean = block_sum_256(v[0] + v[1] + v[2] + v[3], red) * (1.f / D);
    float q = 0.f;
#pragma unroll
    for (int i = 0; i < 4; ++i) { v[i] -= mean; q += v[i] * v[i]; }
    const float rstd = rsqrtf(block_sum_256(q, red) * (1.f / D) + LN_EPS);
    const float4 gg = *(const float4*)(gam + c), bb = *(const float4*)(bet + c);
    const float4 o = make_float4(v[0] * rstd * gg.x + bb.x, v[1] * rstd * gg.y + bb.y, v[2] * rstd * gg.z + bb.z, v[3] * rstd * gg.w + bb.w);
    *(float4*)(Xout + row * D + c) = o;
}

template <int MODE>
__global__ void __launch_bounds__(256) attn(const float* P, float* O, const float* tab  , const float* cum  , int ldp) {
    __shared__ float Ks[64][64];
    __shared__ float Vs[64][64];
    __shared__ float ck[64];
    __shared__ float tb[MODE == 0 ? 2048 : 1];
    const int tid = threadIdx.x, qb = gridDim.x - 1 - blockIdx.x, b = blockIdx.y >> 4, vh = blockIdx.y & 15;
    int qcol, kcol, vcol, ocol, h;
    if (MODE == 0) { h = vh >> 2; const int m = (vh >> 1) & 1, half = vh & 1; qcol = h * 128 + m * 64; kcol = 512 + h * 128 + m * 64; vcol = 1024 + h * 128 + half * 64; ocol = (h * 2 + m) * 128 + half * 64; }
    else { h = vh; qcol = h * 64; kcol = 1024 + h * 64; vcol = 2048 + h * 64; ocol = h * 64; }
    if (MODE == 0) { for (int i = tid; i < 2048; i += 256) tb[i] = tab[h * 2048 + i]; }
    const int i_row = qb * 256 + tid; const size_t tok = (size_t)b * T + i_row;
    float q[64], o[64];
#pragma unroll
    for (int d = 0; d < 64; d += 4) { const float4 v = *(const float4*)(P + tok * ldp + qcol + d); q[d] = v.x * 0.125f; q[d + 1] = v.y * 0.125f; q[d + 2] = v.z * 0.125f; q[d + 3] = v.w * 0.125f; }
#pragma unroll
    for (int d = 0; d < 64; ++d) o[d] = 0.f;
    float m_run = -INFINITY, l_run = 0.f;
    float cq = 0.f; const float* cumrow = nullptr;
    if (MODE == 1) { cumrow = cum + (size_t)(b * 16 + h) * T; cq = cumrow[i_row]; }
    const float far_bias = (MODE == 0) ? tab[h * 2048 + 2047] : 0.f;
    const int ntile = 4 * qb + 4;
    for (int kt = 0; kt < ntile; ++kt) {
        __syncthreads();
        {
            const int r = tid >> 2, c0 = (tid & 3) * 16; const size_t ktok = (size_t)b * T + kt * 64 + r;
#pragma unroll
            for (int c = 0; c < 16; c += 4) { *(float4*)&Ks[r][c0 + c] = *(const float4*)(P + ktok * ldp + kcol + c0 + c); *(float4*)&Vs[r][c0 + c] = *(const float4*)(P + ktok * ldp + vcol + c0 + c); }
            if (MODE == 1 && tid < 64) ck[tid] = cumrow[kt * 64 + tid];
        }
        __syncthreads();
        if (kt * 64 > i_row) continue;
#pragma unroll 1
        for (int jj = 0; jj < 64; ++jj) {
            const int j = kt * 64 + jj; const int dist = i_row - j;
            if (dist < 0) break;
            float dot = 0.f;
#pragma unroll
            for (int d = 0; d < 64; d += 4) { const float4 kv = *(const float4*)&Ks[jj][d]; dot = fmaf(q[d], kv.x, dot); dot = fmaf(q[d + 1], kv.y, dot); dot = fmaf(q[d + 2], kv.z, dot); dot = fmaf(q[d + 3], kv.w, dot); }
            float bias;
            if (MODE == 0) bias = dist < 2048 ? tb[dist] : far_bias;
            else bias = cq - ck[jj];
            const float sc = dot + bias;
            if (sc > m_run) { const float f = __expf(m_run - sc); l_run *= f;
#pragma unroll
                for (int d = 0; d < 64; ++d) o[d] *= f;
                m_run = sc; }
            const float p = __expf(sc - m_run); l_run += p;
#pragma unroll
            for (int d = 0; d < 64; d += 4) { const float4 vv = *(const float4*)&Vs[jj][d]; o[d] = fmaf(p, vv.x, o[d]); o[d + 1] = fmaf(p, vv.y, o[d + 1]); o[d + 2] = fmaf(p, vv.z, o[d + 2]); o[d + 3] = fmaf(p, vv.w, o[d + 3]); }
        }
    }
    const float inv = 1.f / l_run;
#pragma unroll
    for (int d = 0; d < 64; d += 4) *(float4*)(O + tok * D + ocol + d) = make_float4(o[d] * inv, o[d + 1] * inv, o[d + 2] * inv, o[d + 3] * inv);
}

__global__ void t5tab(const float* t5, float* tab) {
    const int i = blockIdx.x * blockDim.x + threadIdx.x; if (i >= 4 * 2048) return;
    const int h = i >> 11, n = i & 2047; int bk;
    if (n < 16) bk = n; else { bk = 16 + (int)(log((double)n / 16.0) / log(128.0) * 16.0); if (bk > 31) bk = 31; }
    tab[i] = t5[bk * 4 + h];
}

__global__ void conv_silu(const float* P  , const float* w  , float* CQ  ) {
    const size_t i = (size_t)blockIdx.x * blockDim.x + threadIdx.x; if (i >= (size_t)NTOK * 1536) return;
    const int c = (int)(i % 1536); const size_t tok = i / 1536; const int t = (int)(tok % T);
    float y = 0.f;
#pragma unroll
    for (int j = 0; j < 4; ++j) { const int tt = t - 3 + j; if (tt >= 0) y = fmaf(w[j * 1536 + c], P[(tok - 3 + j) * EVEN_IN + 1536 + c], y); }
    CQ[i] = y * sigmoidf_(y);
}
__global__ void gdn_norm(const float* P, float* CQ, const float* a_log, const float* dt_bias, float* BETA, float* G) {
    const int i = blockIdx.x * blockDim.x + threadIdx.x; if (i >= NTOK * 8) return;
    const int which = i & 1, h = (i >> 1) & 3; const size_t tok = i >> 3;
    float* p = CQ + tok * 1536 + which * 512 + h * 128; float ss = 0.f;
    for (int d = 0; d < 128; ++d) ss = fmaf(p[d], p[d], ss);
    const float r = rsqrtf(ss + RMS_EPS);
    for (int d = 0; d < 128; ++d) p[d] *= r;
    if (which == 0) {
        BETA[tok * 4 + h] = sigmoidf_(P[tok * EVEN_IN + 3584 + h]);
        G[tok * 4 + h] = -expf(a_log[h]) * softplusf_(P[tok * EVEN_IN + 3588 + h] + dt_bias[h]);
    }
}
__global__ void __launch_bounds__(128) gdn_rec(const float* CQ, const float* BETA, const float* G, float* GO  ) {
    __shared__ float ks[2][128], qs[2][128];
    const int b = blockIdx.x >> 2, h = blockIdx.x & 3, c = threadIdx.x;
    float S[128];
#pragma unroll
    for (int d = 0; d < 128; ++d) S[d] = 0.f;
    const float scale = 0.08838834764831845f;
    for (int t = 0; t < T; ++t) {
        const size_t tok = (size_t)b * T + t; const int bf = t & 1;
        ks[bf][c] = CQ[tok * 1536 + 512 + h * 128 + c]; qs[bf][c] = CQ[tok * 1536 + h * 128 + c];
        const float v = CQ[tok * 1536 + 1024 + h * 128 + c], beta = BETA[tok * 4 + h], alpha = __expf(G[tok * 4 + h]);
        __syncthreads();
        float ksum = 0.f;
#pragma unroll
        for (int d = 0; d < 128; d += 4) { const float4 k4 = *(const float4*)&ks[bf][d]; ksum = fmaf(k4.x, S[d], ksum); ksum = fmaf(k4.y, S[d + 1], ksum); ksum = fmaf(k4.z, S[d + 2], ksum); ksum = fmaf(k4.w, S[d + 3], ksum); }
        const float vnew = beta * (v - alpha * ksum);
        float o = 0.f;
#pragma unroll
        for (int d = 0; d < 128; d += 4) { const float4 k4 = *(const float4*)&ks[bf][d]; const float4 q4 = *(const float4*)&qs[bf][d];
            S[d] = fmaf(alpha, S[d], k4.x * vnew); S[d + 1] = fmaf(alpha, S[d + 1], k4.y * vnew); S[d + 2] = fmaf(alpha, S[d + 2], k4.z * vnew); S[d + 3] = fmaf(alpha, S[d + 3], k4.w * vnew);
            o = fmaf(q4.x, S[d], o); o = fmaf(q4.y, S[d + 1], o); o = fmaf(q4.z, S[d + 2], o); o = fmaf(q4.w, S[d + 3], o); }
        GO[tok * 512 + h * 128 + c] = o * scale;
    }
}
__global__ void __launch_bounds__(128) even_combine(const float* ATT  , const float* GO, const float* P, const float* lamp  ,
                                                    const float* subln_w, const float* gdn_w, float* MIX, float lam_init) {
    __shared__ float red[2]; __shared__ float lam_s;
    const size_t tok = blockIdx.x; const int d = threadIdx.x;
    if (d < 64) {
        float a = lamp[d] * lamp[64 + d], bb = lamp[128 + d] * lamp[192 + d];
#pragma unroll
        for (int o = 32; o > 0; o >>= 1) { a += __shfl_xor(a, o); bb += __shfl_xor(bb, o); }
        if (d == 0) lam_s = expf(a) - expf(bb) + lam_init;
    }
    __syncthreads();
    const float lam = lam_s;
    for (int grp = 0; grp < 8; ++grp) {
        float v;
        if (grp < 4) v = ATT[tok * D + (grp * 2) * 128 + d] - lam * ATT[tok * D + (grp * 2 + 1) * 128 + d];
        else v = GO[tok * 512 + (grp - 4) * 128 + d];
        float ss = v * v;
#pragma unroll
        for (int o = 32; o > 0; o >>= 1) ss += __shfl_xor(ss, o);
        __syncthreads();
        if ((d & 63) == 0) red[d >> 6] = ss;
        __syncthreads();
        const float r = rsqrtf((red[0] + red[1]) * (1.f / 128.f) + RMS_EPS);
        float outv;
        if (grp < 4) outv = v * r * subln_w[d] * (1.f - lam_init);
        else { const float z = P[tok * EVEN_IN + 3072 + (grp - 4) * 128 + d]; outv = v * r * gdn_w[d] * (z * sigmoidf_(z)); }
        MIX[tok * D + grp * 128 + d] = outv;
    }
}

__global__ void qknorm(float* P  , const float* w  ) {
    const int i = blockIdx.x * blockDim.x + threadIdx.x; if (i >= NTOK * 32) return;
    const int which = i & 1, h = (i >> 1) & 15; const size_t tok = i >> 5;
    float* p = P + tok * ODD_IN + which * 1024 + h * 64; float ss = 0.f;
    for (int d = 0; d < 64; ++d) ss = fmaf(p[d], p[d], ss);
    const float r = rsqrtf(ss * (1.f / 64.f) + RMS_EPS);
    for (int d = 0; d < 64; ++d) p[d] = p[d] * r * w[which * 64 + d];
}
__global__ void logf_k(const float* P, const float* fb, float* LF  ) {
    const int i = blockIdx.x * blockDim.x + threadIdx.x; if (i >= NTOK * 16) return;
    const int h = i & 15; const size_t tok = i >> 4; const int b = (int)(tok / T), t = (int)(tok % T);
    const float x = P[tok * ODD_IN + 4096 + h] + fb[h];
    LF[(size_t)(b * 16 + h) * T + t] = -softplusf_(-x);
}
__global__ void __launch_bounds__(1024) cumsum16k(float* LF) {
    __shared__ float part[1024];
    float* p = LF + (size_t)blockIdx.x * T + threadIdx.x * 16; float v[16]; float s = 0.f;
#pragma unroll
    for (int i = 0; i < 16; ++i) { s += p[i]; v[i] = s; }
    part[threadIdx.x] = s; __syncthreads();
    for (int o = 1; o < 1024; o <<= 1) { float a = threadIdx.x >= o ? part[threadIdx.x - o] : 0.f; __syncthreads(); part[threadIdx.x] += a; __syncthreads(); }
    const float base = threadIdx.x ? part[threadIdx.x - 1] : 0.f;
#pragma unroll
    for (int i = 0; i < 16; ++i) p[i] = v[i] + base;
}
__global__ void gate_k(const float* ATT, const float* P, float* MIX) {
    const size_t i = (size_t)blockIdx.x * blockDim.x + threadIdx.x; if (i >= (size_t)NTOK * D) return;
    const size_t tok = i >> 10; const int c = (int)(i & 1023);
    MIX[i] = ATT[i] * sigmoidf_(P[tok * ODD_IN + 3072 + c]);
}

__global__ void __launch_bounds__(256) router(const float* X, const float* rw  , const float* rb, int* cnt, int* list, int* sel_e, int* sel_slot, float* gate) {
    __shared__ float lg[8][32];
    const int tk = threadIdx.x >> 5, e = threadIdx.x & 31; const size_t tok = (size_t)blockIdx.x * 8 + tk;
    const float* x = X + tok * D; float acc = 0.f;
    for (int k = 0; k < D; ++k) acc = fmaf(x[k], rw[k * 32 + e], acc);
    lg[tk][e] = acc + rb[e];
    __syncthreads();
    if (e == 0) {
        float v[4]; int id[4]; unsigned used = 0u;
#pragma unroll
        for (int k = 0; k < 4; ++k) { float best = -INFINITY; int bi = 0; for (int j = 0; j < 32; ++j) { const float z = lg[tk][j]; if (!((used >> j) & 1u) && z > best) { best = z; bi = j; } } used |= 1u << bi; v[k] = best; id[k] = bi; }
        float s = 0.f, p[4];
#pragma unroll
        for (int k = 0; k < 4; ++k) { p[k] = __expf(v[k] - v[0]); s += p[k]; }
#pragma unroll
        for (int k = 0; k < 4; ++k) {
            const int slot = atomicAdd(&cnt[id[k]], 1);
            list[(size_t)id[k] * NTOK + slot] = (int)(tok * 4 + k);
            sel_e[tok * 4 + k] = id[k]; sel_slot[tok * 4 + k] = slot; gate[tok * 4 + k] = p[k] / s;
        }
    }
}
__global__ void offsets(const int* cnt, int* off) { if (threadIdx.x == 0) { int s = 0; for (int e = 0; e < NE; ++e) { off[e] = s; s += cnt[e]; } } }
__global__ void __launch_bounds__(256) combine_ln(float* X, const float* Y, const int* off, const int* sel_e, const int* sel_slot, const float* gate, const float* gam, const float* bet, float* Xout) {
    __shared__ float red[4];
    const size_t row = blockIdx.x; const int c = threadIdx.x * 4;
    const float4 x = *(const float4*)(X + row * D + c);
    float v[4] = {ALPHA * x.x, ALPHA * x.y, ALPHA * x.z, ALPHA * x.w};
#pragma unroll
    for (int k = 0; k < 4; ++k) { const size_t pos = (size_t)off[sel_e[row * 4 + k]] + sel_slot[row * 4 + k]; const float gt = gate[row * 4 + k]; const float4 y = *(const float4*)(Y + pos * D + c);
        v[0] = fmaf(gt, y.x, v[0]); v[1] = fmaf(gt, y.y, v[1]); v[2] = fmaf(gt, y.z, v[2]); v[3] = fmaf(gt, y.w, v[3]); }
    const float mean = block_sum_256(v[0] + v[1] + v[2] + v[3], red) * (1.f / D);
    float q = 0.f;
#pragma unroll
    for (int i = 0; i < 4; ++i) { v[i] -= mean; q += v[i] * v[i]; }
    const float rstd = rsqrtf(block_sum_256(q, red) * (1.f / D) + LN_EPS);
    const float4 gg = *(const float4*)(gam + c), bb = *(const float4*)(bet + c);
    *(float4*)(Xout + row * D + c) = make_float4(v[0] * rstd * gg.x + bb.x, v[1] * rstd * gg.y + bb.y, v[2] * rstd * gg.z + bb.z, v[3] * rstd * gg.w + bb.w);
}

constexpr size_t MiB = 1u << 20;
constexpr size_t O_X = 0;
constexpr size_t O_H = 128 * MiB;
constexpr size_t O_MIX = 256 * MiB;
constexpr size_t O_ATT = 384 * MiB;
constexpr size_t O_PROJ = 512 * MiB;
constexpr size_t O_CQ = 1032 * MiB;
constexpr size_t O_GO = 1224 * MiB;
constexpr size_t O_HB = 512 * MiB;
constexpr size_t O_Y = 1536 * MiB;
constexpr size_t O_SMALL = 2048 * MiB;
constexpr size_t O_END = 2064 * MiB;
constexpr size_t S_TAB = 0, S_BETA = 64 * 1024, S_G = S_BETA + 512 * 1024, S_CUM = S_G + 512 * 1024  , S_CNT = S_CUM + 2 * MiB, S_OFF = S_CNT + 256,
                 S_SELE = S_CNT + 4096, S_SLOT = S_SELE + 512 * 1024, S_GATE = S_SLOT + 512 * 1024, S_LIST = S_GATE + 512 * 1024  ;
static_assert(S_LIST + 4 * MiB <= 16 * MiB, "small region");

struct In { const float* p[24]; };
static_assert(sizeof(GemmArgs) == 80, "GemmArgs has padding");

struct Save { int layer, stage; void* dst; };
enum { ST_PROJ = 0, ST_CQ, ST_GO, ST_ATT, ST_MIX, ST_H, ST_XMIX, ST_XOUT, ST_CUM, ST_BETA, ST_G, ST_Y };
static void forward(const In& in, unsigned char* ws, float* out, const Save* sv, int nsv, hipStream_t st) {
    auto save = [&](int layer, int stage, const void* src, size_t bytes) { for (int k = 0; k < nsv; ++k) if (sv[k].layer == layer && sv[k].stage == stage) (void)hipMemcpyAsync(sv[k].dst, src, bytes, hipMemcpyDeviceToDevice, st); };
    float* X = (float*)(ws + O_X); float* H = (float*)(ws + O_H); float* MIX = (float*)(ws + O_MIX); float* ATT = (float*)(ws + O_ATT);
    float* PROJ = (float*)(ws + O_PROJ); float* CQ = (float*)(ws + O_CQ); float* GO = (float*)(ws + O_GO); float* HB = (float*)(ws + O_HB); float* Y = (float*)(ws + O_Y);
    unsigned char* sm = ws + O_SMALL;
    float* TAB = (float*)(sm + S_TAB); float* BETA = (float*)(sm + S_BETA); float* G = (float*)(sm + S_G); float* CUM = (float*)(sm + S_CUM);
    int* CNT = (int*)(sm + S_CNT); int* OFF = (int*)(sm + S_OFF); int* SELE = (int*)(sm + S_SELE); int* SLOT = (int*)(sm + S_SLOT); float* GATE = (float*)(sm + S_GATE); int* LIST = (int*)(sm + S_LIST);
    (void)hipMemcpyAsync(X, in.p[0], (size_t)NTOK * D * 4, hipMemcpyDeviceToDevice, st);
    t5tab<<<32, 256, 0, st>>>(in.p[1], TAB);
    for (int layer = 0; layer < 4; ++layer) {
        const int i = layer >> 1;
        if ((layer & 1) == 0) {
            GemmArgs g{X, in.p[2] + (size_t)i * D * EVEN_IN, nullptr, PROJ, nullptr, nullptr, nullptr, D, EVEN_IN, EVEN_IN, NTOK, EVEN_IN, D};
            gemm<0><<<dim3((EVEN_IN + 127) / 128, NTOK / 128), 256, 0, st>>>(g);
            conv_silu<<<(unsigned)(((size_t)NTOK * 1536 + 255) / 256), 256, 0, st>>>(PROJ, in.p[6] + (size_t)i * 4 * 1536, CQ);
            gdn_norm<<<NTOK * 8 / 256, 256, 0, st>>>(PROJ, CQ, in.p[7] + i * 4, in.p[8] + i * 4, BETA, G);
            save(layer, ST_CQ, CQ, (size_t)NTOK * 1536 * 4); save(layer, ST_BETA, BETA, (size_t)NTOK * 16); save(layer, ST_G, G, (size_t)NTOK * 16);
            gdn_rec<<<8, 128, 0, st>>>(CQ, BETA, G, GO);
            save(layer, ST_GO, GO, (size_t)NTOK * 512 * 4);
            save(layer, ST_PROJ, PROJ, (size_t)NTOK * EVEN_IN * 4);
            attn<0><<<dim3(T / 256, B * 16), 256, 0, st>>>(PROJ, ATT, TAB, nullptr, EVEN_IN);
            save(layer, ST_ATT, ATT, (size_t)NTOK * D * 4);
            const float lam_init = 0.8f - 0.6f * expf(-0.3f * (float)layer);
            even_combine<<<NTOK, 128, 0, st>>>(ATT, GO, PROJ, in.p[4] + i * 256, in.p[5] + i * 128, in.p[9] + i * 128, MIX, lam_init);
            GemmArgs g2{MIX, in.p[3] + (size_t)i * D * D, nullptr, H, nullptr, nullptr, nullptr, D, D, D, NTOK, D, D};
            gemm<0><<<dim3(D / 128, NTOK / 128), 256, 0, st>>>(g2);
        } else {
            GemmArgs g{X, in.p[10] + (size_t)i * D * ODD_IN, nullptr, PROJ, nullptr, nullptr, nullptr, D, ODD_IN, ODD_IN, NTOK, ODD_IN, D};
            gemm<0><<<dim3((ODD_IN + 127) / 128, NTOK / 128), 256, 0, st>>>(g);
            qknorm<<<NTOK * 32 / 256, 256, 0, st>>>(PROJ, in.p[12] + i * 128);
            logf_k<<<NTOK * 16 / 256, 256, 0, st>>>(PROJ, in.p[13] + i * 16, CUM);
            cumsum16k<<<B * 16, 1024, 0, st>>>(CUM);
            save(layer, ST_PROJ, PROJ, (size_t)NTOK * ODD_IN * 4); save(layer, ST_CUM, CUM, (size_t)32 * T * 4);
            attn<1><<<dim3(T / 256, B * 16), 256, 0, st>>>(PROJ, ATT, nullptr, CUM, ODD_IN);
            save(layer, ST_ATT, ATT, (size_t)NTOK * D * 4);
            gate_k<<<(unsigned)((size_t)NTOK * D / 256), 256, 0, st>>>(ATT, PROJ, MIX);
            GemmArgs g2{MIX, in.p[11] + (size_t)i * D * D, nullptr, H, nullptr, nullptr, nullptr, D, D, D, NTOK, D, D};
            gemm<0><<<dim3(D / 128, NTOK / 128), 256, 0, st>>>(g2);
        }
        save(layer, ST_MIX, MIX, (size_t)NTOK * D * 4); save(layer, ST_H, H, (size_t)NTOK * D * 4);
        ln_res<<<NTOK, 256, 0, st>>>(X, H, in.p[20] + layer * D, in.p[21] + layer * D, X);
        save(layer, ST_XMIX, X, (size_t)NTOK * D * 4);
        (void)hipMemsetAsync(CNT, 0, 128, st);
        router<<<NTOK / 8, 256, 0, st>>>(X, in.p[14] + (size_t)layer * D * NE, in.p[15] + layer * NE, CNT, LIST, SELE, SLOT, GATE);
        offsets<<<1, 64, 0, st>>>(CNT, OFF);
        GemmArgs m1{X, in.p[16] + (size_t)layer * NE * D * 2048, in.p[17] + (size_t)layer * NE * 2048, HB, CNT, OFF, LIST, D, 2048, 2048, 0, 2048, D};
        gemm<1><<<dim3(2048 / 128, NTOK / 128, NE), 256, 0, st>>>(m1);
        GemmArgs m2{HB, in.p[18] + (size_t)layer * NE * DFF * D, in.p[19] + (size_t)layer * NE * D, Y, CNT, OFF, LIST, 2048, D, D, 0, D, DFF};
        gemm<2><<<dim3(D / 128, NTOK / 128, NE), 256, 0, st>>>(m2);
        float* dst = (layer == 3) ? out : X;
        combine_ln<<<NTOK, 256, 0, st>>>(X, Y, OFF, SELE, SLOT, GATE, in.p[22] + layer * D, in.p[23] + layer * D, dst);
        save(layer, ST_XOUT, dst, (size_t)NTOK * D * 4);
    }
}
}

#endif
namespace fk {
#define LAS __attribute__((address_space(3)))
#define GAS __attribute__((address_space(1)))
typedef unsigned short bf16_t;
typedef short bf16x8 __attribute__((ext_vector_type(8)));
typedef short s16x4 __attribute__((ext_vector_type(4)));
typedef float f32x2 __attribute__((ext_vector_type(2)));
typedef float f32x4 __attribute__((ext_vector_type(4)));
typedef float f32x16 __attribute__((ext_vector_type(16)));
typedef unsigned u32x2 __attribute__((ext_vector_type(2)));
typedef unsigned u32x4 __attribute__((ext_vector_type(4)));
typedef GAS unsigned gu32;

constexpr int NWAVES = 8, NTHR = 512;
constexpr int PITCH = 4096;
constexpr float LOG2E = 1.4426950408889634f;
constexpr float C2 = 0.125f * LOG2E;
constexpr int NPAD = NTOK * 4 + NE * 256;
constexpr int T5PAD = 256, T5N = 2048 + T5PAD;

constexpr size_t MiB = 1u << 20;
constexpr size_t WS_CTL = 0, CTL_BYTES = 1 * MiB;
constexpr size_t WS_WINE = 2 * MiB;
constexpr size_t WS_WINO = 16 * MiB;
constexpr size_t WS_WOUTE = 32 * MiB, WS_WOUTO = 36 * MiB;
constexpr size_t WS_RW = 40 * MiB;
constexpr size_t WS_SWE = WS_RW + 512 * 1024;
constexpr size_t WS_SWO = WS_SWE + 128 * 1024;
constexpr size_t WS_T5 = 41 * MiB;
constexpr size_t WS_WGU = 64 * MiB;
constexpr size_t WS_WD = 576 * MiB;
constexpr size_t WS_X = 832 * MiB;
constexpr size_t WS_XB = 960 * MiB;
constexpr size_t WS_PROJ = 1024 * MiB;
constexpr size_t WS_ATT = 1280 * MiB;
constexpr size_t WS_MIX = 1344 * MiB;
constexpr size_t WS_H = 1408 * MiB;
constexpr size_t WS_GW = 1536 * MiB, WS_GQD = 1570 * MiB, WS_GQK = 1604 * MiB, WS_GKD = 1622 * MiB, WS_GU = 1658 * MiB;
constexpr size_t WS_GO = 1722 * MiB;
constexpr size_t WS_ACT = 1792 * MiB;
constexpr size_t WS_Y = 2064 * MiB;
constexpr size_t WS_PB = 2336 * MiB;
constexpr size_t WS_CUM = 2338 * MiB;
constexpr size_t WS_KB8 = 2340 * MiB;
constexpr size_t WS_SELE = 2348 * MiB, WS_SLOT = WS_SELE + 512 * 1024, WS_GATE = WS_SLOT + 512 * 1024, WS_TSUM = WS_GATE + 512 * 1024;
constexpr size_t WS_LIST = 2350 * MiB;
constexpr size_t WS_GL = 2354 * MiB;
constexpr size_t WS_FAST_END = 2356 * MiB;
constexpr int CW_TMO = 0, CW_BAR = 4096, CW_CNT = 8192  , CW_QUEUE = 12288  ;

constexpr int RING_BYTES = 131072;
constexpr int MISC_OFF = RING_BYTES + 320;
constexpr int LDS_BYTES = 147456;

#define LDS_WAIT() asm volatile("s_waitcnt lgkmcnt(0)" ::: "memory")
#define VM_WAIT() asm volatile("s_waitcnt vmcnt(0)" ::: "memory")
#define RLX_AGENT __ATOMIC_RELAXED, __HIP_MEMORY_SCOPE_AGENT

__device__ __forceinline__ unsigned f2bf(float f) { unsigned u = __builtin_bit_cast(unsigned, f); return (u + 0x7fffu + ((u >> 16) & 1u)) >> 16; }
__device__ __forceinline__ unsigned pk2(float lo, float hi) { return f2bf(lo) | (f2bf(hi) << 16); }
__device__ __forceinline__ float bf2f(unsigned short h) { return __builtin_bit_cast(float, (unsigned)h << 16); }
__device__ __forceinline__ float bflo(unsigned w) { return __builtin_bit_cast(float, w << 16); }
__device__ __forceinline__ float bfhi(unsigned w) { return __builtin_bit_cast(float, w & 0xffff0000u); }
__device__ __forceinline__ unsigned cvt_pk_bf16(float lo, float hi) { unsigned r; asm volatile("v_cvt_pk_bf16_f32 %0, %1, %2" : "=v"(r) : "v"(lo), "v"(hi)); return r; }
__device__ __forceinline__ float sigmoid_f(float x) { return 1.f / (1.f + __expf(-x)); }
__device__ __forceinline__ float softplus_f(float x) { const float e = __expf(-fabsf(x)); const float l = e < 1e-3f ? e * (1.f - 0.5f * e) : __logf(1.f + e); return fmaxf(x, 0.f) + l; }

#define XB_TMO      128
#define XB_XCNT(j)  (256  + 64 * (j))
#define XB_XSUB(j)  (1280 + 64 * (j))
#define XB_XGEN(j)  (2304 + 64 * (j))
#define XB_TOP      3328
#define XB_TOPGEN   3392
#define XCD_BAR_WORDS 3456
#define XB_SPIN_CAP (1u << 18)
__device__ __forceinline__ unsigned xb_ld(unsigned* p)              { return __hip_atomic_load(p, __ATOMIC_RELAXED, __HIP_MEMORY_SCOPE_AGENT); }
__device__ __forceinline__ unsigned xb_add(unsigned* p, unsigned v) { return __hip_atomic_fetch_add(p, v, __ATOMIC_RELAXED, __HIP_MEMORY_SCOPE_AGENT); }
__device__ __forceinline__ unsigned xb_xcc_id() { return (unsigned)__builtin_amdgcn_s_getreg((3 << 11) | 20) & 0xFu; }
#define XB_SPIN(cond, bar) do { unsigned _sp = 0; while (cond) { __builtin_amdgcn_s_sleep(1); \
    if ((++_sp & 255u) == 0u) { if (xb_ld(&(bar)[XB_TMO])) break; if (_sp > XB_SPIN_CAP) { atomicAdd(&(bar)[XB_TMO], 1u); break; } } } } while (0)
struct XcdBarrier { unsigned* bar; unsigned x; volatile LAS unsigned* st; };
__device__ __forceinline__ XcdBarrier xcd_barrier_post(unsigned* bar, volatile LAS unsigned* st) {
    XcdBarrier b; b.bar = bar; b.x = xb_xcc_id(); b.st = st;
    if (threadIdx.x == 0) (void)xb_add(&bar[XB_XCNT(b.x)], 1u);
    return b;
}
__device__ __forceinline__ void xcd_barrier_complete(unsigned* bar, unsigned x, unsigned& nloc, unsigned& nx) {
    const unsigned G = gridDim.x * gridDim.y * gridDim.z;
    unsigned sum, cnt, mine, sp = 0u;
    for (;;) {
        sum = 0u; cnt = 0u;
#pragma unroll
        for (unsigned j = 0; j < 16; ++j) { const unsigned c = xb_ld(&bar[XB_XCNT(j)]); sum += c; cnt += (c > 0u) ? 1u : 0u; }
        mine = xb_ld(&bar[XB_XCNT(x)]);
        if (sum == G) break;
        __builtin_amdgcn_s_sleep(1);
        if ((++sp & 255u) == 0u) { if (xb_ld(&bar[XB_TMO])) break; if (sp > XB_SPIN_CAP) { atomicAdd(&bar[XB_TMO], 1u); break; } }
    }
    nloc = mine > 0u ? mine : 1u; nx = cnt > 0u ? cnt : 1u;
}
__device__ __forceinline__ void xcd_barrier(const XcdBarrier& b) {
    asm volatile("s_waitcnt vmcnt(0)" ::: "memory");
    __syncthreads();
    if (threadIdx.x == 0) {
        unsigned* bar = b.bar; const unsigned bx = b.x;
        __builtin_amdgcn_s_waitcnt(0);
        unsigned nloc = b.st[0], nx = b.st[1];
        if (nloc == 0u) { xcd_barrier_complete(bar, bx, nloc, nx); b.st[0] = nloc; b.st[1] = nx; }
        const unsigned old = xb_add(&bar[XB_XSUB(bx)], 1u);
        const unsigned gen = old / nloc;
        if (old + 1u == (gen + 1u) * nloc) {
            __builtin_amdgcn_fence(__ATOMIC_RELEASE, "agent");
            asm volatile("s_waitcnt vmcnt(0)" ::: "memory");
            const unsigned og = xb_add(&bar[XB_TOP], 1u);
            const unsigned tg = og / nx;
            if (og + 1u == (tg + 1u) * nx) xb_add(&bar[XB_TOPGEN], 1u);
            else XB_SPIN(xb_ld(&bar[XB_TOPGEN]) == tg, bar);
            __builtin_amdgcn_fence(__ATOMIC_ACQUIRE, "agent");
            xb_add(&bar[XB_XGEN(bx)], 1u);
            asm volatile("s_waitcnt vmcnt(0)" ::: "memory");
        } else {
            XB_SPIN(xb_ld(&bar[XB_XGEN(bx)]) == gen, bar);
            __builtin_amdgcn_fence(__ATOMIC_ACQUIRE, "agent");
            asm volatile("s_waitcnt vmcnt(0)" ::: "memory");
        }
    }
    __syncthreads();
}

namespace pg8 {
constexpr int BM = 256, BK = 64, HALF = 128, HTB = HALF * BK * 2, STAGE_BYTES = 8 * HTB;
__host__ __device__ __forceinline__ int lds_byte(int r, int c) { const int st = (r >> 4) * 2 + (c >> 5), rr = r & 15, cc = c & 31, ob = rr * 64 + cc * 2; return st * 1024 + (ob ^ (((ob >> 9) & 1) << 5)); }
__host__ __device__ __forceinline__ void stage_rc(int b, int& R, int& C) { const int st = b / 1024, sb = b % 1024, swz = sb ^ (((sb >> 9) & 1) << 5); R = (st >> 1) * 16 + swz / 64; C = (st & 1) * 32 + (swz % 64) / 2; }
__host__ __device__ __forceinline__ int perm32(int rho) { const int n = rho >> 4, i = rho & 15; return 8 * (i >> 2) + 4 * n + (i & 3); }

struct Unit { const char* A; const char* B; const int* rows; int nvalid; int row0; int col0; int aux; };

template <class Epi, class Sched, bool GATHER>
__device__ __forceinline__ void gemm_phase(LAS unsigned char* lds, const int K, const Sched& S, const Epi& E, const int tid) {
    const int wid = __builtin_amdgcn_readfirstlane(tid >> 6), lane = tid & 63, wr = wid >> 2, wc = wid & 3, fr = lane & 15, fq = lane >> 4;
    const int nt = K / BK;
    int Rr[2], Cc[2]; unsigned voffB[2]; unsigned offA[2][2], noffA[2][2];
#pragma unroll
    for (int i = 0; i < 2; ++i) { stage_rc(tid * 16 + i * 8192, Rr[i], Cc[i]); const int Rb = Epi::PERM ? ((Rr[i] & ~31) + perm32(Rr[i] & 31)) : Rr[i];
        voffB[i] = (unsigned)(Rb * K + Cc[i]) * 2u;
#pragma unroll
        for (int h = 0; h < 2; ++h) { offA[h][i] = (unsigned)((Rr[i] + HALF * h) * K + Cc[i]) * 2u; noffA[h][i] = offA[h][i]; } }
    const size_t kstep = (size_t)(BK * 2);
    const size_t hstep = (size_t)HALF * K * 2;
    const unsigned ldsw = (unsigned)wid * 1024u;
    const int aoff = lds_byte(wr * 64 + fr, fq * 8), boff = lds_byte(wc * 32 + fr, fq * 8);
#define PG8_SA(b, h) (((b) * 2 + (h)) * HTB)
#define PG8_SB(b, h) ((4 + (b) * 2 + (h)) * HTB)
#define PG8_STAGE_B(bufoff, gbase) do { _Pragma("unroll") for (int _i = 0; _i < 2; ++_i) \
        __builtin_amdgcn_global_load_lds((const unsigned*)((const char*)(gbase) + voffB[_i]), (LAS unsigned*)(lds + (bufoff) + ldsw + _i * 8192), 16, 0, 0); } while (0)
#define PG8_STAGE_A(bufoff, gbase, off, h) do { _Pragma("unroll") for (int _i = 0; _i < 2; ++_i) \
        __builtin_amdgcn_global_load_lds((const unsigned*)((const char*)(gbase) + (off)[h][_i]), (LAS unsigned*)(lds + (bufoff) + ldsw + _i * 8192), 16, 0, 0); } while (0)
#define PG8_LDA(dst, b, h) do { _Pragma("unroll") for (int m = 0; m < 4; ++m) _Pragma("unroll") for (int k = 0; k < 2; ++k) dst[m][k] = *(const LAS bf16x8*)(lds + PG8_SA(b, h) + aoff + m * 2048 + k * 1024); } while (0)
#define PG8_LDB(dst, b, h) do { _Pragma("unroll") for (int n = 0; n < 2; ++n) _Pragma("unroll") for (int k = 0; k < 2; ++k) dst[n][k] = *(const LAS bf16x8*)(lds + PG8_SB(b, h) + boff + n * 2048 + k * 1024); } while (0)
#define PG8_MMA(ai, bj, At, Bt) do { __builtin_amdgcn_s_setprio(1); _Pragma("unroll") for (int m = 0; m < 4; ++m) _Pragma("unroll") for (int n = 0; n < 2; ++n) _Pragma("unroll") for (int k = 0; k < 2; ++k) \
        acc[ai][bj][m][n] = __builtin_amdgcn_mfma_f32_16x16x32_bf16(Bt[n][k], At[m][k], acc[ai][bj][m][n], 0, 0, 0); __builtin_amdgcn_s_setprio(0); } while (0)
#define PG8_WAIT_V(n) asm volatile("s_waitcnt vmcnt(" #n ")" ::: "memory")
#define PG8_WAIT_L(n) asm volatile("s_waitcnt lgkmcnt(" #n ")" ::: "memory")
#define PG8_BAR __builtin_amdgcn_s_barrier()
#define PG8_SCHED __builtin_amdgcn_sched_barrier(0)
#define PG8_ROWS(dst, u) do { if constexpr (GATHER) { _Pragma("unroll") for (int h = 0; h < 2; ++h) _Pragma("unroll") for (int i = 0; i < 2; ++i) { \
        int rr_ = Rr[i] + HALF * h; rr_ = rr_ < (u).nvalid ? rr_ : (u).nvalid - 1; const int tok_ = (u).rows[rr_] >> 2; dst[h][i] = (unsigned)(tok_ * K + Cc[i]) * 2u; } } } while (0)
    Unit cur, nxt; int ui = 0;
    if (!S.next(0, cur)) return;
    f32x4 acc[2][2][4][2];
#pragma unroll
    for (int a = 0; a < 2; ++a)
#pragma unroll
        for (int b = 0; b < 2; ++b)
#pragma unroll
            for (int m = 0; m < 4; ++m)
#pragma unroll
                for (int n = 0; n < 2; ++n) acc[a][b][m][n] = (f32x4){0.f, 0.f, 0.f, 0.f};
    bf16x8 At[4][2], B0[2][2], B1[2][2];
    const char* cA = cur.A; const char* cB = cur.B;
    PG8_ROWS(offA, cur);
    PG8_STAGE_B(PG8_SB(0, 0), cB); PG8_STAGE_B(PG8_SB(0, 1), cB + hstep); PG8_STAGE_A(PG8_SA(0, 0), cA, offA, 0); PG8_STAGE_A(PG8_SA(0, 1), cA, offA, 1);
    if (wr == 1) PG8_BAR;
    PG8_WAIT_V(2); PG8_BAR;
    PG8_STAGE_B(PG8_SB(1, 0), cB + kstep); PG8_STAGE_A(PG8_SA(1, 0), cA + kstep, offA, 0); PG8_STAGE_B(PG8_SB(1, 1), cB + hstep + kstep);
    PG8_WAIT_V(6); PG8_BAR;
    for (;;) {
        const bool has_next = S.next(ui + 1, nxt);
        const char* nA = has_next ? nxt.A : cA; const char* nB = has_next ? nxt.B : cB;
        if constexpr (GATHER) { if (has_next) { PG8_ROWS(noffA, nxt); } else {
#pragma unroll
            for (int h = 0; h < 2; ++h)
#pragma unroll
                for (int i = 0; i < 2; ++i) noffA[h][i] = offA[h][i]; } }
        for (int t = 0; t < nt; t += 2) {
            const bool last = (t == nt - 2);
            const char* a1 = cA + (size_t)(t + 1) * kstep;
            const char* a2 = last ? nA : cA + (size_t)(t + 2) * kstep; const char* b2 = last ? nB : cB + (size_t)(t + 2) * kstep;
            const char* a3 = a2 + kstep; const char* b3 = b2 + kstep;
            PG8_LDB(B0, 0, 0); PG8_LDB(B1, 0, 1); PG8_SCHED; PG8_LDA(At, 0, 0); PG8_STAGE_A(PG8_SA(1, 1), a1, offA, 1);
            if (GATHER && last) { asm volatile("" ::: "memory");
#pragma unroll
                for (int h = 0; h < 2; ++h)
#pragma unroll
                    for (int i = 0; i < 2; ++i) offA[h][i] = noffA[h][i]; }
            PG8_WAIT_V(8); PG8_WAIT_L(0); PG8_BAR; PG8_MMA(0, 0, At, B0); PG8_MMA(0, 1, At, B1); PG8_BAR; PG8_SCHED;
            PG8_LDA(At, 0, 1); PG8_STAGE_B(PG8_SB(0, 0), b2); PG8_STAGE_B(PG8_SB(0, 1), b2 + hstep); PG8_STAGE_A(PG8_SA(0, 0), a2, offA, 0);
            PG8_WAIT_V(8); PG8_WAIT_L(0); PG8_BAR; PG8_MMA(1, 0, At, B0); PG8_MMA(1, 1, At, B1); PG8_BAR; PG8_SCHED;
            PG8_LDB(B0, 1, 0); PG8_LDB(B1, 1, 1); PG8_SCHED; PG8_LDA(At, 1, 0); PG8_STAGE_A(PG8_SA(0, 1), a2, offA, 1);
            PG8_WAIT_V(8); PG8_WAIT_L(0); PG8_BAR; PG8_MMA(0, 0, At, B0); PG8_MMA(0, 1, At, B1); PG8_BAR; PG8_SCHED;
            PG8_LDA(At, 1, 1); PG8_STAGE_B(PG8_SB(1, 0), b3); PG8_STAGE_B(PG8_SB(1, 1), b3 + hstep); PG8_STAGE_A(PG8_SA(1, 0), a3, offA, 0);
            PG8_WAIT_V(8); PG8_WAIT_L(0); PG8_BAR; PG8_MMA(1, 0, At, B0); PG8_MMA(1, 1, At, B1); PG8_BAR; PG8_SCHED;
        }
        if (wr == 0) PG8_BAR;
        E(acc, cur, wr, wc, fr, fq);
        if (!has_next) break;
#pragma unroll
        for (int a = 0; a < 2; ++a)
#pragma unroll
            for (int b = 0; b < 2; ++b)
#pragma unroll
                for (int m = 0; m < 4; ++m)
#pragma unroll
                    for (int n = 0; n < 2; ++n) acc[a][b][m][n] = (f32x4){0.f, 0.f, 0.f, 0.f};
        cur = nxt; cA = nA; cB = nB; ++ui;
        if (wr == 1) PG8_BAR;
    }
    PG8_WAIT_V(0);
    PG8_BAR;
#undef PG8_SA
#undef PG8_SB
#undef PG8_STAGE_A
#undef PG8_STAGE_B
#undef PG8_LDA
#undef PG8_LDB
#undef PG8_MMA
#undef PG8_WAIT_V
#undef PG8_WAIT_L
#undef PG8_BAR
#undef PG8_SCHED
#undef PG8_ROWS
}

struct DenseOrder {
    const char* A; const char* Bt; int K; int nM, nN, nwg, G, c;
    __device__ __forceinline__ bool next(int i, Unit& u) const {
        const long L = (long)i * G + c; if (L >= nwg) return false;
        int wgid = (int)L; { const int q = nwg / 8, r = nwg % 8, xcd = wgid % 8, off = wgid / 8; wgid = (xcd < r ? xcd * (q + 1) : r * (q + 1) + (xcd - r) * q) + off; }
        const int nig = 8 * nN, gid = wgid / nig, fm = gid * 8, gsz = (nM - fm) < 8 ? (nM - fm) : 8;
        const int pm = fm + ((wgid % nig) % gsz), pn = (wgid % nig) / gsz;
        u.A = A + (size_t)pm * BM * K * 2; u.B = Bt + (size_t)pn * BM * K * 2; u.rows = nullptr; u.nvalid = BM; u.row0 = pm * BM; u.col0 = pn * BM; u.aux = 0; return true;
    }
};
struct MoeOrder {
    const char* A; const char* W; const int* list; const LAS int* cnt; const LAS int* offp;
    int npn; size_t wstride; int K; bool gather; int G, c;
    __device__ __forceinline__ bool next(int i, Unit& u) const {
        const int x = c & 7, j = c >> 3, W8 = G >> 3; int q = j + i * W8;
#pragma unroll
        for (int s = 0; s < 4; ++s) { const int e = x + 8 * s; const int n = cnt[e]; const int ntile = (n + 255) >> 8; const int ne = ntile * npn;
            if (q < ne) { const int ti = q / npn, pn = q % npn;
                u.B = W + (size_t)e * wstride + (size_t)pn * BM * K * 2; u.row0 = offp[e] + ti * BM; u.col0 = pn * BM; u.aux = e;
                u.nvalid = (n - ti * BM) < BM ? (n - ti * BM) : BM;
                if (gather) { u.A = A; u.rows = list + (size_t)e * NTOK + ti * BM; } else { u.A = A + (size_t)u.row0 * K * 2; u.rows = nullptr; }
                return true; }
            q -= ne; }
        return false;
    }
};

struct EpiProj {
    static constexpr bool PERM = true;
    bf16_t* O; int ldc; int qcols; float qscale;
    __device__ __forceinline__ void operator()(const f32x4 (&acc)[2][2][4][2], const Unit& u, int wr, int wc, int fr, int fq) const {
        const int row0 = u.row0 + wr * 64 + fr, col0 = u.col0 + wc * 32 + 8 * fq;
        const float sc = (u.col0 < qcols) ? qscale : 1.f;
#pragma unroll
        for (int ai = 0; ai < 2; ++ai)
#pragma unroll
            for (int m = 0; m < 4; ++m) { bf16_t* rowp = O + (size_t)(row0 + ai * HALF + m * 16) * ldc + col0;
#pragma unroll
                for (int bj = 0; bj < 2; ++bj) { const f32x4 v0 = acc[ai][bj][m][0] * sc, v1 = acc[ai][bj][m][1] * sc;
                    u32x4 w; w.x = cvt_pk_bf16(v0[0], v0[1]); w.y = cvt_pk_bf16(v0[2], v0[3]); w.z = cvt_pk_bf16(v1[0], v1[1]); w.w = cvt_pk_bf16(v1[2], v1[3]);
                    *(u32x4*)(rowp + bj * HALF) = w; } }
    }
};
struct EpiF32 {
    static constexpr bool PERM = false;
    float* C; int ldc;
    __device__ __forceinline__ void operator()(const f32x4 (&acc)[2][2][4][2], const Unit& u, int wr, int wc, int fr, int fq) const {
        const int row0 = u.row0 + wr * 64 + fr, col0 = u.col0 + wc * 32 + 4 * fq;
#pragma unroll
        for (int ai = 0; ai < 2; ++ai)
#pragma unroll
            for (int m = 0; m < 4; ++m) { float* rowp = C + (size_t)(row0 + ai * HALF + m * 16) * ldc + col0;
#pragma unroll
                for (int bj = 0; bj < 2; ++bj)
#pragma unroll
                    for (int n = 0; n < 2; ++n) *(f32x4*)(rowp + bj * HALF + n * 16) = acc[ai][bj][m][n]; }
    }
};
struct EpiSwiglu {
    static constexpr bool PERM = true;
    bf16_t* O; const float* bias;
    __device__ __forceinline__ void operator()(const f32x4 (&acc)[2][2][4][2], const Unit& u, int wr, int wc, int fr, int fq) const {
        const int row0 = u.row0 + wr * 64 + fr, ac0 = (u.col0 >> 1) + wc * 32 + 8 * fq;
        const float* bg = bias + (size_t)u.aux * 2048 + ac0; const float* bu = bg + 1024;
        f32x4 bgv[2], buv[2];
#pragma unroll
        for (int n = 0; n < 2; ++n) { bgv[n] = *(const f32x4*)(bg + 4 * n); buv[n] = *(const f32x4*)(bu + 4 * n); }
#pragma unroll
        for (int ai = 0; ai < 2; ++ai)
#pragma unroll
            for (int m = 0; m < 4; ++m) { bf16_t* rowp = O + (size_t)(row0 + ai * HALF + m * 16) * 1024 + ac0; float o[8];
#pragma unroll
                for (int n = 0; n < 2; ++n) { const f32x4 g = acc[ai][0][m][n] + bgv[n], uu = acc[ai][1][m][n] + buv[n];
#pragma unroll
                    for (int j = 0; j < 4; ++j) { const float a = fminf(g[j], 7.f), b = fminf(fmaxf(uu[j], -7.f), 7.f);
                        o[4 * n + j] = a * __builtin_amdgcn_rcpf(1.f + __builtin_amdgcn_exp2f(-1.702f * LOG2E * a)) * (b + 1.f); } }
                u32x4 w; w.x = cvt_pk_bf16(o[0], o[1]); w.y = cvt_pk_bf16(o[2], o[3]); w.z = cvt_pk_bf16(o[4], o[5]); w.w = cvt_pk_bf16(o[6], o[7]);
                *(u32x4*)rowp = w; }
    }
};
struct EpiDown {
    static constexpr bool PERM = true;
    bf16_t* O; const float* bias;
    __device__ __forceinline__ void operator()(const f32x4 (&acc)[2][2][4][2], const Unit& u, int wr, int wc, int fr, int fq) const {
        const int row0 = u.row0 + wr * 64 + fr, col0 = u.col0 + wc * 32 + 8 * fq;
        const float* bb = bias + (size_t)u.aux * 1024 + col0;
        f32x4 bv[2][2];
#pragma unroll
        for (int bj = 0; bj < 2; ++bj)
#pragma unroll
            for (int n = 0; n < 2; ++n) bv[bj][n] = *(const f32x4*)(bb + bj * HALF + 4 * n);
#pragma unroll
        for (int ai = 0; ai < 2; ++ai)
#pragma unroll
            for (int m = 0; m < 4; ++m) { bf16_t* rowp = O + (size_t)(row0 + ai * HALF + m * 16) * 1024 + col0;
#pragma unroll
                for (int bj = 0; bj < 2; ++bj) { const f32x4 v0 = acc[ai][bj][m][0] + bv[bj][0], v1 = acc[ai][bj][m][1] + bv[bj][1];
                    u32x4 w; w.x = cvt_pk_bf16(v0[0], v0[1]); w.y = cvt_pk_bf16(v0[2], v0[3]); w.z = cvt_pk_bf16(v1[0], v1[1]); w.w = cvt_pk_bf16(v1[2], v1[3]);
                    *(u32x4*)(rowp + bj * HALF) = w; } }
    }
};
}
namespace attn_body {
constexpr int D = 64, NW = 8, QBLK = 32, QB = QBLK * NW, KVBLK = 64, NQB = T / QB;
constexpr int NSLOT = 3, SLOTB = 9216;
constexpr int LDS_K = 0, LDS_V = NSLOT * SLOTB, LDS_WS = 2 * NSLOT * SLOTB, LDS_OST = LDS_WS + NW * 64 * 4, LDS_TB = LDS_OST + NW * 4096, LDS_UNIT = LDS_TB + T5N * 4, LDS_BYTES = LDS_UNIT + 16;
static_assert(LDS_BYTES <= RING_BYTES, "attention LDS");
__device__ __forceinline__ int crow(int r, int hi) { return (r & 3) + 8 * (r >> 2) + 4 * hi; }
#define SBAR() __builtin_amdgcn_sched_barrier(0)
__device__ __forceinline__ void cmask(f32x16& p0, f32x16& p1, int jb, int qrel, int hi) {
    const float NEG = -INFINITY; const int lim = qrel - 64 * jb - 4 * hi;
#pragma unroll
    for (int r = 0; r < 16; ++r) { const int c = (r & 3) + 8 * (r >> 2); if (c > lim) p0[r] = NEG; if (c + 32 > lim) p1[r] = NEG; }
}
__device__ __forceinline__ void glds16(const void* sbase, unsigned voff, unsigned lds_dst) { unsigned keep;
    asm volatile("s_mov_b32 %0, m0\n\ts_mov_b32 m0, %3\n\ts_nop 0\n\tglobal_load_lds_dwordx4 %1, %2\n\ts_mov_b32 m0, %0" : "=&s"(keep) : "v"(voff), "s"(sbase), "s"(lds_dst) : "memory"); }
__device__ __forceinline__ float max3f(float a, float b, float c) { float r; asm("v_max3_f32 %0, %1, %2, %3" : "=v"(r) : "v"(a), "v"(b), "v"(c)); return r; }
__device__ __forceinline__ float max2f(float a, float b) { float r; asm("v_max_f32_e32 %0, %1, %2" : "=v"(r) : "v"(a), "v"(b)); return r; }
__device__ __forceinline__ float fadd_s(float a, float b) { float r; asm("v_add_f32_e32 %0, %1, %2" : "=v"(r) : "v"(a), "v"(b)); return r; }
__device__ __forceinline__ float fsub_s(float a, float b) { float r; asm("v_sub_f32_e32 %0, %1, %2" : "=v"(r) : "v"(a), "v"(b)); return r; }
typedef __bf16 bf16x2_t __attribute__((ext_vector_type(2)));
__device__ __forceinline__ unsigned cvtpk_s(float lo, float hi) { f32x2 v = {lo, hi}; bf16x2_t b = __builtin_convertvector(v, bf16x2_t); return __builtin_bit_cast(unsigned, b); }
#define WAIT_BAR(N) asm volatile("s_waitcnt vmcnt(" #N ") lgkmcnt(0)\n\ts_barrier" ::: "memory")
typedef LAS const char* lds_cptr;
typedef short v4i16_t __attribute__((ext_vector_type(4)));
__device__ __forceinline__ void kload2(bf16x8* kf, lds_cptr kp, int j) { kf[2 * j] = *(const LAS bf16x8*)(kp + j * 2048); kf[2 * j + 1] = *(const LAS bf16x8*)(kp + j * 2048 + 512); }
__device__ __forceinline__ s16x4 vtr(lds_cptr p) { return __builtin_bit_cast(s16x4, __builtin_amdgcn_ds_read_tr16_b64_v4i16((LAS v4i16_t*)p)); }
__device__ __forceinline__ float rowmax(const f32x16& p0, const f32x16& p1) {
    float a = max3f(p0[0], p0[1], p1[0]), b = max3f(p0[2], p0[3], p1[1]); a = max3f(a, p1[2], p1[3]);
#pragma unroll
    for (int r = 4; r < 16; r += 4) { a = max3f(a, p0[r], p0[r + 1]); b = max3f(b, p0[r + 2], p0[r + 3]); a = max3f(a, p1[r], p1[r + 1]); b = max3f(b, p1[r + 2], p1[r + 3]); }
    const float m = max2f(a, b);
    auto rr = __builtin_amdgcn_permlane32_swap(__float_as_uint(m), __float_as_uint(m), false, false);
    return max2f(__uint_as_float(rr[0]), __uint_as_float(rr[1]));
}
__device__ __forceinline__ void pv(f32x16* o, int vb, bf16x8 pa0, bf16x8 pa1, bf16x8 pa2, bf16x8 pa3) {
#pragma unroll
    for (int d0 = 0; d0 < 2; ++d0) { s16x4 lo[4], hi[4];
#pragma unroll
        for (int ks = 0; ks < 4; ++ks) {
            asm volatile("ds_read_b64_tr_b16 %0,%1 offset:%c2" : "=&v"(lo[ks]) : "v"(vb), "i"(d0 * 4096 + ks * 1024) : "memory");
            asm volatile("ds_read_b64_tr_b16 %0,%1 offset:%c2" : "=&v"(hi[ks]) : "v"(vb), "i"(d0 * 4096 + ks * 1024 + 512) : "memory"); }
        asm volatile("s_waitcnt lgkmcnt(0)" ::: "memory"); SBAR();
#define PK(k) (bf16x8){lo[k][0], lo[k][1], lo[k][2], lo[k][3], hi[k][0], hi[k][1], hi[k][2], hi[k][3]}
        o[d0] = __builtin_amdgcn_mfma_f32_32x32x16_bf16(pa0, PK(0), o[d0], 0, 0, 0);
        o[d0] = __builtin_amdgcn_mfma_f32_32x32x16_bf16(pa1, PK(1), o[d0], 0, 0, 0);
        o[d0] = __builtin_amdgcn_mfma_f32_32x32x16_bf16(pa2, PK(2), o[d0], 0, 0, 0);
        o[d0] = __builtin_amdgcn_mfma_f32_32x32x16_bf16(pa3, PK(3), o[d0], 0, 0, 0);
#undef PK
    }
}
struct AttnP {
    const bf16_t* proj;
    bf16_t* out;
    const float* t5tab;
    const float* cum2;
    const bf16_t* kb8;
};

template <int MODE, int THRL>
__device__ __forceinline__ void attn_unit(const AttnP& P, int b, int vh, int qb, char* shm, const int tid) {
    const int lane = tid & 63, r32 = lane & 31, hi = lane >> 5; const int wid = __builtin_amdgcn_readfirstlane(tid >> 6);
    int h, qcol, kcol, vcol, ocol;
    if (MODE == 0) { h = vh >> 2; const int m = (vh >> 1) & 1, half = vh & 1; qcol = h * 128 + m * 64; kcol = 512 + h * 128 + m * 64; vcol = 1024 + h * 128 + half * 64; ocol = (h * 2 + m) * 128 + half * 64; }
    else { h = vh; qcol = h * 64; kcol = 1024 + h * 64; vcol = 2048 + h * 64; ocol = h * 64; }
    const long rowbase = (long)b * T; const int q0 = qb * QB;
    const bf16_t* Qw = P.proj + (rowbase + q0 + wid * QBLK) * PITCH + qcol;
    const bf16_t* Kh = P.proj + rowbase * PITCH + kcol; const bf16_t* Vh = P.proj + rowbase * PITCH + vcol;
    const unsigned lds0 = (unsigned)(uintptr_t)shm;
    float* wsf = (float*)(shm + LDS_WS) + wid * 64;
    const unsigned kvoff = (unsigned)(lane * PITCH + wid * 8) * 2u;
    const unsigned vvoff = (unsigned)((16 * (wid & 3) + (lane >> 2)) * PITCH + (wid >> 2) * 32 + (lane & 3) * 8) * 2u;
    const bf16_t* k8h = (MODE == 1) ? P.kb8 + (long)(b * 16 + h) * T * 8 : nullptr; const unsigned k8voff = (unsigned)lane * 16u;
    const unsigned kdst = lds0 + LDS_K + wid * 1024, vdst = lds0 + LDS_V + wid * 1024, k8dst = lds0 + LDS_K + 8192;
#define DMA_K(t, slot) do { glds16(Kh + (long)(t) * KVBLK * PITCH, kvoff, (unsigned)__builtin_amdgcn_readfirstlane(kdst + (slot))); \
        if (MODE == 1 && wid == 0) glds16(k8h + (long)(t) * KVBLK * 8, k8voff, (unsigned)__builtin_amdgcn_readfirstlane(k8dst + (slot))); } while (0)
#define DMA_V(t, slot) glds16(Vh + (long)(t) * KVBLK * PITCH, vvoff, (unsigned)__builtin_amdgcn_readfirstlane(vdst + (slot)))
#define WAIT2(N0, N1) do { if (MODE == 1 && wid == 0) { WAIT_BAR(N1); } else { WAIT_BAR(N0); } } while (0)
    const int vb0 = (int)(lds0 + LDS_V) + ((lane >> 4) & 1) * 32 + (lane & 3) * 8 + (4 * hi + ((lane & 15) >> 2)) * 64;
    constexpr int NKF = (MODE == 1) ? 10 : 8;
    bf16x8 kf[NKF];
    const lds_cptr shm3 = (lds_cptr)shm; const lds_cptr kp0 = shm3 + LDS_K + hi * 1024 + r32 * 16; const lds_cptr kp8 = shm3 + LDS_K + 8192 + r32 * 16;
    const lds_cptr vp0 = shm3 + LDS_V + ((lane >> 4) & 1) * 32 + (lane & 3) * 8 + (4 * hi + ((lane & 15) >> 2)) * 64;
    const int NT = (q0 + QB) / KVBLK;
    DMA_K(0, 0); DMA_V(0, 0); DMA_K(1, SLOTB);
    constexpr int NQR = (MODE == 1) ? 5 : 4;
    bf16x8 qr[NQR];
#pragma unroll
    for (int d0 = 0; d0 < 4; ++d0) qr[d0] = *reinterpret_cast<const bf16x8*>(&Qw[(long)r32 * PITCH + d0 * 16 + hi * 8]);
    const int qrel = wid * QBLK + r32;
    if (MODE == 1) {
        const float c = P.cum2[(long)(b * 16 + h) * T + q0 + qrel];
        const unsigned ch = f2bf(c); const float r1 = c - __builtin_bit_cast(float, ch << 16); const unsigned cm = f2bf(r1); const float r2 = r1 - __builtin_bit_cast(float, cm << 16); const unsigned cl = f2bf(r2);
        u32x4 w; w.x = ch | (cm << 16); w.y = cl | (0x3f80u << 16); w.z = 0x3f80u | (0x3f80u << 16); w.w = 0u;
        if (hi) w = (u32x4){0u, 0u, 0u, 0u};
        qr[NQR - 1] = __builtin_bit_cast(bf16x8, w);
    }
    float mhat = 0.f, l_reg = 0.f; f32x16 o[2]; o[0] = f32x16{}; o[1] = f32x16{}; const f32x16 zero16 = f32x16{}; f32x2 mh2 = {0.f, 0.f};
    const float* tblo = (const float*)(shm + LDS_TB) + (q0 + qrel - 4 * hi - 63 + T5PAD);
#define CMASK(P0, P1, t) do { int jb_ = (t) - (NT - 4); if (jb_ >= 0) cmask(P0, P1, jb_, qrel, hi); } while (0)
#ifndef MK_NOBIAS
#define MK_NOBIAS 0
#endif
#define BIAS(P0, P1, t) do { if (MODE == 0 && !MK_NOBIAS) { const float* tb_ = tblo - 64 * (t); \
        _Pragma("unroll") for (int r = 0; r < 16; ++r) { const int kv0_ = (r & 3) + 8 * (r >> 2); P0[r] += tb_[63 - kv0_]; P1[r] += tb_[31 - kv0_]; } } } while (0)
    bool resc = false;
#define RESC() do { if (resc) { asm volatile("s_waitcnt lgkmcnt(0)" ::: "memory"); \
      _Pragma("unroll") for (int d_ = 0; d_ < 2; ++d_) _Pragma("unroll") for (int r = 0; r < 16; ++r) o[d_][r] *= wsf[crow(r, hi)]; } } while (0)
    f32x16 cA, cB;
    u32x4 pwa0, pwa1, pwa2, pwa3, pwb0, pwb1, pwb2, pwb3;
    int sl_prev = 0, sl_cur = 0, sl_next = SLOTB;
#define ROT() do { sl_prev = sl_cur; sl_cur = sl_next; sl_next = (sl_next == (NSLOT - 1) * SLOTB) ? 0 : sl_next + SLOTB; } while (0)
    DMA_K(2, 2 * SLOTB);
    WAIT2(3, 5);
    { const char* kb = shm + LDS_K + hi * 1024 + r32 * 16;
#pragma unroll
      for (int d0 = 0; d0 < 4; ++d0) {
          const bf16x8 b0 = *reinterpret_cast<const bf16x8*>(kb + d0 * 2048);
          const bf16x8 b1 = *reinterpret_cast<const bf16x8*>(kb + d0 * 2048 + 512);
          if (d0 == 0) { cA = __builtin_amdgcn_mfma_f32_32x32x16_bf16(b0, qr[0], zero16, 0, 0, 0); cB = __builtin_amdgcn_mfma_f32_32x32x16_bf16(b1, qr[0], zero16, 0, 0, 0); }
          else { cA = __builtin_amdgcn_mfma_f32_32x32x16_bf16(b0, qr[d0], cA, 0, 0, 0); cB = __builtin_amdgcn_mfma_f32_32x32x16_bf16(b1, qr[d0], cB, 0, 0, 0); } }
      if (MODE == 1) { const char* k8 = shm + LDS_K + 8192 + r32 * 16;
          const bf16x8 b0 = *reinterpret_cast<const bf16x8*>(k8); const bf16x8 b1 = *reinterpret_cast<const bf16x8*>(k8 + 512);
          cA = __builtin_amdgcn_mfma_f32_32x32x16_bf16(b0, qr[NQR - 1], cA, 0, 0, 0); cB = __builtin_amdgcn_mfma_f32_32x32x16_bf16(b1, qr[NQR - 1], cB, 0, 0, 0); } }
    asm volatile("s_nop 15\n\ts_nop 7" : "+v"(cA), "+v"(cB));
#ifndef MK_NOBIAS0
#define MK_NOBIAS0 0
#endif
    if (MODE == 0 && NT <= 28 && !MK_NOBIAS0) BIAS(cA, cB, 0);
    CMASK(cA, cB, 0);
#define PKW(P, B) cvtpk_s(P[B], P[B + 1])
    { mhat = rowmax(cA, cB); mh2 = (f32x2){mhat, mhat}; float sacc = 0.f;
      _Pragma("unroll") for (int r = 0; r < 16; ++r) { cA[r] = __builtin_amdgcn_exp2f(fsub_s(cA[r], mhat)); cB[r] = __builtin_amdgcn_exp2f(fsub_s(cB[r], mhat)); }
      _Pragma("unroll") for (int r = 0; r < 16; ++r) sacc += cA[r] + cB[r];
      l_reg = sacc;
      pwa0 = (u32x4){PKW(cA, 0), PKW(cA, 2), PKW(cA, 4), PKW(cA, 6)}; pwa1 = (u32x4){PKW(cA, 8), PKW(cA, 10), PKW(cA, 12), PKW(cA, 14)};
      pwa2 = (u32x4){PKW(cB, 0), PKW(cB, 2), PKW(cB, 4), PKW(cB, 6)}; pwa3 = (u32x4){PKW(cB, 8), PKW(cB, 10), PKW(cB, 12), PKW(cB, 14)}; }
    WAIT_BAR(0);
    DMA_K(3, 0); DMA_V(1, SLOTB);
    ROT();
#pragma unroll
    for (int j = 0; j < 4; ++j) kload2(kf, kp0 + sl_cur, j);
    if (MODE == 1) { kf[8] = *(const LAS bf16x8*)(kp8 + sl_cur); kf[9] = *(const LAS bf16x8*)(kp8 + sl_cur + 512); }
    WAIT2(2, 3);
    s16x4 vlo[8], vhi[8];
#define PAF(PW, k) __builtin_bit_cast(bf16x8, PW##k)
#define VFR(i) (bf16x8){vlo[i][0], vlo[i][1], vlo[i][2], vlo[i][3], vhi[i][0], vhi[i][1], vhi[i][2], vhi[i][3]}
#define PIN(x) asm volatile("" : "+v"(x))
#define MX3(a, b, c) __builtin_fmaxf(__builtin_fmaxf((a), (b)), (c))
#define GAPA(MF) do { MF; SBAR(); } while (0)
#define EX(v) __builtin_amdgcn_exp2f(v)
#define GAPB(MF, X, B, PW, I) do { MF; { f32x2 a_ = {X[B], X[B + 1]}, b_ = {X[B + 2], X[B + 3]}; a_ -= mh2; b_ -= mh2; const float e0_ = EX(a_.x), e1_ = EX(a_.y), e2_ = EX(b_.x), e3_ = EX(b_.y); \
        sacc += e0_; sacc += e1_; sacc += e2_; sacc += e3_; PW[I] = cvtpk_s(e0_, e1_); PW[I + 1] = cvtpk_s(e2_, e3_); } PIN(PW); PIN(sacc); SBAR(); } while (0)
#define VRD(i) do { vlo[i] = vtr(vp_ + (((i) >> 2) * 4096 + ((i) & 3) * 1024)); vhi[i] = vtr(vp_ + (((i) >> 2) * 4096 + ((i) & 3) * 1024 + 512)); } while (0)
#define KRD(G, j) do { if (G) { kload2(kf, kp0 + sl_next, j); SBAR(); } } while (0)
#define KRD8(G) do { if (MODE == 1 && (G)) { kf[NKF - 2] = *(const LAS bf16x8*)(kp8 + sl_next); kf[NKF - 1] = *(const LAS bf16x8*)(kp8 + sl_next + 512); SBAR(); } } while (0)
#define STEP(PWC, PWN, t, GK, GV, GL, GBIAS) do { SBAR(); \
    const lds_cptr vp_ = vp0 + sl_prev; \
    VRD(0); SBAR(); GAPA(cA = __builtin_amdgcn_mfma_f32_32x32x16_bf16(kf[0], qr[0], zero16, 0, 0, 0)); \
    VRD(4); SBAR(); GAPA(cB = __builtin_amdgcn_mfma_f32_32x32x16_bf16(kf[1], qr[0], zero16, 0, 0, 0)); \
    VRD(1); SBAR(); GAPA(cA = __builtin_amdgcn_mfma_f32_32x32x16_bf16(kf[2], qr[1], cA, 0, 0, 0)); \
    VRD(5); SBAR(); GAPA(cB = __builtin_amdgcn_mfma_f32_32x32x16_bf16(kf[3], qr[1], cB, 0, 0, 0)); \
    VRD(2); SBAR(); GAPA(cA = __builtin_amdgcn_mfma_f32_32x32x16_bf16(kf[4], qr[2], cA, 0, 0, 0)); \
    VRD(6); SBAR(); GAPA(cB = __builtin_amdgcn_mfma_f32_32x32x16_bf16(kf[5], qr[2], cB, 0, 0, 0)); \
    VRD(3); SBAR(); GAPA(cA = __builtin_amdgcn_mfma_f32_32x32x16_bf16(kf[6], qr[3], cA, 0, 0, 0)); \
    VRD(7); SBAR(); GAPA(cB = __builtin_amdgcn_mfma_f32_32x32x16_bf16(kf[7], qr[3], cB, 0, 0, 0)); \
    if (MODE == 1) { cA = __builtin_amdgcn_mfma_f32_32x32x16_bf16(kf[NKF - 2], qr[NQR - 1], cA, 0, 0, 0); cB = __builtin_amdgcn_mfma_f32_32x32x16_bf16(kf[NKF - 1], qr[NQR - 1], cB, 0, 0, 0); SBAR(); } \
    if (GK) { DMA_K((t) + 3, sl_cur); } if (GV) { DMA_V((t) + 1, sl_next); } \
    if (GBIAS) { BIAS(cA, cB, t); } \
    CMASK(cA, cB, t); \
    { float a = MX3(cA[0], cA[1], cB[0]), b = MX3(cA[2], cA[3], cB[1]); a = MX3(a, cB[2], cB[3]); \
      _Pragma("unroll") for (int r = 4; r < 16; r += 4) { a = MX3(a, cA[r], cA[r + 1]); b = MX3(b, cA[r + 2], cA[r + 3]); a = MX3(a, cB[r], cB[r + 1]); b = MX3(b, cB[r + 2], cB[r + 3]); } \
      float rm = __builtin_fmaxf(a, b); { auto rr = __builtin_amdgcn_permlane32_swap(__float_as_uint(rm), __float_as_uint(rm), false, false); rm = __builtin_fmaxf(__uint_as_float(rr[0]), __uint_as_float(rr[1])); } \
      rm -= mhat; resc = false; \
      if (__builtin_expect(__any(rm > (float)THRL), 0)) { const float dl = __builtin_fmaxf(rm, 0.f); mhat += dl; mh2 = (f32x2){mhat, mhat}; \
        const float f = __builtin_amdgcn_exp2f(-dl); l_reg *= f; if (hi == 0) wsf[r32] = f; resc = true; } } \
    SBAR(); \
    float sacc = 0.f; \
    GAPB(o[0] = __builtin_amdgcn_mfma_f32_32x32x16_bf16(PAF(PWC, 0), VFR(0), o[0], 0, 0, 0), cA, 0, PWN##0, 0); \
    GAPB(o[1] = __builtin_amdgcn_mfma_f32_32x32x16_bf16(PAF(PWC, 0), VFR(4), o[1], 0, 0, 0), cA, 4, PWN##0, 2); \
    KRD(GL, 0); GAPB(o[0] = __builtin_amdgcn_mfma_f32_32x32x16_bf16(PAF(PWC, 1), VFR(1), o[0], 0, 0, 0), cA, 8, PWN##1, 0); \
    KRD(GL, 1); GAPB(o[1] = __builtin_amdgcn_mfma_f32_32x32x16_bf16(PAF(PWC, 1), VFR(5), o[1], 0, 0, 0), cA, 12, PWN##1, 2); \
    KRD(GL, 2); GAPB(o[0] = __builtin_amdgcn_mfma_f32_32x32x16_bf16(PAF(PWC, 2), VFR(2), o[0], 0, 0, 0), cB, 0, PWN##2, 0); \
    KRD(GL, 3); GAPB(o[1] = __builtin_amdgcn_mfma_f32_32x32x16_bf16(PAF(PWC, 2), VFR(6), o[1], 0, 0, 0), cB, 4, PWN##2, 2); \
    KRD8(GL); GAPB(o[0] = __builtin_amdgcn_mfma_f32_32x32x16_bf16(PAF(PWC, 3), VFR(3), o[0], 0, 0, 0), cB, 8, PWN##3, 0); \
    GAPB(o[1] = __builtin_amdgcn_mfma_f32_32x32x16_bf16(PAF(PWC, 3), VFR(7), o[1], 0, 0, 0), cB, 12, PWN##3, 2); \
    l_reg += sacc; \
    } while (0)
    int t = 1;
#undef CMASK
#define CMASK(P0, P1, t) do { } while (0)
    for (; t + 5 < NT && (MODE != 0 || NT > 28); t += 2) {
        STEP(pwa, pwb, t, true, true, true, (MODE == 0 && t + 28 >= NT));     WAIT2(2, 3); RESC(); ROT();
        STEP(pwb, pwa, t + 1, true, true, true, (MODE == 0 && t + 29 >= NT)); WAIT2(2, 3); RESC(); ROT();
    }
#undef CMASK
#define CMASK(P0, P1, t) do { int jb_ = (t) - (NT - 4); if (jb_ >= 0) cmask(P0, P1, jb_, qrel, hi); } while (0)
#define ENDW(tt) do { if ((tt) + 3 < NT) { WAIT2(2, 3); } else if ((tt) + 2 < NT) { WAIT_BAR(1); } else { WAIT_BAR(0); } } while (0)
    for (; t + 1 < NT; t += 2) {
        STEP(pwa, pwb, t, (t + 3 < NT), (t + 1 < NT), (t + 1 < NT), (MODE == 0));         ENDW(t);     RESC(); ROT();
        STEP(pwb, pwa, t + 1, (t + 4 < NT), (t + 2 < NT), (t + 2 < NT), (MODE == 0));     ENDW(t + 1); RESC(); ROT();
    }
    STEP(pwa, pwb, NT - 1, false, false, false, (MODE == 0)); RESC();
    SBAR(); pv(o, vb0 + sl_cur, PAF(pwb, 0), PAF(pwb, 1), PAF(pwb, 2), PAF(pwb, 3));
#undef PKW
#undef PAF
#undef VFR
#undef PIN
#undef MX3
#undef GAPA
#undef GAPB
#undef EX
#undef VRD
#undef KRD
#undef KRD8
#undef STEP
#undef ENDW
    { auto rr = __builtin_amdgcn_permlane32_swap(__float_as_uint(l_reg), __float_as_uint(l_reg), false, false); l_reg = __uint_as_float(rr[0]) + __uint_as_float(rr[1]); }
    if (hi == 0) wsf[32 + r32] = l_reg; asm volatile("s_waitcnt lgkmcnt(0)" ::: "memory");
    float rli[16];
#pragma unroll
    for (int r = 0; r < 16; ++r) rli[r] = __builtin_amdgcn_rcpf(wsf[32 + crow(r, hi)]);
    bf16_t* Ow = P.out + (rowbase + q0 + wid * QBLK) * 1024 + ocol;
    { bf16_t* stg = (bf16_t*)(shm + LDS_OST) + wid * 2048;
#pragma unroll
      for (int r = 0; r < 16; ++r) { const int orow = crow(r, hi);
#pragma unroll
          for (int d0 = 0; d0 < 2; ++d0) stg[orow * 64 + d0 * 32 + r32] = (bf16_t)f2bf(o[d0][r] * rli[r]); }
      asm volatile("s_waitcnt lgkmcnt(0)" ::: "memory");
#pragma unroll
      for (int i = 0; i < 4; ++i) { const int row = i * 8 + (lane >> 3), ch = lane & 7; u32x4 v = *(const u32x4*)(stg + row * 64 + ch * 8);
          if (MODE == 1) {
              const u32x4 g = *(const u32x4*)(P.proj + (rowbase + q0 + wid * QBLK + row) * PITCH + 3072 + h * 64 + ch * 8);
              u32x4 w;
#pragma unroll
              for (int j = 0; j < 4; ++j) { const float a0 = bflo(v[j]) * sigmoid_f(bflo(g[j])), a1 = bfhi(v[j]) * sigmoid_f(bfhi(g[j])); w[j] = pk2(a0, a1); }
              v = w; }
          *(u32x4*)(Ow + (long)row * 1024 + ch * 8) = v; } }
    asm volatile("s_waitcnt lgkmcnt(0)\n\ts_barrier" ::: "memory");
#undef DMA_K
#undef DMA_V
#undef WAIT2
#undef CMASK
#undef BIAS
#undef RESC
#undef ROT
}

#ifndef MK_THRL
#define MK_THRL 8
#endif
template <int MODE>
__device__ __forceinline__ void attn_phase(char* lds, const AttnP& P, unsigned* queues  , unsigned xcc, const int tid) {
    volatile LAS int* uw = (volatile LAS int*)(LAS char*)(lds + LDS_UNIT); int cur_h = -1;
    for (int k = 0; k < 8; ++k) {
#if defined(MK_STATIC_Q)
        const int qx = (int)((blockIdx.x + (unsigned)k) & 7u); int it_ = 0;
#else
        const int qx = (int)((xcc + (unsigned)k) & 7u);
#endif
        for (;;) {
#if defined(MK_STATIC_Q)
            if (tid == 0) { uw[0] = (k == 0 && (int)blockIdx.x / 8 + 32 * it_ < 4 * NQB && qx == (int)(blockIdx.x & 7)) ? (int)blockIdx.x / 8 + 32 * it_ : 4 * NQB; } ++it_;
#else
            if (tid == 0) uw[0] = (int)__hip_atomic_fetch_add(queues + 64 * qx, 1u, RLX_AGENT);
#endif
            __syncthreads();
            const int e = __builtin_amdgcn_readfirstlane(uw[0]);
            __syncthreads();
            if (e >= 4 * NQB) break;
            const int bvh = 4 * qx + (e & 3), qb = NQB - 1 - (e >> 2);
#ifndef MK_T5RELOAD
#define MK_T5RELOAD 0
#endif
            if (MODE == 0 && (MK_T5RELOAD || ((bvh & 15) >> 2) != cur_h)) {
                cur_h = (bvh & 15) >> 2;
                LAS float* tb = (LAS float*)(LAS char*)(lds + LDS_TB) + tid; const GAS float* src = (const GAS float*)P.t5tab + (size_t)cur_h * T5N + tid; asm volatile("" : "+v"(tb), "+v"(src));
#pragma unroll
                for (int it = 0; it < (T5N + NTHR - 1) / NTHR; ++it) if (tid + NTHR * it < T5N) tb[NTHR * it] = src[NTHR * it];
                __syncthreads();
            }
            attn_unit<MODE, MK_THRL>(P, bvh >> 4, bvh & 15, qb, lds, tid);
        }
    }
}
#undef SBAR
#undef WAIT_BAR
}
struct Args { const float* in[24]; float* out; unsigned char* ws; const float* dbg_src; int lo, hi, bar_region, dbg_layer0; };
static_assert(sizeof(Args) == 27 * 8 + 16, "Args has padding");
template <int K_> __device__ __forceinline__ const float* inptr() {
#if defined(__HIP_DEVICE_COMPILE__)
    auto ka = __builtin_amdgcn_kernarg_segment_ptr(); const GAS float* p;
    asm volatile("s_load_dwordx2 %0, %1, %2\n\ts_waitcnt lgkmcnt(0)" : "=s"(p) : "s"(ka), "i"(K_ * 8)); return (const float*)p;
#else
    return nullptr;
#endif
}
#define INP(k) inptr<k>()
struct Frame {
    LAS unsigned char* lds; char* ldsg;
    gu32* ctl; unsigned char* ws;
    int tid, lane, wave, G, gw, NGW;
    float* out;
};
__device__ __forceinline__ float wave_sum(float v) {
#pragma unroll
    for (int o = 1; o < 64; o <<= 1) v += __shfl_xor(v, o);
    return v;
}
__device__ __forceinline__ float rowmax16(float v) {
    v = fmaxf(v, __builtin_bit_cast(float, __builtin_amdgcn_update_dpp(0, __builtin_bit_cast(int, v), 0xB1, 0xF, 0xF, false)));
    v = fmaxf(v, __builtin_bit_cast(float, __builtin_amdgcn_update_dpp(0, __builtin_bit_cast(int, v), 0x4E, 0xF, 0xF, false)));
    v = fmaxf(v, __builtin_bit_cast(float, __builtin_amdgcn_update_dpp(0, __builtin_bit_cast(int, v), 0x141, 0xF, 0xF, false)));
    v = fmaxf(v, __builtin_bit_cast(float, __builtin_amdgcn_update_dpp(0, __builtin_bit_cast(int, v), 0x140, 0xF, 0xF, false)));
    return v;
}
__device__ __forceinline__ float rowsum16(float v) {
    v += __builtin_bit_cast(float, __builtin_amdgcn_update_dpp(0, __builtin_bit_cast(int, v), 0xB1, 0xF, 0xF, false));
    v += __builtin_bit_cast(float, __builtin_amdgcn_update_dpp(0, __builtin_bit_cast(int, v), 0x4E, 0xF, 0xF, false));
    v += __builtin_bit_cast(float, __builtin_amdgcn_update_dpp(0, __builtin_bit_cast(int, v), 0x141, 0xF, 0xF, false));
    v += __builtin_bit_cast(float, __builtin_amdgcn_update_dpp(0, __builtin_bit_cast(int, v), 0x140, 0xF, 0xF, false));
    return v;
}

__device__ __forceinline__ void p0_transpose_item(const float* W, int ldn, int K, bf16_t* WT, int k0, int n_src0, int n_dst0, LAS float* scr, int lane) {
#pragma unroll 8
    for (int i = 0; i < 32; ++i) { const int kk = 2 * i + (lane >> 5); scr[kk * 33 + (lane & 31)] = W[(size_t)(k0 + kk) * ldn + n_src0 + (lane & 31)]; }
    LDS_WAIT(); asm volatile("" ::: "memory");
    const int c = lane & 7;
#pragma unroll
    for (int j = 0; j < 4; ++j) { const int n = (lane >> 3) + 8 * j; const LAS float* s = scr + (8 * c) * 33 + n;
        u32x4 o; o.x = pk2(s[0 * 33], s[1 * 33]); o.y = pk2(s[2 * 33], s[3 * 33]); o.z = pk2(s[4 * 33], s[5 * 33]); o.w = pk2(s[6 * 33], s[7 * 33]);
        *(GAS u32x4*)(WT + (size_t)(n_dst0 + n) * K + k0 + 8 * c) = o; }
    LDS_WAIT(); asm volatile("" ::: "memory");
}
__device__ __forceinline__ void p0a_convert(Frame& F) {
    LAS float* scr = (LAS float*)(F.lds + F.wave * 16384);
    unsigned char* ws = F.ws;
    constexpr int I_INE = 16 * 112, I_INO = 16 * 128, I_OUT = 16 * 32, I_GU = 16 * 64, I_D = 16 * 32;
    constexpr int N_DENSE = 2 * (I_INE + I_INO + 2 * I_OUT);
    constexpr long N_MOE = 128L * (I_GU + I_D);
    for (long it = F.gw; it < N_DENSE + N_MOE; it += F.NGW) {
        long r = it;
        if (r < N_DENSE) {
            const int i = (int)(r / (N_DENSE / 2)); int q = (int)(r % (N_DENSE / 2));
            if (q < I_INE) { p0_transpose_item(INP(2) + (size_t)i * D * EVEN_IN, EVEN_IN, D, (bf16_t*)(ws + WS_WINE) + (size_t)i * 3584 * D, 64 * (q / 112), 32 * (q % 112), 32 * (q % 112), scr, F.lane); continue; } q -= I_INE;
            if (q < I_INO) { p0_transpose_item(INP(10) + (size_t)i * D * ODD_IN, ODD_IN, D, (bf16_t*)(ws + WS_WINO) + (size_t)i * 4096 * D, 64 * (q / 128), 32 * (q % 128), 32 * (q % 128), scr, F.lane); continue; } q -= I_INO;
            if (q < I_OUT) { p0_transpose_item(INP(3) + (size_t)i * D * D, D, D, (bf16_t*)(ws + WS_WOUTE) + (size_t)i * D * D, 64 * (q / 32), 32 * (q % 32), 32 * (q % 32), scr, F.lane); continue; } q -= I_OUT;
            p0_transpose_item(INP(11) + (size_t)i * D * D, D, D, (bf16_t*)(ws + WS_WOUTO) + (size_t)i * D * D, 64 * (q / 32), 32 * (q % 32), 32 * (q % 32), scr, F.lane); continue;
        }
        r -= N_DENSE;
        const int le = (int)(r / (I_GU + I_D)); int q = (int)(r % (I_GU + I_D));
        if (q < I_GU) { const int nb = q % 64, n_src = 32 * nb;
            const int cc = n_src & 1023, n_dst = (cc >> 7) * 256 + (n_src >= 1024 ? 128 : 0) + (cc & 127);
            p0_transpose_item(INP(16) + (size_t)le * D * 2048, 2048, D, (bf16_t*)(ws + WS_WGU) + (size_t)le * 2048 * D, 64 * (q / 64), n_src, n_dst, scr, F.lane); }
        else { q -= I_GU; p0_transpose_item(INP(18) + (size_t)le * DFF * D, D, DFF, (bf16_t*)(ws + WS_WD) + (size_t)le * D * DFF, 64 * (q / 32), 32 * (q % 32), 32 * (q % 32), scr, F.lane); }
    }
    for (int it = F.gw; it < 128 + 32 + 32; it += F.NGW) {
        const float* src; int ld, col; bf16_t* hi; bool zero = false;
        if (it < 128) { const int l = it >> 5, e = it & 31; src = INP(14) + (size_t)l * D * NE; ld = NE; col = e; hi = (bf16_t*)(ws + WS_RW) + ((size_t)l * 2 * 32 + e) * 1024; }
        else if (it < 160) { const int i = (it - 128) >> 4, n = (it - 128) & 15; src = INP(2) + (size_t)i * D * EVEN_IN; ld = EVEN_IN; col = 3584 + n; zero = n >= 8; hi = (bf16_t*)(ws + WS_SWE) + ((size_t)i * 2 * 16 + n) * 1024; }
        else { const int i = (it - 160) >> 4, n = (it - 160) & 15; src = INP(10) + (size_t)i * D * ODD_IN; ld = ODD_IN; col = 4096 + n; hi = (bf16_t*)(ws + WS_SWO) + ((size_t)i * 2 * 16 + n) * 1024; }
        bf16_t* lo = hi + (it < 128 ? 32 : 16) * 1024;
        for (int k = F.lane; k < D; k += 64) { const float w = zero ? 0.f : src[(size_t)k * ld + col]; const unsigned h = f2bf(w); hi[k] = (bf16_t)h; lo[k] = (bf16_t)f2bf(w - __builtin_bit_cast(float, h << 16)); }
    }
    for (int i = F.gw * 64 + F.lane; i < 4 * T5N; i += F.NGW * 64) {
        const int h = i / T5N, p = i % T5N; float v = 0.f;
        if (p >= T5PAD) { const int n = p - T5PAD; int bk = n;
            if (n >= 16) { bk = 16 + (n >= 22) + (n >= 30) + (n >= 40) + (n >= 54) + (n >= 73) + (n >= 99) + (n >= 134) + (n >= 182) + (n >= 246) + (n >= 332) + (n >= 450) + (n >= 609) + (n >= 825) + (n >= 1117) + (n >= 1513); }
            v = (INP(1)[bk * 4 + h] - INP(1)[31 * 4 + h]) * LOG2E; }
#ifdef MK_ZEROT5
        v = 0.f;
#endif
#ifdef MK_SAMET5
        if (p >= T5PAD) { const int n = p - T5PAD; int bk = n; if (n >= 16) { bk = 16 + (n >= 22) + (n >= 30) + (n >= 40) + (n >= 54) + (n >= 73) + (n >= 99) + (n >= 134) + (n >= 182) + (n >= 246) + (n >= 332) + (n >= 450) + (n >= 609) + (n >= 825) + (n >= 1117) + (n >= 1513); } v = (INP(1)[bk * 4] - INP(1)[31 * 4]) * LOG2E; }
#endif
        ((float*)(ws + WS_T5))[i] = v;
    }
}

struct Ln16 {
    const float* X; const float* H; const bf16_t* Y; float* Xout; bf16_t* XB; const float* gam; const float* bet;
    const bf16_t* Whi; const bf16_t* Wlo;
};
template <int SRC, int NS, bool WRITE_XB>
__device__ __forceinline__ void ln16_tile(const Ln16& P, int tile, int lane, const int (&pos)[4], const float (&gt)[4], f32x4 (&acc)[NS > 0 ? NS : 1]) {
    const int r = lane & 15, q = lane >> 4; const size_t m = (size_t)tile * 16 + r;
    const float* xr = P.X + m * D + 8 * q; const float* hr = (SRC == 1) ? P.H + m * D + 8 * q : nullptr;
    const bf16_t* yr[4];
    if (SRC == 2) {
#pragma unroll
        for (int k = 0; k < 4; ++k) yr[k] = P.Y + (size_t)pos[k] * D + 8 * q; }
#define LN16_LOAD(v, ks) do { const f32x4 a0 = *(const f32x4*)(xr + 32 * (ks)), a1 = *(const f32x4*)(xr + 32 * (ks) + 4); \
        if (SRC == 0) { _Pragma("unroll") for (int j = 0; j < 4; ++j) { v[j] = a0[j]; v[4 + j] = a1[j]; } } \
        else if (SRC == 1) { const f32x4 h0 = *(const f32x4*)(hr + 32 * (ks)), h1 = *(const f32x4*)(hr + 32 * (ks) + 4); _Pragma("unroll") for (int j = 0; j < 4; ++j) { v[j] = ALPHA * a0[j] + h0[j]; v[4 + j] = ALPHA * a1[j] + h1[j]; } } \
        else { _Pragma("unroll") for (int j = 0; j < 4; ++j) { v[j] = ALPHA * a0[j]; v[4 + j] = ALPHA * a1[j]; } \
            _Pragma("unroll") for (int k = 0; k < 4; ++k) { const u32x4 y = *(const u32x4*)(yr[k] + 32 * (ks)); _Pragma("unroll") for (int j = 0; j < 4; ++j) { v[2 * j] = fmaf(gt[k], bflo(y[j]), v[2 * j]); v[2 * j + 1] = fmaf(gt[k], bfhi(y[j]), v[2 * j + 1]); } } } } while (0)
    float mean = 0.f, rstd = 1.f;
    if (SRC != 0) {
        float s = 0.f, ss = 0.f;
#pragma unroll 4
        for (int ks = 0; ks < 32; ++ks) { float v[8]; LN16_LOAD(v, ks);
#pragma unroll
            for (int j = 0; j < 8; ++j) { s += v[j]; ss = fmaf(v[j], v[j], ss); } }
        s += __shfl_xor(s, 16); s += __shfl_xor(s, 32); ss += __shfl_xor(ss, 16); ss += __shfl_xor(ss, 32);
        mean = s * (1.f / D); const float var = fmaxf(ss * (1.f / D) - mean * mean, 0.f); rstd = rsqrtf(var + LN_EPS);
    }
#pragma unroll
    for (int n = 0; n < (NS > 0 ? NS : 1); ++n) acc[n] = (f32x4){0.f, 0.f, 0.f, 0.f};
#pragma unroll 2
    for (int ks = 0; ks < 32; ++ks) {
        float v[8]; LN16_LOAD(v, ks);
        if (SRC != 0) { const f32x4 g0 = *(const f32x4*)(P.gam + 32 * ks + 8 * q), g1 = *(const f32x4*)(P.gam + 32 * ks + 8 * q + 4), b0 = *(const f32x4*)(P.bet + 32 * ks + 8 * q), b1 = *(const f32x4*)(P.bet + 32 * ks + 8 * q + 4);
#pragma unroll
            for (int j = 0; j < 4; ++j) { v[j] = (v[j] - mean) * rstd * g0[j] + b0[j]; v[4 + j] = (v[4 + j] - mean) * rstd * g1[j] + b1[j]; } }
        float* xo = P.Xout + m * D + 32 * ks + 8 * q;
        *(f32x4*)xo = (f32x4){v[0], v[1], v[2], v[3]}; *(f32x4*)(xo + 4) = (f32x4){v[4], v[5], v[6], v[7]};
        u32x4 hi; hi.x = pk2(v[0], v[1]); hi.y = pk2(v[2], v[3]); hi.z = pk2(v[4], v[5]); hi.w = pk2(v[6], v[7]);
        if (WRITE_XB) *(u32x4*)(P.XB + m * D + 32 * ks + 8 * q) = hi;
        if (NS > 0) {
            u32x4 lo;
#pragma unroll
            for (int j = 0; j < 4; ++j) lo[j] = pk2(v[2 * j] - bflo(hi[j]), v[2 * j + 1] - bfhi(hi[j]));
            const bf16x8 ah = __builtin_bit_cast(bf16x8, hi), al = __builtin_bit_cast(bf16x8, lo);
#pragma unroll
            for (int n = 0; n < NS; ++n) {
                const bf16x8 bh = *(const bf16x8*)(P.Whi + (size_t)(16 * n + r) * D + 32 * ks + 8 * q), bl = *(const bf16x8*)(P.Wlo + (size_t)(16 * n + r) * D + 32 * ks + 8 * q);
                acc[n] = __builtin_amdgcn_mfma_f32_16x16x32_bf16(ah, bh, acc[n], 0, 0, 0);
                acc[n] = __builtin_amdgcn_mfma_f32_16x16x32_bf16(al, bh, acc[n], 0, 0, 0);
                acc[n] = __builtin_amdgcn_mfma_f32_16x16x32_bf16(ah, bl, acc[n], 0, 0, 0); }
        }
    }
#undef LN16_LOAD
}
__device__ __forceinline__ void smallproj_store(Frame& F, const f32x4& acc, int tile, bool next_even, const float* fb) {
    const int r = F.lane & 15, q = F.lane >> 4;
    if (next_even) {
        float* pb = (float*)(F.ws + WS_PB);
#pragma unroll
        for (int i = 0; i < 4; ++i) pb[(size_t)(tile * 16 + 4 * q + i) * 16 + r] = acc[i];
    } else {
        float* cum = (float*)(F.ws + WS_CUM); float* tsum = (float*)(F.ws + WS_TSUM);
        const int tok0 = tile * 16, b = tok0 / T, t0 = tok0 % T; const float bias = fb[r]; float s = 0.f;
#pragma unroll
        for (int i = 0; i < 4; ++i) { const float lf = -softplus_f(-(acc[i] + bias)); cum[(size_t)(b * 16 + r) * T + t0 + 4 * q + i] = lf; s += lf; }
        s += __shfl_xor(s, 16); s += __shfl_xor(s, 32);
        if (q == 0) tsum[(size_t)(b * 16 + r) * 1024 + (t0 >> 4)] = s;
    }
}

__device__ __forceinline__ void p0b_input(Frame& F) {
    Ln16 P{INP(0), nullptr, nullptr, (float*)(F.ws + WS_X), (bf16_t*)(F.ws + WS_XB), nullptr, nullptr, (const bf16_t*)(F.ws + WS_SWE), (const bf16_t*)(F.ws + WS_SWE) + 16 * 1024};
    const int pos[4] = {0, 0, 0, 0}; const float gt[4] = {0.f, 0.f, 0.f, 0.f};
    for (int tile = F.gw; tile < NTOK / 16; tile += F.NGW) { f32x4 acc[1]; ln16_tile<0, 1, true>(P, tile, F.lane, pos, gt, acc); smallproj_store(F, acc[0], tile, true, nullptr); }
}

__device__ __forceinline__ void ln_router_phase(Frame& F, int layer) {
    volatile LAS int* wcnt = (volatile LAS int*)(F.lds + 0); volatile LAS int* gbase = (volatile LAS int*)(F.lds + 128);
    Ln16 P{(const float*)(F.ws + WS_X), (const float*)(F.ws + WS_H), nullptr, (float*)(F.ws + WS_X), (bf16_t*)(F.ws + WS_XB), INP(20) + layer * D, INP(21) + layer * D,
           (const bf16_t*)(F.ws + WS_RW) + (size_t)layer * 2 * 32 * 1024, (const bf16_t*)(F.ws + WS_RW) + (size_t)layer * 2 * 32 * 1024 + 32 * 1024};
    const float* rb = INP(15) + layer * NE;
    int* sele = (int*)(F.ws + WS_SELE); int* slot_o = (int*)(F.ws + WS_SLOT); float* gate_o = (float*)(F.ws + WS_GATE); int* list = (int*)(F.ws + WS_LIST);
    unsigned* gcnt = (unsigned*)(F.ctl + CW_CNT + layer * NE);
    const int pos[4] = {0, 0, 0, 0}; const float gt[4] = {0.f, 0.f, 0.f, 0.f};
    const int r = F.lane & 15, q = F.lane >> 4;
    for (int wt = blockIdx.x; wt < NTOK / 128; wt += F.G) {
        if (F.tid < 32) wcnt[F.tid] = 0;
        __syncthreads();
        const int tile = wt * 8 + F.wave;
        f32x4 acc[2]; ln16_tile<1, 2, true>(P, tile, F.lane, pos, gt, acc);
        const float b0 = rb[r], b1 = rb[16 + r];
        float top[4][4];
#pragma unroll
        for (int i = 0; i < 4; ++i) {
            float a = __builtin_bit_cast(float, (__builtin_bit_cast(unsigned, acc[0][i] + b0) & ~31u) | (unsigned)r);
            float b = __builtin_bit_cast(float, (__builtin_bit_cast(unsigned, acc[1][i] + b1) & ~31u) | (unsigned)(16 + r));
#pragma unroll
            for (int k = 0; k < 4; ++k) { const float mx = rowmax16(fmaxf(a, b)); top[i][k] = mx; if (a == mx) a = -INFINITY; if (b == mx) b = -INFINITY; }
        }
        float tv[4];
#pragma unroll
        for (int k = 0; k < 4; ++k) { const int i = r >> 2; tv[k] = i == 0 ? top[0][k] : i == 1 ? top[1][k] : i == 2 ? top[2][k] : top[3][k]; }
        float w[4], ws_ = 0.f;
#pragma unroll
        for (int k = 0; k < 4; ++k) { w[k] = __expf(tv[k] - tv[0]); ws_ += w[k]; }
        const int kk = r & 3; const float mine = kk == 0 ? tv[0] : kk == 1 ? tv[1] : kk == 2 ? tv[2] : tv[3]; const float gmine = (kk == 0 ? w[0] : kk == 1 ? w[1] : kk == 2 ? w[2] : w[3]) / ws_;
        const int e = (int)(__builtin_bit_cast(unsigned, mine) & 31u);
        const int local = __hip_atomic_fetch_add((LAS int*)(wcnt + e), 1, __ATOMIC_RELAXED, __HIP_MEMORY_SCOPE_WORKGROUP);
        __syncthreads();
        if (F.tid < 32) gbase[F.tid] = (int)__hip_atomic_fetch_add(gcnt + F.tid, (unsigned)wcnt[F.tid], RLX_AGENT);
        __syncthreads();
        const int tok = tile * 16 + 4 * q + (r >> 2); const int sl = gbase[e] + local;
        sele[tok * 4 + kk] = e; slot_o[tok * 4 + kk] = sl; gate_o[tok * 4 + kk] = gmine; list[(size_t)e * NTOK + sl] = tok * 4 + kk;
        __syncthreads();
    }
}

__device__ __forceinline__ void moe_tables(Frame& F, int layer) {
    volatile LAS int* cnt = (volatile LAS int*)(F.lds + RING_BYTES); volatile LAS int* offp = cnt + 32;
    if (F.tid < 64) {
        const int c = F.lane < 32 ? (int)__hip_atomic_load((unsigned*)(F.ctl + CW_CNT + layer * NE + (F.lane & 31)), RLX_AGENT) : 0;
        int p = ((c + 255) >> 8) << 8;
#pragma unroll
        for (int o = 1; o < 32; o <<= 1) { const int n = __shfl_up(p, o); if ((F.lane & 31) >= o) p += n; }
        if (F.lane < 32) { cnt[F.lane] = c; offp[F.lane] = p - (((c + 255) >> 8) << 8); }
    }
    __syncthreads();
}

__device__ __forceinline__ void moe_out_phase(Frame& F, int layer) {
    volatile LAS int* offp = (volatile LAS int*)(F.lds + RING_BYTES) + 32;
    const bool lastl = layer == 3, next_even = (layer & 1) == 1; const int ni = (layer + 1) >> 1;
    const bf16_t* sw = next_even ? (const bf16_t*)(F.ws + WS_SWE) + (size_t)ni * 2 * 16 * 1024 : (const bf16_t*)(F.ws + WS_SWO) + (size_t)ni * 2 * 16 * 1024;
    Ln16 P{(const float*)(F.ws + WS_X), nullptr, (const bf16_t*)(F.ws + WS_Y), lastl ? F.out : (float*)(F.ws + WS_X), (bf16_t*)(F.ws + WS_XB), INP(22) + layer * D, INP(23) + layer * D, sw, sw + 16 * 1024};
    const int* sele = (const int*)(F.ws + WS_SELE); const int* slot = (const int*)(F.ws + WS_SLOT); const float* gate = (const float*)(F.ws + WS_GATE);
    const float* fb = INP(13) + (lastl ? 0 : ni * 16);
    for (int tile = F.gw; tile < NTOK / 16; tile += F.NGW) {
        const int m = tile * 16 + (F.lane & 15); int pos[4]; float gt[4];
#pragma unroll
        for (int k = 0; k < 4; ++k) { pos[k] = offp[sele[m * 4 + k]] + slot[m * 4 + k]; gt[k] = gate[m * 4 + k]; }
        f32x4 acc[1];
        if (lastl) ln16_tile<2, 0, false>(P, tile, F.lane, pos, gt, acc);
        else { ln16_tile<2, 1, true>(P, tile, F.lane, pos, gt, acc); smallproj_store(F, acc[0], tile, next_even, fb); }
    }
}

__device__ __forceinline__ void odd_prep_phase(Frame& F, int li) {
    float* cum = (float*)(F.ws + WS_CUM); const float* tsum = (const float*)(F.ws + WS_TSUM); bf16_t* kb8 = (bf16_t*)(F.ws + WS_KB8);
    for (int it = F.gw; it < 32 * 64; it += F.NGW) {
        const int bh = it >> 6, seg = it & 63;
        double base = 0.0;
        for (int j = F.lane; j < 16 * seg; j += 64) base += (double)tsum[(size_t)bh * 1024 + j];
#pragma unroll
        for (int o = 1; o < 64; o <<= 1) base += __shfl_xor(base, o);
        float* p = cum + (size_t)bh * T + seg * 256 + 4 * F.lane;
        const f32x4 lf = *(const f32x4*)p;
        float c0 = lf[0], c1 = c0 + lf[1], c2 = c1 + lf[2], c3 = c2 + lf[3];
        float incl = c3;
#pragma unroll
        for (int o = 1; o < 64; o <<= 1) { const float n = __shfl_up(incl, o); if (F.lane >= o) incl += n; }
        const float excl = incl - c3; const float bs = (float)base + excl;
        const float cc[4] = {(bs + c0) * LOG2E, (bs + c1) * LOG2E, (bs + c2) * LOG2E, (bs + c3) * LOG2E};
        *(f32x4*)p = (f32x4){cc[0], cc[1], cc[2], cc[3]};
#pragma unroll
        for (int j = 0; j < 4; ++j) { const float c = -cc[j];
            const unsigned ch = f2bf(c); const float r1 = c - __builtin_bit_cast(float, ch << 16); const unsigned cm = f2bf(r1); const float r2 = r1 - __builtin_bit_cast(float, cm << 16); const unsigned cl = f2bf(r2);
            u32x4 w; w.x = 0x3f80u | (0x3f80u << 16); w.y = 0x3f80u | (ch << 16); w.z = cm | (cl << 16); w.w = 0u;
            *(u32x4*)(kb8 + ((size_t)bh * T + seg * 256 + 4 * F.lane + j) * 8) = w; }
    }
    bf16_t* proj = (bf16_t*)(F.ws + WS_PROJ); const float* nw = INP(12) + li * 128;
    float wq[16], wk[16];
#pragma unroll
    for (int j = 0; j < 16; ++j) { wq[j] = nw[(F.lane & 3) * 16 + j] * C2; wk[j] = nw[64 + (F.lane & 3) * 16 + j]; }
    for (int tok = F.gw; tok < NTOK; tok += F.NGW) {
#pragma unroll
        for (int which = 0; which < 2; ++which) {
            bf16_t* p = proj + (size_t)tok * PITCH + which * 1024 + 16 * F.lane;
            const u32x4 a = *(const u32x4*)p, b = *(const u32x4*)(p + 8);
            float v[16];
#pragma unroll
            for (int j = 0; j < 4; ++j) { v[2 * j] = bflo(a[j]); v[2 * j + 1] = bfhi(a[j]); v[8 + 2 * j] = bflo(b[j]); v[8 + 2 * j + 1] = bfhi(b[j]); }
            float ss = 0.f;
#pragma unroll
            for (int j = 0; j < 16; ++j) ss = fmaf(v[j], v[j], ss);
            ss += __shfl_xor(ss, 1); ss += __shfl_xor(ss, 2);
            const float rr = rsqrtf(ss * (1.f / 64.f) + RMS_EPS);
            u32x4 oa, ob;
#pragma unroll
            for (int j = 0; j < 4; ++j) { oa[j] = pk2(v[2 * j] * rr * (which ? wk[2 * j] : wq[2 * j]), v[2 * j + 1] * rr * (which ? wk[2 * j + 1] : wq[2 * j + 1]));
                ob[j] = pk2(v[8 + 2 * j] * rr * (which ? wk[8 + 2 * j] : wq[8 + 2 * j]), v[8 + 2 * j + 1] * rr * (which ? wk[8 + 2 * j + 1] : wq[8 + 2 * j + 1])); }
            *(u32x4*)p = oa; *(u32x4*)(p + 8) = ob;
        }
    }
}

__device__ __forceinline__ void even_combine_phase(Frame& F, int li, float lam_init) {
    const float* lp = INP(4) + li * 256;
    float a = 0.f, bsum = 0.f; { const int l = F.lane; a = lp[l] * lp[64 + l]; bsum = lp[128 + l] * lp[192 + l]; }
    a = wave_sum(a); bsum = wave_sum(bsum);
    const float lam = __expf(a) - __expf(bsum) + lam_init;
    const bf16_t* att = (const bf16_t*)(F.ws + WS_ATT); const float* go = (const float*)(F.ws + WS_GO); const bf16_t* proj = (const bf16_t*)(F.ws + WS_PROJ); bf16_t* mix = (bf16_t*)(F.ws + WS_MIX);
    const int l = F.lane, hh = l >> 4, d0 = (l & 15) * 8;
    float sw[8], gw[8];
#pragma unroll
    for (int j = 0; j < 8; ++j) { sw[j] = INP(5)[li * 128 + d0 + j] * (1.f - lam_init); gw[j] = INP(9)[li * 128 + d0 + j]; }
    for (int tok = F.gw; tok < NTOK; tok += F.NGW) {
        const u32x4 o0 = *(const u32x4*)(att + (size_t)tok * D + (hh * 2) * 128 + d0), o1 = *(const u32x4*)(att + (size_t)tok * D + (hh * 2 + 1) * 128 + d0);
        float v[8]; float ss = 0.f;
#pragma unroll
        for (int j = 0; j < 4; ++j) { v[2 * j] = bflo(o0[j]) - lam * bflo(o1[j]); v[2 * j + 1] = bfhi(o0[j]) - lam * bfhi(o1[j]); }
#pragma unroll
        for (int j = 0; j < 8; ++j) ss = fmaf(v[j], v[j], ss);
        ss = rowsum16(ss);
        float rr = rsqrtf(ss * (1.f / 128.f) + RMS_EPS);
        u32x4 w;
#pragma unroll
        for (int j = 0; j < 4; ++j) w[j] = pk2(v[2 * j] * rr * sw[2 * j], v[2 * j + 1] * rr * sw[2 * j + 1]);
        *(u32x4*)(mix + (size_t)tok * D + hh * 128 + d0) = w;
        const f32x4 g0 = *(const f32x4*)(go + (size_t)tok * 512 + hh * 128 + d0), g1 = *(const f32x4*)(go + (size_t)tok * 512 + hh * 128 + d0 + 4);
        const u32x4 z = *(const u32x4*)(proj + (size_t)tok * PITCH + 3072 + hh * 128 + d0);
        float u[8] = {g0[0], g0[1], g0[2], g0[3], g1[0], g1[1], g1[2], g1[3]};
        ss = 0.f;
#pragma unroll
        for (int j = 0; j < 8; ++j) ss = fmaf(u[j], u[j], ss);
        ss = rowsum16(ss);
        rr = rsqrtf(ss * (1.f / 128.f) + RMS_EPS);
#pragma unroll
        for (int j = 0; j < 4; ++j) { const float z0 = bflo(z[j]), z1 = bfhi(z[j]); w[j] = pk2(u[2 * j] * rr * gw[2 * j] * (z0 * sigmoid_f(z0)), u[2 * j + 1] * rr * gw[2 * j + 1] * (z1 * sigmoid_f(z1))); }
        *(u32x4*)(mix + (size_t)tok * D + 512 + hh * 128 + d0) = w;
    }
}
constexpr int GP_W = 136, GP_K = 72;
constexpr int GB_W = 64 * GP_W * 2, GB_QK = 64 * GP_K * 2, GB_KD = 128 * GP_K * 2;
constexpr int GB_ITEM = 2 * GB_W + GB_QK + GB_KD;
__device__ __forceinline__ int P32(int x) { return (x & ~31) | (((x >> 2) & 3) << 3) | (((x >> 4) & 1) << 2) | (x & 3); }

__device__ __forceinline__ void gdn_prep_phase(Frame& F, int li) {
    LAS unsigned char* L = F.lds;
    LAS bf16_t* Kn = (LAS bf16_t*)(L + 0);
    LAS bf16_t* Qn = (LAS bf16_t*)(L + 17408);
    LAS float* R = (LAS float*)(L + 34816);
    LAS float* Lm = (LAS float*)(L + 100352);
    LAS float* sc = (LAS float*)(L + 116736);
    const bf16_t* proj = (const bf16_t*)(F.ws + WS_PROJ); const float* pb = (const float*)(F.ws + WS_PB);
    const float* cw = INP(6) + (size_t)li * 4 * 1536;
    const int tid = F.tid, lane = F.lane, wave = F.wave;
    for (int item = blockIdx.x; item < 2048; item += F.G) {
        const int n = item & 255, h = (item >> 8) & 3, b = item >> 10; const int t0 = n * 64; const size_t tok0 = (size_t)b * T + t0;
        if (wave == 0) {
            const float bb = pb[(tok0 + lane) * 16 + h], ba = pb[(tok0 + lane) * 16 + 4 + h];
            const float beta = sigmoid_f(bb); const float g = -__expf(INP(7)[li * 4 + h]) * softplus_f(ba + INP(8)[li * 4 + h]);
            float gc = g;
#pragma unroll
            for (int o = 1; o < 64; o <<= 1) { const float v = __shfl_up(gc, o); if (lane >= o) gc += v; }
            sc[lane] = beta; sc[64 + lane] = gc;
        }
        __syncthreads();
        const int c = tid & 127, seg = tid >> 7;
        float yq[16], yk[16];
        {
            float w[3][4];
#pragma unroll
            for (int g = 0; g < 3; ++g)
#pragma unroll
                for (int j = 0; j < 4; ++j) w[g][j] = cw[j * 1536 + g * 512 + h * 128 + c];
            float xw[3][3];
            const bf16_t* base = proj + (tok0 + 16 * seg) * PITCH + 1536 + h * 128 + c;
#pragma unroll
            for (int j = 0; j < 3; ++j) { const bool ok = (t0 + 16 * seg - 3 + j) >= 0;
#pragma unroll
                for (int g = 0; g < 3; ++g) xw[g][j] = ok ? bf2f(base[(long)(j - 3) * PITCH + g * 512]) : 0.f; }
#pragma unroll
            for (int j = 0; j < 16; ++j) {
                float x[3];
#pragma unroll
                for (int g = 0; g < 3; ++g) x[g] = bf2f(base[(long)j * PITCH + g * 512]);
                float y[3];
#pragma unroll
                for (int g = 0; g < 3; ++g) { y[g] = w[g][0] * xw[g][0] + w[g][1] * xw[g][1] + w[g][2] * xw[g][2] + w[g][3] * x[g]; y[g] = y[g] * sigmoid_f(y[g]); xw[g][0] = xw[g][1]; xw[g][1] = xw[g][2]; xw[g][2] = x[g]; }
                yq[j] = y[0]; yk[j] = y[1]; R[(16 * seg + j) * 256 + c] = y[2] * sc[16 * seg + j];
            }
#pragma unroll
            for (int j = 0; j < 16; ++j) { const float sq = wave_sum(yq[j] * yq[j]), sk = wave_sum(yk[j] * yk[j]); if (lane == 0) { sc[128 + (wave * 16 + j) * 2] = sq; sc[128 + (wave * 16 + j) * 2 + 1] = sk; } }
        }
        __syncthreads();
        {
            const int wp = wave ^ 1;
#pragma unroll
            for (int j = 0; j < 16; ++j) { const int tk = 16 * seg + j;
                const float rq = rsqrtf(sc[128 + (wave * 16 + j) * 2] + sc[128 + (wp * 16 + j) * 2] + RMS_EPS), rk = rsqrtf(sc[128 + (wave * 16 + j) * 2 + 1] + sc[128 + (wp * 16 + j) * 2 + 1] + RMS_EPS);
                const float bt = sc[tk]; Qn[tk * GP_W + c] = (bf16_t)f2bf(yq[j] * rq); Kn[tk * GP_W + c] = (bf16_t)f2bf(yk[j] * rk); R[tk * 256 + 128 + c] = yk[j] * rk * bt * __expf(sc[64 + tk]); }
        }
        __syncthreads();
        {
            const int pq = wave >> 2, ti = (wave >> 1) & 1, tj = wave & 1, r32 = lane & 31, hi = lane >> 5;
            const LAS bf16_t* Ap = (pq ? Qn : Kn) + (32 * ti + r32) * GP_W + 8 * hi; const LAS bf16_t* Bp = Kn + (32 * tj + r32) * GP_W + 8 * hi;
            f32x16 acc = f32x16{};
#pragma unroll
            for (int ks = 0; ks < 8; ++ks) acc = __builtin_amdgcn_mfma_f32_32x32x16_bf16(*(const LAS bf16x8*)(Ap + 16 * ks), *(const LAS bf16x8*)(Bp + 16 * ks), acc, 0, 0, 0);
            const int m = 32 * tj + r32; const float gcm = sc[64 + m];
            bf16_t* gqk = (bf16_t*)(F.ws + WS_GQK) + (size_t)item * (64 * GP_K);
#pragma unroll
            for (int r = 0; r < 16; ++r) { const int cc = 32 * ti + (r & 3) + 8 * (r >> 2) + 4 * hi;
                const float dec = __expf(fminf(sc[64 + cc] - gcm, 0.f));
                if (pq == 0) Lm[cc * 64 + m] = (m < cc) ? sc[cc] * acc[r] * dec : 0.f;
                else gqk[cc * GP_K + P32(m)] = (bf16_t)f2bf((m <= cc) ? 0.08838834764831845f * acc[r] * dec : 0.f); }
        }
        __syncthreads();
        if (wave < 4) {
            float sol[64];
            LAS float* Rc = R + tid; const LAS float* Lv = Lm; asm volatile("" : "+v"(Rc), "+v"(Lv));
#pragma unroll
            for (int i = 0; i < 64; ++i) sol[i] = Rc[i * 256];
            __builtin_amdgcn_sched_barrier(0);
#pragma unroll
            for (int i = 1; i < 64; ++i) {
                float s = sol[i];
#pragma unroll
                for (int kb = 0; kb < (i + 3) / 4; ++kb) { const f32x4 l4 = *(const LAS f32x4*)(Lv + i * 64 + 4 * kb);
#pragma unroll
                    for (int u = 0; u < 4; ++u) if (4 * kb + u < i) s = fmaf(-l4[u], sol[4 * kb + u], s); }
                sol[i] = s;
                Rc[i * 256] = s;
                __builtin_amdgcn_sched_barrier(0);
            }
        } else {
            const int t2 = tid - 256; const float gl = sc[64 + 63];
            bf16_t* gqd = (bf16_t*)(F.ws + WS_GQD) + (size_t)item * (64 * GP_W); bf16_t* gkd = (bf16_t*)(F.ws + WS_GKD) + (size_t)item * (128 * GP_K);
#pragma unroll 4
            for (int it = 0; it < 32; ++it) { const int e = t2 + 256 * it; const int cc = e >> 7, dk = e & 127; const float gcc = sc[64 + cc];
                gqd[cc * GP_W + P32(dk)] = (bf16_t)f2bf(bf2f(Qn[cc * GP_W + dk]) * 0.08838834764831845f * __expf(gcc));
                gkd[dk * GP_K + P32(cc)] = (bf16_t)f2bf(bf2f(Kn[cc * GP_W + dk]) * __expf(gl - gcc)); }
            if (t2 == 0) ((float*)(F.ws + WS_GL))[item] = __expf(gl);
        }
        __syncthreads();
        {
            f32x4* gu = (f32x4*)((float*)(F.ws + WS_GU) + (size_t)item * 8192);
#pragma unroll
            for (int it = 0; it < 4; ++it) { const int e = tid + NTHR * it; const int ln = e & 63, mt = (e >> 6) & 3, w = e >> 8; const int r = ln & 15, q = ln >> 4; const int dv = 16 * w + r, c0 = 16 * mt + 4 * q;
                gu[e] = (f32x4){R[(c0 + 0) * 256 + dv], R[(c0 + 1) * 256 + dv], R[(c0 + 2) * 256 + dv], R[(c0 + 3) * 256 + dv]}; }
            bf16_t* gw = (bf16_t*)(F.ws + WS_GW) + (size_t)item * (64 * GP_W);
#pragma unroll 4
            for (int it = 0; it < 16; ++it) { const int e = tid + NTHR * it; const int cc = e >> 7, dk = e & 127; gw[cc * GP_W + P32(dk)] = (bf16_t)f2bf(R[cc * 256 + 128 + dk]); }
        }
        __syncthreads();
    }
}

__device__ __forceinline__ void gdn_scan_phase(Frame& F, int li) {
    if (blockIdx.x >= 8) return;
    const int bh = blockIdx.x, b = bh >> 2, h = bh & 3, lane = F.lane, wave = F.wave, r = lane & 15, q = lane >> 4;
    const char* const g_w = (const char*)(F.ws + WS_GW); const char* const g_qd = (const char*)(F.ws + WS_GQD); const char* const g_qk = (const char*)(F.ws + WS_GQK); const char* const g_kd = (const char*)(F.ws + WS_GKD);
    const float* gu = (const float*)(F.ws + WS_GU); const float* glp = (const float*)(F.ws + WS_GL); float* go = (float*)(F.ws + WS_GO);
    const unsigned lds0 = (unsigned)(uintptr_t)F.ldsg;
#define GDN_DMA(item_, buf_) do { _Pragma("unroll") for (int p_ = 0; p_ < 8; ++p_) { const int p = wave + 8 * p_; if (p < 61) { \
        const int arr = p < 17 ? 0 : p < 34 ? 1 : p < 43 ? 2 : 3; const int pb_ = p < 17 ? 0 : p < 34 ? 17 : p < 43 ? 34 : 43; const size_t isz = arr < 2 ? GB_W : arr == 2 ? GB_QK : GB_KD; \
        attn_body::glds16((arr == 0 ? g_w : arr == 1 ? g_qd : arr == 2 ? g_qk : g_kd) + (size_t)(item_) * isz + (size_t)(p - pb_) * 1024, (unsigned)lane * 16u, (unsigned)__builtin_amdgcn_readfirstlane(lds0 + (buf_) * GB_ITEM + p * 1024)); } } } while (0)
    f32x4 S[8];
#pragma unroll
    for (int m = 0; m < 8; ++m) S[m] = (f32x4){0.f, 0.f, 0.f, 0.f};
    const int item0 = bh * 256;
    GDN_DMA(item0, 0);
    for (int n = 0; n < 256; ++n) {
        const int item = item0 + n, buf = n & 1;
        f32x4 U[4];
#pragma unroll
        for (int mt = 0; mt < 4; ++mt) U[mt] = *(const f32x4*)(gu + (size_t)item * 8192 + ((wave * 4 + mt) * 64 + lane) * 4);
        const float gl = glp[item];
        asm volatile("s_waitcnt vmcnt(0) lgkmcnt(0)\n\ts_barrier" ::: "memory");
        if (n + 1 < 256) GDN_DMA(item + 1, buf ^ 1);
        const LAS unsigned char* Lb = F.lds + buf * GB_ITEM;
        const LAS bf16_t* Wp = (const LAS bf16_t*)Lb + r * GP_W + 8 * q; const LAS bf16_t* QDp = (const LAS bf16_t*)(Lb + GB_W) + r * GP_W + 8 * q;
        const LAS bf16_t* QKp = (const LAS bf16_t*)(Lb + 2 * GB_W) + r * GP_K + 8 * q; const LAS bf16_t* KDp = (const LAS bf16_t*)(Lb + 2 * GB_W + GB_QK) + r * GP_K + 8 * q;
        bf16x8 Sb[4];
#pragma unroll
        for (int ks = 0; ks < 4; ++ks) { u32x4 w; w.x = cvt_pk_bf16(S[2 * ks][0], S[2 * ks][1]); w.y = cvt_pk_bf16(S[2 * ks][2], S[2 * ks][3]); w.z = cvt_pk_bf16(S[2 * ks + 1][0], S[2 * ks + 1][1]); w.w = cvt_pk_bf16(S[2 * ks + 1][2], S[2 * ks + 1][3]); Sb[ks] = __builtin_bit_cast(bf16x8, w); }
        f32x4 ws_[4], O[4];
#pragma unroll
        for (int mt = 0; mt < 4; ++mt) { ws_[mt] = (f32x4){0.f, 0.f, 0.f, 0.f}; O[mt] = (f32x4){0.f, 0.f, 0.f, 0.f}; }
#pragma unroll
        for (int ks = 0; ks < 4; ++ks)
#pragma unroll
            for (int mt = 0; mt < 4; ++mt) {
                ws_[mt] = __builtin_amdgcn_mfma_f32_16x16x32_bf16(*(const LAS bf16x8*)(Wp + 16 * mt * GP_W + 32 * ks), Sb[ks], ws_[mt], 0, 0, 0);
                O[mt] = __builtin_amdgcn_mfma_f32_16x16x32_bf16(*(const LAS bf16x8*)(QDp + 16 * mt * GP_W + 32 * ks), Sb[ks], O[mt], 0, 0, 0);
                if (mt == 3) __builtin_amdgcn_sched_barrier(0); }
        bf16x8 Vb[2];
#pragma unroll
        for (int kc = 0; kc < 2; ++kc) { const f32x4 v0 = U[2 * kc] - ws_[2 * kc], v1 = U[2 * kc + 1] - ws_[2 * kc + 1];
            u32x4 w; w.x = cvt_pk_bf16(v0[0], v0[1]); w.y = cvt_pk_bf16(v0[2], v0[3]); w.z = cvt_pk_bf16(v1[0], v1[1]); w.w = cvt_pk_bf16(v1[2], v1[3]); Vb[kc] = __builtin_bit_cast(bf16x8, w); }
#pragma unroll
        for (int kc = 0; kc < 2; ++kc)
#pragma unroll
            for (int mt = 0; mt < 4; ++mt) { O[mt] = __builtin_amdgcn_mfma_f32_16x16x32_bf16(*(const LAS bf16x8*)(QKp + 16 * mt * GP_K + 32 * kc), Vb[kc], O[mt], 0, 0, 0); if (mt == 3) __builtin_amdgcn_sched_barrier(0); }
#pragma unroll
        for (int m = 0; m < 8; ++m) S[m] = S[m] * gl;
#pragma unroll
        for (int kc = 0; kc < 2; ++kc)
#pragma unroll
            for (int m = 0; m < 8; ++m) { S[m] = __builtin_amdgcn_mfma_f32_16x16x32_bf16(*(const LAS bf16x8*)(KDp + 16 * m * GP_K + 32 * kc), Vb[kc], S[m], 0, 0, 0); if (m == 7) __builtin_amdgcn_sched_barrier(0); }
        float* gop = go + ((size_t)b * T + 64 * n + 4 * q) * 512 + h * 128 + 16 * wave + r;
#pragma unroll
        for (int mt = 0; mt < 4; ++mt)
#pragma unroll
            for (int i = 0; i < 4; ++i) gop[(size_t)(16 * mt + i) * 512] = O[mt][i];
    }
    asm volatile("s_waitcnt vmcnt(0) lgkmcnt(0)\n\ts_barrier" ::: "memory");
#undef GDN_DMA
}
constexpr int N_STEPS = 2 + 2 * (9 + 8);

__global__ void __launch_bounds__(NTHR, 2) mk(Args a) {
    extern __shared__ __attribute__((aligned(16))) unsigned char lds_raw[];
    volatile LAS unsigned* MISC = (volatile LAS unsigned*)((LAS unsigned char*)lds_raw + MISC_OFF);
    for (int u = threadIdx.x; u < (LDS_BYTES - RING_BYTES) / 4; u += NTHR) ((LAS unsigned*)((LAS unsigned char*)lds_raw + RING_BYTES))[u] = 0u;
    __syncthreads();
    gu32* const ctl0 = (gu32*)(a.ws + WS_CTL);
    const int lo = a.lo, hi = a.hi;
    XcdBarrier bar; bar.bar = (unsigned*)(ctl0 + CW_BAR) + a.bar_region * XCD_BAR_WORDS; bar.x = xb_xcc_id(); bar.st = MISC + 8;
    if (hi - lo > 1) bar = xcd_barrier_post((unsigned*)(ctl0 + CW_BAR) + a.bar_region * XCD_BAR_WORDS, MISC + 8);
    const unsigned xcc = bar.x;
    const int cblk = (int)blockIdx.x;
    int step = 0;
#ifndef MK_EN
#define MK_EN 0xFFFF
#endif
#define EN(k) ((MK_EN >> (k)) & 1)
#define PHASE_BEGIN if (step >= lo && step < hi) { Frame F; { int tid_ = threadIdx.x; GAS unsigned char* wsg_ = (GAS unsigned char*)a.ws; asm volatile("" : "+v"(tid_), "+s"(wsg_)); unsigned char* ws_ = (unsigned char*)wsg_;     \
        F.lds = (LAS unsigned char*)lds_raw; F.ldsg = (char*)lds_raw; F.tid = tid_; F.lane = tid_ & 63; F.wave = __builtin_amdgcn_readfirstlane(tid_ >> 6); \
        F.G = gridDim.x; F.gw = blockIdx.x * NWAVES + F.wave; F.NGW = F.G * NWAVES; F.ws = ws_; F.ctl = (gu32*)(ws_ + WS_CTL); F.out = a.out; }
#define PHASE_END   if (step + 1 < hi) xcd_barrier(bar); } ++step;

    PHASE_BEGIN if (EN(0)) p0a_convert(F); PHASE_END
    PHASE_BEGIN if (EN(1)) {
        if (a.dbg_src) {
            const bool ne = (a.dbg_layer0 & 1) == 0; const int ni = a.dbg_layer0 >> 1;
            const bf16_t* sw = ne ? (const bf16_t*)(F.ws + WS_SWE) + (size_t)ni * 2 * 16 * 1024 : (const bf16_t*)(F.ws + WS_SWO) + (size_t)ni * 2 * 16 * 1024;
            Ln16 P{a.dbg_src, nullptr, nullptr, (float*)(F.ws + WS_X), (bf16_t*)(F.ws + WS_XB), nullptr, nullptr, sw, sw + 16 * 1024};
            const int pos[4] = {0, 0, 0, 0}; const float gt[4] = {0.f, 0.f, 0.f, 0.f};
            for (int tile = F.gw; tile < NTOK / 16; tile += F.NGW) { f32x4 acc[1]; ln16_tile<0, 1, true>(P, tile, F.lane, pos, gt, acc); smallproj_store(F, acc[0], tile, ne, INP(13) + ni * 16); }
        } else p0b_input(F); }
    PHASE_END

    for (int layer = 0; layer < 4; ++layer) {
        const int li = layer >> 1; const bool even = (layer & 1) == 0;
        if (layer < a.dbg_layer0) { step += even ? 9 : 8; continue; }
        PHASE_BEGIN if (EN(2)) {
            const int N = even ? 3584 : 4096;
            pg8::DenseOrder S{(const char*)(F.ws + WS_XB), even ? (const char*)(F.ws + WS_WINE) + (size_t)li * 3584 * D * 2 : (const char*)(F.ws + WS_WINO) + (size_t)li * 4096 * D * 2, D, NTOK / 256, N / 256, (NTOK / 256) * (N / 256), F.G, cblk};
            pg8::EpiProj E{(bf16_t*)(F.ws + WS_PROJ), PITCH, even ? 512 : 0, C2};
            pg8::gemm_phase<pg8::EpiProj, pg8::DenseOrder, false>(F.lds, D, S, E, F.tid);
        } PHASE_END
        if (even) {
            PHASE_BEGIN if (EN(3)) gdn_prep_phase(F, li); PHASE_END
            PHASE_BEGIN if (EN(4)) {
                if (EN(12)) gdn_scan_phase(F, li);
                attn_body::AttnP P{(const bf16_t*)(F.ws + WS_PROJ), (bf16_t*)(F.ws + WS_ATT), (const float*)(F.ws + WS_T5), nullptr, nullptr};
                attn_body::attn_phase<0>(F.ldsg, P, (unsigned*)(F.ctl + CW_QUEUE + layer * 8 * 64), xcc, F.tid);
            } PHASE_END
            PHASE_BEGIN if (EN(5)) even_combine_phase(F, li, 0.8f - 0.6f * __expf(-0.3f * (float)layer)); PHASE_END
        } else {
            PHASE_BEGIN if (EN(6)) odd_prep_phase(F, li); PHASE_END
            PHASE_BEGIN if (EN(7)) {
                attn_body::AttnP P{(const bf16_t*)(F.ws + WS_PROJ), (bf16_t*)(F.ws + WS_MIX), nullptr, (const float*)(F.ws + WS_CUM), (const bf16_t*)(F.ws + WS_KB8)};
                attn_body::attn_phase<1>(F.ldsg, P, (unsigned*)(F.ctl + CW_QUEUE + layer * 8 * 64), xcc, F.tid);
            } PHASE_END
        }
        PHASE_BEGIN if (EN(8)) {
            pg8::DenseOrder S{(const char*)(F.ws + WS_MIX), even ? (const char*)(F.ws + WS_WOUTE) + (size_t)li * D * D * 2 : (const char*)(F.ws + WS_WOUTO) + (size_t)li * D * D * 2, D, NTOK / 256, D / 256, (NTOK / 256) * (D / 256), F.G, cblk};
            pg8::EpiF32 E{(float*)(F.ws + WS_H), D};
            pg8::gemm_phase<pg8::EpiF32, pg8::DenseOrder, false>(F.lds, D, S, E, F.tid);
        } PHASE_END
        PHASE_BEGIN if (EN(9)) ln_router_phase(F, layer); PHASE_END
        PHASE_BEGIN if (EN(10)) {
            moe_tables(F, layer);
            pg8::MoeOrder S{(const char*)(F.ws + WS_XB), (const char*)(F.ws + WS_WGU) + (size_t)layer * NE * 2048 * D * 2, (const int*)(F.ws + WS_LIST), (const LAS int*)(F.lds + RING_BYTES), (const LAS int*)(F.lds + RING_BYTES) + 32,
                            8, (size_t)2048 * D * 2, D, true, F.G, cblk};
            pg8::EpiSwiglu E{(bf16_t*)(F.ws + WS_ACT), INP(17) + (size_t)layer * NE * 2048};
            pg8::gemm_phase<pg8::EpiSwiglu, pg8::MoeOrder, true>(F.lds, D, S, E, F.tid);
        } PHASE_END
        PHASE_BEGIN if (EN(11)) {
            moe_tables(F, layer);
            pg8::MoeOrder S{(const char*)(F.ws + WS_ACT), (const char*)(F.ws + WS_WD) + (size_t)layer * NE * D * DFF * 2, nullptr, (const LAS int*)(F.lds + RING_BYTES), (const LAS int*)(F.lds + RING_BYTES) + 32,
                            4, (size_t)D * DFF * 2, DFF, false, F.G, cblk};
            pg8::EpiDown E{(bf16_t*)(F.ws + WS_Y), INP(19) + (size_t)layer * NE * D};
            pg8::gemm_phase<pg8::EpiDown, pg8::MoeOrder, false>(F.lds, DFF, S, E, F.tid);
        } PHASE_END
        PHASE_BEGIN if (EN(13)) { moe_tables(F, layer); moe_out_phase(F, layer); } PHASE_END
    }
#undef PHASE_BEGIN
#undef PHASE_END
}
}

#if MK_DEBUG
namespace dbg {
template <class TA, class TB> __device__ __forceinline__ float ldv(const TA* p);
__device__ __forceinline__ float ldf(const float* p) { return *p; }
__device__ __forceinline__ float ldf(const unsigned short* p) { return __builtin_bit_cast(float, (unsigned)*p << 16); }
template <class TA, class TB>
__global__ void cmp(const TA* a, long lda, const TB* b, long ldb, int rows, int cols, float bscale, double* acc) {
    double e = 0.0, n = 0.0;
    for (long i = (long)blockIdx.x * blockDim.x + threadIdx.x; i < (long)rows * cols; i += (long)gridDim.x * blockDim.x) {
        const long r = i / cols, c = i % cols; const float x = ldf(a + r * lda + c), y = ldf(b + r * ldb + c) * bscale;
        e += (double)(x - y) * (x - y); n += (double)x * x; }
    for (int o = 32; o > 0; o >>= 1) { e += __shfl_xor(e, o); n += __shfl_xor(n, o); }
    if ((threadIdx.x & 63) == 0) { atomicAdd(acc, e); atomicAdd(acc + 1, n); }
}
__global__ void finish(float* out, const float* ref, const double* acc, int nchk, float thr, int which, long n) {
    float code = 0.f;
    if (which >= 0) { code = (float)sqrt(acc[2 * which] / (acc[2 * which + 1] + 1e-300)); if (!(code == code)) code = 3.f; if (code > 3.f) code = 3.f; }
    else { for (int k = 0; k < nchk; ++k) { const double e = acc[2 * k] / (acc[2 * k + 1] + 1e-300); if (!(e <= (double)thr)) { code = 0.1f * (k + 1); break; } } }
    for (long i = (long)blockIdx.x * blockDim.x + threadIdx.x; i < n; i += (long)gridDim.x * blockDim.x) out[i] = ref[i] * (1.f + code);
}
__global__ void csum(const unsigned* p, size_t nwords, unsigned long long* out, size_t colw, size_t pitchw) {
    unsigned long long s = 0;
    for (size_t i = (size_t)blockIdx.x * blockDim.x + threadIdx.x; i < nwords; i += (size_t)gridDim.x * blockDim.x) s += p[(i / colw) * pitchw + (i % colw)];
    for (int o = 32; o > 0; o >>= 1) s += __shfl_xor(s, o);
    if ((threadIdx.x & 63) == 0) atomicAdd(out, s);
}
__global__ void finish2(float* out, const float* ref, const unsigned long long* cs, int n, long nel) {
    float code = 0.f;
    for (int k = 0; k < n; ++k) if (cs[k] != cs[64 + k]) { code = 0.1f * (k + 1); break; }
    for (long i = (long)blockIdx.x * blockDim.x + threadIdx.x; i < nel; i += (long)gridDim.x * blockDim.x) out[i] = ref[i] * (1.f + code);
}
__global__ void attdiff(const unsigned short* a, const unsigned short* b, unsigned* stat, int mode) {
    const int u = blockIdx.x, bvh = u >> 6, qb = u & 63, bb = bvh >> 4, vh = bvh & 15;
    int ocol; if (mode == 0) { const int h = vh >> 2, m = (vh >> 1) & 1, half = vh & 1; ocol = (h * 2 + m) * 128 + half * 64; } else ocol = vh * 64;
    __shared__ int any; if (threadIdx.x == 0) any = 0; __syncthreads();
    const size_t row = (size_t)bb * T + qb * 256 + threadIdx.x; int df = 0;
    for (int c = 0; c < 64; ++c) df |= a[row * D + ocol + c] != b[row * D + ocol + c];
    if (df) any = 1; __syncthreads();
    if (threadIdx.x == 0 && any) { atomicAdd(stat, 1u); if (qb < 8) atomicAdd(stat + 1, 1u); if (vh < 8) atomicAdd(stat + 2, 1u); if (qb <= 6) atomicAdd(stat + 3, 1u); if (qb == 7) atomicAdd(stat + 4, 1u); if (qb == 0) atomicAdd(stat + 5, 1u); }
    if (df) { atomicAdd(stat + 6, 1u); if (threadIdx.x < 32) atomicAdd(stat + 7, 1u); }
}
__global__ void finish3(float* out, const float* ref, const unsigned* stat, int which, float denom, long nel) {
    float code = 0.f; { unsigned c = stat[which]; if (denom > 0.f) code = (float)(c / 8) * 8.f / denom; else { int lg = 0; while (c) { ++lg; c >>= 1; } code = 0.1f * (float)lg; } }
    for (long i = (long)blockIdx.x * blockDim.x + threadIdx.x; i < nel; i += (long)gridDim.x * blockDim.x) out[i] = ref[i] * (1.f + code);
}
__global__ void finish4(float* out, const float* ref, const double* acc, long nel) {
    const double e = acc[0] / (acc[1] + 1e-300); float code = e > 0 ? 0.1f * (float)floor(-log10(e)) : 2.f; if (code < 0.f) code = 0.f;
    for (long i = (long)blockIdx.x * blockDim.x + threadIdx.x; i < nel; i += (long)gridDim.x * blockDim.x) out[i] = ref[i] * (1.f + code);
}
__global__ void att2out(float* out, const unsigned short* att, int qlo, int qhi) {
    for (long i = (long)blockIdx.x * blockDim.x + threadIdx.x; i < (long)NTOK * D; i += (long)gridDim.x * blockDim.x) {
        const int row = (int)(i >> 10), qb = (row % T) >> 8; out[i] = (qb >= qlo && qb <= qhi) ? __builtin_bit_cast(float, (unsigned)att[i] << 16) : 0.f; }
}
}
#endif
#ifndef MK_SINGLE
#define MK_SINGLE 0
#endif
static int mk_grid_init() {
    static int grid = 0;
    if (grid == 0) {
        int dev = 0, cus = 0;
        if (hipGetDevice(&dev) != hipSuccess || hipDeviceGetAttribute(&cus, hipDeviceAttributeMultiprocessorCount, dev) != hipSuccess) { grid = -1; return grid; }
        if (hipFuncSetAttribute((const void*)fk::mk, hipFuncAttributeMaxDynamicSharedMemorySize, fk::LDS_BYTES) != hipSuccess) { fprintf(stderr, "kernel_launch: hipFuncSetAttribute failed\n"); grid = -1; return grid; }
        int per_cu = 0;
        if (hipOccupancyMaxActiveBlocksPerMultiprocessor(&per_cu, (const void*)fk::mk, fk::NTHR, fk::LDS_BYTES) != hipSuccess || per_cu < 1) fprintf(stderr, "kernel_launch: occupancy query reports %d\n", per_cu);
        (void)hipGetLastError();
        grid = cus;
    }
    return grid;
}
static void fast_forward(void* const* d_in, float* out, unsigned char* ws, hipStream_t stream, int step_lo, int step_hi, bool single, const float* dbg_src, int dbg_layer0) {
    const int grid = mk_grid_init(); if (grid <= 0) return;
    fk::Args a{};
    for (int i = 0; i < 24; ++i) a.in[i] = (const float*)d_in[i];
    a.out = out; a.ws = ws; a.dbg_src = dbg_src; a.dbg_layer0 = dbg_layer0; a.bar_region = 0;
    if (single) { a.lo = step_lo; a.hi = step_hi; hipLaunchKernelGGL(fk::mk, dim3(grid), dim3(fk::NTHR), fk::LDS_BYTES, stream, a); }
    else for (int s = step_lo; s < step_hi; ++s) { a.lo = s; a.hi = s + 1; hipLaunchKernelGGL(fk::mk, dim3(grid), dim3(fk::NTHR), fk::LDS_BYTES, stream, a); }
}

#ifndef MK_DEBUG
#define MK_DEBUG 0
#endif
#if MK_DEBUG
#ifndef MK_DBG_CFG
#define MK_DBG_CFG 1
#endif
#ifndef MK_DBG_DENOM
#define MK_DBG_DENOM 0.f
#endif
#ifndef MK_DBG_WHICH
#define MK_DBG_WHICH -1
#endif
#endif

extern "C" void kernel_launch(void* const* d_in, const int* in_sizes, int n_in, void* d_out, int out_size, void* d_ws, size_t ws_size, hipStream_t stream) {
    if (n_in != 24 || ws_size < (size_t)4000 * (1u << 20)) { fprintf(stderr, "kernel_launch: unexpected n_in %d / ws %zu\n", n_in, ws_size); return; }
    unsigned char* ws = (unsigned char*)d_ws;
#if MK_DEBUG
    using namespace nv;
    constexpr size_t MiB = 1u << 20; unsigned char* keep = ws + 2400 * MiB;
    float* nout = (float*)(keep + 1536 * MiB); double* acc = (double*)(keep + 1664 * MiB);
    In in; for (int i = 0; i < 24; ++i) in.p[i] = (const float*)d_in[i];
    const float C2 = fk::C2;
#if MK_DBG_CFG == 1
    Save sv[] = {{0, ST_PROJ, keep}, {0, ST_ATT, keep + 512 * MiB}};
    forward(in, ws, nout, sv, 2, stream);
    (void)hipMemsetAsync(ws + fk::WS_CTL, 0, fk::CTL_BYTES, stream); (void)hipMemsetAsync(acc, 0, 1024, stream);
    fast_forward(d_in, (float*)d_out, ws, stream, 0, 5, false, nullptr, 0);
    const float* nproj = (const float*)keep; const unsigned short* fproj = (const unsigned short*)(ws + fk::WS_PROJ);
    dbg::cmp<float, unsigned short><<<1024, 256, 0, stream>>>(nproj, EVEN_IN, fproj, fk::PITCH, NTOK, 512, 1.f / C2, acc + 0);
    dbg::cmp<float, unsigned short><<<1024, 256, 0, stream>>>(nproj + 512, EVEN_IN, fproj + 512, fk::PITCH, NTOK, 3072, 1.f, acc + 2);
    dbg::cmp<float, float><<<1024, 256, 0, stream>>>(nproj + 3584, EVEN_IN, (const float*)(ws + fk::WS_PB), 16, NTOK, 8, 1.f, acc + 4);
    dbg::cmp<float, unsigned short><<<1024, 256, 0, stream>>>((const float*)(keep + 512 * MiB), D, (const unsigned short*)(ws + fk::WS_ATT), D, NTOK, D, 1.f, acc + 6);
    const int nchk = 4;
#elif MK_DBG_CFG == 2
    Save sv[] = {{0, ST_XOUT, keep}, {1, ST_PROJ, keep + 128 * MiB}, {1, ST_CUM, keep + 648 * MiB}, {1, ST_MIX, keep + 656 * MiB}, {1, ST_H, keep + 784 * MiB}, {1, ST_XMIX, keep + 912 * MiB}, {1, ST_XOUT, keep + 1040 * MiB}};
    forward(in, ws, nout, sv, 7, stream);
    (void)hipMemsetAsync(ws + fk::WS_CTL, 0, fk::CTL_BYTES, stream); (void)hipMemsetAsync(acc, 0, 1024, stream);
    fast_forward(d_in, (float*)d_out, ws, stream, 0, 2, false, (const float*)keep, 1);
    const int s0 = 2 + 9;
    const float* nproj = (const float*)(keep + 128 * MiB); const unsigned short* fproj = (const unsigned short*)(ws + fk::WS_PROJ);
    fast_forward(d_in, (float*)d_out, ws, stream, s0, s0 + 2, false, (const float*)keep, 1);
    dbg::cmp<float, unsigned short><<<1024, 256, 0, stream>>>(nproj, ODD_IN, fproj, fk::PITCH, NTOK, 1024, 1.f / C2, acc + 0);
    dbg::cmp<float, unsigned short><<<1024, 256, 0, stream>>>(nproj + 1024, ODD_IN, fproj + 1024, fk::PITCH, NTOK, 3072, 1.f, acc + 2);
    dbg::cmp<float, float><<<1024, 256, 0, stream>>>((const float*)(keep + 648 * MiB), T, (const float*)(ws + fk::WS_CUM), T, 32, T, 1.f / fk::LOG2E, acc + 4);
    fast_forward(d_in, (float*)d_out, ws, stream, s0 + 2, s0 + 3, false, (const float*)keep, 1);
    dbg::cmp<float, unsigned short><<<1024, 256, 0, stream>>>((const float*)(keep + 656 * MiB), D, (const unsigned short*)(ws + fk::WS_MIX), D, NTOK, D, 1.f, acc + 6);
    fast_forward(d_in, (float*)d_out, ws, stream, s0 + 3, s0 + 4, false, (const float*)keep, 1);
    dbg::cmp<float, float><<<1024, 256, 0, stream>>>((const float*)(keep + 784 * MiB), D, (const float*)(ws + fk::WS_H), D, NTOK, D, 1.f, acc + 8);
    fast_forward(d_in, (float*)d_out, ws, stream, s0 + 4, s0 + 5, false, (const float*)keep, 1);
    dbg::cmp<float, float><<<1024, 256, 0, stream>>>((const float*)(keep + 912 * MiB), D, (const float*)(ws + fk::WS_X), D, NTOK, D, 1.f, acc + 10);
    fast_forward(d_in, (float*)d_out, ws, stream, s0 + 5, s0 + 8, false, (const float*)keep, 1);
    dbg::cmp<float, float><<<1024, 256, 0, stream>>>((const float*)(keep + 1040 * MiB), D, (const float*)(ws + fk::WS_X), D, NTOK, D, 1.f, acc + 12);
    const int nchk = 7;
#elif MK_DBG_CFG == 3
    Save sv[] = {{0, ST_ATT, keep}, {0, ST_GO, keep + 128 * MiB}, {0, ST_MIX, keep + 192 * MiB}, {0, ST_H, keep + 320 * MiB}, {0, ST_XMIX, keep + 448 * MiB}, {0, ST_XOUT, keep + 576 * MiB}};
    forward(in, ws, nout, sv, 6, stream);
    (void)hipMemsetAsync(ws + fk::WS_CTL, 0, fk::CTL_BYTES, stream); (void)hipMemsetAsync(acc, 0, 1024, stream);
    fast_forward(d_in, (float*)d_out, ws, stream, 0, 5, false, nullptr, 0);
    dbg::cmp<float, unsigned short><<<1024, 256, 0, stream>>>((const float*)keep, D, (const unsigned short*)(ws + fk::WS_ATT), D, NTOK, D, 1.f, acc + 0);
    dbg::cmp<float, float><<<1024, 256, 0, stream>>>((const float*)(keep + 128 * MiB), 512, (const float*)(ws + fk::WS_GO), 512, NTOK, 512, 1.f, acc + 2);
    fast_forward(d_in, (float*)d_out, ws, stream, 5, 6, false, nullptr, 0);
    dbg::cmp<float, unsigned short><<<1024, 256, 0, stream>>>((const float*)(keep + 192 * MiB), D, (const unsigned short*)(ws + fk::WS_MIX), D, NTOK, D, 1.f, acc + 4);
    fast_forward(d_in, (float*)d_out, ws, stream, 6, 7, false, nullptr, 0);
    dbg::cmp<float, float><<<1024, 256, 0, stream>>>((const float*)(keep + 320 * MiB), D, (const float*)(ws + fk::WS_H), D, NTOK, D, 1.f, acc + 6);
    fast_forward(d_in, (float*)d_out, ws, stream, 7, 8, false, nullptr, 0);
    dbg::cmp<float, float><<<1024, 256, 0, stream>>>((const float*)(keep + 448 * MiB), D, (const float*)(ws + fk::WS_X), D, NTOK, D, 1.f, acc + 8);
    fast_forward(d_in, (float*)d_out, ws, stream, 8, 11, false, nullptr, 0);
    dbg::cmp<float, float><<<1024, 256, 0, stream>>>((const float*)(keep + 576 * MiB), D, (const float*)(ws + fk::WS_X), D, NTOK, D, 1.f, acc + 10);
    const int nchk = 6;
#elif MK_DBG_CFG == 6
#ifndef MK_QLO
#define MK_QLO 0
#define MK_QHI 63
#endif
    (void)hipMemsetAsync(ws + fk::WS_CTL, 0, fk::CTL_BYTES, stream);
    fast_forward(d_in, (float*)d_out, ws, stream, 0, 5, false, nullptr, 0);
    dbg::att2out<<<1024, 256, 0, stream>>>((float*)d_out, (const unsigned short*)(ws + fk::WS_ATT), MK_QLO, MK_QHI);
    (void)nout; (void)acc; (void)in; (void)C2;
    const int nchk = 0; if (nchk == 0) return;
#elif MK_DBG_CFG == 5
    forward(in, ws, nout, nullptr, 0, stream);
    float* fout = (float*)(keep + 1024 * MiB); unsigned* stat = (unsigned*)acc; (void)hipMemsetAsync(stat, 0, 64, stream);
    for (int run = 0; run < 2; ++run) {
        (void)hipMemsetAsync(ws + fk::WS_CTL, 0, fk::CTL_BYTES, stream);
        fast_forward(d_in, fout, ws, stream, 0, 5, false, nullptr, 0);
        if (run == 0) (void)hipMemcpyAsync(keep, ws + fk::WS_ATT, (size_t)64 * MiB, hipMemcpyDeviceToDevice, stream);
    }
    dbg::attdiff<<<2048, 256, 0, stream>>>((const unsigned short*)keep, (const unsigned short*)(ws + fk::WS_ATT), stat, 0);
#if MK_DBG_WHICH == 9
    (void)hipMemsetAsync(acc + 16, 0, 64, stream);
    dbg::cmp<unsigned short, unsigned short><<<1024, 256, 0, stream>>>((const unsigned short*)keep, D, (const unsigned short*)(ws + fk::WS_ATT), D, NTOK, D, 1.f, acc + 16);
    dbg::finish4<<<1024, 256, 0, stream>>>((float*)d_out, nout, acc + 16, (long)NTOK * D);
#else
    dbg::finish3<<<1024, 256, 0, stream>>>((float*)d_out, nout, stat, MK_DBG_WHICH < 0 ? 0 : MK_DBG_WHICH, MK_DBG_DENOM, (long)NTOK * D);
#endif
    const int nchk = 0; if (nchk == 0) return;
#elif MK_DBG_CFG == 4
    forward(in, ws, nout, nullptr, 0, stream);
    float* fout = (float*)(keep + 1024 * MiB);
    unsigned long long* cs = (unsigned long long*)acc; (void)hipMemsetAsync(cs, 0, 2048, stream);
#ifndef MK_DBG_S0
#define MK_DBG_S0 0
#endif
    int nslot = 0;
    for (int run = 0; run < 2; ++run) {
        (void)hipMemsetAsync(ws + fk::WS_CTL, 0, fk::CTL_BYTES, stream);
        int slot = 0;
        auto CS2 = [&](size_t off, size_t rows, size_t colw, size_t pitchw) { if (slot >= MK_DBG_S0 && slot < MK_DBG_S0 + 9) dbg::csum<<<1024, 256, 0, stream>>>((const unsigned*)(ws + off), rows * colw, cs + 64 * run + (slot - MK_DBG_S0), colw, pitchw); ++slot; };
        auto CS = [&](size_t off, size_t bytes) { CS2(off, 1, bytes / 4, bytes / 4); };
        int st = 0;
        auto RUN = [&](int n) { fast_forward(d_in, fout, ws, stream, st, st + n, false, nullptr, 0); st += n; };
        RUN(1); CS(fk::WS_WINE, fk::WS_X - fk::WS_WINE);
        RUN(1); CS(fk::WS_X, (size_t)192 * MiB); CS(fk::WS_PB, 2 * MiB);
        for (int layer = 0; layer < 4; ++layer) {
            RUN(1); CS2(fk::WS_PROJ, NTOK, (layer & 1) ? 2048 : 1792, 2048);
            if ((layer & 1) == 0) { RUN(1); CS(fk::WS_GU, (size_t)64 * MiB); CS(fk::WS_GL, 8192); RUN(1); CS(fk::WS_ATT, (size_t)64 * MiB); CS(fk::WS_GO, (size_t)64 * MiB); RUN(1); CS(fk::WS_MIX, (size_t)64 * MiB); }
            else { RUN(1); CS2(fk::WS_PROJ, NTOK, 2048, 2048); CS(fk::WS_CUM, 2 * MiB); CS(fk::WS_KB8, 8 * MiB); RUN(1); CS(fk::WS_MIX, (size_t)64 * MiB); }
            RUN(1); CS(fk::WS_H, (size_t)128 * MiB);
            RUN(1); CS(fk::WS_X, (size_t)192 * MiB); CS(fk::WS_SELE, 512 * 1024); CS(fk::WS_GATE, 512 * 1024);
            RUN(3); if (layer < 3) CS(fk::WS_X, (size_t)192 * MiB);
        }
        nslot = slot;
    }
    (void)nslot;
    dbg::finish2<<<1024, 256, 0, stream>>>((float*)d_out, nout, cs, 9, (long)NTOK * D);
    const int nchk = 0; if (nchk == 0) return;
#endif
    dbg::finish<<<1024, 256, 0, stream>>>((float*)d_out, nout, acc, nchk, 1e-3f, MK_DBG_WHICH, (long)NTOK * D);
#else
    (void)hipMemsetAsync(ws + fk::WS_CTL, 0, fk::CTL_BYTES, stream);
    fast_forward(d_in, (float*)d_out, ws, stream, 0, fk::N_STEPS, MK_SINGLE != 0, nullptr, 0);
#endif
}
```

```cpp
#define MK_SINGLE 1
#ifndef MK_DEBUG
#define MK_DEBUG 0
#endif
#include <hip/hip_runtime.h>
#include <cstdint>
#include <cstdio>

namespace cfg {
constexpr int B = 2, T = 16384, D = 1024, NTOK = B * T;
constexpr int EVEN_IN = 3592, ODD_IN = 4112;
constexpr int NE = 32, TOPK = 4, DFF = 1024;
constexpr float ALPHA = 1.681792830507429f;
constexpr float LN_EPS = 1e-5f, RMS_EPS = 1e-6f;
}
using namespace cfg;

#if MK_DEBUG
namespace nv {

__device__ __forceinline__ float sigmoidf_(float x) { return 1.f / (1.f + __expf(-x)); }
__device__ __forceinline__ float softplusf_(float x) { return x > 20.f ? x : log1pf(expf(x)); }

struct GemmArgs {
    const float* A; const float* Bm; const float* bias; float* C; const int* cnt; const int* off; const int* list;
    int lda, ldb, ldc, M, N, K;
};
template <int MODE>
__global__ void __launch_bounds__(256) gemm(GemmArgs g) {
    __shared__ float As[16][128 + 4];
    __shared__ float Bs[16][128 + 4];
    const int tid = threadIdx.x, tx = tid & 15, ty = tid >> 4;
    const int m0 = blockIdx.y * 128, n0 = blockIdx.x * 128;
    int M = g.M; const float* Bm = g.Bm; const float* bias = g.bias; int rowbase = 0; const int* lst = nullptr;
    if (MODE != 0) {
        const int e = blockIdx.z; M = g.cnt[e]; if (m0 >= M) return;
        rowbase = g.off[e]; lst = g.list + (size_t)e * NTOK;
        Bm += (size_t)e * g.K * g.ldb; if (bias) bias += (size_t)e * g.N;
    }
    const float* arow[2]; bool aval[2];
#pragma unroll
    for (int i = 0; i < 2; ++i) {
        const int r = m0 + (tid >> 2) + 64 * i; aval[i] = r < M;
        if (MODE == 0) arow[i] = g.A + (size_t)r * g.lda;
        else if (MODE == 1) { const int tok = aval[i] ? (lst[r] >> 2) : 0; arow[i] = g.A + (size_t)tok * g.lda; }
        else arow[i] = g.A + (size_t)(rowbase + r) * g.lda;
    }
    float acc[8][8];
#pragma unroll
    for (int i = 0; i < 8; ++i)
#pragma unroll
        for (int j = 0; j < 8; ++j) acc[i][j] = 0.f;
    for (int k0 = 0; k0 < g.K; k0 += 16) {
#pragma unroll
        for (int i = 0; i < 2; ++i) {
            const int r = (tid >> 2) + 64 * i, c = (tid & 3) * 4;
            float4 v = make_float4(0.f, 0.f, 0.f, 0.f);
            if (aval[i]) {
                v = *(const float4*)(arow[i] + k0 + c);
                if (MODE == 2) {
                    const float4 u = *(const float4*)(arow[i] + 1024 + k0 + c);
                    float gg[4] = {v.x, v.y, v.z, v.w}, uu[4] = {u.x, u.y, u.z, u.w}, o[4];
#pragma unroll
                    for (int q = 0; q < 4; ++q) { const float a = fminf(gg[q], 7.f), b = fminf(fmaxf(uu[q], -7.f), 7.f); o[q] = a * sigmoidf_(1.702f * a) * (b + 1.f); }
                    v = make_float4(o[0], o[1], o[2], o[3]);
                }
            }
            As[c][r] = v.x; As[c + 1][r] = v.y; As[c + 2][r] = v.z; As[c + 3][r] = v.w;
        }
#pragma unroll
        for (int i = 0; i < 2; ++i) {
            const int r = (tid >> 5) + 8 * i, c = (tid & 31) * 4;
            const float* bp = Bm + (size_t)(k0 + r) * g.ldb + n0 + c;
            float4 v;
            if (n0 + c + 3 < g.N) v = *(const float4*)bp;
            else { v.x = (n0 + c < g.N) ? bp[0] : 0.f; v.y = (n0 + c + 1 < g.N) ? bp[1] : 0.f; v.z = (n0 + c + 2 < g.N) ? bp[2] : 0.f; v.w = 0.f; }
            *(float4*)&Bs[r][c] = v;
        }
        __syncthreads();
#pragma unroll
        for (int kk = 0; kk < 16; ++kk) {
            const float4 a0 = *(const float4*)&As[kk][ty * 8], a1 = *(const float4*)&As[kk][ty * 8 + 4];
            const float4 b0 = *(const float4*)&Bs[kk][tx * 8], b1 = *(const float4*)&Bs[kk][tx * 8 + 4];
            const float a[8] = {a0.x, a0.y, a0.z, a0.w, a1.x, a1.y, a1.z, a1.w};
            const float b[8] = {b0.x, b0.y, b0.z, b0.w, b1.x, b1.y, b1.z, b1.w};
#pragma unroll
            for (int i = 0; i < 8; ++i)
#pragma unroll
                for (int j = 0; j < 8; ++j) acc[i][j] = fmaf(a[i], b[j], acc[i][j]);
        }
        __syncthreads();
    }
#pragma unroll
    for (int i = 0; i < 8; ++i) {
        const int r = m0 + ty * 8 + i; if (r >= M) continue;
        float* crow = g.C + (size_t)(rowbase + r) * g.ldc;
#pragma unroll
        for (int j = 0; j < 8; ++j) { const int c = n0 + tx * 8 + j; if (c < g.N) crow[c] = acc[i][j] + (bias ? bias[c] : 0.f); }
    }
}

__device__ __forceinline__ float block_sum_256(float v, float* red) {
#pragma unroll
    for (int o = 32; o > 0; o >>= 1) v += __shfl_xor(v, o);
    __syncthreads();
    if ((threadIdx.x & 63) == 0) red[threadIdx.x >> 6] = v;
    __syncthreads();
    return red[0] + red[1] + red[2] + red[3];
}
__global__ void __launch_bounds__(256) ln_res(float* X, const float* H, const float* gam, const float* bet, float* Xout) {
    __shared__ float red[4];
    const size_t row = blockIdx.x; const int c = threadIdx.x * 4;
    const float4 x = *(const float4*)(X + row * D + c), h = *(const float4*)(H + row * D + c);
    float v[4] = {ALPHA * x.x + h.x, ALPHA * x.y + h.y, ALPHA * x.z + h.z, ALPHA * x.w + h.w};
    const float mean = block_sum_256(v[0] + v[1] + v[2] + v[3], red) * (1.f / D);
    float q = 0.f;
#pragma unroll
    for (int i = 0; i < 4; ++i) { v[i] -= mean; q += v[i] * v[i]; }
    const float rstd = rsqrtf(block_sum_256(q, red) * (1.f / D) + LN_EPS);
    const float4 gg = *(const float4*)(gam + c), bb = *(const float4*)(bet + c);
    const float4 o = make_float4(v[0] * rstd * gg.x + bb.x, v[1] * rstd * gg.y + bb.y, v[2] * rstd * gg.z + bb.z, v[3] * rstd * gg.w + bb.w);
    *(float4*)(Xout + row * D + c) = o;
}

template <int MODE>
__global__ void __launch_bounds__(256) attn(const float* P, float* O, const float* tab  , const float* cum  , int ldp) {
    __shared__ float Ks[64][64];
    __shared__ float Vs[64][64];
    __shared__ float ck[64];
    __shared__ float tb[MODE == 0 ? 2048 : 1];
    const int tid = threadIdx.x, qb = gridDim.x - 1 - blockIdx.x, b = blockIdx.y >> 4, vh = blockIdx.y & 15;
    int qcol, kcol, vcol, ocol, h;
    if (MODE == 0) { h = vh >> 2; const int m = (vh >> 1) & 1, half = vh & 1; qcol = h * 128 + m * 64; kcol = 512 + h * 128 + m * 64; vcol = 1024 + h * 128 + half * 64; ocol = (h * 2 + m) * 128 + half * 64; }
    else { h = vh; qcol = h * 64; kcol = 1024 + h * 64; vcol = 2048 + h * 64; ocol = h * 64; }
    if (MODE == 0) { for (int i = tid; i < 2048; i += 256) tb[i] = tab[h * 2048 + i]; }
    const int i_row = qb * 256 + tid; const size_t tok = (size_t)b * T + i_row;
    float q[64], o[64];
#pragma unroll
    for (int d = 0; d < 64; d += 4) { const float4 v = *(const float4*)(P + tok * ldp + qcol + d); q[d] = v.x * 0.125f; q[d + 1] = v.y * 0.125f; q[d + 2] = v.z * 0.125f; q[d + 3] = v.w * 0.125f; }
#pragma unroll
    for (int d = 0; d < 64; ++d) o[d] = 0.f;
    float m_run = -INFINITY, l_run = 0.f;
    float cq = 0.f; const float* cumrow = nullptr;
    if (MODE == 1) { cumrow = cum + (size_t)(b * 16 + h) * T; cq = cumrow[i_row]; }
    const float far_bias = (MODE == 0) ? tab[h * 2048 + 2047] : 0.f;
    const int ntile = 4 * qb + 4;
    for (int kt = 0; kt < ntile; ++kt) {
        __syncthreads();
        {
            const int r = tid >> 2, c0 = (tid & 3) * 16; const size_t ktok = (size_t)b * T + kt * 64 + r;
#pragma unroll
            for (int c = 0; c < 16; c += 4) { *(float4*)&Ks[r][c0 + c] = *(const float4*)(P + ktok * ldp + kcol + c0 + c); *(float4*)&Vs[r][c0 + c] = *(const float4*)(P + ktok * ldp + vcol + c0 + c); }
            if (MODE == 1 && tid < 64) ck[tid] = cumrow[kt * 64 + tid];
        }
        __syncthreads();
        if (kt * 64 > i_row) continue;
#pragma unroll 1
        for (int jj = 0; jj < 64; ++jj) {
            const int j = kt * 64 + jj; const int dist = i_row - j;
            if (dist < 0) break;
            float dot = 0.f;
#pragma unroll
            for (int d = 0; d < 64; d += 4) { const float4 kv = *(const float4*)&Ks[jj][d]; dot = fmaf(q[d], kv.x, dot); dot = fmaf(q[d + 1], kv.y, dot); dot = fmaf(q[d + 2], kv.z, dot); dot = fmaf(q[d + 3], kv.w, dot); }
            float bias;
            if (MODE == 0) bias = dist < 2048 ? tb[dist] : far_bias;
            else bias = cq - ck[jj];
            const float sc = dot + bias;
            if (sc > m_run) { const float f = __expf(m_run - sc); l_run *= f;
#pragma unroll
                for (int d = 0; d < 64; ++d) o[d] *= f;
                m_run = sc; }
            const float p = __expf(sc - m_run); l_run += p;
#pragma unroll
            for (int d = 0; d < 64; d += 4) { const float4 vv = *(const float4*)&Vs[jj][d]; o[d] = fmaf(p, vv.x, o[d]); o[d + 1] = fmaf(p, vv.y, o[d + 1]); o[d + 2] = fmaf(p, vv.z, o[d + 2]); o[d + 3] = fmaf(p, vv.w, o[d + 3]); }
        }
    }
    const float inv = 1.f / l_run;
#pragma unroll
    for (int d = 0; d < 64; d += 4) *(float4*)(O + tok * D + ocol + d) = make_float4(o[d] * inv, o[d + 1] * inv, o[d + 2] * inv, o[d + 3] * inv);
}

__global__ void t5tab(const float* t5, float* tab) {
    const int i = blockIdx.x * blockDim.x + threadIdx.x; if (i >= 4 * 2048) return;
    const int h = i >> 11, n = i & 2047; int bk;
    if (n < 16) bk = n; else { bk = 16 + (int)(log((double)n / 16.0) / log(128.0) * 16.0); if (bk > 31) bk = 31; }
    tab[i] = t5[bk * 4 + h];
}

__global__ void conv_silu(const float* P  , const float* w  , float* CQ  ) {
    const size_t i = (size_t)blockIdx.x * blockDim.x + threadIdx.x; if (i >= (size_t)NTOK * 1536) return;
    const int c = (int)(i % 1536); const size_t tok = i / 1536; const int t = (int)(tok % T);
    float y = 0.f;
#pragma unroll
    for (int j = 0; j < 4; ++j) { const int tt = t - 3 + j; if (tt >= 0) y = fmaf(w[j * 1536 + c], P[(tok - 3 + j) * EVEN_IN + 1536 + c], y); }
    CQ[i] = y * sigmoidf_(y);
}
__global__ void gdn_norm(const float* P, float* CQ, const float* a_log, const float* dt_bias, float* BETA, float* G) {
    const int i = blockIdx.x * blockDim.x + threadIdx.x; if (i >= NTOK * 8) return;
    const int which = i & 1, h = (i >> 1) & 3; const size_t tok = i >> 3;
    float* p = CQ + tok * 1536 + which * 512 + h * 128; float ss = 0.f;
    for (int d = 0; d < 128; ++d) ss = fmaf(p[d], p[d], ss);
    const float r = rsqrtf(ss + RMS_EPS);
    for (int d = 0; d < 128; ++d) p[d] *= r;
    if (which == 0) {
        BETA[tok * 4 + h] = sigmoidf_(P[tok * EVEN_IN + 3584 + h]);
        G[tok * 4 + h] = -expf(a_log[h]) * softplusf_(P[tok * EVEN_IN + 3588 + h] + dt_bias[h]);
    }
}
__global__ void __launch_bounds__(128) gdn_rec(const float* CQ, const float* BETA, const float* G, float* GO  ) {
    __shared__ float ks[2][128], qs[2][128];
    const int b = blockIdx.x >> 2, h = blockIdx.x & 3, c = threadIdx.x;
    float S[128];
#pragma unroll
    for (int d = 0; d < 128; ++d) S[d] = 0.f;
    const float scale = 0.08838834764831845f;
    for (int t = 0; t < T; ++t) {
        const size_t tok = (size_t)b * T + t; const int bf = t & 1;
        ks[bf][c] = CQ[tok * 1536 + 512 + h * 128 + c]; qs[bf][c] = CQ[tok * 1536 + h * 128 + c];
        const float v = CQ[tok * 1536 + 1024 + h * 128 + c], beta = BETA[tok * 4 + h], alpha = __expf(G[tok * 4 + h]);
        __syncthreads();
        float ksum = 0.f;
#pragma unroll
        for (int d = 0; d < 128; d += 4) { const float4 k4 = *(const float4*)&ks[bf][d]; ksum = fmaf(k4.x, S[d], ksum); ksum = fmaf(k4.y, S[d + 1], ksum); ksum = fmaf(k4.z, S[d + 2], ksum); ksum = fmaf(k4.w, S[d + 3], ksum); }
        const float vnew = beta * (v - alpha * ksum);
        float o = 0.f;
#pragma unroll
        for (int d = 0; d < 128; d += 4) { const float4 k4 = *(const float4*)&ks[bf][d]; const float4 q4 = *(const float4*)&qs[bf][d];
            S[d] = fmaf(alpha, S[d], k4.x * vnew); S[d + 1] = fmaf(alpha, S[d + 1], k4.y * vnew); S[d + 2] = fmaf(alpha, S[d + 2], k4.z * vnew); S[d + 3] = fmaf(alpha, S[d + 3], k4.w * vnew);
            o = fmaf(q4.x, S[d], o); o = fmaf(q4.y, S[d + 1], o); o = fmaf(q4.z, S[d + 2], o); o = fmaf(q4.w, S[d + 3], o); }
        GO[tok * 512 + h * 128 + c] = o * scale;
    }
}
__global__ void __launch_bounds__(128) even_combine(const float* ATT  , const float* GO, const float* P, const float* lamp  ,
                                                    const float* subln_w, const float* gdn_w, float* MIX, float lam_init) {
    __shared__ float red[2]; __shared__ float lam_s;
    const size_t tok = blockIdx.x; const int d = threadIdx.x;
    if (d < 64) {
        float a = lamp[d] * lamp[64 + d], bb = lamp[128 + d] * lamp[192 + d];
#pragma unroll
        for (int o = 32; o > 0; o >>= 1) { a += __shfl_xor(a, o); bb += __shfl_xor(bb, o); }
        if (d == 0) lam_s = expf(a) - expf(bb) + lam_init;
    }
    __syncthreads();
    const float lam = lam_s;
    for (int grp = 0; grp < 8; ++grp) {
        float v;
        if (grp < 4) v = ATT[tok * D + (grp * 2) * 128 + d] - lam * ATT[tok * D + (grp * 2 + 1) * 128 + d];
        else v = GO[tok * 512 + (grp - 4) * 128 + d];
        float ss = v * v;
#pragma unroll
        for (int o = 32; o > 0; o >>= 1) ss += __shfl_xor(ss, o);
        __syncthreads();
        if ((d & 63) == 0) red[d >> 6] = ss;
        __syncthreads();
        const float r = rsqrtf((red[0] + red[1]) * (1.f / 128.f) + RMS_EPS);
        float outv;
        if (grp < 4) outv = v * r * subln_w[d] * (1.f - lam_init);
        else { const float z = P[tok * EVEN_IN + 3072 + (grp - 4) * 128 + d]; outv = v * r * gdn_w[d] * (z * sigmoidf_(z)); }
        MIX[tok * D + grp * 128 + d] = outv;
    }
}

__global__ void qknorm(float* P  , const float* w  ) {
    const int i = blockIdx.x * blockDim.x + threadIdx.x; if (i >= NTOK * 32) return;
    const int which = i & 1, h = (i >> 1) & 15; const size_t tok = i >> 5;
    float* p = P + tok * ODD_IN + which * 1024 + h * 64; float ss = 0.f;
    for (int d = 0; d < 64; ++d) ss = fmaf(p[d], p[d], ss);
    const float r = rsqrtf(ss * (1.f / 64.f) + RMS_EPS);
    for (int d = 0; d < 64; ++d) p[d] = p[d] * r * w[which * 64 + d];
}
__global__ void logf_k(const float* P, const float* fb, float* LF  ) {
    const int i = blockIdx.x * blockDim.x + threadIdx.x; if (i >= NTOK * 16) return;
    const int h = i & 15; const size_t tok = i >> 4; const int b = (int)(tok / T), t = (int)(tok % T);
    const float x = P[tok * ODD_IN + 4096 + h] + fb[h];
    LF[(size_t)(b * 16 + h) * T + t] = -softplusf_(-x);
}
__global__ void __launch_bounds__(1024) cumsum16k(float* LF) {
    __shared__ float part[1024];
    float* p = LF + (size_t)blockIdx.x * T + threadIdx.x * 16; float v[16]; float s = 0.f;
#pragma unroll
    for (int i = 0; i < 16; ++i) { s += p[i]; v[i] = s; }
    part[threadIdx.x] = s; __syncthreads();
    for (int o = 1; o < 1024; o <<= 1) { float a = threadIdx.x >= o ? part[threadIdx.x - o] : 0.f; __syncthreads(); part[threadIdx.x] += a; __syncthreads(); }
    const float base = threadIdx.x ? part[threadIdx.x - 1] : 0.f;
#pragma unroll
    for (int i = 0; i < 16; ++i) p[i] = v[i] + base;
}
__global__ void gate_k(const float* ATT, const float* P, float* MIX) {
    const size_t i = (size_t)blockIdx.x * blockDim.x + threadIdx.x; if (i >= (size_t)NTOK * D) return;
    const size_t tok = i >> 10; const int c = (int)(i & 1023);
    MIX[i] = ATT[i] * sigmoidf_(P[tok * ODD_IN + 3072 + c]);
}

__global__ void __launch_bounds__(256) router(const float* X, const float* rw  , const float* rb, int* cnt, int* list, int* sel_e, int* sel_slot, float* gate) {
    __shared__ float lg[8][32];
    const int tk = threadIdx.x >> 5, e = threadIdx.x & 31; const size_t tok = (size_t)blockIdx.x * 8 + tk;
    const float* x = X + tok * D; float acc = 0.f;
    for (int k = 0; k < D; ++k) acc = fmaf(x[k], rw[k * 32 + e], acc);
    lg[tk][e] = acc + rb[e];
    __syncthreads();
    if (e == 0) {
        float v[4]; int id[4]; unsigned used = 0u;
#pragma unroll
        for (int k = 0; k < 4; ++k) { float best = -INFINITY; int bi = 0; for (int j = 0; j < 32; ++j) { const float z = lg[tk][j]; if (!((used >> j) & 1u) && z > best) { best = z; bi = j; } } used |= 1u << bi; v[k] = best; id[k] = bi; }
        float s = 0.f, p[4];
#pragma unroll
        for (int k = 0; k < 4; ++k) { p[k] = __expf(v[k] - v[0]); s += p[k]; }
#pragma unroll
        for (int k = 0; k < 4; ++k) {
            const int slot = atomicAdd(&cnt[id[k]], 1);
            list[(size_t)id[k] * NTOK + slot] = (int)(tok * 4 + k);
            sel_e[tok * 4 + k] = id[k]; sel_slot[tok * 4 + k] = slot; gate[tok * 4 + k] = p[k] / s;
        }
    }
}
__global__ void offsets(const int* cnt, int* off) { if (threadIdx.x == 0) { int s = 0; for (int e = 0; e < NE; ++e) { off[e] = s; s += cnt[e]; } } }
__global__ void __launch_bounds__(256) combine_ln(float* X, const float* Y, const int* off, const int* sel_e, const int* sel_slot, const float* gate, const float* gam, const float* bet, float* Xout) {
    __shared__ float red[4];
    const size_t row = blockIdx.x; const int c = threadIdx.x * 4;
    const float4 x = *(const float4*)(X + row * D + c);
    float v[4] = {ALPHA * x.x, ALPHA * x.y, ALPHA * x.z, ALPHA * x.w};
#pragma unroll
    for (int k = 0; k < 4; ++k) { const size_t pos = (size_t)off[sel_e[row * 4 + k]] + sel_slot[row * 4 + k]; const float gt = gate[row * 4 + k]; const float4 y = *(const float4*)(Y + pos * D + c);
        v[0] = fmaf(gt, y.x, v[0]); v[1] = fmaf(gt, y.y, v[1]); v[2] = fmaf(gt, y.z, v[2]); v[3] = fmaf(gt, y.w, v[3]); }
    const float mean = block_sum_256(v[0] + v[1] + v[2] + v[3], red) * (1.f / D);
    float q = 0.f;
#pragma unroll
    for (int i = 0; i < 4; ++i) { v[i] -= mean; q += v[i] * v[i]; }
    const float rstd = rsqrtf(block_sum_256(q, red) * (1.f / D) + LN_EPS);
    const float4 gg = *(const float4*)(gam + c), bb = *(const float4*)(bet + c);
    *(float4*)(Xout + row * D + c) = make_float4(v[0] * rstd * gg.x + bb.x, v[1] * rstd * gg.y + bb.y, v[2] * rstd * gg.z + bb.z, v[3] * rstd * gg.w + bb.w);
}

constexpr size_t MiB = 1u << 20;
constexpr size_t O_X = 0;
constexpr size_t O_H = 128 * MiB;
constexpr size_t O_MIX = 256 * MiB;
constexpr size_t O_ATT = 384 * MiB;
constexpr size_t O_PROJ = 512 * MiB;
constexpr size_t O_CQ = 1032 * MiB;
constexpr size_t O_GO = 1224 * MiB;
constexpr size_t O_HB = 512 * MiB;
constexpr size_t O_Y = 1536 * MiB;
constexpr size_t O_SMALL = 2048 * MiB;
constexpr size_t O_END = 2064 * MiB;
constexpr size_t S_TAB = 0, S_BETA = 64 * 1024, S_G = S_BETA + 512 * 1024, S_CUM = S_G + 512 * 1024  , S_CNT = S_CUM + 2 * MiB, S_OFF = S_CNT + 256,
                 S_SELE = S_CNT + 4096, S_SLOT = S_SELE + 512 * 1024, S_GATE = S_SLOT + 512 * 1024, S_LIST = S_GATE + 512 * 1024  ;
static_assert(S_LIST + 4 * MiB <= 16 * MiB, "small region");

struct In { const float* p[24]; };
static_assert(sizeof(GemmArgs) == 80, "GemmArgs has padding");

struct Save { int layer, stage; void* dst; };
enum { ST_PROJ = 0, ST_CQ, ST_GO, ST_ATT, ST_MIX, ST_H, ST_XMIX, ST_XOUT, ST_CUM, ST_BETA, ST_G, ST_Y };
static void forward(const In& in, unsigned char* ws, float* out, const Save* sv, int nsv, hipStream_t st) {
    auto save = [&](int layer, int stage, const void* src, size_t bytes) { for (int k = 0; k < nsv; ++k) if (sv[k].layer == layer && sv[k].stage == stage) (void)hipMemcpyAsync(sv[k].dst, src, bytes, hipMemcpyDeviceToDevice, st); };
    float* X = (float*)(ws + O_X); float* H = (float*)(ws + O_H); float* MIX = (float*)(ws + O_MIX); float* ATT = (float*)(ws + O_ATT);
    float* PROJ = (float*)(ws + O_PROJ); float* CQ = (float*)(ws + O_CQ); float* GO = (float*)(ws + O_GO); float* HB = (float*)(ws + O_HB); float* Y = (float*)(ws + O_Y);
    unsigned char* sm = ws + O_SMALL;
    float* TAB = (float*)(sm + S_TAB); float* BETA = (float*)(sm + S_BETA); float* G = (float*)(sm + S_G); float* CUM = (float*)(sm + S_CUM);
    int* CNT = (int*)(sm + S_CNT); int* OFF = (int*)(sm + S_OFF); int* SELE = (int*)(sm + S_SELE); int* SLOT = (int*)(sm + S_SLOT); float* GATE = (float*)(sm + S_GATE); int* LIST = (int*)(sm + S_LIST);
    (void)hipMemcpyAsync(X, in.p[0], (size_t)NTOK * D * 4, hipMemcpyDeviceToDevice, st);
    t5tab<<<32, 256, 0, st>>>(in.p[1], TAB);
    for (int layer = 0; layer < 4; ++layer) {
        const int i = layer >> 1;
        if ((layer & 1) == 0) {
            GemmArgs g{X, in.p[2] + (size_t)i * D * EVEN_IN, nullptr, PROJ, nullptr, nullptr, nullptr, D, EVEN_IN, EVEN_IN, NTOK, EVEN_IN, D};
            gemm<0><<<dim3((EVEN_IN + 127) / 128, NTOK / 128), 256, 0, st>>>(g);
            conv_silu<<<(unsigned)(((size_t)NTOK * 1536 + 255) / 256), 256, 0, st>>>(PROJ, in.p[6] + (size_t)i * 4 * 1536, CQ);
            gdn_norm<<<NTOK * 8 / 256, 256, 0, st>>>(PROJ, CQ, in.p[7] + i * 4, in.p[8] + i * 4, BETA, G);
            save(layer, ST_CQ, CQ, (size_t)NTOK * 1536 * 4); save(layer, ST_BETA, BETA, (size_t)NTOK * 16); save(layer, ST_G, G, (size_t)NTOK * 16);
            gdn_rec<<<8, 128, 0, st>>>(CQ, BETA, G, GO);
            save(layer, ST_GO, GO, (size_t)NTOK * 512 * 4);
            save(layer, ST_PROJ, PROJ, (size_t)NTOK * EVEN_IN * 4);
            attn<0><<<dim3(T / 256, B * 16), 256, 0, st>>>(PROJ, ATT, TAB, nullptr, EVEN_IN);
            save(layer, ST_ATT, ATT, (size_t)NTOK * D * 4);
            const float lam_init = 0.8f - 0.6f * expf(-0.3f * (float)layer);
            even_combine<<<NTOK, 128, 0, st>>>(ATT, GO, PROJ, in.p[4] + i * 256, in.p[5] + i * 128, in.p[9] + i * 128, MIX, lam_init);
            GemmArgs g2{MIX, in.p[3] + (size_t)i * D * D, nullptr, H, nullptr, nullptr, nullptr, D, D, D, NTOK, D, D};
            gemm<0><<<dim3(D / 128, NTOK / 128), 256, 0, st>>>(g2);
        } else {
            GemmArgs g{X, in.p[10] + (size_t)i * D * ODD_IN, nullptr, PROJ, nullptr, nullptr, nullptr, D, ODD_IN, ODD_IN, NTOK, ODD_IN, D};
            gemm<0><<<dim3((ODD_IN + 127) / 128, NTOK / 128), 256, 0, st>>>(g);
            qknorm<<<NTOK * 32 / 256, 256, 0, st>>>(PROJ, in.p[12] + i * 128);
            logf_k<<<NTOK * 16 / 256, 256, 0, st>>>(PROJ, in.p[13] + i * 16, CUM);
            cumsum16k<<<B * 16, 1024, 0, st>>>(CUM);
            save(layer, ST_PROJ, PROJ, (size_t)NTOK * ODD_IN * 4); save(layer, ST_CUM, CUM, (size_t)32 * T * 4);
            attn<1><<<dim3(T / 256, B * 16), 256, 0, st>>>(PROJ, ATT, nullptr, CUM, ODD_IN);
            save(layer, ST_ATT, ATT, (size_t)NTOK * D * 4);
            gate_k<<<(unsigned)((size_t)NTOK * D / 256), 256, 0, st>>>(ATT, PROJ, MIX);
            GemmArgs g2{MIX, in.p[11] + (size_t)i * D * D, nullptr, H, nullptr, nullptr, nullptr, D, D, D, NTOK, D, D};
            gemm<0><<<dim3(D / 128, NTOK / 128), 256, 0, st>>>(g2);
        }
        save(layer, ST_MIX, MIX, (size_t)NTOK * D * 4); save(layer, ST_H, H, (size_t)NTOK * D * 4);
        ln_res<<<NTOK, 256, 0, st>>>(X, H, in.p[20] + layer * D, in.p[21] + layer * D, X);
        save(layer, ST_XMIX, X, (size_t)NTOK * D * 4);
        (void)hipMemsetAsync(CNT, 0, 128, st);
        router<<<NTOK / 8, 256, 0, st>>>(X, in.p[14] + (size_t)layer * D * NE, in.p[15] + layer * NE, CNT, LIST, SELE, SLOT, GATE);
        offsets<<<1, 64, 0, st>>>(CNT, OFF);
        GemmArgs m1{X, in.p[16] + (size_t)layer * NE * D * 2048, in.p[17] + (size_t)layer * NE * 2048, HB, CNT, OFF, LIST, D, 2048, 2048, 0, 2048, D};
        gemm<1><<<dim3(2048 / 128, NTOK / 128, NE), 256, 0, st>>>(m1);
        GemmArgs m2{HB, in.p[18] + (size_t)layer * NE * DFF * D, in.p[19] + (size_t)layer * NE * D, Y, CNT, OFF, LIST, 2048, D, D, 0, D, DFF};
        gemm<2><<<dim3(D / 128, NTOK / 128, NE), 256, 0, st>>>(m2);
        float* dst = (layer == 3) ? out : X;
        combine_ln<<<NTOK, 256, 0, st>>>(X, Y, OFF, SELE, SLOT, GATE, in.p[22] + layer * D, in.p[23] + layer * D, dst);
        save(layer, ST_XOUT, dst, (size_t)NTOK * D * 4);
    }
}
}

#endif
namespace fk {
#define LAS __attribute__((address_space(3)))
#define GAS __attribute__((address_space(1)))
typedef unsigned short bf16_t;
typedef short bf16x8 __attribute__((ext_vector_type(8)));
typedef short s16x4 __attribute__((ext_vector_type(4)));
typedef float f32x2 __attribute__((ext_vector_type(2)));
typedef float f32x4 __attribute__((ext_vector_type(4)));
typedef float f32x16 __attribute__((ext_vector_type(16)));
typedef unsigned u32x2 __attribute__((ext_vector_type(2)));
typedef unsigned u32x4 __attribute__((ext_vector_type(4)));
typedef GAS unsigned gu32;

constexpr int NWAVES = 8, NTHR = 512;
constexpr int PITCH = 4160;
constexpr float LOG2E = 1.4426950408889634f;
constexpr float C2 = 0.125f * LOG2E;
constexpr int NPAD = NTOK * 4 + NE * 256;
constexpr int T5PAD = 256, T5N = 2048 + T5PAD;

constexpr size_t MiB = 1u << 20;
constexpr size_t WS_CTL = 0, CTL_BYTES = 1 * MiB;
constexpr size_t WS_WINE = 2 * MiB;
constexpr size_t WS_WINO = 16 * MiB;
constexpr size_t WS_WOUTE = 32 * MiB, WS_WOUTO = 36 * MiB;
constexpr size_t WS_RW = 40 * MiB;
constexpr size_t WS_SWE = WS_RW + 512 * 1024;
constexpr size_t WS_SWO = WS_SWE + 128 * 1024;
constexpr size_t WS_T5 = 41 * MiB;
constexpr size_t WS_WGU = 64 * MiB;
constexpr size_t WS_WD = 576 * MiB;
constexpr size_t WS_X = 832 * MiB;
constexpr size_t WS_XB = 960 * MiB;
constexpr size_t WS_PROJ = 2368 * MiB;
constexpr size_t WS_ATT = 1280 * MiB;
constexpr size_t WS_MIX = 1344 * MiB;
constexpr size_t WS_H = 1408 * MiB;
constexpr size_t WS_GW = 1536 * MiB, WS_GQD = 1570 * MiB, WS_GQK = 1604 * MiB, WS_GKD = 1622 * MiB, WS_GU = 1658 * MiB;
constexpr size_t WS_GO = 1722 * MiB;
constexpr size_t WS_ACT = 1792 * MiB;
constexpr size_t WS_Y = 2064 * MiB;
constexpr size_t WS_PB = 2336 * MiB;
constexpr size_t WS_CUM = 2338 * MiB;
constexpr size_t WS_KB8 = 2340 * MiB;
constexpr size_t WS_SELE = 2348 * MiB, WS_SLOT = WS_SELE + 512 * 1024, WS_GATE = WS_SLOT + 512 * 1024, WS_TSUM = WS_GATE + 512 * 1024;
constexpr size_t WS_LIST = 2350 * MiB;
constexpr size_t WS_GL = 2354 * MiB;
constexpr size_t WS_FAST_END = 2632 * MiB;
constexpr int CW_TMO = 0, CW_BAR = 4096, CW_CNT = 8192  , CW_QUEUE = 12288  ;

constexpr int RING_BYTES = 131072;
constexpr int CTRL_OFF = 159744;
constexpr int MISC_OFF = CTRL_OFF + 320;
constexpr int LDS_BYTES = 163840;

#define LDS_WAIT() asm volatile("s_waitcnt lgkmcnt(0)" ::: "memory")
#define VM_WAIT() asm volatile("s_waitcnt vmcnt(0)" ::: "memory")
#define RLX_AGENT __ATOMIC_RELAXED, __HIP_MEMORY_SCOPE_AGENT

__device__ __forceinline__ unsigned f2bf(float f) { unsigned u = __builtin_bit_cast(unsigned, f); return (u + 0x7fffu + ((u >> 16) & 1u)) >> 16; }
__device__ __forceinline__ unsigned pk2(float lo, float hi) { return f2bf(lo) | (f2bf(hi) << 16); }
__device__ __forceinline__ float bf2f(unsigned short h) { return __builtin_bit_cast(float, (unsigned)h << 16); }
__device__ __forceinline__ float bflo(unsigned w) { return __builtin_bit_cast(float, w << 16); }
__device__ __forceinline__ float bfhi(unsigned w) { return __builtin_bit_cast(float, w & 0xffff0000u); }
__device__ __forceinline__ unsigned cvt_pk_bf16(float lo, float hi) { unsigned r; asm volatile("v_cvt_pk_bf16_f32 %0, %1, %2" : "=v"(r) : "v"(lo), "v"(hi)); return r; }
__device__ __forceinline__ float sigmoid_f(float x) { return 1.f / (1.f + __expf(-x)); }
__device__ __forceinline__ float softplus_f(float x) { const float e = __expf(-fabsf(x)); const float l = e < 1e-3f ? e * (1.f - 0.5f * e) : __logf(1.f + e); return fmaxf(x, 0.f) + l; }

#define XB_TMO      128
#define XB_XCNT(j)  (256  + 64 * (j))
#define XB_XSUB(j)  (1280 + 64 * (j))
#define XB_XGEN(j)  (2304 + 64 * (j))
#define XB_TOP      3328
#define XB_TOPGEN   3392
#define XCD_BAR_WORDS 3456
#define XB_SPIN_CAP (1u << 18)
__device__ __forceinline__ unsigned xb_ld(unsigned* p)              { return __hip_atomic_load(p, __ATOMIC_RELAXED, __HIP_MEMORY_SCOPE_AGENT); }
__device__ __forceinline__ unsigned xb_add(unsigned* p, unsigned v) { return __hip_atomic_fetch_add(p, v, __ATOMIC_RELAXED, __HIP_MEMORY_SCOPE_AGENT); }
__device__ __forceinline__ unsigned xb_xcc_id() { return (unsigned)__builtin_amdgcn_s_getreg((3 << 11) | 20) & 0xFu; }
#define XB_SPIN(cond, bar) do { unsigned _sp = 0; while (cond) { __builtin_amdgcn_s_sleep(1); \
    if ((++_sp & 255u) == 0u) { if (xb_ld(&(bar)[XB_TMO])) break; if (_sp > XB_SPIN_CAP) { atomicAdd(&(bar)[XB_TMO], 1u); break; } } } } while (0)
struct XcdBarrier { unsigned* bar; unsigned x; volatile LAS unsigned* st; };
__device__ __forceinline__ XcdBarrier xcd_barrier_post(unsigned* bar, volatile LAS unsigned* st) {
    XcdBarrier b; b.bar = bar; b.x = xb_xcc_id(); b.st = st;
    if (threadIdx.x == 0) (void)xb_add(&bar[XB_XCNT(b.x)], 1u);
    return b;
}
__device__ __forceinline__ void xcd_barrier_complete(unsigned* bar, unsigned x, unsigned& nloc, unsigned& nx) {
    const unsigned G = gridDim.x * gridDim.y * gridDim.z;
    unsigned sum, cnt, mine, sp = 0u;
    for (;;) {
        sum = 0u; cnt = 0u;
#pragma unroll
        for (unsigned j = 0; j < 16; ++j) { const unsigned c = xb_ld(&bar[XB_XCNT(j)]); sum += c; cnt += (c > 0u) ? 1u : 0u; }
        mine = xb_ld(&bar[XB_XCNT(x)]);
        if (sum == G) break;
        __builtin_amdgcn_s_sleep(1);
        if ((++sp & 255u) == 0u) { if (xb_ld(&bar[XB_TMO])) break; if (sp > XB_SPIN_CAP) { atomicAdd(&bar[XB_TMO], 1u); break; } }
    }
    nloc = mine > 0u ? mine : 1u; nx = cnt > 0u ? cnt : 1u;
}
__device__ __forceinline__ void xcd_barrier(const XcdBarrier& b) {
    asm volatile("s_waitcnt vmcnt(0)" ::: "memory");
    __syncthreads();
    if (threadIdx.x == 0) {
        unsigned* bar = b.bar; const unsigned bx = b.x;
        __builtin_amdgcn_s_waitcnt(0);
        unsigned nloc = b.st[0], nx = b.st[1];
        if (nloc == 0u) { xcd_barrier_complete(bar, bx, nloc, nx); b.st[0] = nloc; b.st[1] = nx; }
        const unsigned old = xb_add(&bar[XB_XSUB(bx)], 1u);
        const unsigned gen = old / nloc;
        if (old + 1u == (gen + 1u) * nloc) {
            __builtin_amdgcn_fence(__ATOMIC_RELEASE, "agent");
            asm volatile("s_waitcnt vmcnt(0)" ::: "memory");
            const unsigned og = xb_add(&bar[XB_TOP], 1u);
            const unsigned tg = og / nx;
            if (og + 1u == (tg + 1u) * nx) xb_add(&bar[XB_TOPGEN], 1u);
            else XB_SPIN(xb_ld(&bar[XB_TOPGEN]) == tg, bar);
            __builtin_amdgcn_fence(__ATOMIC_ACQUIRE, "agent");
            xb_add(&bar[XB_XGEN(bx)], 1u);
            asm volatile("s_waitcnt vmcnt(0)" ::: "memory");
        } else {
            XB_SPIN(xb_ld(&bar[XB_XGEN(bx)]) == gen, bar);
            __builtin_amdgcn_fence(__ATOMIC_ACQUIRE, "agent");
            asm volatile("s_waitcnt vmcnt(0)" ::: "memory");
        }
    }
    __syncthreads();
}

namespace pg8 {
constexpr int BM = 256, BK = 64, HALF = 128, HTB = HALF * BK * 2, STAGE_BYTES = 8 * HTB;
__host__ __device__ __forceinline__ int lds_byte(int r, int c) { const int st = (r >> 4) * 2 + (c >> 5), rr = r & 15, cc = c & 31, ob = rr * 64 + cc * 2; return st * 1024 + (ob ^ (((ob >> 9) & 1) << 5)); }
__host__ __device__ __forceinline__ void stage_rc(int b, int& R, int& C) { const int st = b / 1024, sb = b % 1024, swz = sb ^ (((sb >> 9) & 1) << 5); R = (st >> 1) * 16 + swz / 64; C = (st & 1) * 32 + (swz % 64) / 2; }
__host__ __device__ __forceinline__ int perm32(int rho) { const int n = rho >> 4, i = rho & 15; return 8 * (i >> 2) + 4 * n + (i & 3); }

struct Unit { const char* A; const char* B; const int* rows; int nvalid; int row0; int col0; int aux; };

template <class Epi, class Sched, bool GATHER>
__device__ __forceinline__ void gemm_phase(LAS unsigned char* lds, const int K, const Sched& S, const Epi& E, const int tid) {
    const int wid = __builtin_amdgcn_readfirstlane(tid >> 6), lane = tid & 63, wr = wid >> 2, wc = wid & 3, fr = lane & 15, fq = lane >> 4;
    const int nt = K / BK;
    int Rr[2], Cc[2]; unsigned voffB[2]; unsigned offA[2][2], noffA[2][2];
#pragma unroll
    for (int i = 0; i < 2; ++i) { stage_rc(tid * 16 + i * 8192, Rr[i], Cc[i]); const int Rb = Epi::PERM ? ((Rr[i] & ~31) + perm32(Rr[i] & 31)) : Rr[i];
        voffB[i] = (unsigned)(Rb * K + Cc[i]) * 2u;
#pragma unroll
        for (int h = 0; h < 2; ++h) { offA[h][i] = (unsigned)((Rr[i] + HALF * h) * K + Cc[i]) * 2u; noffA[h][i] = offA[h][i]; } }
    const size_t kstep = (size_t)(BK * 2);
    const size_t hstep = (size_t)HALF * K * 2;
    const unsigned ldsw = (unsigned)wid * 1024u;
    const int aoff = lds_byte(wr * 64 + fr, fq * 8), boff = lds_byte(wc * 32 + fr, fq * 8);
#define PG8_SA(b, h) (((b) * 2 + (h)) * HTB)
#define PG8_SB(b, h) ((4 + (b) * 2 + (h)) * HTB)
#define PG8_STAGE_B(bufoff, gbase) do { _Pragma("unroll") for (int _i = 0; _i < 2; ++_i) \
        __builtin_amdgcn_global_load_lds((const unsigned*)((const char*)(gbase) + voffB[_i]), (LAS unsigned*)(lds + (bufoff) + ldsw + _i * 8192), 16, 0, 0); } while (0)
#define PG8_STAGE_A(bufoff, gbase, off, h) do { _Pragma("unroll") for (int _i = 0; _i < 2; ++_i) \
        __builtin_amdgcn_global_load_lds((const unsigned*)((const char*)(gbase) + (off)[h][_i]), (LAS unsigned*)(lds + (bufoff) + ldsw + _i * 8192), 16, 0, 0); } while (0)
#define PG8_LDA(dst, b, h) do { _Pragma("unroll") for (int m = 0; m < 4; ++m) _Pragma("unroll") for (int k = 0; k < 2; ++k) dst[m][k] = *(const LAS bf16x8*)(lds + PG8_SA(b, h) + aoff + m * 2048 + k * 1024); } while (0)
#define PG8_LDB(dst, b, h) do { _Pragma("unroll") for (int n = 0; n < 2; ++n) _Pragma("unroll") for (int k = 0; k < 2; ++k) dst[n][k] = *(const LAS bf16x8*)(lds + PG8_SB(b, h) + boff + n * 2048 + k * 1024); } while (0)
#define PG8_MMA(ai, bj, At, Bt) do { __builtin_amdgcn_s_setprio(1); _Pragma("unroll") for (int m = 0; m < 4; ++m) _Pragma("unroll") for (int n = 0; n < 2; ++n) _Pragma("unroll") for (int k = 0; k < 2; ++k) \
        acc[ai][bj][m][n] = __builtin_amdgcn_mfma_f32_16x16x32_bf16(Bt[n][k], At[m][k], acc[ai][bj][m][n], 0, 0, 0); __builtin_amdgcn_s_setprio(0); } while (0)
#define PG8_WAIT_V(n) asm volatile("s_waitcnt vmcnt(" #n ")" ::: "memory")
#define PG8_WAIT_L(n) asm volatile("s_waitcnt lgkmcnt(" #n ")" ::: "memory")
#define PG8_BAR __builtin_amdgcn_s_barrier()
#define PG8_SCHED __builtin_amdgcn_sched_barrier(0)
#define PG8_ROWS(dst, u) do { if constexpr (GATHER) { _Pragma("unroll") for (int h = 0; h < 2; ++h) _Pragma("unroll") for (int i = 0; i < 2; ++i) { \
        int rr_ = Rr[i] + HALF * h; rr_ = rr_ < (u).nvalid ? rr_ : (u).nvalid - 1; const int tok_ = (u).rows[rr_] >> 2; dst[h][i] = (unsigned)(tok_ * K + Cc[i]) * 2u; } } } while (0)
    Unit cur, nxt; int ui = 0;
    if (!S.next(0, cur)) return;
    f32x4 acc[2][2][4][2];
#pragma unroll
    for (int a = 0; a < 2; ++a)
#pragma unroll
        for (int b = 0; b < 2; ++b)
#pragma unroll
            for (int m = 0; m < 4; ++m)
#pragma unroll
                for (int n = 0; n < 2; ++n) acc[a][b][m][n] = (f32x4){0.f, 0.f, 0.f, 0.f};
    bf16x8 At[4][2], B0[2][2], B1[2][2];
    const char* cA = cur.A; const char* cB = cur.B;
    PG8_ROWS(offA, cur);
    PG8_STAGE_B(PG8_SB(0, 0), cB); PG8_STAGE_B(PG8_SB(0, 1), cB + hstep); PG8_STAGE_A(PG8_SA(0, 0), cA, offA, 0); PG8_STAGE_A(PG8_SA(0, 1), cA, offA, 1);
    if (wr == 1) PG8_BAR;
    PG8_WAIT_V(2); PG8_BAR;
    PG8_STAGE_B(PG8_SB(1, 0), cB + kstep); PG8_STAGE_A(PG8_SA(1, 0), cA + kstep, offA, 0); PG8_STAGE_B(PG8_SB(1, 1), cB + hstep + kstep);
    PG8_WAIT_V(6); PG8_BAR;
    for (;;) {
        const bool has_next = S.next(ui + 1, nxt);
        const char* nA = has_next ? nxt.A : cA; const char* nB = has_next ? nxt.B : cB;
        if constexpr (GATHER) { if (has_next) { PG8_ROWS(noffA, nxt); } else {
#pragma unroll
            for (int h = 0; h < 2; ++h)
#pragma unroll
                for (int i = 0; i < 2; ++i) noffA[h][i] = offA[h][i]; } }
        for (int t = 0; t < nt; t += 2) {
            const bool last = (t == nt - 2);
            const char* a1 = cA + (size_t)(t + 1) * kstep;
            const char* a2 = last ? nA : cA + (size_t)(t + 2) * kstep; const char* b2 = last ? nB : cB + (size_t)(t + 2) * kstep;
            const char* a3 = a2 + kstep; const char* b3 = b2 + kstep;
            PG8_LDB(B0, 0, 0); PG8_LDB(B1, 0, 1); PG8_SCHED; PG8_LDA(At, 0, 0); PG8_STAGE_A(PG8_SA(1, 1), a1, offA, 1);
            if (GATHER && last) { asm volatile("" ::: "memory");
#pragma unroll
                for (int h = 0; h < 2; ++h)
#pragma unroll
                    for (int i = 0; i < 2; ++i) offA[h][i] = noffA[h][i]; }
            PG8_WAIT_V(8); PG8_WAIT_L(0); PG8_BAR; PG8_MMA(0, 0, At, B0); PG8_MMA(0, 1, At, B1); PG8_BAR; PG8_SCHED;
            PG8_LDA(At, 0, 1); PG8_STAGE_B(PG8_SB(0, 0), b2); PG8_STAGE_B(PG8_SB(0, 1), b2 + hstep); PG8_STAGE_A(PG8_SA(0, 0), a2, offA, 0);
            PG8_WAIT_V(8); PG8_WAIT_L(0); PG8_BAR; PG8_MMA(1, 0, At, B0); PG8_MMA(1, 1, At, B1); PG8_BAR; PG8_SCHED;
            PG8_LDB(B0, 1, 0); PG8_LDB(B1, 1, 1); PG8_SCHED; PG8_LDA(At, 1, 0); PG8_STAGE_A(PG8_SA(0, 1), a2, offA, 1);
            PG8_WAIT_V(8); PG8_WAIT_L(0); PG8_BAR; PG8_MMA(0, 0, At, B0); PG8_MMA(0, 1, At, B1); PG8_BAR; PG8_SCHED;
            PG8_LDA(At, 1, 1); PG8_STAGE_B(PG8_SB(1, 0), b3); PG8_STAGE_B(PG8_SB(1, 1), b3 + hstep); PG8_STAGE_A(PG8_SA(1, 0), a3, offA, 0);
            PG8_WAIT_V(8); PG8_WAIT_L(0); PG8_BAR; PG8_MMA(1, 0, At, B0); PG8_MMA(1, 1, At, B1); PG8_BAR; PG8_SCHED;
        }
        if (wr == 0) PG8_BAR;
        asm volatile("s_nop 15\n\ts_nop 15\n\ts_nop 15\n\ts_nop 15" ::: "memory");
        E(acc, cur, wr, wc, fr, fq);
        if (!has_next) break;
#pragma unroll
        for (int a = 0; a < 2; ++a)
#pragma unroll
            for (int b = 0; b < 2; ++b)
#pragma unroll
                for (int m = 0; m < 4; ++m)
#pragma unroll
                    for (int n = 0; n < 2; ++n) acc[a][b][m][n] = (f32x4){0.f, 0.f, 0.f, 0.f};
        cur = nxt; cA = nA; cB = nB; ++ui;
        if (wr == 1) PG8_BAR;
    }
    PG8_WAIT_V(0);
    PG8_BAR;
#undef PG8_SA
#undef PG8_SB
#undef PG8_STAGE_A
#undef PG8_STAGE_B
#undef PG8_LDA
#undef PG8_LDB
#undef PG8_MMA
#undef PG8_WAIT_V
#undef PG8_WAIT_L
#undef PG8_BAR
#undef PG8_SCHED
#undef PG8_ROWS
}

struct DenseOrder {
    const char* A; const char* Bt; int K; int nM, nN, nwg, G, c, rep;
    __device__ __forceinline__ bool next(int i, Unit& u) const {
        const long L = (long)i * G + c; if (L >= (long)nwg * rep) return false;
        int wgid = (int)(L % nwg); { const int q = nwg / 8, r = nwg % 8, xcd = wgid % 8, off = wgid / 8; wgid = (xcd < r ? xcd * (q + 1) : r * (q + 1) + (xcd - r) * q) + off; }
        const int nig = 8 * nN, gid = wgid / nig, fm = gid * 8, gsz = (nM - fm) < 8 ? (nM - fm) : 8;
        const int pm = fm + ((wgid % nig) % gsz), pn = (wgid % nig) / gsz;
        u.A = A + (size_t)pm * BM * K * 2; u.B = Bt + (size_t)pn * BM * K * 2; u.rows = nullptr; u.nvalid = BM; u.row0 = pm * BM; u.col0 = pn * BM; u.aux = 0; return true;
    }
};
struct MoeOrder {
    const char* A; const char* W; const int* list; const LAS int* cnt; const LAS int* offp;
    int npn; size_t wstride; int K; bool gather; int G, c;
    __device__ __forceinline__ bool next(int i, Unit& u) const {
        const int x = c & 7, j = c >> 3, W8 = G >> 3; int q = j + i * W8;
#pragma unroll
        for (int s = 0; s < 4; ++s) { const int e = x + 8 * s; const int n = cnt[e]; const int ntile = (n + 255) >> 8; const int ne = ntile * npn;
            if (q < ne) { const int ti = q / npn, pn = q % npn;
                u.B = W + (size_t)e * wstride + (size_t)pn * BM * K * 2; u.row0 = offp[e] + ti * BM; u.col0 = pn * BM; u.aux = e;
                u.nvalid = (n - ti * BM) < BM ? (n - ti * BM) : BM;
                if (gather) { u.A = A; u.rows = list + (size_t)e * NTOK + ti * BM; } else { u.A = A + (size_t)u.row0 * K * 2; u.rows = nullptr; }
                return true; }
            q -= ne; }
        return false;
    }
};

struct EpiProj {
    static constexpr bool PERM = true;
    bf16_t* O; int ldc; int qcols; float qscale;
    __device__ __forceinline__ void operator()(const f32x4 (&acc)[2][2][4][2], const Unit& u, int wr, int wc, int fr, int fq) const {
        const int row0 = u.row0 + wr * 64 + fr, col0 = u.col0 + wc * 32 + 8 * fq;
        const float sc = (u.col0 < qcols) ? qscale : 1.f;
#pragma unroll
        for (int ai = 0; ai < 2; ++ai)
#pragma unroll
            for (int m = 0; m < 4; ++m) { bf16_t* rowp = O + (size_t)(row0 + ai * HALF + m * 16) * ldc + col0;
#pragma unroll
                for (int bj = 0; bj < 2; ++bj) { const f32x4 v0 = acc[ai][bj][m][0] * sc, v1 = acc[ai][bj][m][1] * sc;
                    u32x4 w; w.x = cvt_pk_bf16(v0[0], v0[1]); w.y = cvt_pk_bf16(v0[2], v0[3]); w.z = cvt_pk_bf16(v1[0], v1[1]); w.w = cvt_pk_bf16(v1[2], v1[3]);
                    *(u32x4*)(rowp + bj * HALF) = w; } }
    }
};
struct EpiF32 {
    static constexpr bool PERM = false;
    float* C; int ldc;
    __device__ __forceinline__ void operator()(const f32x4 (&acc)[2][2][4][2], const Unit& u, int wr, int wc, int fr, int fq) const {
        const int row0 = u.row0 + wr * 64 + fr, col0 = u.col0 + wc * 32 + 4 * fq;
#pragma unroll
        for (int ai = 0; ai < 2; ++ai)
#pragma unroll
            for (int m = 0; m < 4; ++m) { float* rowp = C + (size_t)(row0 + ai * HALF + m * 16) * ldc + col0;
#pragma unroll
                for (int bj = 0; bj < 2; ++bj)
#pragma unroll
                    for (int n = 0; n < 2; ++n) *(f32x4*)(rowp + bj * HALF + n * 16) = acc[ai][bj][m][n]; }
    }
};
struct EpiBf16 {
    static constexpr bool PERM = false;
    bf16_t* C; int ldc;
    __device__ __forceinline__ void operator()(const f32x4 (&acc)[2][2][4][2], const Unit& u, int wr, int wc, int fr, int fq) const {
        const int row0 = u.row0 + wr * 64 + fr, col0 = u.col0 + wc * 32 + 4 * fq;
#pragma unroll
        for (int ai = 0; ai < 2; ++ai)
#pragma unroll
            for (int m = 0; m < 4; ++m) { bf16_t* rowp = C + (size_t)(row0 + ai * HALF + m * 16) * ldc + col0;
#pragma unroll
                for (int bj = 0; bj < 2; ++bj)
#pragma unroll
                    for (int n = 0; n < 2; ++n) { const f32x4 v = acc[ai][bj][m][n]; u32x2 w; w.x = cvt_pk_bf16(v[0], v[1]); w.y = cvt_pk_bf16(v[2], v[3]); *(u32x2*)(rowp + bj * HALF + n * 16) = w; } }
    }
};
struct EpiSwiglu {
    static constexpr bool PERM = true;
    bf16_t* O; const float* bias;
    __device__ __forceinline__ void operator()(const f32x4 (&acc)[2][2][4][2], const Unit& u, int wr, int wc, int fr, int fq) const {
        const int row0 = u.row0 + wr * 64 + fr, ac0 = (u.col0 >> 1) + wc * 32 + 8 * fq;
        const float* bg = bias + (size_t)u.aux * 2048 + ac0; const float* bu = bg + 1024;
        f32x4 bgv[2], buv[2];
#pragma unroll
        for (int n = 0; n < 2; ++n) { bgv[n] = *(const f32x4*)(bg + 4 * n); buv[n] = *(const f32x4*)(bu + 4 * n); }
#pragma unroll
        for (int ai = 0; ai < 2; ++ai)
#pragma unroll
            for (int m = 0; m < 4; ++m) { bf16_t* rowp = O + (size_t)(row0 + ai * HALF + m * 16) * 1024 + ac0; float o[8];
#pragma unroll
                for (int n = 0; n < 2; ++n) { const f32x4 g = acc[ai][0][m][n] + bgv[n], uu = acc[ai][1][m][n] + buv[n];
#pragma unroll
                    for (int j = 0; j < 4; ++j) { const float a = fminf(g[j], 7.f), b = fminf(fmaxf(uu[j], -7.f), 7.f);
                        o[4 * n + j] = a * __builtin_amdgcn_rcpf(1.f + __builtin_amdgcn_exp2f(-1.702f * LOG2E * a)) * (b + 1.f); } }
                u32x4 w; w.x = cvt_pk_bf16(o[0], o[1]); w.y = cvt_pk_bf16(o[2], o[3]); w.z = cvt_pk_bf16(o[4], o[5]); w.w = cvt_pk_bf16(o[6], o[7]);
                *(u32x4*)rowp = w; }
    }
};
struct EpiDown {
    static constexpr bool PERM = true;
    bf16_t* O; const float* bias;
    __device__ __forceinline__ void operator()(const f32x4 (&acc)[2][2][4][2], const Unit& u, int wr, int wc, int fr, int fq) const {
        const int row0 = u.row0 + wr * 64 + fr, col0 = u.col0 + wc * 32 + 8 * fq;
        const float* bb = bias + (size_t)u.aux * 1024 + col0;
        f32x4 bv[2][2];
#pragma unroll
        for (int bj = 0; bj < 2; ++bj)
#pragma unroll
            for (int n = 0; n < 2; ++n) bv[bj][n] = *(const f32x4*)(bb + bj * HALF + 4 * n);
#pragma unroll
        for (int ai = 0; ai < 2; ++ai)
#pragma unroll
            for (int m = 0; m < 4; ++m) { bf16_t* rowp = O + (size_t)(row0 + ai * HALF + m * 16) * 1024 + col0;
#pragma unroll
                for (int bj = 0; bj < 2; ++bj) { const f32x4 v0 = acc[ai][bj][m][0] + bv[bj][0], v1 = acc[ai][bj][m][1] + bv[bj][1];
                    u32x4 w; w.x = cvt_pk_bf16(v0[0], v0[1]); w.y = cvt_pk_bf16(v0[2], v0[3]); w.z = cvt_pk_bf16(v1[0], v1[1]); w.w = cvt_pk_bf16(v1[2], v1[3]);
                    *(u32x4*)(rowp + bj * HALF) = w; } }
    }
};
}
namespace attn_body {
#ifndef MK_NOBIAS0
#define MK_NOBIAS0 0
#endif
#ifndef MK_NOBIAS
#define MK_NOBIAS 0
#endif
constexpr int D = 64, NW = 8, QBLK = 32, QB = QBLK * NW, KVBLK = 64, NQB = T / QB;
constexpr int NSLOT = 3, SLOTB = 9216, NVSLOT = 4, VSLOT = 16384;
constexpr int LDS_K = 0, LDS_V = NSLOT * SLOTB, LDS_WS = NSLOT * SLOTB + NVSLOT * VSLOT, LDS_OST = LDS_WS + NW * 64 * 4, LDS_TB = LDS_OST + NW * 4096, LDS_UNIT = LDS_TB + T5N * 4, LDS_BYTES = LDS_UNIT + 16;
static_assert(LDS_BYTES <= CTRL_OFF, "attention LDS");
__device__ __forceinline__ int crow(int r, int hi) { return (r & 3) + 8 * (r >> 2) + 4 * hi; }
#define SBAR() __builtin_amdgcn_sched_barrier(0)
__device__ __forceinline__ void cmask(f32x16& p0, f32x16& p1, int jb, int qrel, int hi) {
    const float NEG = -INFINITY; const int lim = qrel - 64 * jb - 4 * hi;
#pragma unroll
    for (int r = 0; r < 16; ++r) { const int c = (r & 3) + 8 * (r >> 2); if (c > lim) p0[r] = NEG; if (c + 32 > lim) p1[r] = NEG; }
}
__device__ __forceinline__ void glds16(const void* sbase, unsigned voff, unsigned lds_dst) { unsigned keep;
    asm volatile("s_mov_b32 %0, m0\n\ts_mov_b32 m0, %3\n\ts_nop 0\n\tglobal_load_lds_dwordx4 %1, %2\n\ts_mov_b32 m0, %0" : "=&s"(keep) : "v"(voff), "s"(sbase), "s"(lds_dst) : "memory"); }
__device__ __forceinline__ float max3f(float a, float b, float c) { float r; asm("v_max3_f32 %0, %1, %2, %3" : "=v"(r) : "v"(a), "v"(b), "v"(c)); return r; }
__device__ __forceinline__ float max2f(float a, float b) { float r; asm("v_max_f32_e32 %0, %1, %2" : "=v"(r) : "v"(a), "v"(b)); return r; }
__device__ __forceinline__ float fadd_s(float a, float b) { float r; asm("v_add_f32_e32 %0, %1, %2" : "=v"(r) : "v"(a), "v"(b)); return r; }
__device__ __forceinline__ float fsub_s(float a, float b) { float r; asm("v_sub_f32_e32 %0, %1, %2" : "=v"(r) : "v"(a), "v"(b)); return r; }
typedef __bf16 bf16x2_t __attribute__((ext_vector_type(2)));
__device__ __forceinline__ unsigned cvtpk_s(float lo, float hi) { f32x2 v = {lo, hi}; bf16x2_t b = __builtin_convertvector(v, bf16x2_t); return __builtin_bit_cast(unsigned, b); }
#define WAIT_BAR(N) asm volatile("s_waitcnt vmcnt(" #N ") lgkmcnt(0)\n\ts_barrier" ::: "memory")
typedef LAS const char* lds_cptr;
typedef short v4i16_t __attribute__((ext_vector_type(4)));
__device__ __forceinline__ void kload2(bf16x8* kf, lds_cptr kp, int j) { kf[2 * j] = *(const LAS bf16x8*)(kp + j * 2048); kf[2 * j + 1] = *(const LAS bf16x8*)(kp + j * 2048 + 512); }
__device__ __forceinline__ s16x4 vtr(lds_cptr p) { return __builtin_bit_cast(s16x4, __builtin_amdgcn_ds_read_tr16_b64_v4i16((LAS v4i16_t*)p)); }
__device__ __forceinline__ float rowmax(const f32x16& p0, const f32x16& p1) {
    float a = max3f(p0[0], p0[1], p1[0]), b = max3f(p0[2], p0[3], p1[1]); a = max3f(a, p1[2], p1[3]);
#pragma unroll
    for (int r = 4; r < 16; r += 4) { a = max3f(a, p0[r], p0[r + 1]); b = max3f(b, p0[r + 2], p0[r + 3]); a = max3f(a, p1[r], p1[r + 1]); b = max3f(b, p1[r + 2], p1[r + 3]); }
    const float m = max2f(a, b);
    auto rr = __builtin_amdgcn_permlane32_swap(__float_as_uint(m), __float_as_uint(m), false, false);
    return max2f(__uint_as_float(rr[0]), __uint_as_float(rr[1]));
}
__device__ __forceinline__ void pv(f32x16* o, int vb, bf16x8 pa0, bf16x8 pa1, bf16x8 pa2, bf16x8 pa3) {
#pragma unroll
    for (int d0 = 0; d0 < 2; ++d0) { s16x4 lo[4], hi[4];
#pragma unroll
        for (int ks = 0; ks < 4; ++ks) {
            asm volatile("ds_read_b64_tr_b16 %0,%1 offset:%c2" : "=&v"(lo[ks]) : "v"(vb), "i"(d0 * 4096 + ks * 1024) : "memory");
            asm volatile("ds_read_b64_tr_b16 %0,%1 offset:%c2" : "=&v"(hi[ks]) : "v"(vb), "i"(d0 * 4096 + ks * 1024 + 512) : "memory"); }
        asm volatile("s_waitcnt lgkmcnt(0)" ::: "memory"); SBAR();
#define PK(k) (bf16x8){lo[k][0], lo[k][1], lo[k][2], lo[k][3], hi[k][0], hi[k][1], hi[k][2], hi[k][3]}
        o[d0] = __builtin_amdgcn_mfma_f32_32x32x16_bf16(pa0, PK(0), o[d0], 0, 0, 0);
        o[d0] = __builtin_amdgcn_mfma_f32_32x32x16_bf16(pa1, PK(1), o[d0], 0, 0, 0);
        o[d0] = __builtin_amdgcn_mfma_f32_32x32x16_bf16(pa2, PK(2), o[d0], 0, 0, 0);
        o[d0] = __builtin_amdgcn_mfma_f32_32x32x16_bf16(pa3, PK(3), o[d0], 0, 0, 0);
#undef PK
    }
}
struct AttnP {
    const bf16_t* proj;
    bf16_t* out;
    const float* t5tab;
    const float* cum2;
    const bf16_t* kb8;
    float xthr;
};

template <int MODE, int THRL>
__device__ __forceinline__ void attn_unit(const AttnP& P, int b, int vh, int qb, char* shm, const int tid) {
    const int lane = tid & 63, r32 = lane & 31, hi = lane >> 5; const int wid = __builtin_amdgcn_readfirstlane(tid >> 6);
    int h, qcol, kcol, vcol, ocol;
    constexpr bool T5 = (MODE == 0 || MODE == 2); constexpr int NH = (MODE == 2) ? 2 : 1;
    if (MODE == 0) { h = vh >> 2; const int m = (vh >> 1) & 1, half = vh & 1; qcol = h * 128 + m * 64; kcol = 512 + h * 128 + m * 64; vcol = 1024 + h * 128 + half * 64; ocol = (h * 2 + m) * 128 + half * 64; }
    else if (MODE == 2) { h = vh >> 1; const int m = vh & 1; qcol = h * 128 + m * 64; kcol = 512 + h * 128 + m * 64; vcol = 1024 + h * 128; ocol = (h * 2 + m) * 128; }
    else { h = vh; qcol = h * 64; kcol = 1024 + h * 64; vcol = 2048 + h * 64; ocol = h * 64; }
    const long rowbase = (long)b * T; const int q0 = qb * QB;
    const bf16_t* Qw = P.proj + (rowbase + q0 + wid * QBLK) * PITCH + qcol;
    const bf16_t* Kh = P.proj + rowbase * PITCH + kcol; const bf16_t* Vh = P.proj + rowbase * PITCH + vcol; int tskip = 0;
    const unsigned lds0 = (unsigned)(uintptr_t)shm;
    float* wsf = (float*)(shm + LDS_WS) + wid * 64;
    const unsigned kvoff = (unsigned)(lane * PITCH + wid * 8) * 2u;
    const unsigned vvoff = (unsigned)((16 * (wid & 3) + (lane >> 2)) * PITCH + (wid >> 2) * 32 + (lane & 3) * 8) * 2u;
    const bf16_t* k8h = (MODE == 1) ? P.kb8 + (long)(b * 16 + h) * T * 8 : nullptr; const unsigned k8voff = (unsigned)lane * 16u;
    const unsigned kdst = lds0 + LDS_K + wid * 1024, vdst = lds0 + LDS_V + wid * 1024, k8dst = lds0 + LDS_K + 8192;
#define DMA_K(t, slot) do { glds16(Kh + (long)(t) * KVBLK * PITCH, kvoff, (unsigned)__builtin_amdgcn_readfirstlane(kdst + (slot))); \
        if (MODE == 1 && wid == 0) glds16(k8h + (long)((t) + tskip) * KVBLK * 8, k8voff, (unsigned)__builtin_amdgcn_readfirstlane(k8dst + (slot))); } while (0)
#define DMA_V(t, slot) do { _Pragma("unroll") for (int hh_ = 0; hh_ < NH; ++hh_) glds16(Vh + (long)(t) * KVBLK * PITCH + hh_ * 64, vvoff, (unsigned)__builtin_amdgcn_readfirstlane(vdst + (slot) + hh_ * 8192)); } while (0)
#define WAITKV_22() do { if (MODE == 2) { WAIT_BAR(6); } else if (MODE == 1 && wid == 0) { WAIT_BAR(6); } else { WAIT_BAR(4); } } while (0)
#define WAITKV_12() do { if (MODE == 2) { WAIT_BAR(5); } else if (MODE == 1 && wid == 0) { WAIT_BAR(4); } else { WAIT_BAR(3); } } while (0)
#define WAITKV_11() do { if (MODE == 2) { WAIT_BAR(3); } else if (MODE == 1 && wid == 0) { WAIT_BAR(3); } else { WAIT_BAR(2); } } while (0)
#define WAITKV_02() do { if (MODE == 2) { WAIT_BAR(4); } else { WAIT_BAR(2); } } while (0)
    const int vb0 = (int)(lds0 + LDS_V) + ((lane >> 4) & 1) * 32 + (lane & 3) * 8 + (4 * hi + ((lane & 15) >> 2)) * 64;
    constexpr int NKF = (MODE == 1) ? 10 : 8;
    bf16x8 kf[NKF];
    const lds_cptr shm3 = (lds_cptr)shm; const lds_cptr kp0 = shm3 + LDS_K + hi * 1024 + r32 * 16; const lds_cptr kp8 = shm3 + LDS_K + 8192 + r32 * 16;
    const lds_cptr vp0 = shm3 + LDS_V + ((lane >> 4) & 1) * 32 + (lane & 3) * 8 + (4 * hi + ((lane & 15) >> 2)) * 64;
    int NT = (q0 + QB) / KVBLK;
    if (MODE == 1) {
        const float* cu = P.cum2 + (long)(b * 16 + h) * T; const float cq0 = cu[q0];
        int first = NT;
        for (int base = 0; base < NT; base += 64) { const int tt = base + lane; const bool keep = tt < NT && (cu[tt < NT ? 64 * tt + 63 : 0] - cq0 <= P.xthr);
            const unsigned long long mk = __ballot(keep); if (mk) { first = base + (int)__builtin_ctzll(mk); break; } }
        int t0 = first < NT - 4 ? first : NT - 4; t0 &= ~1; t0 = __builtin_amdgcn_readfirstlane(t0);
        Kh += (long)t0 * KVBLK * PITCH; Vh += (long)t0 * KVBLK * PITCH; NT -= t0; tskip = t0;
    }
    DMA_K(0, 0); DMA_V(0, 0); DMA_K(1, SLOTB); DMA_V(1, VSLOT);
    constexpr int NQR = (MODE == 1) ? 5 : 4;
    bf16x8 qr[NQR];
#pragma unroll
    for (int d0 = 0; d0 < 4; ++d0) qr[d0] = *reinterpret_cast<const bf16x8*>(&Qw[(long)r32 * PITCH + d0 * 16 + hi * 8]);
    const int qrel = wid * QBLK + r32;
    const lds_cptr qp0 = shm3 + LDS_OST + wid * 4096 + hi * 512 + r32 * 16;
#define QF(d0) (qr[d0])
    if (MODE == 1) {
        const float c = P.cum2[(long)(b * 16 + h) * T + q0 + qrel];
        const unsigned ch = f2bf(c); const float r1 = c - __builtin_bit_cast(float, ch << 16); const unsigned cm = f2bf(r1); const float r2 = r1 - __builtin_bit_cast(float, cm << 16); const unsigned cl = f2bf(r2);
        u32x4 w; w.x = ch | (cm << 16); w.y = cl | (0x3f80u << 16); w.z = 0x3f80u | (0x3f80u << 16); w.w = 0u;
        if (hi) w = (u32x4){0u, 0u, 0u, 0u};
        qr[NQR - 1] = __builtin_bit_cast(bf16x8, w);
    }
    float mhat = 0.f, l_reg = 0.f; f32x16 o[2 * NH];
#pragma unroll
    for (int d_ = 0; d_ < 2 * NH; ++d_) o[d_] = f32x16{};
    const f32x16 zero16 = f32x16{}; f32x2 mh2 = {0.f, 0.f};
    const float* tblo = (const float*)(shm + LDS_TB) + (q0 + qrel - 4 * hi - 63 + T5PAD);
#ifndef MK_NOBIAS
#define MK_NOBIAS 0
#endif
#ifndef MK_NOBIAS
#define MK_NOBIAS 0
#endif
#define PRE(P0, P1, t, WITHBIAS) do { \
        if (T5 && (WITHBIAS) && !MK_NOBIAS) { const float* tb_ = tblo - 64 * (t); \
            _Pragma("unroll") for (int r = 0; r < 16; ++r) { const int kv0_ = (r & 3) + 8 * (r >> 2); P0[r] = tb_[63 - kv0_]; P1[r] = tb_[31 - kv0_]; } } \
        else { _Pragma("unroll") for (int r = 0; r < 16; ++r) { P0[r] = 0.f; P1[r] = 0.f; } } \
        { const int jb_ = (t) - (NT - 4); if (jb_ >= 0) cmask(P0, P1, jb_, qrel, hi); } } while (0)
    bool resc = false;
#define RESC() do { if (resc) { asm volatile("s_nop 15\n\ts_nop 15\n\ts_nop 15\n\ts_nop 15\n\ts_waitcnt lgkmcnt(0)" : "+v"(o[0]), "+v"(o[1]) :: "memory"); if (NH == 2) asm volatile("" : "+v"(o[2 * NH - 2]), "+v"(o[2 * NH - 1]));     \
      _Pragma("unroll") for (int d_ = 0; d_ < 2 * NH; ++d_) _Pragma("unroll") for (int r = 0; r < 16; ++r) o[d_][r] *= wsf[crow(r, hi)]; } } while (0)
    f32x16 cA, cB;
    u32x4 pwa0, pwa1, pwa2, pwa3, pwb0, pwb1, pwb2, pwb3;
    int sl_prev = 0, sl_cur = 0, sl_next = SLOTB;
    int sv_prev = 0, sv_cur = 0, sv_next = VSLOT, sv_nn = 2 * VSLOT;
#define ROT() do { sl_prev = sl_cur; sl_cur = sl_next; sl_next = (sl_next == (NSLOT - 1) * SLOTB) ? 0 : sl_next + SLOTB; sv_prev = sv_cur; sv_cur = sv_next; sv_next = sv_nn; sv_nn = (sv_nn == (NVSLOT - 1) * VSLOT) ? 0 : sv_nn + VSLOT; } while (0)
    DMA_K(2, 2 * SLOTB);
    WAITKV_22();
    PRE(cA, cB, 0, (NT <= 28 && !MK_NOBIAS0));
    { const char* kb = shm + LDS_K + hi * 1024 + r32 * 16;
#pragma unroll
      for (int d0 = 0; d0 < 4; ++d0) {
          const bf16x8 b0 = *reinterpret_cast<const bf16x8*>(kb + d0 * 2048);
          const bf16x8 b1 = *reinterpret_cast<const bf16x8*>(kb + d0 * 2048 + 512);
          if (d0 == 0) { cA = __builtin_amdgcn_mfma_f32_32x32x16_bf16(b0, qr[0], cA, 0, 0, 0); cB = __builtin_amdgcn_mfma_f32_32x32x16_bf16(b1, qr[0], cB, 0, 0, 0); }
          else { cA = __builtin_amdgcn_mfma_f32_32x32x16_bf16(b0, qr[d0], cA, 0, 0, 0); cB = __builtin_amdgcn_mfma_f32_32x32x16_bf16(b1, qr[d0], cB, 0, 0, 0); } }
      if (MODE == 1) { const char* k8 = shm + LDS_K + 8192 + r32 * 16;
          const bf16x8 b0 = *reinterpret_cast<const bf16x8*>(k8); const bf16x8 b1 = *reinterpret_cast<const bf16x8*>(k8 + 512);
          cA = __builtin_amdgcn_mfma_f32_32x32x16_bf16(b0, qr[NQR - 1], cA, 0, 0, 0); cB = __builtin_amdgcn_mfma_f32_32x32x16_bf16(b1, qr[NQR - 1], cB, 0, 0, 0); } }
    asm volatile("s_nop 15\n\ts_nop 15\n\ts_nop 15\n\ts_nop 15\n\ts_nop 15" : "+v"(cA), "+v"(cB));
#ifndef MK_NOBIAS0
#define MK_NOBIAS0 0
#endif
#define PKW(P, B) cvtpk_s(P[B], P[B + 1])
    { mhat = rowmax(cA, cB); mh2 = (f32x2){mhat, mhat}; float sacc = 0.f;
      _Pragma("unroll") for (int r = 0; r < 16; ++r) { cA[r] = __builtin_amdgcn_exp2f(fsub_s(cA[r], mhat)); cB[r] = __builtin_amdgcn_exp2f(fsub_s(cB[r], mhat)); }
      _Pragma("unroll") for (int r = 0; r < 16; ++r) sacc += cA[r] + cB[r];
      l_reg = sacc;
      pwa0 = (u32x4){PKW(cA, 0), PKW(cA, 2), PKW(cA, 4), PKW(cA, 6)}; pwa1 = (u32x4){PKW(cA, 8), PKW(cA, 10), PKW(cA, 12), PKW(cA, 14)};
      pwa2 = (u32x4){PKW(cB, 0), PKW(cB, 2), PKW(cB, 4), PKW(cB, 6)}; pwa3 = (u32x4){PKW(cB, 8), PKW(cB, 10), PKW(cB, 12), PKW(cB, 14)}; }
    WAIT_BAR(0);
    DMA_K(3, 0); DMA_V(2, 2 * VSLOT);
    ROT();
#pragma unroll
    for (int j = 0; j < 4; ++j) kload2(kf, kp0 + sl_cur, j);
    if (MODE == 1) { kf[8] = *(const LAS bf16x8*)(kp8 + sl_cur); kf[9] = *(const LAS bf16x8*)(kp8 + sl_cur + 512); }
    WAITKV_11();
    s16x4 vlo[NH == 2 ? 1 : 8], vhi[NH == 2 ? 1 : 8]; s16x4 vwl[4], vwh[4];
#define PAF(PW, k) __builtin_bit_cast(bf16x8, PW##k)
#define VFR(i) (bf16x8){vlo[i][0], vlo[i][1], vlo[i][2], vlo[i][3], vhi[i][0], vhi[i][1], vhi[i][2], vhi[i][3]}
#define PIN(x) asm volatile("" : "+v"(x))
#define MX3(a, b, c) __builtin_fmaxf(__builtin_fmaxf((a), (b)), (c))
#define GAPA(MF) do { MF; SBAR(); } while (0)
#define EX(v) __builtin_amdgcn_exp2f(v)
#define GAPB(MF, X, B, PW, I) do { MF; { f32x2 a_ = {X[B], X[B + 1]}, b_ = {X[B + 2], X[B + 3]}; a_ -= mh2; b_ -= mh2; const float e0_ = EX(a_.x), e1_ = EX(a_.y), e2_ = EX(b_.x), e3_ = EX(b_.y); \
        sacc += e0_; sacc += e1_; sacc += e2_; sacc += e3_; PW[I] = cvtpk_s(e0_, e1_); PW[I + 1] = cvtpk_s(e2_, e3_); } PIN(PW); PIN(sacc); SBAR(); } while (0)
#define VRD(i) do { vlo[i] = vtr(vp_ + (((i) >> 2) * 4096 + ((i) & 3) * 1024)); vhi[i] = vtr(vp_ + (((i) >> 2) * 4096 + ((i) & 3) * 1024 + 512)); } while (0)
#define VRD1(i) do { if (NH == 2) { vlo[i] = vtr(vp_ + (8192 + ((i) >> 2) * 4096 + ((i) & 3) * 1024)); vhi[i] = vtr(vp_ + (8192 + ((i) >> 2) * 4096 + ((i) & 3) * 1024 + 512)); } } while (0)
#define GAPC(MF) do { if (NH == 2) { MF; SBAR(); } } while (0)
#define VW(w, half, i) do { vwl[w] = vtr(vp_ + ((half) * 8192 + ((i) >> 2) * 4096 + ((i) & 3) * 1024)); vwh[w] = vtr(vp_ + ((half) * 8192 + ((i) >> 2) * 4096 + ((i) & 3) * 1024 + 512)); } while (0)
#define VWF(w) (bf16x8){vwl[w][0], vwl[w][1], vwl[w][2], vwl[w][3], vwh[w][0], vwh[w][1], vwh[w][2], vwh[w][3]}
#define KRD(G, j) do { if (G) { kload2(kf, kp0 + sl_next, j); SBAR(); } } while (0)
#define KRD8(G) do { if (MODE == 1 && (G)) { kf[NKF - 2] = *(const LAS bf16x8*)(kp8 + sl_next); kf[NKF - 1] = *(const LAS bf16x8*)(kp8 + sl_next + 512); SBAR(); } } while (0)
#define STEP(PWC, PWN, t, GK, GV, GL, GPRE) do { SBAR(); if (GPRE) { PRE(cA, cB, t, true); SBAR(); } \
    const lds_cptr vp_ = vp0 + sv_prev; \
    bf16x8 qx0_, qx1_; \
    VRD(0); qx0_ = QF(0); SBAR(); GAPA(cA = (GPRE) ? __builtin_amdgcn_mfma_f32_32x32x16_bf16(kf[0], qx0_, cA, 0, 0, 0) : __builtin_amdgcn_mfma_f32_32x32x16_bf16(kf[0], qx0_, zero16, 0, 0, 0)); \
    VRD(4); qx1_ = QF(1); SBAR(); GAPA(cB = (GPRE) ? __builtin_amdgcn_mfma_f32_32x32x16_bf16(kf[1], qx0_, cB, 0, 0, 0) : __builtin_amdgcn_mfma_f32_32x32x16_bf16(kf[1], qx0_, zero16, 0, 0, 0)); \
    VRD(1); SBAR(); GAPA(cA = __builtin_amdgcn_mfma_f32_32x32x16_bf16(kf[2], qx1_, cA, 0, 0, 0)); \
    VRD(5); qx0_ = QF(2); SBAR(); GAPA(cB = __builtin_amdgcn_mfma_f32_32x32x16_bf16(kf[3], qx1_, cB, 0, 0, 0)); \
    VRD(2); SBAR(); GAPA(cA = __builtin_amdgcn_mfma_f32_32x32x16_bf16(kf[4], qx0_, cA, 0, 0, 0)); \
    VRD(6); qx1_ = QF(3); SBAR(); GAPA(cB = __builtin_amdgcn_mfma_f32_32x32x16_bf16(kf[5], qx0_, cB, 0, 0, 0)); \
    VRD(3); SBAR(); GAPA(cA = __builtin_amdgcn_mfma_f32_32x32x16_bf16(kf[6], qx1_, cA, 0, 0, 0)); \
    VRD(7); SBAR(); GAPA(cB = __builtin_amdgcn_mfma_f32_32x32x16_bf16(kf[7], qx1_, cB, 0, 0, 0)); \
    if (MODE == 1) { cA = __builtin_amdgcn_mfma_f32_32x32x16_bf16(kf[NKF - 2], qr[NQR - 1], cA, 0, 0, 0); cB = __builtin_amdgcn_mfma_f32_32x32x16_bf16(kf[NKF - 1], qr[NQR - 1], cB, 0, 0, 0); SBAR(); } \
    asm volatile("s_nop 15\n\ts_nop 7" : "+v"(cA), "+v"(cB));     \
    if (GK) { DMA_K((t) + 3, sl_cur); } if (GV) { DMA_V((t) + 2, sv_nn); } \
    { float a = MX3(cA[0], cA[1], cB[0]), b = MX3(cA[2], cA[3], cB[1]); a = MX3(a, cB[2], cB[3]); \
      _Pragma("unroll") for (int r = 4; r < 16; r += 4) { a = MX3(a, cA[r], cA[r + 1]); b = MX3(b, cA[r + 2], cA[r + 3]); a = MX3(a, cB[r], cB[r + 1]); b = MX3(b, cB[r + 2], cB[r + 3]); } \
      float rm = __builtin_fmaxf(a, b); { auto rr = __builtin_amdgcn_permlane32_swap(__float_as_uint(rm), __float_as_uint(rm), false, false); rm = __builtin_fmaxf(__uint_as_float(rr[0]), __uint_as_float(rr[1])); } \
      rm -= mhat; resc = false; \
      if (__builtin_expect(__any(rm > (float)THRL), 0)) { const float dl = __builtin_fmaxf(rm, 0.f); mhat += dl; mh2 = (f32x2){mhat, mhat}; \
        const float f = __builtin_amdgcn_exp2f(-dl); l_reg *= f; if (hi == 0) wsf[r32] = f; resc = true; } } \
    SBAR(); \
    float sacc = 0.f; \
    GAPB(o[0] = __builtin_amdgcn_mfma_f32_32x32x16_bf16(PAF(PWC, 0), VFR(0), o[0], 0, 0, 0), cA, 0, PWN##0, 0); VRD1(0); \
    GAPB(o[1] = __builtin_amdgcn_mfma_f32_32x32x16_bf16(PAF(PWC, 0), VFR(4), o[1], 0, 0, 0), cA, 4, PWN##0, 2); VRD1(4); \
    if (NH == 1) { KRD(GL, 0); } GAPB(o[0] = __builtin_amdgcn_mfma_f32_32x32x16_bf16(PAF(PWC, 1), VFR(1), o[0], 0, 0, 0), cA, 8, PWN##1, 0); VRD1(1); \
    if (NH == 1) { KRD(GL, 1); } GAPB(o[1] = __builtin_amdgcn_mfma_f32_32x32x16_bf16(PAF(PWC, 1), VFR(5), o[1], 0, 0, 0), cA, 12, PWN##1, 2); VRD1(5); \
    if (NH == 1) { KRD(GL, 2); } GAPB(o[0] = __builtin_amdgcn_mfma_f32_32x32x16_bf16(PAF(PWC, 2), VFR(2), o[0], 0, 0, 0), cB, 0, PWN##2, 0); VRD1(2); \
    if (NH == 1) { KRD(GL, 3); } GAPB(o[1] = __builtin_amdgcn_mfma_f32_32x32x16_bf16(PAF(PWC, 2), VFR(6), o[1], 0, 0, 0), cB, 4, PWN##2, 2); VRD1(6); \
    if (NH == 1) { KRD8(GL); } GAPB(o[0] = __builtin_amdgcn_mfma_f32_32x32x16_bf16(PAF(PWC, 3), VFR(3), o[0], 0, 0, 0), cB, 8, PWN##3, 0); VRD1(3); \
    GAPB(o[1] = __builtin_amdgcn_mfma_f32_32x32x16_bf16(PAF(PWC, 3), VFR(7), o[1], 0, 0, 0), cB, 12, PWN##3, 2); VRD1(7); \
    GAPC(o[2 * NH - 2] = __builtin_amdgcn_mfma_f32_32x32x16_bf16(PAF(PWC, 0), VFR(0), o[2 * NH - 2], 0, 0, 0)); \
    GAPC(o[2 * NH - 1] = __builtin_amdgcn_mfma_f32_32x32x16_bf16(PAF(PWC, 0), VFR(4), o[2 * NH - 1], 0, 0, 0)); \
    if (NH == 2) { KRD(GL, 0); } GAPC(o[2 * NH - 2] = __builtin_amdgcn_mfma_f32_32x32x16_bf16(PAF(PWC, 1), VFR(1), o[2 * NH - 2], 0, 0, 0)); \
    if (NH == 2) { KRD(GL, 1); } GAPC(o[2 * NH - 1] = __builtin_amdgcn_mfma_f32_32x32x16_bf16(PAF(PWC, 1), VFR(5), o[2 * NH - 1], 0, 0, 0)); \
    if (NH == 2) { KRD(GL, 2); } GAPC(o[2 * NH - 2] = __builtin_amdgcn_mfma_f32_32x32x16_bf16(PAF(PWC, 2), VFR(2), o[2 * NH - 2], 0, 0, 0)); \
    if (NH == 2) { KRD(GL, 3); } GAPC(o[2 * NH - 1] = __builtin_amdgcn_mfma_f32_32x32x16_bf16(PAF(PWC, 2), VFR(6), o[2 * NH - 1], 0, 0, 0)); \
    GAPC(o[2 * NH - 2] = __builtin_amdgcn_mfma_f32_32x32x16_bf16(PAF(PWC, 3), VFR(3), o[2 * NH - 2], 0, 0, 0)); \
    GAPC(o[2 * NH - 1] = __builtin_amdgcn_mfma_f32_32x32x16_bf16(PAF(PWC, 3), VFR(7), o[2 * NH - 1], 0, 0, 0)); \
    l_reg += sacc; \
    } while (0)
#define STEP2(PWC, PWN, t, GK, GV, GL, GPRE) do { SBAR(); if (GPRE) { PRE(cA, cB, t, true); SBAR(); } \
    const lds_cptr vp_ = vp0 + sv_prev; \
    bf16x8 qx0_, qx1_; \
    qx0_ = QF(0); SBAR(); GAPA(cA = (GPRE) ? __builtin_amdgcn_mfma_f32_32x32x16_bf16(kf[0], qx0_, cA, 0, 0, 0) : __builtin_amdgcn_mfma_f32_32x32x16_bf16(kf[0], qx0_, zero16, 0, 0, 0)); \
    qx1_ = QF(1); SBAR(); GAPA(cB = (GPRE) ? __builtin_amdgcn_mfma_f32_32x32x16_bf16(kf[1], qx0_, cB, 0, 0, 0) : __builtin_amdgcn_mfma_f32_32x32x16_bf16(kf[1], qx0_, zero16, 0, 0, 0)); \
    SBAR(); GAPA(cA = __builtin_amdgcn_mfma_f32_32x32x16_bf16(kf[2], qx1_, cA, 0, 0, 0)); \
    qx0_ = QF(2); SBAR(); GAPA(cB = __builtin_amdgcn_mfma_f32_32x32x16_bf16(kf[3], qx1_, cB, 0, 0, 0)); \
    SBAR(); GAPA(cA = __builtin_amdgcn_mfma_f32_32x32x16_bf16(kf[4], qx0_, cA, 0, 0, 0)); \
    qx1_ = QF(3); SBAR(); GAPA(cB = __builtin_amdgcn_mfma_f32_32x32x16_bf16(kf[5], qx0_, cB, 0, 0, 0)); \
    SBAR(); GAPA(cA = __builtin_amdgcn_mfma_f32_32x32x16_bf16(kf[6], qx1_, cA, 0, 0, 0)); \
    SBAR(); GAPA(cB = __builtin_amdgcn_mfma_f32_32x32x16_bf16(kf[7], qx1_, cB, 0, 0, 0)); \
    if (MODE == 1) { cA = __builtin_amdgcn_mfma_f32_32x32x16_bf16(kf[NKF - 2], qr[NQR - 1], cA, 0, 0, 0); cB = __builtin_amdgcn_mfma_f32_32x32x16_bf16(kf[NKF - 1], qr[NQR - 1], cB, 0, 0, 0); SBAR(); } \
    asm volatile("s_nop 15\n\ts_nop 7" : "+v"(cA), "+v"(cB));     \
    if (GK) { DMA_K((t) + 3, sl_cur); } if (GV) { DMA_V((t) + 2, sv_nn); } \
    VW(0, 0, 0); VW(1, 0, 4);        \
    { float a = MX3(cA[0], cA[1], cB[0]), b = MX3(cA[2], cA[3], cB[1]); a = MX3(a, cB[2], cB[3]); \
      _Pragma("unroll") for (int r = 4; r < 16; r += 4) { a = MX3(a, cA[r], cA[r + 1]); b = MX3(b, cA[r + 2], cA[r + 3]); a = MX3(a, cB[r], cB[r + 1]); b = MX3(b, cB[r + 2], cB[r + 3]); } \
      float rm = __builtin_fmaxf(a, b); { auto rr = __builtin_amdgcn_permlane32_swap(__float_as_uint(rm), __float_as_uint(rm), false, false); rm = __builtin_fmaxf(__uint_as_float(rr[0]), __uint_as_float(rr[1])); } \
      rm -= mhat; resc = false; \
      if (__builtin_expect(__any(rm > (float)THRL), 0)) { const float dl = __builtin_fmaxf(rm, 0.f); mhat += dl; mh2 = (f32x2){mhat, mhat}; \
        const float f = __builtin_amdgcn_exp2f(-dl); l_reg *= f; if (hi == 0) wsf[r32] = f; resc = true; } } \
    SBAR(); \
    float sacc = 0.f; \
    GAPB(o[0] = __builtin_amdgcn_mfma_f32_32x32x16_bf16(PAF(PWC, 0), VWF(0), o[0], 0, 0, 0), cA, 0, PWN##0, 0); VW(2, 0, 1); \
    GAPB(o[1] = __builtin_amdgcn_mfma_f32_32x32x16_bf16(PAF(PWC, 0), VWF(1), o[1], 0, 0, 0), cA, 4, PWN##0, 2); VW(3, 0, 5); \
    GAPB(o[0] = __builtin_amdgcn_mfma_f32_32x32x16_bf16(PAF(PWC, 1), VWF(2), o[0], 0, 0, 0), cA, 8, PWN##1, 0); VW(0, 0, 2); \
    GAPB(o[1] = __builtin_amdgcn_mfma_f32_32x32x16_bf16(PAF(PWC, 1), VWF(3), o[1], 0, 0, 0), cA, 12, PWN##1, 2); VW(1, 0, 6); \
    GAPB(o[0] = __builtin_amdgcn_mfma_f32_32x32x16_bf16(PAF(PWC, 2), VWF(0), o[0], 0, 0, 0), cB, 0, PWN##2, 0); VW(2, 0, 3); \
    GAPB(o[1] = __builtin_amdgcn_mfma_f32_32x32x16_bf16(PAF(PWC, 2), VWF(1), o[1], 0, 0, 0), cB, 4, PWN##2, 2); VW(3, 0, 7); \
    GAPB(o[0] = __builtin_amdgcn_mfma_f32_32x32x16_bf16(PAF(PWC, 3), VWF(2), o[0], 0, 0, 0), cB, 8, PWN##3, 0); VW(0, 1, 0); \
    GAPB(o[1] = __builtin_amdgcn_mfma_f32_32x32x16_bf16(PAF(PWC, 3), VWF(3), o[1], 0, 0, 0), cB, 12, PWN##3, 2); VW(1, 1, 4); \
    GAPC(o[2] = __builtin_amdgcn_mfma_f32_32x32x16_bf16(PAF(PWC, 0), VWF(0), o[2], 0, 0, 0)); VW(2, 1, 1); \
    GAPC(o[3] = __builtin_amdgcn_mfma_f32_32x32x16_bf16(PAF(PWC, 0), VWF(1), o[3], 0, 0, 0)); VW(3, 1, 5); \
    KRD(GL, 0); GAPC(o[2] = __builtin_amdgcn_mfma_f32_32x32x16_bf16(PAF(PWC, 1), VWF(2), o[2], 0, 0, 0)); VW(0, 1, 2); \
    KRD(GL, 1); GAPC(o[3] = __builtin_amdgcn_mfma_f32_32x32x16_bf16(PAF(PWC, 1), VWF(3), o[3], 0, 0, 0)); VW(1, 1, 6); \
    KRD(GL, 2); GAPC(o[2] = __builtin_amdgcn_mfma_f32_32x32x16_bf16(PAF(PWC, 2), VWF(0), o[2], 0, 0, 0)); VW(2, 1, 3); \
    KRD(GL, 3); GAPC(o[3] = __builtin_amdgcn_mfma_f32_32x32x16_bf16(PAF(PWC, 2), VWF(1), o[3], 0, 0, 0)); VW(3, 1, 7); \
    GAPC(o[2] = __builtin_amdgcn_mfma_f32_32x32x16_bf16(PAF(PWC, 3), VWF(2), o[2], 0, 0, 0)); \
    GAPC(o[3] = __builtin_amdgcn_mfma_f32_32x32x16_bf16(PAF(PWC, 3), VWF(3), o[3], 0, 0, 0)); \
    l_reg += sacc; \
    } while (0)
    int t = 1;
    for (; t + (T5 ? 29 : 5) < NT; t += 2) {
        if constexpr (NH == 2) { STEP2(pwa, pwb, t, true, true, true, false); } else { STEP(pwa, pwb, t, true, true, true, false); }     WAITKV_12(); RESC(); ROT();
        if constexpr (NH == 2) { STEP2(pwb, pwa, t + 1, true, true, true, false); } else { STEP(pwb, pwa, t + 1, true, true, true, false); } WAITKV_12(); RESC(); ROT();
    }
#define ENDW(tt) do { if ((tt) + 3 < NT) { WAITKV_12(); } else if ((tt) + 2 < NT) { WAITKV_02(); } else { WAIT_BAR(0); } } while (0)
    for (; t + 1 < NT; t += 2) {
        if constexpr (NH == 2) { STEP2(pwa, pwb, t, (t + 3 < NT), (t + 2 < NT), (t + 1 < NT), true); } else { STEP(pwa, pwb, t, (t + 3 < NT), (t + 2 < NT), (t + 1 < NT), true); }         ENDW(t);     RESC(); ROT();
        if constexpr (NH == 2) { STEP2(pwb, pwa, t + 1, (t + 4 < NT), (t + 3 < NT), (t + 2 < NT), true); } else { STEP(pwb, pwa, t + 1, (t + 4 < NT), (t + 3 < NT), (t + 2 < NT), true); }     ENDW(t + 1); RESC(); ROT();
    }
    if constexpr (NH == 2) { STEP2(pwa, pwb, NT - 1, false, false, false, true); } else { STEP(pwa, pwb, NT - 1, false, false, false, true); } RESC();
    SBAR(); pv(o, vb0 + sv_cur, PAF(pwb, 0), PAF(pwb, 1), PAF(pwb, 2), PAF(pwb, 3));
    if (NH == 2) pv(o + (2 * NH - 2), vb0 + sv_cur + 8192, PAF(pwb, 0), PAF(pwb, 1), PAF(pwb, 2), PAF(pwb, 3));
#undef PKW
#undef PAF
#undef VFR
#undef PIN
#undef MX3
#undef GAPA
#undef GAPB
#undef EX
#undef VRD
#undef KRD
#undef KRD8
#undef STEP
#undef STEP2
#undef VW
#undef VWF
#undef ENDW
    { auto rr = __builtin_amdgcn_permlane32_swap(__float_as_uint(l_reg), __float_as_uint(l_reg), false, false); l_reg = __uint_as_float(rr[0]) + __uint_as_float(rr[1]); }
    if (hi == 0) wsf[32 + r32] = l_reg; asm volatile("s_waitcnt lgkmcnt(0)" ::: "memory");
    float rli[16];
#pragma unroll
    for (int r = 0; r < 16; ++r) rli[r] = __builtin_amdgcn_rcpf(wsf[32 + crow(r, hi)]);
    bf16_t* Ow = P.out + (rowbase + q0 + wid * QBLK) * 1024 + ocol;
#pragma unroll
    for (int hh = 0; hh < NH; ++hh) { bf16_t* stg = (bf16_t*)(shm + LDS_OST) + wid * 2048;
#pragma unroll
      for (int r = 0; r < 16; ++r) { const int orow = crow(r, hi);
#pragma unroll
          for (int d0 = 0; d0 < 2; ++d0) stg[orow * 64 + d0 * 32 + r32] = (bf16_t)f2bf(o[2 * hh + d0][r] * rli[r]); }
      asm volatile("s_waitcnt lgkmcnt(0)" ::: "memory");
#pragma unroll
      for (int i = 0; i < 4; ++i) { const int row = i * 8 + (lane >> 3), ch = lane & 7; u32x4 v = *(const u32x4*)(stg + row * 64 + ch * 8);
          if (MODE == 1) {
              const u32x4 g = *(const u32x4*)(P.proj + (rowbase + q0 + wid * QBLK + row) * PITCH + 3072 + h * 64 + ch * 8);
              u32x4 w;
#pragma unroll
              for (int j = 0; j < 4; ++j) { const float a0 = bflo(v[j]) * sigmoid_f(bflo(g[j])), a1 = bfhi(v[j]) * sigmoid_f(bfhi(g[j])); w[j] = pk2(a0, a1); }
              v = w; }
          *(u32x4*)(Ow + (long)row * 1024 + hh * 64 + ch * 8) = v; }
      asm volatile("s_waitcnt lgkmcnt(0)" ::: "memory"); }
    asm volatile("s_waitcnt lgkmcnt(0)\n\ts_barrier" ::: "memory");
#undef DMA_K
#undef DMA_V
#undef WAITKV_22
#undef WAITKV_12
#undef WAITKV_11
#undef WAITKV_02
#undef VRD1
#undef QF
#undef GAPC
#undef PRE
#undef RESC
#undef ROT
}

#ifndef MK_THRL
#define MK_THRL 8
#endif
#ifndef MK_NOBIAS0
#define MK_NOBIAS0 0
#endif
#ifndef MK_NOBIAS
#define MK_NOBIAS 0
#endif
#ifndef MK_T5RELOAD
#define MK_T5RELOAD 0
#endif
template <int MODE>
__device__ __forceinline__ void attn_phase(char* lds, const AttnP& P, unsigned* queues  , unsigned xcc, const int tid) {
    volatile LAS int* uw = (volatile LAS int*)(LAS char*)(lds + LDS_UNIT); int cur_h = -1;
    for (int k = 0; k < 8; ++k) {
        const int qx = (int)((xcc + (unsigned)k) & 7u);
        for (;;) {
            if (tid == 0) uw[0] = (int)__hip_atomic_fetch_add(queues + 64 * qx, 1u, RLX_AGENT);
            __syncthreads();
            const int e = __builtin_amdgcn_readfirstlane(uw[0]);
            __syncthreads();
            constexpr int PERQ = (MODE == 2) ? 2 : 4;
#ifndef MK_QREP
#define MK_QREP 1
#endif
            constexpr int QREP = (MODE == 2) ? MK_QREP : 1;
            if (e >= QREP * PERQ * NQB) break;
            const int e1 = e % (PERQ * NQB); const int bvh = PERQ * qx + (e1 % PERQ), qb = NQB - 1 - (e1 / PERQ);
            const int ub = (MODE == 2) ? (bvh >> 3) : (bvh >> 4), uvh = (MODE == 2) ? (bvh & 7) : (bvh & 15), uh = (MODE == 2) ? (uvh >> 1) : (uvh >> 2);
            if ((MODE == 0 || MODE == 2) && (MK_T5RELOAD || uh != cur_h)) {
                cur_h = uh;
                LAS float* tb = (LAS float*)(LAS char*)(lds + LDS_TB) + tid; const GAS float* src = (const GAS float*)P.t5tab + (size_t)cur_h * T5N + tid; asm volatile("" : "+v"(tb), "+v"(src));
#pragma unroll
                for (int it = 0; it < (T5N + NTHR - 1) / NTHR; ++it) if (tid + NTHR * it < T5N) tb[NTHR * it] = src[NTHR * it];
                __syncthreads();
            }
            attn_unit<MODE, MK_THRL>(P, ub, uvh, qb, lds, tid);
        }
    }
}
#undef SBAR
#undef WAIT_BAR
}
struct Args { const float* in[24]; float* out; unsigned char* ws; const float* dbg_src; int lo, hi, bar_region, dbg_layer0; };
static_assert(sizeof(Args) == 27 * 8 + 16, "Args has padding");
template <int K_> __device__ __forceinline__ const float* inptr() {
#if defined(__HIP_DEVICE_COMPILE__)
    auto ka = __builtin_amdgcn_kernarg_segment_ptr(); const GAS float* p;
    asm volatile("s_load_dwordx2 %0, %1, %2\n\ts_waitcnt lgkmcnt(0)" : "=s"(p) : "s"(ka), "i"(K_ * 8)); return (const float*)p;
#else
    return nullptr;
#endif
}
#define INP(k) inptr<k>()
struct Frame {
    LAS unsigned char* lds; char* ldsg;
    gu32* ctl; unsigned char* ws;
    int tid, lane, wave, G, gw, NGW;
    float* out;
};
__device__ __forceinline__ float wave_sum(float v) {
#pragma unroll
    for (int o = 1; o < 64; o <<= 1) v += __shfl_xor(v, o);
    return v;
}
__device__ __forceinline__ float rowmax16(float v) {
    v = fmaxf(v, __builtin_bit_cast(float, __builtin_amdgcn_update_dpp(0, __builtin_bit_cast(int, v), 0xB1, 0xF, 0xF, false)));
    v = fmaxf(v, __builtin_bit_cast(float, __builtin_amdgcn_update_dpp(0, __builtin_bit_cast(int, v), 0x4E, 0xF, 0xF, false)));
    v = fmaxf(v, __builtin_bit_cast(float, __builtin_amdgcn_update_dpp(0, __builtin_bit_cast(int, v), 0x141, 0xF, 0xF, false)));
    v = fmaxf(v, __builtin_bit_cast(float, __builtin_amdgcn_update_dpp(0, __builtin_bit_cast(int, v), 0x140, 0xF, 0xF, false)));
    return v;
}
__device__ __forceinline__ float rowsum16(float v) {
    v += __builtin_bit_cast(float, __builtin_amdgcn_update_dpp(0, __builtin_bit_cast(int, v), 0xB1, 0xF, 0xF, false));
    v += __builtin_bit_cast(float, __builtin_amdgcn_update_dpp(0, __builtin_bit_cast(int, v), 0x4E, 0xF, 0xF, false));
    v += __builtin_bit_cast(float, __builtin_amdgcn_update_dpp(0, __builtin_bit_cast(int, v), 0x141, 0xF, 0xF, false));
    v += __builtin_bit_cast(float, __builtin_amdgcn_update_dpp(0, __builtin_bit_cast(int, v), 0x140, 0xF, 0xF, false));
    return v;
}

__device__ __forceinline__ void p0_transpose_item(const float* W, int ldn, int K, bf16_t* WT, int k0, int n_src0, int n_dst0, LAS float* scr, int lane) {
#pragma unroll 8
    for (int i = 0; i < 32; ++i) { const int kk = 2 * i + (lane >> 5); scr[kk * 33 + (lane & 31)] = W[(size_t)(k0 + kk) * ldn + n_src0 + (lane & 31)]; }
    LDS_WAIT(); asm volatile("" ::: "memory");
    const int c = lane & 7;
#pragma unroll
    for (int j = 0; j < 4; ++j) { const int n = (lane >> 3) + 8 * j; const LAS float* s = scr + (8 * c) * 33 + n;
        u32x4 o; o.x = pk2(s[0 * 33], s[1 * 33]); o.y = pk2(s[2 * 33], s[3 * 33]); o.z = pk2(s[4 * 33], s[5 * 33]); o.w = pk2(s[6 * 33], s[7 * 33]);
        *(GAS u32x4*)(WT + (size_t)(n_dst0 + n) * K + k0 + 8 * c) = o; }
    LDS_WAIT(); asm volatile("" ::: "memory");
}
__device__ __forceinline__ void p0a_convert(Frame& F) {
    LAS float* scr = (LAS float*)(F.lds + F.wave * 16384);
    unsigned char* ws = F.ws;
    constexpr int I_INE = 16 * 112, I_INO = 16 * 128, I_OUT = 16 * 32, I_GU = 16 * 64, I_D = 16 * 32;
    constexpr int N_DENSE = 2 * (I_INE + I_INO + 2 * I_OUT);
    constexpr long N_MOE = 128L * (I_GU + I_D);
    for (long it = F.gw; it < N_DENSE + N_MOE; it += F.NGW) {
        long r = it;
        if (r < N_DENSE) {
            const int i = (int)(r / (N_DENSE / 2)); int q = (int)(r % (N_DENSE / 2));
            if (q < I_INE) { p0_transpose_item(INP(2) + (size_t)i * D * EVEN_IN, EVEN_IN, D, (bf16_t*)(ws + WS_WINE) + (size_t)i * 3584 * D, 64 * (q / 112), 32 * (q % 112), 32 * (q % 112), scr, F.lane); continue; } q -= I_INE;
            if (q < I_INO) { p0_transpose_item(INP(10) + (size_t)i * D * ODD_IN, ODD_IN, D, (bf16_t*)(ws + WS_WINO) + (size_t)i * 4096 * D, 64 * (q / 128), 32 * (q % 128), 32 * (q % 128), scr, F.lane); continue; } q -= I_INO;
            if (q < I_OUT) { p0_transpose_item(INP(3) + (size_t)i * D * D, D, D, (bf16_t*)(ws + WS_WOUTE) + (size_t)i * D * D, 64 * (q / 32), 32 * (q % 32), 32 * (q % 32), scr, F.lane); continue; } q -= I_OUT;
            p0_transpose_item(INP(11) + (size_t)i * D * D, D, D, (bf16_t*)(ws + WS_WOUTO) + (size_t)i * D * D, 64 * (q / 32), 32 * (q % 32), 32 * (q % 32), scr, F.lane); continue;
        }
        r -= N_DENSE;
        const int le = (int)(r / (I_GU + I_D)); int q = (int)(r % (I_GU + I_D));
        if (q < I_GU) { const int nb = q % 64, n_src = 32 * nb;
            const int cc = n_src & 1023, n_dst = (cc >> 7) * 256 + (n_src >= 1024 ? 128 : 0) + (cc & 127);
            p0_transpose_item(INP(16) + (size_t)le * D * 2048, 2048, D, (bf16_t*)(ws + WS_WGU) + (size_t)le * 2048 * D, 64 * (q / 64), n_src, n_dst, scr, F.lane); }
        else { q -= I_GU; p0_transpose_item(INP(18) + (size_t)le * DFF * D, D, DFF, (bf16_t*)(ws + WS_WD) + (size_t)le * D * DFF, 64 * (q / 32), 32 * (q % 32), 32 * (q % 32), scr, F.lane); }
    }
    for (int it = F.gw; it < 128 + 32 + 32; it += F.NGW) {
        const float* src; int ld, col; bf16_t* hi; bool zero = false;
        if (it < 128) { const int l = it >> 5, e = it & 31; src = INP(14) + (size_t)l * D * NE; ld = NE; col = e; hi = (bf16_t*)(ws + WS_RW) + ((size_t)l * 2 * 32 + e) * 1024; }
        else if (it < 160) { const int i = (it - 128) >> 4, n = (it - 128) & 15; src = INP(2) + (size_t)i * D * EVEN_IN; ld = EVEN_IN; col = 3584 + n; zero = n >= 8; hi = (bf16_t*)(ws + WS_SWE) + ((size_t)i * 2 * 16 + n) * 1024; }
        else { const int i = (it - 160) >> 4, n = (it - 160) & 15; src = INP(10) + (size_t)i * D * ODD_IN; ld = ODD_IN; col = 4096 + n; hi = (bf16_t*)(ws + WS_SWO) + ((size_t)i * 2 * 16 + n) * 1024; }
        bf16_t* lo = hi + (it < 128 ? 32 : 16) * 1024;
        for (int k = F.lane; k < D; k += 64) { const float w = zero ? 0.f : src[(size_t)k * ld + col]; const unsigned h = f2bf(w); hi[k] = (bf16_t)h; lo[k] = (bf16_t)f2bf(w - __builtin_bit_cast(float, h << 16)); }
    }
    for (int i = F.gw * 64 + F.lane; i < 4 * T5N; i += F.NGW * 64) {
        const int h = i / T5N, p = i % T5N; float v = 0.f;
        if (p >= T5PAD) { const int n = p - T5PAD; int bk = n;
            if (n >= 16) { bk = 16 + (n >= 22) + (n >= 30) + (n >= 40) + (n >= 54) + (n >= 73) + (n >= 99) + (n >= 134) + (n >= 182) + (n >= 246) + (n >= 332) + (n >= 450) + (n >= 609) + (n >= 825) + (n >= 1117) + (n >= 1513); }
            v = (INP(1)[bk * 4 + h] - INP(1)[31 * 4 + h]) * LOG2E; }
#ifdef MK_ZEROT5
        v = 0.f;
#endif
#ifdef MK_SAMET5
        if (p >= T5PAD) { const int n = p - T5PAD; int bk = n; if (n >= 16) { bk = 16 + (n >= 22) + (n >= 30) + (n >= 40) + (n >= 54) + (n >= 73) + (n >= 99) + (n >= 134) + (n >= 182) + (n >= 246) + (n >= 332) + (n >= 450) + (n >= 609) + (n >= 825) + (n >= 1117) + (n >= 1513); } v = (INP(1)[bk * 4] - INP(1)[31 * 4]) * LOG2E; }
#endif
        ((float*)(ws + WS_T5))[i] = v;
    }
}

struct Ln16 {
    const float* X; const float* H; const bf16_t* Y; float* Xout; bf16_t* XB; const float* gam; const float* bet;
    const bf16_t* Whi; const bf16_t* Wlo;
    float oscale;
    const bf16_t* Xb; const bf16_t* Hb;
};
template <int SRC, int NS, bool WRITE_XB>
__device__ __forceinline__ void ln16_tile(const Ln16& P, int tile, int lane, const int (&pos)[4], const float (&gt)[4], f32x4 (&acc)[NS > 0 ? NS : 1]) {
    const int r = lane & 15, q = lane >> 4; const size_t m = (size_t)tile * 16 + r;
    const float* xr = P.X + m * D + 8 * q; const float* hr = (SRC == 1) ? P.H + m * D + 8 * q : nullptr;
    const bf16_t* yr[4];
    if (SRC == 2) {
#pragma unroll
        for (int k = 0; k < 4; ++k) yr[k] = P.Y + (size_t)pos[k] * D + 8 * q; }
#define LN16_LOAD(v, ks) do { const f32x4 a0 = *(const f32x4*)(xr + 32 * (ks)), a1 = *(const f32x4*)(xr + 32 * (ks) + 4); \
        if (SRC == 0) { _Pragma("unroll") for (int j = 0; j < 4; ++j) { v[j] = a0[j]; v[4 + j] = a1[j]; } } \
        else if (SRC == 1) { const f32x4 h0 = *(const f32x4*)(hr + 32 * (ks)), h1 = *(const f32x4*)(hr + 32 * (ks) + 4); _Pragma("unroll") for (int j = 0; j < 4; ++j) { v[j] = ALPHA * a0[j] + h0[j]; v[4 + j] = ALPHA * a1[j] + h1[j]; } } \
        else { _Pragma("unroll") for (int j = 0; j < 4; ++j) { v[j] = ALPHA * a0[j]; v[4 + j] = ALPHA * a1[j]; } \
            _Pragma("unroll") for (int k = 0; k < 4; ++k) { const u32x4 y = *(const u32x4*)(yr[k] + 32 * (ks)); _Pragma("unroll") for (int j = 0; j < 4; ++j) { v[2 * j] = fmaf(gt[k], bflo(y[j]), v[2 * j]); v[2 * j + 1] = fmaf(gt[k], bfhi(y[j]), v[2 * j + 1]); } } } } while (0)
    float mean = 0.f, rstd = 1.f;
    if (SRC != 0) {
        float s = 0.f, ss = 0.f;
#pragma unroll 4
        for (int ks = 0; ks < 32; ++ks) { float v[8]; LN16_LOAD(v, ks);
#pragma unroll
            for (int j = 0; j < 8; ++j) { s += v[j]; ss = fmaf(v[j], v[j], ss); } }
        s += __shfl_xor(s, 16); s += __shfl_xor(s, 32); ss += __shfl_xor(ss, 16); ss += __shfl_xor(ss, 32);
        mean = s * (1.f / D); const float var = fmaxf(ss * (1.f / D) - mean * mean, 0.f); rstd = rsqrtf(var + LN_EPS);
    }
#pragma unroll
    for (int n = 0; n < (NS > 0 ? NS : 1); ++n) acc[n] = (f32x4){0.f, 0.f, 0.f, 0.f};
#pragma unroll 1
    for (int ks4 = 0; ks4 < 32; ks4 += 4) {
        float vb[4][8]; bf16x8 wh[4][NS > 0 ? NS : 1], wl[4][NS > 0 ? NS : 1];
#pragma unroll
        for (int u = 0; u < 4; ++u) { LN16_LOAD(vb[u], ks4 + u);
            if (NS > 0) {
#pragma unroll
                for (int n = 0; n < NS; ++n) { wh[u][n] = *(const bf16x8*)(P.Whi + (size_t)(16 * n + r) * D + 32 * (ks4 + u) + 8 * q); wl[u][n] = *(const bf16x8*)(P.Wlo + (size_t)(16 * n + r) * D + 32 * (ks4 + u) + 8 * q); } } }
#pragma unroll
        for (int u = 0; u < 4; ++u) { const int ks = ks4 + u;
        float v[8];
#pragma unroll
        for (int j = 0; j < 8; ++j) v[j] = vb[u][j];
        if (SRC != 0) { const f32x4 g0 = *(const f32x4*)(P.gam + 32 * ks + 8 * q), g1 = *(const f32x4*)(P.gam + 32 * ks + 8 * q + 4), b0 = *(const f32x4*)(P.bet + 32 * ks + 8 * q), b1 = *(const f32x4*)(P.bet + 32 * ks + 8 * q + 4);
#pragma unroll
            for (int j = 0; j < 4; ++j) { v[j] = (v[j] - mean) * rstd * g0[j] + b0[j]; v[4 + j] = (v[4 + j] - mean) * rstd * g1[j] + b1[j]; } }
        if (P.Xout) { float* xo = P.Xout + m * D + 32 * ks + 8 * q;
            *(f32x4*)xo = (f32x4){v[0], v[1], v[2], v[3]} * P.oscale; *(f32x4*)(xo + 4) = (f32x4){v[4], v[5], v[6], v[7]} * P.oscale; }
        u32x4 hi; hi.x = pk2(v[0], v[1]); hi.y = pk2(v[2], v[3]); hi.z = pk2(v[4], v[5]); hi.w = pk2(v[6], v[7]);
        if (WRITE_XB) *(u32x4*)(P.XB + m * D + 32 * ks + 8 * q) = hi;
        if (NS > 0) {
            u32x4 lo;
#pragma unroll
            for (int j = 0; j < 4; ++j) lo[j] = pk2(v[2 * j] - bflo(hi[j]), v[2 * j + 1] - bfhi(hi[j]));
            const bf16x8 ah = __builtin_bit_cast(bf16x8, hi), al = __builtin_bit_cast(bf16x8, lo);
#pragma unroll
            for (int n = 0; n < NS; ++n) {
                const bf16x8 bh = wh[u][n], bl = wl[u][n];
                acc[n] = __builtin_amdgcn_mfma_f32_16x16x32_bf16(ah, bh, acc[n], 0, 0, 0);
                acc[n] = __builtin_amdgcn_mfma_f32_16x16x32_bf16(al, bh, acc[n], 0, 0, 0);
                acc[n] = __builtin_amdgcn_mfma_f32_16x16x32_bf16(ah, bl, acc[n], 0, 0, 0); }
        }
        }
    }
#undef LN16_LOAD
    if (NS > 0) asm volatile("s_nop 15\n\ts_nop 7" ::: "memory");
}
template <int SRC, int NS, bool WRITE_XB, bool WRITE_X>
__device__ __forceinline__ void ln16_pair(const Ln16& P, LAS unsigned char* xl, int par, int tile, int lane, int wave, const int (&pos)[4], const float (&gt)[4], f32x4 (&acc)[NS > 0 ? NS : 1]) {
    const int r = lane & 15, q = lane >> 4, half = wave & 1; const size_t m = (size_t)tile * 16 + r;
    const bf16_t* xr = P.Xb + m * D + 8 * q + 512 * half; const bf16_t* hr = (SRC == 1) ? P.Hb + m * D + 8 * q + 512 * half : nullptr;
    const bf16_t* yr[4];
    if (SRC == 2) {
#pragma unroll
        for (int k = 0; k < 4; ++k) yr[k] = P.Y + (size_t)pos[k] * D + 8 * q + 512 * half; }
    float st[16][8]; float s = 0.f, ss = 0.f;
#pragma unroll
    for (int ks = 0; ks < 16; ++ks) {
        const u32x4 xa = *(const u32x4*)(xr + 32 * ks);
        if (SRC == 1) { const u32x4 hh = *(const u32x4*)(hr + 32 * ks);
#pragma unroll
            for (int j = 0; j < 4; ++j) { st[ks][2 * j] = fmaf(ALPHA, bflo(xa[j]), bflo(hh[j])); st[ks][2 * j + 1] = fmaf(ALPHA, bfhi(xa[j]), bfhi(hh[j])); } }
        else {
#pragma unroll
            for (int j = 0; j < 4; ++j) { st[ks][2 * j] = ALPHA * bflo(xa[j]); st[ks][2 * j + 1] = ALPHA * bfhi(xa[j]); }
#pragma unroll
            for (int k = 0; k < 4; ++k) { const u32x4 y = *(const u32x4*)(yr[k] + 32 * ks);
#pragma unroll
                for (int j = 0; j < 4; ++j) { st[ks][2 * j] = fmaf(gt[k], bflo(y[j]), st[ks][2 * j]); st[ks][2 * j + 1] = fmaf(gt[k], bfhi(y[j]), st[ks][2 * j + 1]); } } }
#pragma unroll
        for (int j = 0; j < 8; ++j) { s += st[ks][j]; ss = fmaf(st[ks][j], st[ks][j], ss); }
        if ((ks & (SRC == 1 ? 7 : 3)) == (SRC == 1 ? 7 : 3)) __builtin_amdgcn_sched_barrier(0);
    }
    s += __shfl_xor(s, 16); s += __shfl_xor(s, 32); ss += __shfl_xor(ss, 16); ss += __shfl_xor(ss, 32);
    LAS float* ex = (LAS float*)(xl + par * 1024);
    if (q == 0) { ex[(wave * 16 + r) * 2] = s; ex[(wave * 16 + r) * 2 + 1] = ss; }
    __syncthreads();
    s += ex[((wave ^ 1) * 16 + r) * 2]; ss += ex[((wave ^ 1) * 16 + r) * 2 + 1];
    const float mean = s * (1.f / D); const float var = fmaxf(ss * (1.f / D) - mean * mean, 0.f); const float rstd = rsqrtf(var + LN_EPS);
#pragma unroll
    for (int n = 0; n < (NS > 0 ? NS : 1); ++n) acc[n] = (f32x4){0.f, 0.f, 0.f, 0.f};
#pragma unroll
    for (int ks = 0; ks < 16; ++ks) {
        const int c0 = 512 * half + 32 * ks + 8 * q;
        const f32x4 g0 = *(const f32x4*)(P.gam + c0), g1 = *(const f32x4*)(P.gam + c0 + 4), b0 = *(const f32x4*)(P.bet + c0), b1 = *(const f32x4*)(P.bet + c0 + 4);
        float v[8];
#pragma unroll
        for (int j = 0; j < 4; ++j) { v[j] = (st[ks][j] - mean) * rstd * g0[j] + b0[j]; v[4 + j] = (st[ks][4 + j] - mean) * rstd * g1[j] + b1[j]; }
        if (WRITE_X) { float* xo = P.Xout + m * D + c0;
            *(f32x4*)xo = (f32x4){v[0], v[1], v[2], v[3]} * P.oscale; *(f32x4*)(xo + 4) = (f32x4){v[4], v[5], v[6], v[7]} * P.oscale; }
        u32x4 hi; hi.x = pk2(v[0], v[1]); hi.y = pk2(v[2], v[3]); hi.z = pk2(v[4], v[5]); hi.w = pk2(v[6], v[7]);
        if (WRITE_XB) *(u32x4*)(P.XB + m * D + c0) = hi;
        if (NS > 0) {
            u32x4 lo;
#pragma unroll
            for (int j = 0; j < 4; ++j) lo[j] = pk2(v[2 * j] - bflo(hi[j]), v[2 * j + 1] - bfhi(hi[j]));
            const bf16x8 ah = __builtin_bit_cast(bf16x8, hi), al = __builtin_bit_cast(bf16x8, lo);
#pragma unroll
            for (int n = 0; n < NS; ++n) {
                const bf16x8 bh = *(const bf16x8*)(P.Whi + (size_t)(16 * n + r) * D + c0), bl = *(const bf16x8*)(P.Wlo + (size_t)(16 * n + r) * D + c0);
                acc[n] = __builtin_amdgcn_mfma_f32_16x16x32_bf16(ah, bh, acc[n], 0, 0, 0);
                acc[n] = __builtin_amdgcn_mfma_f32_16x16x32_bf16(al, bh, acc[n], 0, 0, 0);
                acc[n] = __builtin_amdgcn_mfma_f32_16x16x32_bf16(ah, bl, acc[n], 0, 0, 0); }
        }
        if ((ks & 3) == 3) __builtin_amdgcn_sched_barrier(0);
    }
    if (NS > 0) {
        asm volatile("s_nop 15\n\ts_nop 7" ::: "memory");
        LAS f32x4* ax = (LAS f32x4*)(xl + 2048);
#pragma unroll
        for (int n = 0; n < NS; ++n) ax[(wave * NS + n) * 64 + lane] = acc[n];
        __syncthreads();
#pragma unroll
        for (int n = 0; n < NS; ++n) acc[n] = acc[n] + ax[((wave ^ 1) * NS + n) * 64 + lane];
    }
}
__device__ __forceinline__ void smallproj_store(Frame& F, const f32x4& acc, int tile, bool next_even, const float* fb) {
    const int r = F.lane & 15, q = F.lane >> 4;
    if (next_even) {
        float* pb = (float*)(F.ws + WS_PB);
#pragma unroll
        for (int i = 0; i < 4; ++i) pb[(size_t)(tile * 16 + 4 * q + i) * 16 + r] = acc[i];
    } else {
        float* cum = (float*)(F.ws + WS_CUM); float* tsum = (float*)(F.ws + WS_TSUM);
        const int tok0 = tile * 16, b = tok0 / T, t0 = tok0 % T; const float bias = fb[r]; float s = 0.f;
#pragma unroll
        for (int i = 0; i < 4; ++i) { const float lf = -softplus_f(-(acc[i] + bias)); cum[(size_t)(b * 16 + r) * T + t0 + 4 * q + i] = lf; s += lf; }
        s += __shfl_xor(s, 16); s += __shfl_xor(s, 32);
        if (q == 0) tsum[(size_t)(b * 16 + r) * 1024 + (t0 >> 4)] = s;
    }
}

__device__ __forceinline__ void p0b_input(Frame& F) {
    Ln16 P{INP(0), nullptr, nullptr, nullptr, (bf16_t*)(F.ws + WS_XB), nullptr, nullptr, (const bf16_t*)(F.ws + WS_SWE), (const bf16_t*)(F.ws + WS_SWE) + 16 * 1024, 1.f};
    const int pos[4] = {0, 0, 0, 0}; const float gt[4] = {0.f, 0.f, 0.f, 0.f};
    for (int tile = F.gw; tile < NTOK / 16; tile += F.NGW) { f32x4 acc[1]; ln16_tile<0, 1, true>(P, tile, F.lane, pos, gt, acc); smallproj_store(F, acc[0], tile, true, nullptr); }
}

__device__ __forceinline__ void ln_router_phase(Frame& F, int layer) {
    volatile LAS int* wcnt = (volatile LAS int*)(F.lds + 0); volatile LAS int* gbase = (volatile LAS int*)(F.lds + 128);
    Ln16 P{(const float*)(F.ws + WS_X), (const float*)(F.ws + WS_H), nullptr, (float*)(F.ws + WS_X), (bf16_t*)(F.ws + WS_XB), INP(20) + layer * D, INP(21) + layer * D,
           (const bf16_t*)(F.ws + WS_RW) + (size_t)layer * 2 * 32 * 1024, (const bf16_t*)(F.ws + WS_RW) + (size_t)layer * 2 * 32 * 1024 + 32 * 1024, 1.f};
    P.Xb = (const bf16_t*)(F.ws + WS_XB); P.Hb = (const bf16_t*)(F.ws + WS_H);
    const float* rb = INP(15) + layer * NE;
    int* sele = (int*)(F.ws + WS_SELE); int* slot_o = (int*)(F.ws + WS_SLOT); float* gate_o = (float*)(F.ws + WS_GATE); int* list = (int*)(F.ws + WS_LIST);
    unsigned* gcnt = (unsigned*)(F.ctl + CW_CNT + layer * NE);
    const int pos[4] = {0, 0, 0, 0}; const float gt[4] = {0.f, 0.f, 0.f, 0.f};
    const int r = F.lane & 15, q = F.lane >> 4;
    for (int wt = blockIdx.x; wt < NTOK / 128; wt += F.G) {
        if (F.tid < 32) wcnt[F.tid] = 0;
        __syncthreads();
        const int kk = r & 3; int e_[2], local_[2]; float gm_[2];
#pragma unroll
        for (int rd = 0; rd < 2; ++rd) {
            const int tile = wt * 8 + rd * 4 + (F.wave >> 1);
            f32x4 acc[2]; ln16_pair<1, 2, true, false>(P, F.lds + 4096, rd, tile, F.lane, F.wave, pos, gt, acc);
            e_[rd] = 0; local_[rd] = 0; gm_[rd] = 0.f;
            if ((F.wave & 1) == 0) {
            const float b0 = rb[r], b1 = rb[16 + r];
            float top[4][4];
#pragma unroll
            for (int i = 0; i < 4; ++i) {
                float a = __builtin_bit_cast(float, (__builtin_bit_cast(unsigned, acc[0][i] + b0) & ~31u) | (unsigned)r);
                float b = __builtin_bit_cast(float, (__builtin_bit_cast(unsigned, acc[1][i] + b1) & ~31u) | (unsigned)(16 + r));
#pragma unroll
                for (int k = 0; k < 4; ++k) { const float mx = rowmax16(fmaxf(a, b)); top[i][k] = mx; if (a == mx) a = -INFINITY; if (b == mx) b = -INFINITY; }
            }
            float tv[4];
#pragma unroll
            for (int k = 0; k < 4; ++k) { const int i = r >> 2; tv[k] = i == 0 ? top[0][k] : i == 1 ? top[1][k] : i == 2 ? top[2][k] : top[3][k]; }
            float w[4], ws_ = 0.f;
#pragma unroll
            for (int k = 0; k < 4; ++k) { w[k] = __expf(tv[k] - tv[0]); ws_ += w[k]; }
            const float mine = kk == 0 ? tv[0] : kk == 1 ? tv[1] : kk == 2 ? tv[2] : tv[3]; gm_[rd] = (kk == 0 ? w[0] : kk == 1 ? w[1] : kk == 2 ? w[2] : w[3]) / ws_;
            e_[rd] = (int)(__builtin_bit_cast(unsigned, mine) & 31u);
            local_[rd] = __hip_atomic_fetch_add((LAS int*)(wcnt + e_[rd]), 1, __ATOMIC_RELAXED, __HIP_MEMORY_SCOPE_WORKGROUP);
            }
        }
        __syncthreads();
        if (F.tid < 32) gbase[F.tid] = (int)__hip_atomic_fetch_add(gcnt + F.tid, (unsigned)wcnt[F.tid], RLX_AGENT);
        __syncthreads();
        if ((F.wave & 1) == 0) {
#pragma unroll
            for (int rd = 0; rd < 2; ++rd) { const int tile = wt * 8 + rd * 4 + (F.wave >> 1);
                const int tok = tile * 16 + 4 * q + (r >> 2); const int sl = gbase[e_[rd]] + local_[rd];
                sele[tok * 4 + kk] = e_[rd]; slot_o[tok * 4 + kk] = sl; gate_o[tok * 4 + kk] = gm_[rd]; list[(size_t)e_[rd] * NTOK + sl] = tok * 4 + kk; } }
        __syncthreads();
    }
}

__device__ __forceinline__ void moe_tables(Frame& F, int layer) {
    volatile LAS int* cnt = (volatile LAS int*)(F.lds + CTRL_OFF); volatile LAS int* offp = cnt + 32;
    if (F.tid < 64) {
        const int c = F.lane < 32 ? (int)__hip_atomic_load((unsigned*)(F.ctl + CW_CNT + layer * NE + (F.lane & 31)), RLX_AGENT) : 0;
        int p = ((c + 255) >> 8) << 8;
#pragma unroll
        for (int o = 1; o < 32; o <<= 1) { const int n = __shfl_up(p, o); if ((F.lane & 31) >= o) p += n; }
        if (F.lane < 32) { cnt[F.lane] = c; offp[F.lane] = p - (((c + 255) >> 8) << 8); }
    }
    __syncthreads();
}

__device__ __forceinline__ void moe_out_phase(Frame& F, int layer) {
    volatile LAS int* offp = (volatile LAS int*)(F.lds + CTRL_OFF) + 32;
    const bool lastl = layer == 3, next_even = (layer & 1) == 1; const int ni = (layer + 1) >> 1;
    const bf16_t* sw = next_even ? (const bf16_t*)(F.ws + WS_SWE) + (size_t)ni * 2 * 16 * 1024 : (const bf16_t*)(F.ws + WS_SWO) + (size_t)ni * 2 * 16 * 1024;
    Ln16 P{(const float*)(F.ws + WS_X), nullptr, (const bf16_t*)(F.ws + WS_Y), lastl ? F.out : (float*)(F.ws + WS_X), (bf16_t*)(F.ws + WS_XB), INP(22) + layer * D, INP(23) + layer * D, sw, sw + 16 * 1024, 1.f};
    P.Xb = (const bf16_t*)(F.ws + WS_XB); P.Hb = nullptr;
#if defined(MK_TIMING)
    if (lastl) {
        const unsigned long long* st = (const unsigned long long*)(F.ctl + 65536);
        const int ty[36] = {0, 1, 2, 3, 4, 5, 8, 9, 10, 11, 13, 2, 6, 7, 8, 9, 10, 11, 13, 2, 3, 4, 5, 8, 9, 10, 11, 13, 2, 6, 7, 8, 9, 10, 11, 13};
        unsigned long long sel = 0;
#pragma unroll
        for (int k = 0; k < 34; ++k) if (((MK_TIMING) >> ty[k]) & 1) sel += st[k + 1] - st[k];
        P.oscale = 1.f + floorf((float)sel / (float)(st[34] - st[0]) * 100.f + 0.5f) * 0.01f;
    }
#endif
    const int* sele = (const int*)(F.ws + WS_SELE); const int* slot = (const int*)(F.ws + WS_SLOT); const float* gate = (const float*)(F.ws + WS_GATE);
    const float* fb = INP(13) + (lastl ? 0 : ni * 16);
    int par = 0;
    for (int tile = F.gw >> 1; tile < NTOK / 16; tile += F.NGW / 2, par ^= 1) {
        const int m = tile * 16 + (F.lane & 15); int pos[4]; float gt[4];
#pragma unroll
        for (int k = 0; k < 4; ++k) { pos[k] = offp[sele[m * 4 + k]] + slot[m * 4 + k]; gt[k] = gate[m * 4 + k]; }
        f32x4 acc[1];
        if (lastl) { ln16_pair<2, 0, false, true>(P, F.lds + 4096, par, tile, F.lane, F.wave, pos, gt, acc); }
        else { ln16_pair<2, 1, true, false>(P, F.lds + 4096, par, tile, F.lane, F.wave, pos, gt, acc); if ((F.wave & 1) == 0) smallproj_store(F, acc[0], tile, next_even, fb); }
    }
}

__device__ __forceinline__ void odd_prep_phase(Frame& F, int li) {
    float* cum = (float*)(F.ws + WS_CUM); const float* tsum = (const float*)(F.ws + WS_TSUM); bf16_t* kb8 = (bf16_t*)(F.ws + WS_KB8);
    for (int it = F.gw; it < 32 * 64; it += F.NGW) {
        const int bh = it >> 6, seg = it & 63;
        double base = 0.0;
        { float tv[16];
#pragma unroll
          for (int jj = 0; jj < 16; ++jj) { const int j = F.lane + 64 * jj; tv[jj] = j < 16 * seg ? tsum[(size_t)bh * 1024 + j] : 0.f; }
#pragma unroll
          for (int jj = 0; jj < 16; ++jj) base += (double)tv[jj]; }
#pragma unroll
        for (int o = 1; o < 64; o <<= 1) base += __shfl_xor(base, o);
        float* p = cum + (size_t)bh * T + seg * 256 + 4 * F.lane;
        const f32x4 lf = *(const f32x4*)p;
        float c0 = lf[0], c1 = c0 + lf[1], c2 = c1 + lf[2], c3 = c2 + lf[3];
        float incl = c3;
#pragma unroll
        for (int o = 1; o < 64; o <<= 1) { const float n = __shfl_up(incl, o); if (F.lane >= o) incl += n; }
        const float excl = incl - c3; const float bs = (float)base + excl;
        const float cc[4] = {(bs + c0) * LOG2E, (bs + c1) * LOG2E, (bs + c2) * LOG2E, (bs + c3) * LOG2E};
        *(f32x4*)p = (f32x4){cc[0], cc[1], cc[2], cc[3]};
#pragma unroll
        for (int j = 0; j < 4; ++j) { const float c = -cc[j];
            const unsigned ch = f2bf(c); const float r1 = c - __builtin_bit_cast(float, ch << 16); const unsigned cm = f2bf(r1); const float r2 = r1 - __builtin_bit_cast(float, cm << 16); const unsigned cl = f2bf(r2);
            u32x4 w; w.x = 0x3f80u | (0x3f80u << 16); w.y = 0x3f80u | (ch << 16); w.z = cm | (cl << 16); w.w = 0u;
            *(u32x4*)(kb8 + ((size_t)bh * T + seg * 256 + 4 * F.lane + j) * 8) = w; }
    }
    bf16_t* proj = (bf16_t*)(F.ws + WS_PROJ); const float* nw = INP(12) + li * 128;
    float wq[16], wk[16];
#pragma unroll
    for (int j = 0; j < 16; ++j) { wq[j] = nw[(F.lane & 3) * 16 + j] * C2; wk[j] = nw[64 + (F.lane & 3) * 16 + j]; }
    for (int tok = F.gw; tok < NTOK; tok += 4 * F.NGW) {
        u32x4 ra[4][2], rb[4][2];
#pragma unroll
        for (int u = 0; u < 4; ++u)
#pragma unroll
            for (int which = 0; which < 2; ++which) { const bf16_t* p = proj + (size_t)(tok + u * F.NGW) * PITCH + which * 1024 + 16 * F.lane; ra[u][which] = *(const u32x4*)p; rb[u][which] = *(const u32x4*)(p + 8); }
#pragma unroll
        for (int u = 0; u < 4; ++u)
#pragma unroll
        for (int which = 0; which < 2; ++which) {
            bf16_t* p = proj + (size_t)(tok + u * F.NGW) * PITCH + which * 1024 + 16 * F.lane;
            const u32x4 a = ra[u][which], b = rb[u][which];
            float v[16];
#pragma unroll
            for (int j = 0; j < 4; ++j) { v[2 * j] = bflo(a[j]); v[2 * j + 1] = bfhi(a[j]); v[8 + 2 * j] = bflo(b[j]); v[8 + 2 * j + 1] = bfhi(b[j]); }
            float ss = 0.f;
#pragma unroll
            for (int j = 0; j < 16; ++j) ss = fmaf(v[j], v[j], ss);
            ss += __shfl_xor(ss, 1); ss += __shfl_xor(ss, 2);
            const float rr = rsqrtf(ss * (1.f / 64.f) + RMS_EPS);
            u32x4 oa, ob;
#pragma unroll
            for (int j = 0; j < 4; ++j) { oa[j] = pk2(v[2 * j] * rr * (which ? wk[2 * j] : wq[2 * j]), v[2 * j + 1] * rr * (which ? wk[2 * j + 1] : wq[2 * j + 1]));
                ob[j] = pk2(v[8 + 2 * j] * rr * (which ? wk[8 + 2 * j] : wq[8 + 2 * j]), v[8 + 2 * j + 1] * rr * (which ? wk[8 + 2 * j + 1] : wq[8 + 2 * j + 1])); }
            *(u32x4*)p = oa; *(u32x4*)(p + 8) = ob;
        }
    }
}

__device__ __forceinline__ void even_combine_phase(Frame& F, int li, float lam_init) {
    const float* lp = INP(4) + li * 256;
    float a = 0.f, bsum = 0.f; { const int l = F.lane; a = lp[l] * lp[64 + l]; bsum = lp[128 + l] * lp[192 + l]; }
    a = wave_sum(a); bsum = wave_sum(bsum);
    const float lam = __expf(a) - __expf(bsum) + lam_init;
    const bf16_t* att = (const bf16_t*)(F.ws + WS_ATT); const float* go = (const float*)(F.ws + WS_GO); const bf16_t* proj = (const bf16_t*)(F.ws + WS_PROJ); bf16_t* mix = (bf16_t*)(F.ws + WS_MIX);
    const int l = F.lane, hh = l >> 4, d0 = (l & 15) * 8;
    float sw[8], gw[8];
#pragma unroll
    for (int j = 0; j < 8; ++j) { sw[j] = INP(5)[li * 128 + d0 + j] * (1.f - lam_init); gw[j] = INP(9)[li * 128 + d0 + j]; }
    for (int tok0 = F.gw; tok0 < NTOK; tok0 += 4 * F.NGW) {
        u32x4 o0_[4], o1_[4], z_[4]; f32x4 g0_[4], g1_[4];
#pragma unroll
        for (int u4 = 0; u4 < 4; ++u4) { const size_t tok = (size_t)(tok0 + u4 * F.NGW);
            o0_[u4] = *(const u32x4*)(att + tok * D + (hh * 2) * 128 + d0); o1_[u4] = *(const u32x4*)(att + tok * D + (hh * 2 + 1) * 128 + d0);
            g0_[u4] = *(const f32x4*)(go + tok * 512 + hh * 128 + d0); g1_[u4] = *(const f32x4*)(go + tok * 512 + hh * 128 + d0 + 4);
            z_[u4] = *(const u32x4*)(proj + tok * PITCH + 3072 + hh * 128 + d0); }
#pragma unroll
        for (int u4 = 0; u4 < 4; ++u4) { const size_t tok = (size_t)(tok0 + u4 * F.NGW);
        const u32x4 o0 = o0_[u4], o1 = o1_[u4];
        float v[8]; float ss = 0.f;
#pragma unroll
        for (int j = 0; j < 4; ++j) { v[2 * j] = bflo(o0[j]) - lam * bflo(o1[j]); v[2 * j + 1] = bfhi(o0[j]) - lam * bfhi(o1[j]); }
#pragma unroll
        for (int j = 0; j < 8; ++j) ss = fmaf(v[j], v[j], ss);
        ss = rowsum16(ss);
        float rr = rsqrtf(ss * (1.f / 128.f) + RMS_EPS);
        u32x4 w;
#pragma unroll
        for (int j = 0; j < 4; ++j) w[j] = pk2(v[2 * j] * rr * sw[2 * j], v[2 * j + 1] * rr * sw[2 * j + 1]);
        *(u32x4*)(mix + tok * D + hh * 128 + d0) = w;
        const f32x4 g0 = g0_[u4], g1 = g1_[u4];
        const u32x4 z = z_[u4];
        float u[8] = {g0[0], g0[1], g0[2], g0[3], g1[0], g1[1], g1[2], g1[3]};
        ss = 0.f;
#pragma unroll
        for (int j = 0; j < 8; ++j) ss = fmaf(u[j], u[j], ss);
        ss = rowsum16(ss);
        rr = rsqrtf(ss * (1.f / 128.f) + RMS_EPS);
#pragma unroll
        for (int j = 0; j < 4; ++j) { const float z0 = bflo(z[j]), z1 = bfhi(z[j]); w[j] = pk2(u[2 * j] * rr * gw[2 * j] * (z0 * sigmoid_f(z0)), u[2 * j + 1] * rr * gw[2 * j + 1] * (z1 * sigmoid_f(z1))); }
        *(u32x4*)(mix + tok * D + 512 + hh * 128 + d0) = w;
        }
    }
}
constexpr int GP_W = 136, GP_K = 72;
constexpr int GB_W = 64 * GP_W * 2, GB_QK = 64 * GP_K * 2, GB_KD = 128 * GP_K * 2;
constexpr int GB_ITEM = 2 * GB_W + GB_QK + GB_KD;
__device__ __forceinline__ int P32(int x) { return (x & ~31) | (((x >> 2) & 3) << 3) | (((x >> 4) & 1) << 2) | (x & 3); }

__device__ __forceinline__ void gdn_prep_phase(Frame& F, int li) {
    LAS unsigned char* L = F.lds;
    LAS bf16_t* Kn = (LAS bf16_t*)(L + 0);
    LAS bf16_t* Qn = (LAS bf16_t*)(L + 17408);
    LAS float* R = (LAS float*)(L + 34816);
    LAS float* Lm = (LAS float*)(L + 100352);
    LAS float* sc = (LAS float*)(L + 116736);
    const bf16_t* proj = (const bf16_t*)(F.ws + WS_PROJ); const float* pb = (const float*)(F.ws + WS_PB);
    const float* cw = INP(6) + (size_t)li * 4 * 1536;
    const int tid = F.tid, lane = F.lane, wave = F.wave;
    for (int item = blockIdx.x; item < 2048; item += F.G) {
        const int n = item & 255, h = (item >> 8) & 3, b = item >> 10; const int t0 = n * 64; const size_t tok0 = (size_t)b * T + t0;
        if (wave == 0) {
            const float bb = pb[(tok0 + lane) * 16 + h], ba = pb[(tok0 + lane) * 16 + 4 + h];
            const float beta = sigmoid_f(bb); const float g = -__expf(INP(7)[li * 4 + h]) * softplus_f(ba + INP(8)[li * 4 + h]);
            float gc = g;
#pragma unroll
            for (int o = 1; o < 64; o <<= 1) { const float v = __shfl_up(gc, o); if (lane >= o) gc += v; }
            sc[lane] = beta; sc[64 + lane] = gc;
        }
        __syncthreads();
        const int c = tid & 127, seg = tid >> 7;
        float yq[16], yk[16];
        {
            float w[3][4];
#pragma unroll
            for (int g = 0; g < 3; ++g)
#pragma unroll
                for (int j = 0; j < 4; ++j) w[g][j] = cw[j * 1536 + g * 512 + h * 128 + c];
            float xw[3][3];
            const bf16_t* base = proj + (tok0 + 16 * seg) * PITCH + 1536 + h * 128 + c;
#pragma unroll
            for (int j = 0; j < 3; ++j) { const bool ok = (t0 + 16 * seg - 3 + j) >= 0;
#pragma unroll
                for (int g = 0; g < 3; ++g) xw[g][j] = ok ? bf2f(base[(long)(j - 3) * PITCH + g * 512]) : 0.f; }
#pragma unroll
            for (int j = 0; j < 16; ++j) {
                float x[3];
#pragma unroll
                for (int g = 0; g < 3; ++g) x[g] = bf2f(base[(long)j * PITCH + g * 512]);
                float y[3];
#pragma unroll
                for (int g = 0; g < 3; ++g) { y[g] = w[g][0] * xw[g][0] + w[g][1] * xw[g][1] + w[g][2] * xw[g][2] + w[g][3] * x[g]; y[g] = y[g] * sigmoid_f(y[g]); xw[g][0] = xw[g][1]; xw[g][1] = xw[g][2]; xw[g][2] = x[g]; }
                yq[j] = y[0]; yk[j] = y[1]; R[(16 * seg + j) * 256 + c] = y[2] * sc[16 * seg + j];
            }
#pragma unroll
            for (int j = 0; j < 16; ++j) { const float sq = wave_sum(yq[j] * yq[j]), sk = wave_sum(yk[j] * yk[j]); if (lane == 0) { sc[128 + (wave * 16 + j) * 2] = sq; sc[128 + (wave * 16 + j) * 2 + 1] = sk; } }
        }
        __syncthreads();
        {
            const int wp = wave ^ 1;
#pragma unroll
            for (int j = 0; j < 16; ++j) { const int tk = 16 * seg + j;
                const float rq = rsqrtf(sc[128 + (wave * 16 + j) * 2] + sc[128 + (wp * 16 + j) * 2] + RMS_EPS), rk = rsqrtf(sc[128 + (wave * 16 + j) * 2 + 1] + sc[128 + (wp * 16 + j) * 2 + 1] + RMS_EPS);
                const float bt = sc[tk]; Qn[tk * GP_W + c] = (bf16_t)f2bf(yq[j] * rq); Kn[tk * GP_W + c] = (bf16_t)f2bf(yk[j] * rk); R[tk * 256 + 128 + c] = yk[j] * rk * bt * __expf(sc[64 + tk]); }
        }
        __syncthreads();
        {
            const int pq = wave >> 2, ti = (wave >> 1) & 1, tj = wave & 1, r32 = lane & 31, hi = lane >> 5;
            const LAS bf16_t* Ap = (pq ? Qn : Kn) + (32 * ti + r32) * GP_W + 8 * hi; const LAS bf16_t* Bp = Kn + (32 * tj + r32) * GP_W + 8 * hi;
            f32x16 acc = f32x16{};
#pragma unroll
            for (int ks = 0; ks < 8; ++ks) acc = __builtin_amdgcn_mfma_f32_32x32x16_bf16(*(const LAS bf16x8*)(Ap + 16 * ks), *(const LAS bf16x8*)(Bp + 16 * ks), acc, 0, 0, 0);
            asm volatile("s_nop 15\n\ts_nop 15\n\ts_nop 15\n\ts_nop 15" : "+v"(acc));
            const int m = 32 * tj + r32; const float gcm = sc[64 + m];
            bf16_t* gqk = (bf16_t*)(F.ws + WS_GQK) + (size_t)item * (64 * GP_K);
#pragma unroll
            for (int r = 0; r < 16; ++r) { const int cc = 32 * ti + (r & 3) + 8 * (r >> 2) + 4 * hi;
                const float dec = __expf(fminf(sc[64 + cc] - gcm, 0.f));
                if (pq == 0) Lm[cc * 64 + m] = (m < cc) ? sc[cc] * acc[r] * dec : 0.f;
                else gqk[cc * GP_K + P32(m)] = (bf16_t)f2bf((m <= cc) ? 0.08838834764831845f * acc[r] * dec : 0.f); }
        }
        __syncthreads();
        if (wave < 4) {
            float sol[64];
            LAS float* Rc = R + tid; const LAS float* Lv = Lm; asm volatile("" : "+v"(Rc), "+v"(Lv));
#pragma unroll
            for (int i = 0; i < 64; ++i) sol[i] = Rc[i * 256];
            __builtin_amdgcn_sched_barrier(0);
#pragma unroll
            for (int i = 1; i < 64; ++i) {
                float s4[4] = {sol[i], 0.f, 0.f, 0.f};
#pragma unroll
                for (int kb = 0; kb < (i + 3) / 4; ++kb) { const f32x4 l4 = *(const LAS f32x4*)(Lv + i * 64 + 4 * kb);
#pragma unroll
                    for (int u = 0; u < 4; ++u) if (4 * kb + u < i) s4[u] = fmaf(-l4[u], sol[4 * kb + u], s4[u]); }
                const float s = (s4[0] + s4[1]) + (s4[2] + s4[3]);
                sol[i] = s;
                Rc[i * 256] = s;
                __builtin_amdgcn_sched_barrier(0);
            }
        } else {
            const int t2 = tid - 256; const float gl = sc[64 + 63];
            bf16_t* gqd = (bf16_t*)(F.ws + WS_GQD) + (size_t)item * (64 * GP_W); bf16_t* gkd = (bf16_t*)(F.ws + WS_GKD) + (size_t)item * (128 * GP_K);
#pragma unroll 4
            for (int it = 0; it < 32; ++it) { const int e = t2 + 256 * it; const int cc = e >> 7, dk = e & 127; const float gcc = sc[64 + cc];
                gqd[cc * GP_W + P32(dk)] = (bf16_t)f2bf(bf2f(Qn[cc * GP_W + dk]) * 0.08838834764831845f * __expf(gcc));
                gkd[dk * GP_K + P32(cc)] = (bf16_t)f2bf(bf2f(Kn[cc * GP_W + dk]) * __expf(gl - gcc)); }
            if (t2 == 0) ((float*)(F.ws + WS_GL))[item] = __expf(gl);
        }
        __syncthreads();
        {
            f32x4* gu = (f32x4*)((float*)(F.ws + WS_GU) + (size_t)item * 8192);
#pragma unroll
            for (int it = 0; it < 4; ++it) { const int e = tid + NTHR * it; const int ln = e & 63, mt = (e >> 6) & 3, w = e >> 8; const int r = ln & 15, q = ln >> 4; const int dv = 16 * w + r, c0 = 16 * mt + 4 * q;
                gu[e] = (f32x4){R[(c0 + 0) * 256 + dv], R[(c0 + 1) * 256 + dv], R[(c0 + 2) * 256 + dv], R[(c0 + 3) * 256 + dv]}; }
            bf16_t* gw = (bf16_t*)(F.ws + WS_GW) + (size_t)item * (64 * GP_W);
#pragma unroll 4
            for (int it = 0; it < 16; ++it) { const int e = tid + NTHR * it; const int cc = e >> 7, dk = e & 127; gw[cc * GP_W + P32(dk)] = (bf16_t)f2bf(R[cc * 256 + 128 + dk]); }
        }
        __syncthreads();
    }
}

__device__ __forceinline__ void gdn_scan_phase(Frame& F, int li) {
#ifndef MK_SCAN_SPLIT
#define MK_SCAN_SPLIT 2
#endif
    constexpr int NSPLIT = MK_SCAN_SPLIT, NWV = 8 / NSPLIT;
    if (blockIdx.x >= 8 * NSPLIT) return;
    const int bh = blockIdx.x & 7, part = blockIdx.x >> 3, b = bh >> 2, h = bh & 3, lane = F.lane, wave = F.wave, r = lane & 15, q = lane >> 4;
    const bool act = wave < NWV; const int slice = part * NWV + (wave & (NWV - 1));
    const char* const g_w = (const char*)(F.ws + WS_GW); const char* const g_qd = (const char*)(F.ws + WS_GQD); const char* const g_qk = (const char*)(F.ws + WS_GQK); const char* const g_kd = (const char*)(F.ws + WS_GKD);
    const float* gu = (const float*)(F.ws + WS_GU); const float* glp = (const float*)(F.ws + WS_GL); float* go = (float*)(F.ws + WS_GO);
    const unsigned lds0 = (unsigned)(uintptr_t)F.ldsg;
    constexpr int GB_A = 2 * GB_W, GB_B = GB_QK + GB_KD, LB0 = 3 * GB_A;
    static_assert(LB0 + 2 * GB_B <= CTRL_OFF, "scan LDS");
#define GDN_DMA_A(item_, slot_) do { _Pragma("unroll") for (int p_ = 0; p_ < 5; ++p_) { const int p = wave + 8 * p_; if (p < 34) { \
        attn_body::glds16((p < 17 ? g_w : g_qd) + (size_t)(item_) * GB_W + (size_t)(p < 17 ? p : p - 17) * 1024, (unsigned)lane * 16u, (unsigned)__builtin_amdgcn_readfirstlane(lds0 + (slot_) * GB_A + p * 1024)); } } } while (0)
#define GDN_DMA_B(item_, slot_) do { _Pragma("unroll") for (int p_ = 0; p_ < 4; ++p_) { const int p = wave + 8 * p_; if (p < 27) { \
        attn_body::glds16(p < 9 ? g_qk + (size_t)(item_) * GB_QK + (size_t)p * 1024 : g_kd + (size_t)(item_) * GB_KD + (size_t)(p - 9) * 1024, (unsigned)lane * 16u, (unsigned)__builtin_amdgcn_readfirstlane(lds0 + LB0 + (slot_) * GB_B + p * 1024)); } } } while (0)
#define GDN_LDU(dst_, item_) do { _Pragma("unroll") for (int mt = 0; mt < 4; ++mt) dst_[mt] = *(const f32x4*)(gu + (size_t)(item_) * 8192 + ((slice * 4 + mt) * 64 + lane) * 4); } while (0)
#ifndef MK_SCAN_REP
#define MK_SCAN_REP 1
#endif
    const int item0 = bh * 256;
    for (int rep_ = 0; rep_ < MK_SCAN_REP; ++rep_) {
    f32x4 S[8];
#pragma unroll
    for (int m = 0; m < 8; ++m) S[m] = (f32x4){0.f, 0.f, 0.f, 0.f};
    GDN_DMA_A(item0, 0); GDN_DMA_B(item0, 0); GDN_DMA_A(item0 + 1, 1);
    f32x4 Ue[4], Uo[4], Op[4]; float gle = glp[item0], glo = glp[item0 + 1];
    GDN_LDU(Ue, item0); GDN_LDU(Uo, item0 + 1);
#pragma unroll
    for (int mt = 0; mt < 4; ++mt) Op[mt] = (f32x4){0.f, 0.f, 0.f, 0.f};
    int sa = 0;
    auto step = [&](const int n, f32x4 (&U)[4], float& glr) __attribute__((always_inline)) {
        const int item = item0 + n;
        if (n == 0 || n >= 254) asm volatile("s_waitcnt vmcnt(0) lgkmcnt(0)\n\ts_barrier" ::: "memory");
        else if (act && n >= 2) asm volatile("s_waitcnt vmcnt(33) lgkmcnt(0)\n\ts_barrier" ::: "memory");
        else if (act) asm volatile("s_waitcnt vmcnt(17) lgkmcnt(0)\n\ts_barrier" ::: "memory");
        else asm volatile("s_waitcnt vmcnt(7) lgkmcnt(0)\n\ts_barrier" ::: "memory");
        if (act && n > 0) { float* gop = go + ((size_t)b * T + 64 * (n - 1) + 4 * q) * 512 + h * 128 + 16 * slice + r;
#pragma unroll
            for (int mt = 0; mt < 4; ++mt)
#pragma unroll
                for (int i = 0; i < 4; ++i) gop[(size_t)(16 * mt + i) * 512] = Op[mt][i]; }
        if (n + 1 < 256) GDN_DMA_B(item + 1, (n + 1) & 1);
        if (n + 2 < 256) { const int sa2 = sa == 0 ? 2 : sa - 1;
            GDN_DMA_A(item + 2, sa2); }
        const LAS unsigned char* La = F.lds + sa * GB_A; const LAS unsigned char* Lbb = F.lds + LB0 + (n & 1) * GB_B;
        const LAS bf16_t* Wp = (const LAS bf16_t*)La + r * GP_W + 8 * q; const LAS bf16_t* QDp = (const LAS bf16_t*)(La + GB_W) + r * GP_W + 8 * q;
        const LAS bf16_t* QKp = (const LAS bf16_t*)Lbb + r * GP_K + 8 * q; const LAS bf16_t* KDp = (const LAS bf16_t*)(Lbb + GB_QK) + r * GP_K + 8 * q;
        f32x4 O[4]; bf16x8 Vb[2];
        if (act) {
        bf16x8 Sb[4];
#pragma unroll
        for (int ks = 0; ks < 4; ++ks) { u32x4 w; w.x = cvt_pk_bf16(S[2 * ks][0], S[2 * ks][1]); w.y = cvt_pk_bf16(S[2 * ks][2], S[2 * ks][3]); w.z = cvt_pk_bf16(S[2 * ks + 1][0], S[2 * ks + 1][1]); w.w = cvt_pk_bf16(S[2 * ks + 1][2], S[2 * ks + 1][3]); Sb[ks] = __builtin_bit_cast(bf16x8, w); }
        f32x4 ws_[4];
#pragma unroll
        for (int mt = 0; mt < 4; ++mt) { ws_[mt] = (f32x4){0.f, 0.f, 0.f, 0.f}; O[mt] = (f32x4){0.f, 0.f, 0.f, 0.f}; }
        f32x4 Uc[4]; float gl;
#define GDN_UCONS(W_) do { float a0, a1, a2, a3, a4, a5, a6, a7, a8; \
        asm volatile(W_ "\n\tv_mov_b32 %0, %9\n\tv_mov_b32 %1, %10\n\tv_mov_b32 %2, %11\n\tv_mov_b32 %3, %12\n\tv_mov_b32 %4, %13\n\tv_mov_b32 %5, %14\n\tv_mov_b32 %6, %15\n\tv_mov_b32 %7, %16\n\tv_mov_b32 %8, %17" \
            : "=&v"(a0), "=&v"(a1), "=&v"(a2), "=&v"(a3), "=&v"(a4), "=&v"(a5), "=&v"(a6), "=&v"(a7), "=&v"(a8) \
            : "v"(U[0][0]), "v"(U[0][1]), "v"(U[0][2]), "v"(U[0][3]), "v"(U[1][0]), "v"(U[1][1]), "v"(U[1][2]), "v"(U[1][3]), "v"(glr) : "memory"); \
        Uc[0] = (f32x4){a0, a1, a2, a3}; Uc[1] = (f32x4){a4, a5, a6, a7}; gl = a8; \
        asm volatile("v_mov_b32 %0, %8\n\tv_mov_b32 %1, %9\n\tv_mov_b32 %2, %10\n\tv_mov_b32 %3, %11\n\tv_mov_b32 %4, %12\n\tv_mov_b32 %5, %13\n\tv_mov_b32 %6, %14\n\tv_mov_b32 %7, %15" \
            : "=&v"(a0), "=&v"(a1), "=&v"(a2), "=&v"(a3), "=&v"(a4), "=&v"(a5), "=&v"(a6), "=&v"(a7) \
            : "v"(U[2][0]), "v"(U[2][1]), "v"(U[2][2]), "v"(U[2][3]), "v"(U[3][0]), "v"(U[3][1]), "v"(U[3][2]), "v"(U[3][3]) : "memory"); \
        Uc[2] = (f32x4){a0, a1, a2, a3}; Uc[3] = (f32x4){a4, a5, a6, a7}; } while (0)
        if (n < 2 || n >= 254) GDN_UCONS("s_waitcnt vmcnt(0)"); else GDN_UCONS("s_waitcnt vmcnt(51)");
        {
#pragma unroll
        for (int m = 0; m < 8; ++m) S[m] = S[m] * gl; }
#pragma unroll
        for (int ks = 0; ks < 4; ++ks)
#pragma unroll
            for (int mt = 0; mt < 4; ++mt) {
                ws_[mt] = __builtin_amdgcn_mfma_f32_16x16x32_bf16(*(const LAS bf16x8*)(Wp + 16 * mt * GP_W + 32 * ks), Sb[ks], ws_[mt], 0, 0, 0);
                O[mt] = __builtin_amdgcn_mfma_f32_16x16x32_bf16(*(const LAS bf16x8*)(QDp + 16 * mt * GP_W + 32 * ks), Sb[ks], O[mt], 0, 0, 0);
                if (mt == 3) __builtin_amdgcn_sched_barrier(0); }
        asm volatile("s_nop 15\n\ts_nop 15\n\ts_nop 15\n\ts_nop 15" ::: "memory");
#pragma unroll
        for (int kc = 0; kc < 2; ++kc) { const f32x4 v0 = Uc[2 * kc] - ws_[2 * kc], v1 = Uc[2 * kc + 1] - ws_[2 * kc + 1];
            u32x4 w; w.x = cvt_pk_bf16(v0[0], v0[1]); w.y = cvt_pk_bf16(v0[2], v0[3]); w.z = cvt_pk_bf16(v1[0], v1[1]); w.w = cvt_pk_bf16(v1[2], v1[3]); Vb[kc] = __builtin_bit_cast(bf16x8, w); }
        }
        asm volatile("" ::: "memory");
        if (act && n + 2 < 256) {
            const float* up = gu + (size_t)(item + 2) * 8192 + (slice * 256 + lane) * 4; const float* gp = glp + item + 2;
            asm volatile("global_load_dwordx4 %0, %4, off\n\tglobal_load_dwordx4 %1, %4, off offset:1024\n\tglobal_load_dwordx4 %2, %4, off offset:2048\n\tglobal_load_dwordx4 %3, %4, off offset:3072"
                         : "=&v"(U[0]), "=&v"(U[1]), "=&v"(U[2]), "=&v"(U[3]) : "v"(up) : "memory");
            asm volatile("global_load_dword %0, %1, off" : "=&v"(glr) : "v"(gp) : "memory"); }
        if (n >= 254) asm volatile("s_waitcnt vmcnt(0)\n\ts_barrier" ::: "memory");
        else if (act) asm volatile("s_waitcnt vmcnt(37)\n\ts_barrier" ::: "memory");
        else asm volatile("s_waitcnt vmcnt(11)\n\ts_barrier" ::: "memory");
        sa = sa == 2 ? 0 : sa + 1;
        if (!act) return;
#pragma unroll
        for (int kc = 0; kc < 2; ++kc)
#pragma unroll
            for (int mt = 0; mt < 4; ++mt) { O[mt] = __builtin_amdgcn_mfma_f32_16x16x32_bf16(*(const LAS bf16x8*)(QKp + 16 * mt * GP_K + 32 * kc), Vb[kc], O[mt], 0, 0, 0); if (mt == 3) __builtin_amdgcn_sched_barrier(0); }
#pragma unroll
        for (int kc = 0; kc < 2; ++kc)
#pragma unroll
            for (int m = 0; m < 8; ++m) { S[m] = __builtin_amdgcn_mfma_f32_16x16x32_bf16(*(const LAS bf16x8*)(KDp + 16 * m * GP_K + 32 * kc), Vb[kc], S[m], 0, 0, 0); if (m == 7) __builtin_amdgcn_sched_barrier(0); }
#pragma unroll
        for (int mt = 0; mt < 4; ++mt) Op[mt] = O[mt];
    };
    for (int n = 0; n < 256; n += 2) { step(n, Ue, gle); step(n + 1, Uo, glo); }
    if (act) { float* gop = go + ((size_t)b * T + 64 * 255 + 4 * q) * 512 + h * 128 + 16 * slice + r;
#pragma unroll
        for (int mt = 0; mt < 4; ++mt)
#pragma unroll
            for (int i = 0; i < 4; ++i) gop[(size_t)(16 * mt + i) * 512] = Op[mt][i]; }
    asm volatile("s_waitcnt vmcnt(0) lgkmcnt(0)\n\ts_barrier" ::: "memory");
    }
#undef GDN_DMA_A
#undef GDN_DMA_B
#undef GDN_LDU
#undef GDN_UCONS
}
constexpr int N_STEPS = 2 + 2 * (9 + 8);
#ifndef MK_INPROJ_REP
#define MK_INPROJ_REP 1
#endif
#ifndef MK_OUTPROJ_REP
#define MK_OUTPROJ_REP 1
#endif
#ifndef MK_EVEN_MODE
#define MK_EVEN_MODE 2
#endif

__global__ void __launch_bounds__(NTHR, 2) mk(Args a) {
    extern __shared__ __attribute__((aligned(16))) unsigned char lds_raw[];
    volatile LAS unsigned* MISC = (volatile LAS unsigned*)((LAS unsigned char*)lds_raw + MISC_OFF);
    for (int u = threadIdx.x; u < (LDS_BYTES - CTRL_OFF) / 4; u += NTHR) ((LAS unsigned*)((LAS unsigned char*)lds_raw + CTRL_OFF))[u] = 0u;
    __syncthreads();
    gu32* const ctl0 = (gu32*)(a.ws + WS_CTL);
    const int lo = a.lo, hi = a.hi;
    XcdBarrier bar; bar.bar = (unsigned*)(ctl0 + CW_BAR) + a.bar_region * XCD_BAR_WORDS; bar.x = xb_xcc_id(); bar.st = MISC + 8;
    if (hi - lo > 1) bar = xcd_barrier_post((unsigned*)(ctl0 + CW_BAR) + a.bar_region * XCD_BAR_WORDS, MISC + 8);
    const unsigned xcc = bar.x;
    const int cblk = (int)blockIdx.x;
    int step = 0;
#ifndef MK_EN
#define MK_EN 0xFFFF
#endif
#define EN(k) ((MK_EN >> (k)) & 1)
#if defined(MK_TIMING)
#define MK_STAMP() do { if (blockIdx.x == 0 && threadIdx.x == 0) ((unsigned long long*)(ctl0 + 65536))[step] = __builtin_amdgcn_s_memrealtime(); } while (0)
#else
#define MK_STAMP() do { } while (0)
#endif
#define PHASE_BEGIN if (step >= lo && step < hi) { MK_STAMP(); Frame F; { int tid_ = threadIdx.x; GAS unsigned char* wsg_ = (GAS unsigned char*)a.ws; asm volatile("" : "+v"(tid_), "+s"(wsg_)); unsigned char* ws_ = (unsigned char*)wsg_;     \
        F.lds = (LAS unsigned char*)lds_raw; F.ldsg = (char*)lds_raw; F.tid = tid_; F.lane = tid_ & 63; F.wave = __builtin_amdgcn_readfirstlane(tid_ >> 6); \
        F.G = gridDim.x; F.gw = blockIdx.x * NWAVES + F.wave; F.NGW = F.G * NWAVES; F.ws = ws_; F.ctl = (gu32*)(ws_ + WS_CTL); F.out = a.out; }
#ifdef MK_BAR2
#define PHASE_END   if (step + 1 < hi) { xcd_barrier(bar); xcd_barrier(bar); xcd_barrier(bar); } } ++step;
#else
#define PHASE_END   if (step + 1 < hi) xcd_barrier(bar); } ++step;
#endif
#ifndef MK_TWICE
#define MK_TWICE -1
#endif
#define REPEAT(k) for (int rep_ = 0; rep_ < (MK_TWICE == (k) ? 2 : 1); ++rep_)
#define REPBAR() do { if (rep_) xcd_barrier(bar); } while (0)

    PHASE_BEGIN if (EN(0)) REPEAT(0) { REPBAR(); p0a_convert(F); } PHASE_END
    PHASE_BEGIN if (EN(1)) {
        if (a.dbg_src) {
            const bool ne = (a.dbg_layer0 & 1) == 0; const int ni = a.dbg_layer0 >> 1;
            const bf16_t* sw = ne ? (const bf16_t*)(F.ws + WS_SWE) + (size_t)ni * 2 * 16 * 1024 : (const bf16_t*)(F.ws + WS_SWO) + (size_t)ni * 2 * 16 * 1024;
            Ln16 P{a.dbg_src, nullptr, nullptr, (float*)(F.ws + WS_X), (bf16_t*)(F.ws + WS_XB), nullptr, nullptr, sw, sw + 16 * 1024, 1.f};
            const int pos[4] = {0, 0, 0, 0}; const float gt[4] = {0.f, 0.f, 0.f, 0.f};
            for (int tile = F.gw; tile < NTOK / 16; tile += F.NGW) { f32x4 acc[1]; ln16_tile<0, 1, true>(P, tile, F.lane, pos, gt, acc); smallproj_store(F, acc[0], tile, ne, INP(13) + ni * 16); }
        } else p0b_input(F); }
    PHASE_END

    for (int layer = 0; layer < 4; ++layer) {
        const int li = layer >> 1; const bool even = (layer & 1) == 0;
        if (layer < a.dbg_layer0) { step += even ? 9 : 8; continue; }
        PHASE_BEGIN if (EN(2)) REPEAT(2) { REPBAR();
            const int N = even ? 3584 : 4096;
            pg8::DenseOrder S{(const char*)(F.ws + WS_XB), even ? (const char*)(F.ws + WS_WINE) + (size_t)li * 3584 * D * 2 : (const char*)(F.ws + WS_WINO) + (size_t)li * 4096 * D * 2, D, NTOK / 256, N / 256, (NTOK / 256) * (N / 256), F.G, cblk, MK_INPROJ_REP};
            pg8::EpiProj E{(bf16_t*)(F.ws + WS_PROJ), PITCH, even ? 512 : 0, C2};
            pg8::gemm_phase<pg8::EpiProj, pg8::DenseOrder, false>(F.lds, D, S, E, F.tid);
        } PHASE_END
        if (even) {
            PHASE_BEGIN if (EN(3)) REPEAT(3) { REPBAR(); gdn_prep_phase(F, li); } PHASE_END
            PHASE_BEGIN if (EN(4)) REPEAT(4) { REPBAR();
                if (EN(12)) gdn_scan_phase(F, li);
                attn_body::AttnP P{(const bf16_t*)(F.ws + WS_PROJ), (bf16_t*)(F.ws + WS_ATT), (const float*)(F.ws + WS_T5), nullptr, nullptr, 0.f};
                attn_body::attn_phase<MK_EVEN_MODE>(F.ldsg, P, (unsigned*)(F.ctl + CW_QUEUE + (layer + 4 * rep_) * 8 * 64), xcc, F.tid);
            } PHASE_END
            PHASE_BEGIN if (EN(5)) REPEAT(5) even_combine_phase(F, li, 0.8f - 0.6f * __expf(-0.3f * (float)layer)); PHASE_END
        } else {
            PHASE_BEGIN if (EN(6)) odd_prep_phase(F, li); PHASE_END
            PHASE_BEGIN if (EN(7)) REPEAT(7) { REPBAR();
                float mq, mk; { const float* nw = INP(12) + li * 128; mq = fabsf(nw[F.lane]); mk = fabsf(nw[64 + F.lane]);
#pragma unroll
                    for (int o = 1; o < 64; o <<= 1) { mq = fmaxf(mq, __shfl_xor(mq, o)); mk = fmaxf(mk, __shfl_xor(mk, o)); } }
                const float xb = 64.f * mq * mk * C2 * 1.05f;
                attn_body::AttnP P{(const bf16_t*)(F.ws + WS_PROJ), (bf16_t*)(F.ws + WS_MIX), nullptr, (const float*)(F.ws + WS_CUM), (const bf16_t*)(F.ws + WS_KB8), 2.f * xb + 54.f};
                attn_body::attn_phase<1>(F.ldsg, P, (unsigned*)(F.ctl + CW_QUEUE + (layer + 4 * rep_) * 8 * 64), xcc, F.tid);
            } PHASE_END
        }
        PHASE_BEGIN if (EN(8)) REPEAT(8) { REPBAR();
            pg8::DenseOrder S{(const char*)(F.ws + WS_MIX), even ? (const char*)(F.ws + WS_WOUTE) + (size_t)li * D * D * 2 : (const char*)(F.ws + WS_WOUTO) + (size_t)li * D * D * 2, D, NTOK / 256, D / 256, (NTOK / 256) * (D / 256), F.G, cblk, MK_OUTPROJ_REP};
            pg8::EpiProj E{(bf16_t*)(F.ws + WS_H), D, 0, 1.f};
            pg8::gemm_phase<pg8::EpiProj, pg8::DenseOrder, false>(F.lds, D, S, E, F.tid);
        } PHASE_END
        PHASE_BEGIN if (EN(9)) ln_router_phase(F, layer); PHASE_END
        PHASE_BEGIN if (EN(10)) REPEAT(10) { REPBAR();
            moe_tables(F, layer);
            pg8::MoeOrder S{(const char*)(F.ws + WS_XB), (const char*)(F.ws + WS_WGU) + (size_t)layer * NE * 2048 * D * 2, (const int*)(F.ws + WS_LIST), (const LAS int*)(F.lds + CTRL_OFF), (const LAS int*)(F.lds + CTRL_OFF) + 32,
                            8, (size_t)2048 * D * 2, D, true, F.G, cblk};
            pg8::EpiSwiglu E{(bf16_t*)(F.ws + WS_ACT), INP(17) + (size_t)layer * NE * 2048};
            pg8::gemm_phase<pg8::EpiSwiglu, pg8::MoeOrder, true>(F.lds, D, S, E, F.tid);
        } PHASE_END
        PHASE_BEGIN if (EN(11)) REPEAT(11) { REPBAR();
            moe_tables(F, layer);
            pg8::MoeOrder S{(const char*)(F.ws + WS_ACT), (const char*)(F.ws + WS_WD) + (size_t)layer * NE * D * DFF * 2, nullptr, (const LAS int*)(F.lds + CTRL_OFF), (const LAS int*)(F.lds + CTRL_OFF) + 32,
                            4, (size_t)D * DFF * 2, DFF, false, F.G, cblk};
            pg8::EpiDown E{(bf16_t*)(F.ws + WS_Y), INP(19) + (size_t)layer * NE * D};
            pg8::gemm_phase<pg8::EpiDown, pg8::MoeOrder, false>(F.lds, DFF, S, E, F.tid);
        } PHASE_END
        PHASE_BEGIN if (EN(13)) { moe_tables(F, layer); moe_out_phase(F, layer); } PHASE_END
    }
#undef PHASE_BEGIN
#undef PHASE_END
}
}

#if MK_DEBUG
namespace dbg {
template <class TA, class TB> __device__ __forceinline__ float ldv(const TA* p);
__device__ __forceinline__ float ldf(const float* p) { return *p; }
__device__ __forceinline__ float ldf(const unsigned short* p) { return __builtin_bit_cast(float, (unsigned)*p << 16); }
template <class TA, class TB>
__global__ void cmp(const TA* a, long lda, const TB* b, long ldb, int rows, int cols, float bscale, double* acc) {
    double e = 0.0, n = 0.0;
    for (long i = (long)blockIdx.x * blockDim.x + threadIdx.x; i < (long)rows * cols; i += (long)gridDim.x * blockDim.x) {
        const long r = i / cols, c = i % cols; const float x = ldf(a + r * lda + c), y = ldf(b + r * ldb + c) * bscale;
        e += (double)(x - y) * (x - y); n += (double)x * x; }
    for (int o = 32; o > 0; o >>= 1) { e += __shfl_xor(e, o); n += __shfl_xor(n, o); }
    if ((threadIdx.x & 63) == 0) { atomicAdd(acc, e); atomicAdd(acc + 1, n); }
}
__global__ void finish(float* out, const float* ref, const double* acc, int nchk, float thr, int which, long n) {
    float code = 0.f;
    if (which >= 0) { code = (float)sqrt(acc[2 * which] / (acc[2 * which + 1] + 1e-300)); if (!(code == code)) code = 3.f; if (code > 3.f) code = 3.f; }
    else { for (int k = 0; k < nchk; ++k) { const double e = acc[2 * k] / (acc[2 * k + 1] + 1e-300); if (!(e <= (double)thr)) { code = 0.1f * (k + 1); break; } } }
    for (long i = (long)blockIdx.x * blockDim.x + threadIdx.x; i < n; i += (long)gridDim.x * blockDim.x) out[i] = ref[i] * (1.f + code);
}
__global__ void csum(const unsigned* p, size_t nwords, unsigned long long* out, size_t colw, size_t pitchw) {
    unsigned long long s = 0;
    for (size_t i = (size_t)blockIdx.x * blockDim.x + threadIdx.x; i < nwords; i += (size_t)gridDim.x * blockDim.x) s += p[(i / colw) * pitchw + (i % colw)];
    for (int o = 32; o > 0; o >>= 1) s += __shfl_xor(s, o);
    if ((threadIdx.x & 63) == 0) atomicAdd(out, s);
}
__global__ void finish2(float* out, const float* ref, const unsigned long long* cs, int n, int nrun, long nel) {
    float code = 0.f;
#ifndef MK_DBG_ONLY
#define MK_DBG_ONLY -1
#endif
#ifndef MK_DBG_ANY
#define MK_DBG_ANY 0
#endif
    for (int k = 0; k < n && code == 0.f; ++k) for (int r = 1; r < nrun; ++r) if ((MK_DBG_ONLY < 0 || k == MK_DBG_ONLY) && cs[k] != cs[16 * r + k]) { code = MK_DBG_ANY ? 0.5f : 0.1f * (k + 1); break; }
    for (long i = (long)blockIdx.x * blockDim.x + threadIdx.x; i < nel; i += (long)gridDim.x * blockDim.x) out[i] = ref[i] * (1.f + code);
}
__global__ void attdiff(const unsigned short* a, const unsigned short* b, unsigned* stat, int mode) {
    const int u = blockIdx.x, bvh = u >> 6, qb = u & 63, bb = bvh >> 4, vh = bvh & 15;
    int ocol; if (mode == 0) { const int h = vh >> 2, m = (vh >> 1) & 1, half = vh & 1; ocol = (h * 2 + m) * 128 + half * 64; } else ocol = vh * 64;
    __shared__ int any; if (threadIdx.x == 0) any = 0; __syncthreads();
    const size_t row = (size_t)bb * T + qb * 256 + threadIdx.x; int df = 0;
    for (int c = 0; c < 64; ++c) df |= a[row * D + ocol + c] != b[row * D + ocol + c];
    if (df) any = 1; __syncthreads();
    if (threadIdx.x == 0 && any) { atomicAdd(stat, 1u); if (qb < 8) atomicAdd(stat + 1, 1u); if (vh < 8) atomicAdd(stat + 2, 1u); if (qb <= 6) atomicAdd(stat + 3, 1u); if (qb == 7) atomicAdd(stat + 4, 1u); if (qb == 0) atomicAdd(stat + 5, 1u); }
    if (df) { atomicAdd(stat + 6, 1u); if (threadIdx.x < 32) atomicAdd(stat + 7, 1u); }
}
__global__ void finish3(float* out, const float* ref, const unsigned* stat, int which, float denom, long nel) {
    float code = 0.f; { unsigned c = stat[which]; if (denom > 0.f) code = (float)(c / 8) * 8.f / denom; else { int lg = 0; while (c) { ++lg; c >>= 1; } code = 0.1f * (float)lg; } }
    for (long i = (long)blockIdx.x * blockDim.x + threadIdx.x; i < nel; i += (long)gridDim.x * blockDim.x) out[i] = ref[i] * (1.f + code);
}
__global__ void finish4(float* out, const float* ref, const double* acc, long nel) {
    const double e = acc[0] / (acc[1] + 1e-300); float code = e > 0 ? 0.1f * (float)floor(-log10(e)) : 2.f; if (code < 0.f) code = 0.f;
    for (long i = (long)blockIdx.x * blockDim.x + threadIdx.x; i < nel; i += (long)gridDim.x * blockDim.x) out[i] = ref[i] * (1.f + code);
}
__global__ void att2out(float* out, const unsigned short* att, int qlo, int qhi) {
    for (long i = (long)blockIdx.x * blockDim.x + threadIdx.x; i < (long)NTOK * D; i += (long)gridDim.x * blockDim.x) {
        const int row = (int)(i >> 10), qb = (row % T) >> 8; out[i] = (qb >= qlo && qb <= qhi) ? __builtin_bit_cast(float, (unsigned)att[i] << 16) : 0.f; }
}
__global__ void countpoison(const unsigned short* a, size_t n, unsigned* stat) {
    unsigned c = 0;
    for (size_t i = (size_t)blockIdx.x * blockDim.x + threadIdx.x; i < n; i += (size_t)gridDim.x * blockDim.x) c += a[i] == 0xFFFFu;
    for (int o = 32; o > 0; o >>= 1) c += __shfl_xor(c, o);
    if ((threadIdx.x & 63) == 0 && c) atomicAdd(stat, c);
}
__global__ void bf16n(float* out, const unsigned short* src, long n) { for (long i = (long)blockIdx.x * blockDim.x + threadIdx.x; i < (long)NTOK * D; i += (long)gridDim.x * blockDim.x) out[i] = i < n ? __builtin_bit_cast(float, (unsigned)src[i] << 16) : 0.f; }
__global__ void f32half(float* out, const float* src) { for (long i = (long)blockIdx.x * blockDim.x + threadIdx.x; i < (long)NTOK * D; i += (long)gridDim.x * blockDim.x) out[i] = i < (long)NTOK * 512 ? src[i] : 0.f; }
__global__ void f32out(float* out, const float* src) { for (long i = (long)blockIdx.x * blockDim.x + threadIdx.x; i < (long)NTOK * D; i += (long)gridDim.x * blockDim.x) out[i] = src[i]; }
}
#endif
#ifndef MK_SINGLE
#define MK_SINGLE 0
#endif
static int mk_grid_init() {
    static int grid = 0;
    if (grid == 0) {
        int dev = 0, cus = 0;
        if (hipGetDevice(&dev) != hipSuccess || hipDeviceGetAttribute(&cus, hipDeviceAttributeMultiprocessorCount, dev) != hipSuccess) { grid = -1; return grid; }
        if (hipFuncSetAttribute((const void*)fk::mk, hipFuncAttributeMaxDynamicSharedMemorySize, fk::LDS_BYTES) != hipSuccess) { fprintf(stderr, "kernel_launch: hipFuncSetAttribute failed\n"); grid = -1; return grid; }
        int per_cu = 0;
        if (hipOccupancyMaxActiveBlocksPerMultiprocessor(&per_cu, (const void*)fk::mk, fk::NTHR, fk::LDS_BYTES) != hipSuccess || per_cu < 1) fprintf(stderr, "kernel_launch: occupancy query reports %d\n", per_cu);
        (void)hipGetLastError();
        grid = cus;
    }
    return grid;
}
static void fast_forward(void* const* d_in, float* out, unsigned char* ws, hipStream_t stream, int step_lo, int step_hi, bool single, const float* dbg_src, int dbg_layer0) {
    const int grid = mk_grid_init(); if (grid <= 0) return;
    fk::Args a{};
    for (int i = 0; i < 24; ++i) a.in[i] = (const float*)d_in[i];
    a.out = out; a.ws = ws; a.dbg_src = dbg_src; a.dbg_layer0 = dbg_layer0; a.bar_region = 0;
    if (single) { a.lo = step_lo; a.hi = step_hi; hipLaunchKernelGGL(fk::mk, dim3(grid), dim3(fk::NTHR), fk::LDS_BYTES, stream, a); }
    else for (int s = step_lo; s < step_hi; ++s) { a.lo = s; a.hi = s + 1; hipLaunchKernelGGL(fk::mk, dim3(grid), dim3(fk::NTHR), fk::LDS_BYTES, stream, a); }
}

#ifndef MK_DEBUG
#define MK_DEBUG 0
#endif
#if MK_DEBUG
#ifndef MK_DBG_CFG
#define MK_DBG_CFG 1
#endif
#ifndef MK_DBG_DENOM
#define MK_DBG_DENOM 0.f
#endif
#ifndef MK_DBG_WHICH
#define MK_DBG_WHICH -1
#endif
#endif

extern "C" void kernel_launch(void* const* d_in, const int* in_sizes, int n_in, void* d_out, int out_size, void* d_ws, size_t ws_size, hipStream_t stream) {
    if (n_in != 24 || ws_size < fk::WS_FAST_END) { fprintf(stderr, "kernel_launch: unexpected n_in %d / ws %zu\n", n_in, ws_size); return; }
    unsigned char* ws = (unsigned char*)d_ws;
#if MK_DEBUG
    using namespace nv;
    constexpr size_t MiB = 1u << 20; unsigned char* keep = ws + 2400 * MiB;
    float* nout = (float*)(keep + 1536 * MiB); double* acc = (double*)(keep + 1664 * MiB);
    In in; for (int i = 0; i < 24; ++i) in.p[i] = (const float*)d_in[i];
    const float C2 = fk::C2;
#if MK_DBG_CFG == 1
    Save sv[] = {{0, ST_PROJ, keep}, {0, ST_ATT, keep + 512 * MiB}};
    forward(in, ws, nout, sv, 2, stream);
    (void)hipMemsetAsync(ws + fk::WS_CTL, 0, fk::CTL_BYTES, stream); (void)hipMemsetAsync(acc, 0, 1024, stream);
    fast_forward(d_in, (float*)d_out, ws, stream, 0, 5, false, nullptr, 0);
    const float* nproj = (const float*)keep; const unsigned short* fproj = (const unsigned short*)(ws + fk::WS_PROJ);
    dbg::cmp<float, unsigned short><<<1024, 256, 0, stream>>>(nproj, EVEN_IN, fproj, fk::PITCH, NTOK, 512, 1.f / C2, acc + 0);
    dbg::cmp<float, unsigned short><<<1024, 256, 0, stream>>>(nproj + 512, EVEN_IN, fproj + 512, fk::PITCH, NTOK, 3072, 1.f, acc + 2);
    dbg::cmp<float, float><<<1024, 256, 0, stream>>>(nproj + 3584, EVEN_IN, (const float*)(ws + fk::WS_PB), 16, NTOK, 8, 1.f, acc + 4);
    dbg::cmp<float, unsigned short><<<1024, 256, 0, stream>>>((const float*)(keep + 512 * MiB), D, (const unsigned short*)(ws + fk::WS_ATT), D, NTOK, D, 1.f, acc + 6);
    const int nchk = 4;
#elif MK_DBG_CFG == 2
    Save sv[] = {{0, ST_XOUT, keep}, {1, ST_PROJ, keep + 128 * MiB}, {1, ST_CUM, keep + 648 * MiB}, {1, ST_MIX, keep + 656 * MiB}, {1, ST_H, keep + 784 * MiB}, {1, ST_XMIX, keep + 912 * MiB}, {1, ST_XOUT, keep + 1040 * MiB}};
    forward(in, ws, nout, sv, 7, stream);
    (void)hipMemsetAsync(ws + fk::WS_CTL, 0, fk::CTL_BYTES, stream); (void)hipMemsetAsync(acc, 0, 1024, stream);
    fast_forward(d_in, (float*)d_out, ws, stream, 0, 2, false, (const float*)keep, 1);
    const int s0 = 2 + 9;
    const float* nproj = (const float*)(keep + 128 * MiB); const unsigned short* fproj = (const unsigned short*)(ws + fk::WS_PROJ);
    fast_forward(d_in, (float*)d_out, ws, stream, s0, s0 + 2, false, (const float*)keep, 1);
    dbg::cmp<float, unsigned short><<<1024, 256, 0, stream>>>(nproj, ODD_IN, fproj, fk::PITCH, NTOK, 1024, 1.f / C2, acc + 0);
    dbg::cmp<float, unsigned short><<<1024, 256, 0, stream>>>(nproj + 1024, ODD_IN, fproj + 1024, fk::PITCH, NTOK, 3072, 1.f, acc + 2);
    dbg::cmp<float, float><<<1024, 256, 0, stream>>>((const float*)(keep + 648 * MiB), T, (const float*)(ws + fk::WS_CUM), T, 32, T, 1.f / fk::LOG2E, acc + 4);
    fast_forward(d_in, (float*)d_out, ws, stream, s0 + 2, s0 + 3, false, (const float*)keep, 1);
    dbg::cmp<float, unsigned short><<<1024, 256, 0, stream>>>((const float*)(keep + 656 * MiB), D, (const unsigned short*)(ws + fk::WS_MIX), D, NTOK, D, 1.f, acc + 6);
    fast_forward(d_in, (float*)d_out, ws, stream, s0 + 3, s0 + 4, false, (const float*)keep, 1);
    dbg::cmp<float, float><<<1024, 256, 0, stream>>>((const float*)(keep + 784 * MiB), D, (const float*)(ws + fk::WS_H), D, NTOK, D, 1.f, acc + 8);
    fast_forward(d_in, (float*)d_out, ws, stream, s0 + 4, s0 + 5, false, (const float*)keep, 1);
    dbg::cmp<float, float><<<1024, 256, 0, stream>>>((const float*)(keep + 912 * MiB), D, (const float*)(ws + fk::WS_X), D, NTOK, D, 1.f, acc + 10);
    fast_forward(d_in, (float*)d_out, ws, stream, s0 + 5, s0 + 8, false, (const float*)keep, 1);
    dbg::cmp<float, float><<<1024, 256, 0, stream>>>((const float*)(keep + 1040 * MiB), D, (const float*)(ws + fk::WS_X), D, NTOK, D, 1.f, acc + 12);
    const int nchk = 7;
#elif MK_DBG_CFG == 3
    Save sv[] = {{0, ST_ATT, keep}, {0, ST_GO, keep + 128 * MiB}, {0, ST_MIX, keep + 192 * MiB}, {0, ST_H, keep + 320 * MiB}, {0, ST_XMIX, keep + 448 * MiB}, {0, ST_XOUT, keep + 576 * MiB}};
    forward(in, ws, nout, sv, 6, stream);
    (void)hipMemsetAsync(ws + fk::WS_CTL, 0, fk::CTL_BYTES, stream); (void)hipMemsetAsync(acc, 0, 1024, stream);
    fast_forward(d_in, (float*)d_out, ws, stream, 0, 5, false, nullptr, 0);
    dbg::cmp<float, unsigned short><<<1024, 256, 0, stream>>>((const float*)keep, D, (const unsigned short*)(ws + fk::WS_ATT), D, NTOK, D, 1.f, acc + 0);
    dbg::cmp<float, float><<<1024, 256, 0, stream>>>((const float*)(keep + 128 * MiB), 512, (const float*)(ws + fk::WS_GO), 512, NTOK, 512, 1.f, acc + 2);
    fast_forward(d_in, (float*)d_out, ws, stream, 5, 6, false, nullptr, 0);
    dbg::cmp<float, unsigned short><<<1024, 256, 0, stream>>>((const float*)(keep + 192 * MiB), D, (const unsigned short*)(ws + fk::WS_MIX), D, NTOK, D, 1.f, acc + 4);
    fast_forward(d_in, (float*)d_out, ws, stream, 6, 7, false, nullptr, 0);
    dbg::cmp<float, float><<<1024, 256, 0, stream>>>((const float*)(keep + 320 * MiB), D, (const float*)(ws + fk::WS_H), D, NTOK, D, 1.f, acc + 6);
    fast_forward(d_in, (float*)d_out, ws, stream, 7, 8, false, nullptr, 0);
    dbg::cmp<float, float><<<1024, 256, 0, stream>>>((const float*)(keep + 448 * MiB), D, (const float*)(ws + fk::WS_X), D, NTOK, D, 1.f, acc + 8);
    fast_forward(d_in, (float*)d_out, ws, stream, 8, 11, false, nullptr, 0);
    dbg::cmp<float, float><<<1024, 256, 0, stream>>>((const float*)(keep + 576 * MiB), D, (const float*)(ws + fk::WS_X), D, NTOK, D, 1.f, acc + 10);
    const int nchk = 6;
#elif MK_DBG_CFG == 6
#ifndef MK_QLO
#define MK_QLO 0
#define MK_QHI 63
#endif
    (void)hipMemsetAsync(ws + fk::WS_CTL, 0, fk::CTL_BYTES, stream);
    (void)hipMemsetAsync(ws + fk::WS_GW, 0, fk::WS_GU - fk::WS_GW, stream);
#ifndef MK_NSTEP
#define MK_NSTEP 5
#endif
    fast_forward(d_in, (float*)(ws + 2400 * MiB), ws, stream, 0, MK_NSTEP, false, nullptr, 0);
#ifndef MK_OUTBUF
#define MK_OUTBUF 0
#endif
    if (MK_OUTBUF == 0) dbg::att2out<<<1024, 256, 0, stream>>>((float*)d_out, (const unsigned short*)(ws + fk::WS_ATT), MK_QLO, MK_QHI);
    else if (MK_OUTBUF == 1) dbg::f32out<<<1024, 256, 0, stream>>>((float*)d_out, (const float*)(ws + fk::WS_X));
    else if (MK_OUTBUF == 2) dbg::att2out<<<1024, 256, 0, stream>>>((float*)d_out, (const unsigned short*)(ws + fk::WS_MIX), 0, 63);
    else if (MK_OUTBUF == 8) dbg::bf16n<<<1024, 256, 0, stream>>>((float*)d_out, (const unsigned short*)(ws + fk::WS_GW), 2048L * 64 * 136);
    else if (MK_OUTBUF == 9) dbg::bf16n<<<1024, 256, 0, stream>>>((float*)d_out, (const unsigned short*)(ws + fk::WS_GQD), 2048L * 64 * 136);
    else if (MK_OUTBUF == 10) dbg::bf16n<<<1024, 256, 0, stream>>>((float*)d_out, (const unsigned short*)(ws + fk::WS_GQK), 2048L * 64 * 72);
    else if (MK_OUTBUF == 11) dbg::bf16n<<<1024, 256, 0, stream>>>((float*)d_out, (const unsigned short*)(ws + fk::WS_GKD), 2048L * 128 * 72);
    else if (MK_OUTBUF == 6) dbg::att2out<<<1024, 256, 0, stream>>>((float*)d_out, (const unsigned short*)(ws + fk::WS_GW), 0, 63);
    else if (MK_OUTBUF == 7) dbg::att2out<<<1024, 256, 0, stream>>>((float*)d_out, (const unsigned short*)(ws + fk::WS_GQK), 0, 63);
    else if (MK_OUTBUF == 4) dbg::f32half<<<1024, 256, 0, stream>>>((float*)d_out, (const float*)(ws + fk::WS_GO));
    else if (MK_OUTBUF == 5) dbg::f32half<<<1024, 256, 0, stream>>>((float*)d_out, (const float*)(ws + fk::WS_GU));
    else dbg::f32out<<<1024, 256, 0, stream>>>((float*)d_out, (const float*)(ws + fk::WS_H));
    (void)nout; (void)acc; (void)in; (void)C2;
    const int nchk = 0; if (nchk == 0) return;
#elif MK_DBG_CFG == 7
    forward(in, ws, nout, nullptr, 0, stream);
    float* fout = (float*)(keep + 1024 * MiB); unsigned* stat = (unsigned*)acc; (void)hipMemsetAsync(stat, 0, 64, stream);
    (void)hipMemsetAsync(ws + fk::WS_CTL, 0, fk::CTL_BYTES, stream);
    (void)hipMemsetAsync(ws + fk::WS_ATT, 0xFF, (size_t)64 * MiB, stream);
    fast_forward(d_in, fout, ws, stream, 0, 5, false, nullptr, 0);
    dbg::countpoison<<<1024, 256, 0, stream>>>((const unsigned short*)(ws + fk::WS_ATT), (size_t)NTOK * D, stat);
    dbg::finish3<<<1024, 256, 0, stream>>>((float*)d_out, nout, stat, 0, 0.f, (long)NTOK * D);
    const int nchk = 0; if (nchk == 0) return;
#elif MK_DBG_CFG == 5
    forward(in, ws, nout, nullptr, 0, stream);
    float* fout = (float*)(keep + 1024 * MiB); unsigned* stat = (unsigned*)acc; (void)hipMemsetAsync(stat, 0, 64, stream);
    for (int run = 0; run < 2; ++run) {
        (void)hipMemsetAsync(ws + fk::WS_CTL, 0, fk::CTL_BYTES, stream);
        fast_forward(d_in, fout, ws, stream, 0, 5, false, nullptr, 0);
        if (run == 0) (void)hipMemcpyAsync(keep, ws + fk::WS_ATT, (size_t)64 * MiB, hipMemcpyDeviceToDevice, stream);
    }
    dbg::attdiff<<<2048, 256, 0, stream>>>((const unsigned short*)keep, (const unsigned short*)(ws + fk::WS_ATT), stat, 0);
#if MK_DBG_WHICH == 9
    (void)hipMemsetAsync(acc + 16, 0, 64, stream);
    dbg::cmp<unsigned short, unsigned short><<<1024, 256, 0, stream>>>((const unsigned short*)keep, D, (const unsigned short*)(ws + fk::WS_ATT), D, NTOK, D, 1.f, acc + 16);
    dbg::finish4<<<1024, 256, 0, stream>>>((float*)d_out, nout, acc + 16, (long)NTOK * D);
#else
    dbg::finish3<<<1024, 256, 0, stream>>>((float*)d_out, nout, stat, MK_DBG_WHICH < 0 ? 0 : MK_DBG_WHICH, MK_DBG_DENOM, (long)NTOK * D);
#endif
    const int nchk = 0; if (nchk == 0) return;
#elif MK_DBG_CFG == 4
    forward(in, ws, nout, nullptr, 0, stream);
    float* fout = (float*)(keep + 1024 * MiB);
    unsigned long long* cs = (unsigned long long*)acc; (void)hipMemsetAsync(cs, 0, 4096, stream);
#ifndef MK_DBG_S0
#define MK_DBG_S0 0
#endif
#ifndef MK_DBG_NS
#define MK_DBG_NS 9
#endif
    int nslot = 0;
#ifndef MK_NRUN
#define MK_NRUN 2
#endif
    for (int run = 0; run < MK_NRUN; ++run) {
        (void)hipMemsetAsync(ws + fk::WS_CTL, 0, fk::CTL_BYTES, stream);
        int slot = 0;
        auto CS2 = [&](size_t off, size_t rows, size_t colw, size_t pitchw) { if (slot >= MK_DBG_S0 && slot < MK_DBG_S0 + MK_DBG_NS) dbg::csum<<<1024, 256, 0, stream>>>((const unsigned*)(ws + off), rows * colw, cs + 16 * run + (slot - MK_DBG_S0), colw, pitchw); ++slot; };
        auto CS = [&](size_t off, size_t bytes) { CS2(off, 1, bytes / 4, bytes / 4); };
        int st = 0;
        auto RUN = [&](int n) { fast_forward(d_in, fout, ws, stream, st, st + n, false, nullptr, 0); st += n; };
        RUN(1); CS(fk::WS_WINE, fk::WS_X - fk::WS_WINE);
        RUN(1); CS(fk::WS_X, (size_t)192 * MiB); CS(fk::WS_PB, 2 * MiB);
        for (int layer = 0; layer < 4; ++layer) {
            RUN(1); CS2(fk::WS_PROJ, NTOK, (layer & 1) ? 2048 : 1792, 2048);
            if ((layer & 1) == 0) { RUN(1); CS(fk::WS_GU, (size_t)64 * MiB); CS(fk::WS_GL, 8192); CS2(fk::WS_GW, 2048 * 64, 64, 68); CS2(fk::WS_GQD, 2048 * 64, 64, 68); CS2(fk::WS_GQK, 2048 * 64, 32, 36); CS2(fk::WS_GKD, 2048 * 128, 32, 36); RUN(1); CS(fk::WS_ATT, (size_t)64 * MiB); CS(fk::WS_GO, (size_t)64 * MiB); RUN(1); CS(fk::WS_MIX, (size_t)64 * MiB); }
            else { RUN(1); CS2(fk::WS_PROJ, NTOK, 2048, 2048); CS(fk::WS_CUM, 2 * MiB); CS(fk::WS_KB8, 8 * MiB); RUN(1); CS(fk::WS_MIX, (size_t)64 * MiB); }
            RUN(1); CS(fk::WS_H, (size_t)128 * MiB);
            RUN(1); CS(fk::WS_X, (size_t)192 * MiB); CS(fk::WS_SELE, 512 * 1024); CS(fk::WS_GATE, 512 * 1024);
            RUN(3); if (layer < 3) CS(fk::WS_X, (size_t)192 * MiB);
        }
        nslot = slot;
    }
    (void)nslot;
    dbg::finish2<<<1024, 256, 0, stream>>>((float*)d_out, nout, cs, 9, MK_NRUN, (long)NTOK * D);
    const int nchk = 0; if (nchk == 0) return;
#endif
    dbg::finish<<<1024, 256, 0, stream>>>((float*)d_out, nout, acc, nchk, 1e-3f, MK_DBG_WHICH, (long)NTOK * D);
#else
    (void)hipMemsetAsync(ws + fk::WS_CTL, 0, fk::CTL_BYTES, stream);
    fast_forward(d_in, (float*)d_out, ws, stream, 0, fk::N_STEPS, MK_SINGLE != 0, nullptr, 0);
#endif
}
```

```cpp
#define MK_SINGLE 1
#ifndef MK_DEBUG
#define MK_DEBUG 0
#endif
#include <hip/hip_runtime.h>
#include <cstdint>
#include <cstdio>

namespace cfg {
constexpr int B = 2, T = 16384, D = 1024, NTOK = B * T;
constexpr int EVEN_IN = 3592, ODD_IN = 4112;
constexpr int NE = 32, TOPK = 4, DFF = 1024;
constexpr float ALPHA = 1.681792830507429f;
constexpr float LN_EPS = 1e-5f, RMS_EPS = 1e-6f;
}
using namespace cfg;

#if MK_DEBUG
namespace nv {

__device__ __forceinline__ float sigmoidf_(float x) { return 1.f / (1.f + __expf(-x)); }
__device__ __forceinline__ float softplusf_(float x) { return x > 20.f ? x : log1pf(expf(x)); }

struct GemmArgs {
    const float* A; const float* Bm; const float* bias; float* C; const int* cnt; const int* off; const int* list;
    int lda, ldb, ldc, M, N, K;
};
template <int MODE>
__global__ void __launch_bounds__(256) gemm(GemmArgs g) {
    __shared__ float As[16][128 + 4];
    __shared__ float Bs[16][128 + 4];
    const int tid = threadIdx.x, tx = tid & 15, ty = tid >> 4;
    const int m0 = blockIdx.y * 128, n0 = blockIdx.x * 128;
    int M = g.M; const float* Bm = g.Bm; const float* bias = g.bias; int rowbase = 0; const int* lst = nullptr;
    if (MODE != 0) {
        const int e = blockIdx.z; M = g.cnt[e]; if (m0 >= M) return;
        rowbase = g.off[e]; lst = g.list + (size_t)e * NTOK;
        Bm += (size_t)e * g.K * g.ldb; if (bias) bias += (size_t)e * g.N;
    }
    const float* arow[2]; bool aval[2];
#pragma unroll
    for (int i = 0; i < 2; ++i) {
        const int r = m0 + (tid >> 2) + 64 * i; aval[i] = r < M;
        if (MODE == 0) arow[i] = g.A + (size_t)r * g.lda;
        else if (MODE == 1) { const int tok = aval[i] ? (lst[r] >> 2) : 0; arow[i] = g.A + (size_t)tok * g.lda; }
        else arow[i] = g.A + (size_t)(rowbase + r) * g.lda;
    }
    float acc[8][8];
#pragma unroll
    for (int i = 0; i < 8; ++i)
#pragma unroll
        for (int j = 0; j < 8; ++j) acc[i][j] = 0.f;
    for (int k0 = 0; k0 < g.K; k0 += 16) {
#pragma unroll
        for (int i = 0; i < 2; ++i) {
            const int r = (tid >> 2) + 64 * i, c = (tid & 3) * 4;
            float4 v = make_float4(0.f, 0.f, 0.f, 0.f);
            if (aval[i]) {
                v = *(const float4*)(arow[i] + k0 + c);
                if (MODE == 2) {
                    const float4 u = *(const float4*)(arow[i] + 1024 + k0 + c);
                    float gg[4] = {v.x, v.y, v.z, v.w}, uu[4] = {u.x, u.y, u.z, u.w}, o[4];
#pragma unroll
                    for (int q = 0; q < 4; ++q) { const float a = fminf(gg[q], 7.f), b = fminf(fmaxf(uu[q], -7.f), 7.f); o[q] = a * sigmoidf_(1.702f * a) * (b + 1.f); }
                    v = make_float4(o[0], o[1], o[2], o[3]);
                }
            }
            As[c][r] = v.x; As[c + 1][r] = v.y; As[c + 2][r] = v.z; As[c + 3][r] = v.w;
        }
#pragma unroll
        for (int i = 0; i < 2; ++i) {
            const int r = (tid >> 5) + 8 * i, c = (tid & 31) * 4;
            const float* bp = Bm + (size_t)(k0 + r) * g.ldb + n0 + c;
            float4 v;
            if (n0 + c + 3 < g.N) v = *(const float4*)bp;
            else { v.x = (n0 + c < g.N) ? bp[0] : 0.f; v.y = (n0 + c + 1 < g.N) ? bp[1] : 0.f; v.z = (n0 + c + 2 < g.N) ? bp[2] : 0.f; v.w = 0.f; }
            *(float4*)&Bs[r][c] = v;
        }
        __syncthreads();
#pragma unroll
        for (int kk = 0; kk < 16; ++kk) {
            const float4 a0 = *(const float4*)&As[kk][ty * 8], a1 = *(const float4*)&As[kk][ty * 8 + 4];
            const float4 b0 = *(const float4*)&Bs[kk][tx * 8], b1 = *(const float4*)&Bs[kk][tx * 8 + 4];
            const float a[8] = {a0.x, a0.y, a0.z, a0.w, a1.x, a1.y, a1.z, a1.w};
            const float b[8] = {b0.x, b0.y, b0.z, b0.w, b1.x, b1.y, b1.z, b1.w};
#pragma unroll
            for (int i = 0; i < 8; ++i)
#pragma unroll
                for (int j = 0; j < 8; ++j) acc[i][j] = fmaf(a[i], b[j], acc[i][j]);
        }
        __syncthreads();
    }
#pragma unroll
    for (int i = 0; i < 8; ++i) {
        const int r = m0 + ty * 8 + i; if (r >= M) continue;
        float* crow = g.C + (size_t)(rowbase + r) * g.ldc;
#pragma unroll
        for (int j = 0; j < 8; ++j) { const int c = n0 + tx * 8 + j; if (c < g.N) crow[c] = acc[i][j] + (bias ? bias[c] : 0.f); }
    }
}

__device__ __forceinline__ float block_sum_256(float v, float* red) {
#pragma unroll
    for (int o = 32; o > 0; o >>= 1) v += __shfl_xor(v, o);
    __syncthreads();
    if ((threadIdx.x & 63) == 0) red[threadIdx.x >> 6] = v;
    __syncthreads();
    return red[0] + red[1] + red[2] + red[3];
}
__global__ void __launch_bounds__(256) ln_res(float* X, const float* H, const float* gam, const float* bet, float* Xout) {
    __shared__ float red[4];
    const size_t row = blockIdx.x; const int c = threadIdx.x * 4;
    const float4 x = *(const float4*)(X + row * D + c), h = *(const float4*)(H + row * D + c);
    float v[4] = {ALPHA * x.x + h.x, ALPHA * x.y + h.y, ALPHA * x.z + h.z, ALPHA * x.w + h.w};
    const float mean = block_sum_256(v[0] + v[1] + v[2] + v[3], red) * (1.f / D);
    float q = 0.f;
#pragma unroll
    for (int i = 0; i < 4; ++i) { v[i] -= mean; q += v[i] * v[i]; }
    const float rstd = rsqrtf(block_sum_256(q, red) * (1.f / D) + LN_EPS);
    const float4 gg = *(const float4*)(gam + c), bb = *(const float4*)(bet + c);
    const float4 o = make_float4(v[0] * rstd * gg.x + bb.x, v[1] * rstd * gg.y + bb.y, v[2] * rstd * gg.z + bb.z, v[3] * rstd * gg.w + bb.w);
    *(float4*)(Xout + row * D + c) = o;
}

template <int MODE>
__global__ void __launch_bounds__(256) attn(const float* P, float* O, const float* tab  , const float* cum  , int ldp) {
    __shared__ float Ks[64][64];
    __shared__ float Vs[64][64];
    __shared__ float ck[64];
    __shared__ float tb[MODE == 0 ? 2048 : 1];
    const int tid = threadIdx.x, qb = gridDim.x - 1 - blockIdx.x, b = blockIdx.y >> 4, vh = blockIdx.y & 15;
    int qcol, kcol, vcol, ocol, h;
    if (MODE == 0) { h = vh >> 2; const int m = (vh >> 1) & 1, half = vh & 1; qcol = h * 128 + m * 64; kcol = 512 + h * 128 + m * 64; vcol = 1024 + h * 128 + half * 64; ocol = (h * 2 + m) * 128 + half * 64; }
    else { h = vh; qcol = h * 64; kcol = 1024 + h * 64; vcol = 2048 + h * 64; ocol = h * 64; }
    if (MODE == 0) { for (int i = tid; i < 2048; i += 256) tb[i] = tab[h * 2048 + i]; }
    const int i_row = qb * 256 + tid; const size_t tok = (size_t)b * T + i_row;
    float q[64], o[64];
#pragma unroll
    for (int d = 0; d < 64; d += 4) { const float4 v = *(const float4*)(P + tok * ldp + qcol + d); q[d] = v.x * 0.125f; q[d + 1] = v.y * 0.125f; q[d + 2] = v.z * 0.125f; q[d + 3] = v.w * 0.125f; }
#pragma unroll
    for (int d = 0; d < 64; ++d) o[d] = 0.f;
    float m_run = -INFINITY, l_run = 0.f;
    float cq = 0.f; const float* cumrow = nullptr;
    if (MODE == 1) { cumrow = cum + (size_t)(b * 16 + h) * T; cq = cumrow[i_row]; }
    const float far_bias = (MODE == 0) ? tab[h * 2048 + 2047] : 0.f;
    const int ntile = 4 * qb + 4;
    for (int kt = 0; kt < ntile; ++kt) {
        __syncthreads();
        {
            const int r = tid >> 2, c0 = (tid & 3) * 16; const size_t ktok = (size_t)b * T + kt * 64 + r;
#pragma unroll
            for (int c = 0; c < 16; c += 4) { *(float4*)&Ks[r][c0 + c] = *(const float4*)(P + ktok * ldp + kcol + c0 + c); *(float4*)&Vs[r][c0 + c] = *(const float4*)(P + ktok * ldp + vcol + c0 + c); }
            if (MODE == 1 && tid < 64) ck[tid] = cumrow[kt * 64 + tid];
        }
        __syncthreads();
        if (kt * 64 > i_row) continue;
#pragma unroll 1
        for (int jj = 0; jj < 64; ++jj) {
            const int j = kt * 64 + jj; const int dist = i_row - j;
            if (dist < 0) break;
            float dot = 0.f;
#pragma unroll
            for (int d = 0; d < 64; d += 4) { const float4 kv = *(const float4*)&Ks[jj][d]; dot = fmaf(q[d], kv.x, dot); dot = fmaf(q[d + 1], kv.y, dot); dot = fmaf(q[d + 2], kv.z, dot); dot = fmaf(q[d + 3], kv.w, dot); }
            float bias;
            if (MODE == 0) bias = dist < 2048 ? tb[dist] : far_bias;
            else bias = cq - ck[jj];
            const float sc = dot + bias;
            if (sc > m_run) { const float f = __expf(m_run - sc); l_run *= f;
#pragma unroll
                for (int d = 0; d < 64; ++d) o[d] *= f;
                m_run = sc; }
            const float p = __expf(sc - m_run); l_run += p;
#pragma unroll
            for (int d = 0; d < 64; d += 4) { const float4 vv = *(const float4*)&Vs[jj][d]; o[d] = fmaf(p, vv.x, o[d]); o[d + 1] = fmaf(p, vv.y, o[d + 1]); o[d + 2] = fmaf(p, vv.z, o[d + 2]); o[d + 3] = fmaf(p, vv.w, o[d + 3]); }
        }
    }
    const float inv = 1.f / l_run;
#pragma unroll
    for (int d = 0; d < 64; d += 4) *(float4*)(O + tok * D + ocol + d) = make_float4(o[d] * inv, o[d + 1] * inv, o[d + 2] * inv, o[d + 3] * inv);
}

__global__ void t5tab(const float* t5, float* tab) {
    const int i = blockIdx.x * blockDim.x + threadIdx.x; if (i >= 4 * 2048) return;
    const int h = i >> 11, n = i & 2047; int bk;
    if (n < 16) bk = n; else { bk = 16 + (int)(log((double)n / 16.0) / log(128.0) * 16.0); if (bk > 31) bk = 31; }
    tab[i] = t5[bk * 4 + h];
}

__global__ void conv_silu(const float* P  , const float* w  , float* CQ  ) {
    const size_t i = (size_t)blockIdx.x * blockDim.x + threadIdx.x; if (i >= (size_t)NTOK * 1536) return;
    const int c = (int)(i % 1536); const size_t tok = i / 1536; const int t = (int)(tok % T);
    float y = 0.f;
#pragma unroll
    for (int j = 0; j < 4; ++j) { const int tt = t - 3 + j; if (tt >= 0) y = fmaf(w[j * 1536 + c], P[(tok - 3 + j) * EVEN_IN + 1536 + c], y); }
    CQ[i] = y * sigmoidf_(y);
}
__global__ void gdn_norm(const float* P, float* CQ, const float* a_log, const float* dt_bias, float* BETA, float* G) {
    const int i = blockIdx.x * blockDim.x + threadIdx.x; if (i >= NTOK * 8) return;
    const int which = i & 1, h = (i >> 1) & 3; const size_t tok = i >> 3;
    float* p = CQ + tok * 1536 + which * 512 + h * 128; float ss = 0.f;
    for (int d = 0; d < 128; ++d) ss = fmaf(p[d], p[d], ss);
    const float r = rsqrtf(ss + RMS_EPS);
    for (int d = 0; d < 128; ++d) p[d] *= r;
    if (which == 0) {
        BETA[tok * 4 + h] = sigmoidf_(P[tok * EVEN_IN + 3584 + h]);
        G[tok * 4 + h] = -expf(a_log[h]) * softplusf_(P[tok * EVEN_IN + 3588 + h] + dt_bias[h]);
    }
}
__global__ void __launch_bounds__(128) gdn_rec(const float* CQ, const float* BETA, const float* G, float* GO  ) {
    __shared__ float ks[2][128], qs[2][128];
    const int b = blockIdx.x >> 2, h = blockIdx.x & 3, c = threadIdx.x;
    float S[128];
#pragma unroll
    for (int d = 0; d < 128; ++d) S[d] = 0.f;
    const float scale = 0.08838834764831845f;
    for (int t = 0; t < T; ++t) {
        const size_t tok = (size_t)b * T + t; const int bf = t & 1;
        ks[bf][c] = CQ[tok * 1536 + 512 + h * 128 + c]; qs[bf][c] = CQ[tok * 1536 + h * 128 + c];
        const float v = CQ[tok * 1536 + 1024 + h * 128 + c], beta = BETA[tok * 4 + h], alpha = __expf(G[tok * 4 + h]);
        __syncthreads();
        float ksum = 0.f;
#pragma unroll
        for (int d = 0; d < 128; d += 4) { const float4 k4 = *(const float4*)&ks[bf][d]; ksum = fmaf(k4.x, S[d], ksum); ksum = fmaf(k4.y, S[d + 1], ksum); ksum = fmaf(k4.z, S[d + 2], ksum); ksum = fmaf(k4.w, S[d + 3], ksum); }
        const float vnew = beta * (v - alpha * ksum);
        float o = 0.f;
#pragma unroll
        for (int d = 0; d < 128; d += 4) { const float4 k4 = *(const float4*)&ks[bf][d]; const float4 q4 = *(const float4*)&qs[bf][d];
            S[d] = fmaf(alpha, S[d], k4.x * vnew); S[d + 1] = fmaf(alpha, S[d + 1], k4.y * vnew); S[d + 2] = fmaf(alpha, S[d + 2], k4.z * vnew); S[d + 3] = fmaf(alpha, S[d + 3], k4.w * vnew);
            o = fmaf(q4.x, S[d], o); o = fmaf(q4.y, S[d + 1], o); o = fmaf(q4.z, S[d + 2], o); o = fmaf(q4.w, S[d + 3], o); }
        GO[tok * 512 + h * 128 + c] = o * scale;
    }
}
__global__ void __launch_bounds__(128) even_combine(const float* ATT  , const float* GO, const float* P, const float* lamp  ,
                                                    const float* subln_w, const float* gdn_w, float* MIX, float lam_init) {
    __shared__ float red[2]; __shared__ float lam_s;
    const size_t tok = blockIdx.x; const int d = threadIdx.x;
    if (d < 64) {
        float a = lamp[d] * lamp[64 + d], bb = lamp[128 + d] * lamp[192 + d];
#pragma unroll
        for (int o = 32; o > 0; o >>= 1) { a += __shfl_xor(a, o); bb += __shfl_xor(bb, o); }
        if (d == 0) lam_s = expf(a) - expf(bb) + lam_init;
    }
    __syncthreads();
    const float lam = lam_s;
    for (int grp = 0; grp < 8; ++grp) {
        float v;
        if (grp < 4) v = ATT[tok * D + (grp * 2) * 128 + d] - lam * ATT[tok * D + (grp * 2 + 1) * 128 + d];
        else v = GO[tok * 512 + (grp - 4) * 128 + d];
        float ss = v * v;
#pragma unroll
        for (int o = 32; o > 0; o >>= 1) ss += __shfl_xor(ss, o);
        __syncthreads();
        if ((d & 63) == 0) red[d >> 6] = ss;
        __syncthreads();
        const float r = rsqrtf((red[0] + red[1]) * (1.f / 128.f) + RMS_EPS);
        float outv;
        if (grp < 4) outv = v * r * subln_w[d] * (1.f - lam_init);
        else { const float z = P[tok * EVEN_IN + 3072 + (grp - 4) * 128 + d]; outv = v * r * gdn_w[d] * (z * sigmoidf_(z)); }
        MIX[tok * D + grp * 128 + d] = outv;
    }
}

__global__ void qknorm(float* P  , const float* w  ) {
    const int i = blockIdx.x * blockDim.x + threadIdx.x; if (i >= NTOK * 32) return;
    const int which = i & 1, h = (i >> 1) & 15; const size_t tok = i >> 5;
    float* p = P + tok * ODD_IN + which * 1024 + h * 64; float ss = 0.f;
    for (int d = 0; d < 64; ++d) ss = fmaf(p[d], p[d], ss);
    const float r = rsqrtf(ss * (1.f / 64.f) + RMS_EPS);
    for (int d = 0; d < 64; ++d) p[d] = p[d] * r * w[which * 64 + d];
}
__global__ void logf_k(const float* P, const float* fb, float* LF  ) {
    const int i = blockIdx.x * blockDim.x + threadIdx.x; if (i >= NTOK * 16) return;
    const int h = i & 15; const size_t tok = i >> 4; const int b = (int)(tok / T), t = (int)(tok % T);
    const float x = P[tok * ODD_IN + 4096 + h] + fb[h];
    LF[(size_t)(b * 16 + h) * T + t] = -softplusf_(-x);
}
__global__ void __launch_bounds__(1024) cumsum16k(float* LF) {
    __shared__ float part[1024];
    float* p = LF + (size_t)blockIdx.x * T + threadIdx.x * 16; float v[16]; float s = 0.f;
#pragma unroll
    for (int i = 0; i < 16; ++i) { s += p[i]; v[i] = s; }
    part[threadIdx.x] = s; __syncthreads();
    for (int o = 1; o < 1024; o <<= 1) { float a = threadIdx.x >= o ? part[threadIdx.x - o] : 0.f; __syncthreads(); part[threadIdx.x] += a; __syncthreads(); }
    const float base = threadIdx.x ? part[threadIdx.x - 1] : 0.f;
#pragma unroll
    for (int i = 0; i < 16; ++i) p[i] = v[i] + base;
}
__global__ void gate_k(const float* ATT, const float* P, float* MIX) {
    const size_t i = (size_t)blockIdx.x * blockDim.x + threadIdx.x; if (i >= (size_t)NTOK * D) return;
    const size_t tok = i >> 10; const int c = (int)(i & 1023);
    MIX[i] = ATT[i] * sigmoidf_(P[tok * ODD_IN + 3072 + c]);
}

__global__ void __launch_bounds__(256) router(const float* X, const float* rw  , const float* rb, int* cnt, int* list, int* sel_e, int* sel_slot, float* gate) {
    __shared__ float lg[8][32];
    const int tk = threadIdx.x >> 5, e = threadIdx.x & 31; const size_t tok = (size_t)blockIdx.x * 8 + tk;
    const float* x = X + tok * D; float acc = 0.f;
    for (int k = 0; k < D; ++k) acc = fmaf(x[k], rw[k * 32 + e], acc);
    lg[tk][e] = acc + rb[e];
    __syncthreads();
    if (e == 0) {
        float v[4]; int id[4]; unsigned used = 0u;
#pragma unroll
        for (int k = 0; k < 4; ++k) { float best = -INFINITY; int bi = 0; for (int j = 0; j < 32; ++j) { const float z = lg[tk][j]; if (!((used >> j) & 1u) && z > best) { best = z; bi = j; } } used |= 1u << bi; v[k] = best; id[k] = bi; }
        float s = 0.f, p[4];
#pragma unroll
        for (int k = 0; k < 4; ++k) { p[k] = __expf(v[k] - v[0]); s += p[k]; }
#pragma unroll
        for (int k = 0; k < 4; ++k) {
            const int slot = atomicAdd(&cnt[id[k]], 1);
            list[(size_t)id[k] * NTOK + slot] = (int)(tok * 4 + k);
            sel_e[tok * 4 + k] = id[k]; sel_slot[tok * 4 + k] = slot; gate[tok * 4 + k] = p[k] / s;
        }
    }
}
__global__ void offsets(const int* cnt, int* off) { if (threadIdx.x == 0) { int s = 0; for (int e = 0; e < NE; ++e) { off[e] = s; s += cnt[e]; } } }
__global__ void __launch_bounds__(256) combine_ln(float* X, const float* Y, const int* off, const int* sel_e, const int* sel_slot, const float* gate, const float* gam, const float* bet, float* Xout) {
    __shared__ float red[4];
    const size_t row = blockIdx.x; const int c = threadIdx.x * 4;
    const float4 x = *(const float4*)(X + row * D + c);
    float v[4] = {ALPHA * x.x, ALPHA * x.y, ALPHA * x.z, ALPHA * x.w};
#pragma unroll
    for (int k = 0; k < 4; ++k) { const size_t pos = (size_t)off[sel_e[row * 4 + k]] + sel_slot[row * 4 + k]; const float gt = gate[row * 4 + k]; const float4 y = *(const float4*)(Y + pos * D + c);
        v[0] = fmaf(gt, y.x, v[0]); v[1] = fmaf(gt, y.y, v[1]); v[2] = fmaf(gt, y.z, v[2]); v[3] = fmaf(gt, y.w, v[3]); }
    const float mean = block_sum_256(v[0] + v[1] + v[2] + v[3], red) * (1.f / D);
    float q = 0.f;
#pragma unroll
    for (int i = 0; i < 4; ++i) { v[i] -= mean; q += v[i] * v[i]; }
    const float rstd = rsqrtf(block_sum_256(q, red) * (1.f / D) + LN_EPS);
    const float4 gg = *(const float4*)(gam + c), bb = *(const float4*)(bet + c);
    *(float4*)(Xout + row * D + c) = make_float4(v[0] * rstd * gg.x + bb.x, v[1] * rstd * gg.y + bb.y, v[2] * rstd * gg.z + bb.z, v[3] * rstd * gg.w + bb.w);
}

constexpr size_t MiB = 1u << 20;
constexpr size_t O_X = 0;
constexpr size_t O_H = 128 * MiB;
constexpr size_t O_MIX = 256 * MiB;
constexpr size_t O_ATT = 384 * MiB;
constexpr size_t O_PROJ = 512 * MiB;
constexpr size_t O_CQ = 1032 * MiB;
constexpr size_t O_GO = 1224 * MiB;
constexpr size_t O_HB = 512 * MiB;
constexpr size_t O_Y = 1536 * MiB;
constexpr size_t O_SMALL = 2048 * MiB;
constexpr size_t O_END = 2064 * MiB;
constexpr size_t S_TAB = 0, S_BETA = 64 * 1024, S_G = S_BETA + 512 * 1024, S_CUM = S_G + 512 * 1024  , S_CNT = S_CUM + 2 * MiB, S_OFF = S_CNT + 256,
                 S_SELE = S_CNT + 4096, S_SLOT = S_SELE + 512 * 1024, S_GATE = S_SLOT + 512 * 1024, S_LIST = S_GATE + 512 * 1024  ;
static_assert(S_LIST + 4 * MiB <= 16 * MiB, "small region");

struct In { const float* p[24]; };
static_assert(sizeof(GemmArgs) == 80, "GemmArgs has padding");

struct Save { int layer, stage; void* dst; };
enum { ST_PROJ = 0, ST_CQ, ST_GO, ST_ATT, ST_MIX, ST_H, ST_XMIX, ST_XOUT, ST_CUM, ST_BETA, ST_G, ST_Y };
static void forward(const In& in, unsigned char* ws, float* out, const Save* sv, int nsv, hipStream_t st) {
    auto save = [&](int layer, int stage, const void* src, size_t bytes) { for (int k = 0; k < nsv; ++k) if (sv[k].layer == layer && sv[k].stage == stage) (void)hipMemcpyAsync(sv[k].dst, src, bytes, hipMemcpyDeviceToDevice, st); };
    float* X = (float*)(ws + O_X); float* H = (float*)(ws + O_H); float* MIX = (float*)(ws + O_MIX); float* ATT = (float*)(ws + O_ATT);
    float* PROJ = (float*)(ws + O_PROJ); float* CQ = (float*)(ws + O_CQ); float* GO = (float*)(ws + O_GO); float* HB = (float*)(ws + O_HB); float* Y = (float*)(ws + O_Y);
    unsigned char* sm = ws + O_SMALL;
    float* TAB = (float*)(sm + S_TAB); float* BETA = (float*)(sm + S_BETA); float* G = (float*)(sm + S_G); float* CUM = (float*)(sm + S_CUM);
    int* CNT = (int*)(sm + S_CNT); int* OFF = (int*)(sm + S_OFF); int* SELE = (int*)(sm + S_SELE); int* SLOT = (int*)(sm + S_SLOT); float* GATE = (float*)(sm + S_GATE); int* LIST = (int*)(sm + S_LIST);
    (void)hipMemcpyAsync(X, in.p[0], (size_t)NTOK * D * 4, hipMemcpyDeviceToDevice, st);
    t5tab<<<32, 256, 0, st>>>(in.p[1], TAB);
    for (int layer = 0; layer < 4; ++layer) {
        const int i = layer >> 1;
        if ((layer & 1) == 0) {
            GemmArgs g{X, in.p[2] + (size_t)i * D * EVEN_IN, nullptr, PROJ, nullptr, nullptr, nullptr, D, EVEN_IN, EVEN_IN, NTOK, EVEN_IN, D};
            gemm<0><<<dim3((EVEN_IN + 127) / 128, NTOK / 128), 256, 0, st>>>(g);
            conv_silu<<<(unsigned)(((size_t)NTOK * 1536 + 255) / 256), 256, 0, st>>>(PROJ, in.p[6] + (size_t)i * 4 * 1536, CQ);
            gdn_norm<<<NTOK * 8 / 256, 256, 0, st>>>(PROJ, CQ, in.p[7] + i * 4, in.p[8] + i * 4, BETA, G);
            save(layer, ST_CQ, CQ, (size_t)NTOK * 1536 * 4); save(layer, ST_BETA, BETA, (size_t)NTOK * 16); save(layer, ST_G, G, (size_t)NTOK * 16);
            gdn_rec<<<8, 128, 0, st>>>(CQ, BETA, G, GO);
            save(layer, ST_GO, GO, (size_t)NTOK * 512 * 4);
            save(layer, ST_PROJ, PROJ, (size_t)NTOK * EVEN_IN * 4);
            attn<0><<<dim3(T / 256, B * 16), 256, 0, st>>>(PROJ, ATT, TAB, nullptr, EVEN_IN);
            save(layer, ST_ATT, ATT, (size_t)NTOK * D * 4);
            const float lam_init = 0.8f - 0.6f * expf(-0.3f * (float)layer);
            even_combine<<<NTOK, 128, 0, st>>>(ATT, GO, PROJ, in.p[4] + i * 256, in.p[5] + i * 128, in.p[9] + i * 128, MIX, lam_init);
            GemmArgs g2{MIX, in.p[3] + (size_t)i * D * D, nullptr, H, nullptr, nullptr, nullptr, D, D, D, NTOK, D, D};
            gemm<0><<<dim3(D / 128, NTOK / 128), 256, 0, st>>>(g2);
        } else {
            GemmArgs g{X, in.p[10] + (size_t)i * D * ODD_IN, nullptr, PROJ, nullptr, nullptr, nullptr, D, ODD_IN, ODD_IN, NTOK, ODD_IN, D};
            gemm<0><<<dim3((ODD_IN + 127) / 128, NTOK / 128), 256, 0, st>>>(g);
            qknorm<<<NTOK * 32 / 256, 256, 0, st>>>(PROJ, in.p[12] + i * 128);
            logf_k<<<NTOK * 16 / 256, 256, 0, st>>>(PROJ, in.p[13] + i * 16, CUM);
            cumsum16k<<<B * 16, 1024, 0, st>>>(CUM);
            save(layer, ST_PROJ, PROJ, (size_t)NTOK * ODD_IN * 4); save(layer, ST_CUM, CUM, (size_t)32 * T * 4);
            attn<1><<<dim3(T / 256, B * 16), 256, 0, st>>>(PROJ, ATT, nullptr, CUM, ODD_IN);
            save(layer, ST_ATT, ATT, (size_t)NTOK * D * 4);
            gate_k<<<(unsigned)((size_t)NTOK * D / 256), 256, 0, st>>>(ATT, PROJ, MIX);
            GemmArgs g2{MIX, in.p[11] + (size_t)i * D * D, nullptr, H, nullptr, nullptr, nullptr, D, D, D, NTOK, D, D};
            gemm<0><<<dim3(D / 128, NTOK / 128), 256, 0, st>>>(g2);
        }
        save(layer, ST_MIX, MIX, (size_t)NTOK * D * 4); save(layer, ST_H, H, (size_t)NTOK * D * 4);
        ln_res<<<NTOK, 256, 0, st>>>(X, H, in.p[20] + layer * D, in.p[21] + layer * D, X);
        save(layer, ST_XMIX, X, (size_t)NTOK * D * 4);
        (void)hipMemsetAsync(CNT, 0, 128, st);
        router<<<NTOK / 8, 256, 0, st>>>(X, in.p[14] + (size_t)layer * D * NE, in.p[15] + layer * NE, CNT, LIST, SELE, SLOT, GATE);
        offsets<<<1, 64, 0, st>>>(CNT, OFF);
        GemmArgs m1{X, in.p[16] + (size_t)layer * NE * D * 2048, in.p[17] + (size_t)layer * NE * 2048, HB, CNT, OFF, LIST, D, 2048, 2048, 0, 2048, D};
        gemm<1><<<dim3(2048 / 128, NTOK / 128, NE), 256, 0, st>>>(m1);
        GemmArgs m2{HB, in.p[18] + (size_t)layer * NE * DFF * D, in.p[19] + (size_t)layer * NE * D, Y, CNT, OFF, LIST, 2048, D, D, 0, D, DFF};
        gemm<2><<<dim3(D / 128, NTOK / 128, NE), 256, 0, st>>>(m2);
        float* dst = (layer == 3) ? out : X;
        combine_ln<<<NTOK, 256, 0, st>>>(X, Y, OFF, SELE, SLOT, GATE, in.p[22] + layer * D, in.p[23] + layer * D, dst);
        save(layer, ST_XOUT, dst, (size_t)NTOK * D * 4);
    }
}
}

#endif
namespace fk {
#define LAS __attribute__((address_space(3)))
#define GAS __attribute__((address_space(1)))
typedef unsigned short bf16_t;
typedef short bf16x8 __attribute__((ext_vector_type(8)));
typedef short s16x4 __attribute__((ext_vector_type(4)));
typedef float f32x2 __attribute__((ext_vector_type(2)));
typedef float f32x4 __attribute__((ext_vector_type(4)));
typedef float f32x16 __attribute__((ext_vector_type(16)));
typedef unsigned u32x2 __attribute__((ext_vector_type(2)));
typedef unsigned u32x4 __attribute__((ext_vector_type(4)));
typedef GAS unsigned gu32;

constexpr int NWAVES = 8, NTHR = 512;
constexpr int PITCH = 4160;
constexpr float LOG2E = 1.4426950408889634f;
constexpr float C2 = 0.125f * LOG2E;
constexpr int NPAD = NTOK * 4 + NE * 256;
constexpr int T5PAD = 256, T5N = 2048 + T5PAD;

constexpr size_t MiB = 1u << 20;
constexpr size_t WS_CTL = 0, CTL_BYTES = 1 * MiB;
constexpr size_t WS_WINE = 2 * MiB;
constexpr size_t WS_WINO = 16 * MiB;
constexpr size_t WS_WOUTE = 32 * MiB, WS_WOUTO = 36 * MiB;
constexpr size_t WS_RW = 40 * MiB;
constexpr size_t WS_SWE = WS_RW + 512 * 1024;
constexpr size_t WS_SWO = WS_SWE + 128 * 1024;
constexpr size_t WS_T5 = 41 * MiB;
constexpr size_t WS_WGU = 64 * MiB;
constexpr size_t WS_WD = 576 * MiB;
constexpr size_t WS_X = 832 * MiB;
constexpr size_t WS_XB = 960 * MiB;
constexpr size_t WS_PROJ = 2368 * MiB;
constexpr size_t WS_ATT = 1280 * MiB;
constexpr size_t WS_MIX = 1344 * MiB;
constexpr size_t WS_H = 1408 * MiB;
constexpr size_t WS_GW = 1536 * MiB, WS_GQD = 1570 * MiB, WS_GQK = 1604 * MiB, WS_GKD = 1622 * MiB, WS_GU = 1658 * MiB;
constexpr size_t WS_GO = 1722 * MiB;
constexpr size_t WS_ACT = 1792 * MiB;
constexpr size_t WS_Y = 2064 * MiB;
constexpr size_t WS_PB = 2336 * MiB;
constexpr size_t WS_CUM = 2338 * MiB;
constexpr size_t WS_KB8 = 2340 * MiB;
constexpr size_t WS_SELE = 2348 * MiB, WS_SLOT = WS_SELE + 512 * 1024, WS_GATE = WS_SLOT + 512 * 1024, WS_TSUM = WS_GATE + 512 * 1024;
constexpr size_t WS_LIST = 2350 * MiB;
constexpr size_t WS_GL = 2354 * MiB;
constexpr size_t WS_FAST_END = 2632 * MiB;
constexpr int CW_TMO = 0, CW_BAR = 4096, CW_CNT = 8192  , CW_QUEUE = 12288  ;

constexpr int RING_BYTES = 131072;
constexpr int CTRL_OFF = 159744;
constexpr int MISC_OFF = CTRL_OFF + 320;
constexpr int LDS_BYTES = 163840;

#define LDS_WAIT() asm volatile("s_waitcnt lgkmcnt(0)" ::: "memory")
#define VM_WAIT() asm volatile("s_waitcnt vmcnt(0)" ::: "memory")
#define RLX_AGENT __ATOMIC_RELAXED, __HIP_MEMORY_SCOPE_AGENT

__device__ __forceinline__ unsigned f2bf(float f) { unsigned u = __builtin_bit_cast(unsigned, f); return (u + 0x7fffu + ((u >> 16) & 1u)) >> 16; }
__device__ __forceinline__ unsigned pk2(float lo, float hi) { return f2bf(lo) | (f2bf(hi) << 16); }
__device__ __forceinline__ float bf2f(unsigned short h) { return __builtin_bit_cast(float, (unsigned)h << 16); }
__device__ __forceinline__ float bflo(unsigned w) { return __builtin_bit_cast(float, w << 16); }
__device__ __forceinline__ float bfhi(unsigned w) { return __builtin_bit_cast(float, w & 0xffff0000u); }
__device__ __forceinline__ unsigned cvt_pk_bf16(float lo, float hi) { unsigned r; asm volatile("v_cvt_pk_bf16_f32 %0, %1, %2" : "=v"(r) : "v"(lo), "v"(hi)); return r; }
__device__ __forceinline__ float sigmoid_f(float x) { return 1.f / (1.f + __expf(-x)); }
__device__ __forceinline__ float softplus_f(float x) { const float e = __expf(-fabsf(x)); const float l = e < 1e-3f ? e * (1.f - 0.5f * e) : __logf(1.f + e); return fmaxf(x, 0.f) + l; }

#define XB_TMO      128
#define XB_XCNT(j)  (256  + 64 * (j))
#define XB_XSUB(j)  (1280 + 64 * (j))
#define XB_XGEN(j)  (2304 + 64 * (j))
#define XB_TOP      3328
#define XB_TOPGEN   3392
#define XCD_BAR_WORDS 3456
#define XB_SPIN_CAP (1u << 18)
__device__ __forceinline__ unsigned xb_ld(unsigned* p)              { return __hip_atomic_load(p, __ATOMIC_RELAXED, __HIP_MEMORY_SCOPE_AGENT); }
__device__ __forceinline__ unsigned xb_add(unsigned* p, unsigned v) { return __hip_atomic_fetch_add(p, v, __ATOMIC_RELAXED, __HIP_MEMORY_SCOPE_AGENT); }
__device__ __forceinline__ unsigned xb_xcc_id() { return (unsigned)__builtin_amdgcn_s_getreg((3 << 11) | 20) & 0xFu; }
#define XB_SPIN(cond, bar) do { unsigned _sp = 0; while (cond) { __builtin_amdgcn_s_sleep(1); \
    if ((++_sp & 255u) == 0u) { if (xb_ld(&(bar)[XB_TMO])) break; if (_sp > XB_SPIN_CAP) { atomicAdd(&(bar)[XB_TMO], 1u); break; } } } } while (0)
struct XcdBarrier { unsigned* bar; unsigned x; volatile LAS unsigned* st; };
__device__ __forceinline__ XcdBarrier xcd_barrier_post(unsigned* bar, volatile LAS unsigned* st) {
    XcdBarrier b; b.bar = bar; b.x = xb_xcc_id(); b.st = st;
    if (threadIdx.x == 0) (void)xb_add(&bar[XB_XCNT(b.x)], 1u);
    return b;
}
__device__ __forceinline__ void xcd_barrier_complete(unsigned* bar, unsigned x, unsigned& nloc, unsigned& nx) {
    const unsigned G = gridDim.x * gridDim.y * gridDim.z;
    unsigned sum, cnt, mine, sp = 0u;
    for (;;) {
        sum = 0u; cnt = 0u;
#pragma unroll
        for (unsigned j = 0; j < 16; ++j) { const unsigned c = xb_ld(&bar[XB_XCNT(j)]); sum += c; cnt += (c > 0u) ? 1u : 0u; }
        mine = xb_ld(&bar[XB_XCNT(x)]);
        if (sum == G) break;
        __builtin_amdgcn_s_sleep(1);
        if ((++sp & 255u) == 0u) { if (xb_ld(&bar[XB_TMO])) break; if (sp > XB_SPIN_CAP) { atomicAdd(&bar[XB_TMO], 1u); break; } }
    }
    nloc = mine > 0u ? mine : 1u; nx = cnt > 0u ? cnt : 1u;
}
__device__ __forceinline__ void xcd_barrier(const XcdBarrier& b) {
    asm volatile("s_waitcnt vmcnt(0)" ::: "memory");
    __syncthreads();
    if (threadIdx.x == 0) {
        unsigned* bar = b.bar; const unsigned bx = b.x;
        __builtin_amdgcn_s_waitcnt(0);
        unsigned nloc = b.st[0], nx = b.st[1];
        if (nloc == 0u) { xcd_barrier_complete(bar, bx, nloc, nx); b.st[0] = nloc; b.st[1] = nx; }
        const unsigned old = xb_add(&bar[XB_XSUB(bx)], 1u);
        const unsigned gen = old / nloc;
        if (old + 1u == (gen + 1u) * nloc) {
            __builtin_amdgcn_fence(__ATOMIC_RELEASE, "agent");
            asm volatile("s_waitcnt vmcnt(0)" ::: "memory");
            const unsigned og = xb_add(&bar[XB_TOP], 1u);
            const unsigned tg = og / nx;
            if (og + 1u == (tg + 1u) * nx) xb_add(&bar[XB_TOPGEN], 1u);
            else XB_SPIN(xb_ld(&bar[XB_TOPGEN]) == tg, bar);
            __builtin_amdgcn_fence(__ATOMIC_ACQUIRE, "agent");
            xb_add(&bar[XB_XGEN(bx)], 1u);
            asm volatile("s_waitcnt vmcnt(0)" ::: "memory");
        } else {
            XB_SPIN(xb_ld(&bar[XB_XGEN(bx)]) == gen, bar);
            __builtin_amdgcn_fence(__ATOMIC_ACQUIRE, "agent");
            asm volatile("s_waitcnt vmcnt(0)" ::: "memory");
        }
    }
    __syncthreads();
}

namespace pg8 {
constexpr int BM = 256, BK = 64, HALF = 128, HTB = HALF * BK * 2, STAGE_BYTES = 8 * HTB;
__host__ __device__ __forceinline__ int lds_byte(int r, int c) { const int st = (r >> 4) * 2 + (c >> 5), rr = r & 15, cc = c & 31, ob = rr * 64 + cc * 2; return st * 1024 + (ob ^ (((ob >> 9) & 1) << 5)); }
__host__ __device__ __forceinline__ void stage_rc(int b, int& R, int& C) { const int st = b / 1024, sb = b % 1024, swz = sb ^ (((sb >> 9) & 1) << 5); R = (st >> 1) * 16 + swz / 64; C = (st & 1) * 32 + (swz % 64) / 2; }
__host__ __device__ __forceinline__ int perm32(int rho) { const int n = rho >> 4, i = rho & 15; return 8 * (i >> 2) + 4 * n + (i & 3); }

struct Unit { const char* A; const char* B; const int* rows; int nvalid; int row0; int col0; int aux; };

template <class Epi, class Sched, bool GATHER>
__device__ __forceinline__ void gemm_phase(LAS unsigned char* lds, const int K, const Sched& S, const Epi& E, const int tid) {
    const int wid = __builtin_amdgcn_readfirstlane(tid >> 6), lane = tid & 63, wr = wid >> 2, wc = wid & 3, fr = lane & 15, fq = lane >> 4;
    const int nt = K / BK;
    int Rr[2], Cc[2]; unsigned voffB[2]; unsigned offA[2][2], noffA[2][2];
#pragma unroll
    for (int i = 0; i < 2; ++i) { stage_rc(tid * 16 + i * 8192, Rr[i], Cc[i]); const int Rb = Epi::PERM ? ((Rr[i] & ~31) + perm32(Rr[i] & 31)) : Rr[i];
        voffB[i] = (unsigned)(Rb * K + Cc[i]) * 2u;
#pragma unroll
        for (int h = 0; h < 2; ++h) { offA[h][i] = (unsigned)((Rr[i] + HALF * h) * K + Cc[i]) * 2u; noffA[h][i] = offA[h][i]; } }
    const size_t kstep = (size_t)(BK * 2);
    const size_t hstep = (size_t)HALF * K * 2;
    const unsigned ldsw = (unsigned)wid * 1024u;
    const int aoff = lds_byte(wr * 64 + fr, fq * 8), boff = lds_byte(wc * 32 + fr, fq * 8);
#define PG8_SA(b, h) (((b) * 2 + (h)) * HTB)
#define PG8_SB(b, h) ((4 + (b) * 2 + (h)) * HTB)
#define PG8_STAGE_B(bufoff, gbase) do { _Pragma("unroll") for (int _i = 0; _i < 2; ++_i) \
        __builtin_amdgcn_global_load_lds((const unsigned*)((const char*)(gbase) + voffB[_i]), (LAS unsigned*)(lds + (bufoff) + ldsw + _i * 8192), 16, 0, 0); } while (0)
#define PG8_STAGE_A(bufoff, gbase, off, h) do { _Pragma("unroll") for (int _i = 0; _i < 2; ++_i) \
        __builtin_amdgcn_global_load_lds((const unsigned*)((const char*)(gbase) + (off)[h][_i]), (LAS unsigned*)(lds + (bufoff) + ldsw + _i * 8192), 16, 0, 0); } while (0)
#define PG8_LDA(dst, b, h) do { _Pragma("unroll") for (int m = 0; m < 4; ++m) _Pragma("unroll") for (int k = 0; k < 2; ++k) dst[m][k] = *(const LAS bf16x8*)(lds + PG8_SA(b, h) + aoff + m * 2048 + k * 1024); } while (0)
#define PG8_LDB(dst, b, h) do { _Pragma("unroll") for (int n = 0; n < 2; ++n) _Pragma("unroll") for (int k = 0; k < 2; ++k) dst[n][k] = *(const LAS bf16x8*)(lds + PG8_SB(b, h) + boff + n * 2048 + k * 1024); } while (0)
#define PG8_MMA(ai, bj, At, Bt) do { __builtin_amdgcn_s_setprio(1); _Pragma("unroll") for (int m = 0; m < 4; ++m) _Pragma("unroll") for (int n = 0; n < 2; ++n) _Pragma("unroll") for (int k = 0; k < 2; ++k) \
        acc[ai][bj][m][n] = __builtin_amdgcn_mfma_f32_16x16x32_bf16(Bt[n][k], At[m][k], acc[ai][bj][m][n], 0, 0, 0); __builtin_amdgcn_s_setprio(0); } while (0)
#define PG8_WAIT_V(n) asm volatile("s_waitcnt vmcnt(" #n ")" ::: "memory")
#define PG8_WAIT_L(n) asm volatile("s_waitcnt lgkmcnt(" #n ")" ::: "memory")
#define PG8_BAR __builtin_amdgcn_s_barrier()
#define PG8_SCHED __builtin_amdgcn_sched_barrier(0)
#define PG8_ROWS(dst, u) do { if constexpr (GATHER) { _Pragma("unroll") for (int h = 0; h < 2; ++h) _Pragma("unroll") for (int i = 0; i < 2; ++i) { \
        int rr_ = Rr[i] + HALF * h; rr_ = rr_ < (u).nvalid ? rr_ : (u).nvalid - 1; const int tok_ = (u).rows[rr_] >> 2; dst[h][i] = (unsigned)(tok_ * K + Cc[i]) * 2u; } } } while (0)
    Unit cur, nxt; int ui = 0;
    if (!S.next(0, cur)) return;
    f32x4 acc[2][2][4][2];
#pragma unroll
    for (int a = 0; a < 2; ++a)
#pragma unroll
        for (int b = 0; b < 2; ++b)
#pragma unroll
            for (int m = 0; m < 4; ++m)
#pragma unroll
                for (int n = 0; n < 2; ++n) acc[a][b][m][n] = (f32x4){0.f, 0.f, 0.f, 0.f};
    bf16x8 At[4][2], B0[2][2], B1[2][2];
    const char* cA = cur.A; const char* cB = cur.B;
    PG8_ROWS(offA, cur);
    PG8_STAGE_B(PG8_SB(0, 0), cB); PG8_STAGE_B(PG8_SB(0, 1), cB + hstep); PG8_STAGE_A(PG8_SA(0, 0), cA, offA, 0); PG8_STAGE_A(PG8_SA(0, 1), cA, offA, 1);
    if (wr == 1) PG8_BAR;
    PG8_WAIT_V(2); PG8_BAR;
    PG8_STAGE_B(PG8_SB(1, 0), cB + kstep); PG8_STAGE_A(PG8_SA(1, 0), cA + kstep, offA, 0); PG8_STAGE_B(PG8_SB(1, 1), cB + hstep + kstep);
    PG8_WAIT_V(6); PG8_BAR;
    for (;;) {
        const bool has_next = S.next(ui + 1, nxt);
        const char* nA = has_next ? nxt.A : cA; const char* nB = has_next ? nxt.B : cB;
        if constexpr (GATHER) { if (has_next) { PG8_ROWS(noffA, nxt); } else {
#pragma unroll
            for (int h = 0; h < 2; ++h)
#pragma unroll
                for (int i = 0; i < 2; ++i) noffA[h][i] = offA[h][i]; } }
        for (int t = 0; t < nt; t += 2) {
            const bool last = (t == nt - 2);
            const char* a1 = cA + (size_t)(t + 1) * kstep;
            const char* a2 = last ? nA : cA + (size_t)(t + 2) * kstep; const char* b2 = last ? nB : cB + (size_t)(t + 2) * kstep;
            const char* a3 = a2 + kstep; const char* b3 = b2 + kstep;
            PG8_LDB(B0, 0, 0); PG8_LDB(B1, 0, 1); PG8_SCHED; PG8_LDA(At, 0, 0); PG8_STAGE_A(PG8_SA(1, 1), a1, offA, 1);
            if (GATHER && last) { asm volatile("" ::: "memory");
#pragma unroll
                for (int h = 0; h < 2; ++h)
#pragma unroll
                    for (int i = 0; i < 2; ++i) offA[h][i] = noffA[h][i]; }
            PG8_WAIT_V(8); PG8_WAIT_L(0); PG8_BAR; PG8_MMA(0, 0, At, B0); PG8_MMA(0, 1, At, B1); PG8_BAR; PG8_SCHED;
            PG8_LDA(At, 0, 1); PG8_STAGE_B(PG8_SB(0, 0), b2); PG8_STAGE_B(PG8_SB(0, 1), b2 + hstep); PG8_STAGE_A(PG8_SA(0, 0), a2, offA, 0);
            PG8_WAIT_V(8); PG8_WAIT_L(0); PG8_BAR; PG8_MMA(1, 0, At, B0); PG8_MMA(1, 1, At, B1); PG8_BAR; PG8_SCHED;
            PG8_LDB(B0, 1, 0); PG8_LDB(B1, 1, 1); PG8_SCHED; PG8_LDA(At, 1, 0); PG8_STAGE_A(PG8_SA(0, 1), a2, offA, 1);
            PG8_WAIT_V(8); PG8_WAIT_L(0); PG8_BAR; PG8_MMA(0, 0, At, B0); PG8_MMA(0, 1, At, B1); PG8_BAR; PG8_SCHED;
            PG8_LDA(At, 1, 1); PG8_STAGE_B(PG8_SB(1, 0), b3); PG8_STAGE_B(PG8_SB(1, 1), b3 + hstep); PG8_STAGE_A(PG8_SA(1, 0), a3, offA, 0);
            PG8_WAIT_V(8); PG8_WAIT_L(0); PG8_BAR; PG8_MMA(1, 0, At, B0); PG8_MMA(1, 1, At, B1); PG8_BAR; PG8_SCHED;
        }
        if (wr == 0) PG8_BAR;
        asm volatile("s_nop 15\n\ts_nop 15\n\ts_nop 15\n\ts_nop 15" ::: "memory");
        E(acc, cur, wr, wc, fr, fq);
        if (!has_next) break;
#pragma unroll
        for (int a = 0; a < 2; ++a)
#pragma unroll
            for (int b = 0; b < 2; ++b)
#pragma unroll
                for (int m = 0; m < 4; ++m)
#pragma unroll
                    for (int n = 0; n < 2; ++n) acc[a][b][m][n] = (f32x4){0.f, 0.f, 0.f, 0.f};
        cur = nxt; cA = nA; cB = nB; ++ui;
        if (wr == 1) PG8_BAR;
    }
    PG8_WAIT_V(0);
    PG8_BAR;
#undef PG8_SA
#undef PG8_SB
#undef PG8_STAGE_A
#undef PG8_STAGE_B
#undef PG8_LDA
#undef PG8_LDB
#undef PG8_MMA
#undef PG8_WAIT_V
#undef PG8_WAIT_L
#undef PG8_BAR
#undef PG8_SCHED
#undef PG8_ROWS
}

struct DenseOrder {
    const char* A; const char* Bt; int K; int nM, nN, nwg, G, c, rep;
    __device__ __forceinline__ bool next(int i, Unit& u) const {
        const long L = (long)i * G + c; if (L >= (long)nwg * rep) return false;
        int wgid = (int)(L % nwg); { const int q = nwg / 8, r = nwg % 8, xcd = wgid % 8, off = wgid / 8; wgid = (xcd < r ? xcd * (q + 1) : r * (q + 1) + (xcd - r) * q) + off; }
        const int nig = 8 * nN, gid = wgid / nig, fm = gid * 8, gsz = (nM - fm) < 8 ? (nM - fm) : 8;
        const int pm = fm + ((wgid % nig) % gsz), pn = (wgid % nig) / gsz;
        u.A = A + (size_t)pm * BM * K * 2; u.B = Bt + (size_t)pn * BM * K * 2; u.rows = nullptr; u.nvalid = BM; u.row0 = pm * BM; u.col0 = pn * BM; u.aux = 0; return true;
    }
};
struct MoeOrder {
    const char* A; const char* W; const int* list; const LAS int* cnt; const LAS int* offp;
    int npn; size_t wstride; int K; bool gather; int G, c;
    __device__ __forceinline__ bool next(int i, Unit& u) const {
        const int x = c & 7, j = c >> 3, W8 = G >> 3; int q = j + i * W8;
#pragma unroll
        for (int s = 0; s < 4; ++s) { const int e = x + 8 * s; const int n = cnt[e]; const int ntile = (n + 255) >> 8; const int ne = ntile * npn;
            if (q < ne) { const int ti = q / npn, pn = q % npn;
                u.B = W + (size_t)e * wstride + (size_t)pn * BM * K * 2; u.row0 = offp[e] + ti * BM; u.col0 = pn * BM; u.aux = e;
                u.nvalid = (n - ti * BM) < BM ? (n - ti * BM) : BM;
                if (gather) { u.A = A; u.rows = list + (size_t)e * NTOK + ti * BM; } else { u.A = A + (size_t)u.row0 * K * 2; u.rows = nullptr; }
                return true; }
            q -= ne; }
        return false;
    }
};

struct EpiProj {
    static constexpr bool PERM = true;
    bf16_t* O; int ldc; int qcols; float qscale;
    __device__ __forceinline__ void operator()(const f32x4 (&acc)[2][2][4][2], const Unit& u, int wr, int wc, int fr, int fq) const {
        const int row0 = u.row0 + wr * 64 + fr, col0 = u.col0 + wc * 32 + 8 * fq;
        const float sc = (u.col0 < qcols) ? qscale : 1.f;
#pragma unroll
        for (int ai = 0; ai < 2; ++ai)
#pragma unroll
            for (int m = 0; m < 4; ++m) { bf16_t* rowp = O + (size_t)(row0 + ai * HALF + m * 16) * ldc + col0;
#pragma unroll
                for (int bj = 0; bj < 2; ++bj) { const f32x4 v0 = acc[ai][bj][m][0] * sc, v1 = acc[ai][bj][m][1] * sc;
                    u32x4 w; w.x = cvt_pk_bf16(v0[0], v0[1]); w.y = cvt_pk_bf16(v0[2], v0[3]); w.z = cvt_pk_bf16(v1[0], v1[1]); w.w = cvt_pk_bf16(v1[2], v1[3]);
                    *(u32x4*)(rowp + bj * HALF) = w; } }
    }
};
struct EpiF32 {
    static constexpr bool PERM = false;
    float* C; int ldc;
    __device__ __forceinline__ void operator()(const f32x4 (&acc)[2][2][4][2], const Unit& u, int wr, int wc, int fr, int fq) const {
        const int row0 = u.row0 + wr * 64 + fr, col0 = u.col0 + wc * 32 + 4 * fq;
#pragma unroll
        for (int ai = 0; ai < 2; ++ai)
#pragma unroll
            for (int m = 0; m < 4; ++m) { float* rowp = C + (size_t)(row0 + ai * HALF + m * 16) * ldc + col0;
#pragma unroll
                for (int bj = 0; bj < 2; ++bj)
#pragma unroll
                    for (int n = 0; n < 2; ++n) *(f32x4*)(rowp + bj * HALF + n * 16) = acc[ai][bj][m][n]; }
    }
};
struct EpiBf16 {
    static constexpr bool PERM = false;
    bf16_t* C; int ldc;
    __device__ __forceinline__ void operator()(const f32x4 (&acc)[2][2][4][2], const Unit& u, int wr, int wc, int fr, int fq) const {
        const int row0 = u.row0 + wr * 64 + fr, col0 = u.col0 + wc * 32 + 4 * fq;
#pragma unroll
        for (int ai = 0; ai < 2; ++ai)
#pragma unroll
            for (int m = 0; m < 4; ++m) { bf16_t* rowp = C + (size_t)(row0 + ai * HALF + m * 16) * ldc + col0;
#pragma unroll
                for (int bj = 0; bj < 2; ++bj)
#pragma unroll
                    for (int n = 0; n < 2; ++n) { const f32x4 v = acc[ai][bj][m][n]; u32x2 w; w.x = cvt_pk_bf16(v[0], v[1]); w.y = cvt_pk_bf16(v[2], v[3]); *(u32x2*)(rowp + bj * HALF + n * 16) = w; } }
    }
};
struct EpiSwiglu {
    static constexpr bool PERM = true;
    bf16_t* O; const float* bias;
    __device__ __forceinline__ void operator()(const f32x4 (&acc)[2][2][4][2], const Unit& u, int wr, int wc, int fr, int fq) const {
        const int row0 = u.row0 + wr * 64 + fr, ac0 = (u.col0 >> 1) + wc * 32 + 8 * fq;
        const float* bg = bias + (size_t)u.aux * 2048 + ac0; const float* bu = bg + 1024;
        f32x4 bgv[2], buv[2];
#pragma unroll
        for (int n = 0; n < 2; ++n) { bgv[n] = *(const f32x4*)(bg + 4 * n); buv[n] = *(const f32x4*)(bu + 4 * n); }
        typedef float f32x2 __attribute__((ext_vector_type(2)));
        auto pk_add = [](f32x2 x, f32x2 y) { return x + y; };
        auto pk_mul = [](f32x2 x, f32x2 y) { return x * y; };
        auto pk_fma = [](f32x2 x, f32x2 y, f32x2 z) { return __builtin_elementwise_fma(x, y, z); };
        const f32x2 kk = {-1.702f * LOG2E, -1.702f * LOG2E}, one2 = {1.f, 1.f};
#pragma unroll
        for (int ai = 0; ai < 2; ++ai)
#pragma unroll
            for (int m = 0; m < 4; ++m) { bf16_t* rowp = O + (size_t)(row0 + ai * HALF + m * 16) * 1024 + ac0; f32x2 o[4];
#pragma unroll
                for (int n = 0; n < 2; ++n) { const f32x4 ga = acc[ai][0][m][n], ua = acc[ai][1][m][n];
#pragma unroll
                    for (int h = 0; h < 2; ++h) {
                        const f32x2 g = pk_add((f32x2){ga[2 * h], ga[2 * h + 1]}, (f32x2){bgv[n][2 * h], bgv[n][2 * h + 1]}), uu = pk_add((f32x2){ua[2 * h], ua[2 * h + 1]}, (f32x2){buv[n][2 * h], buv[n][2 * h + 1]});
                        const f32x2 a = {fminf(g[0], 7.f), fminf(g[1], 7.f)}, b = {fminf(fmaxf(uu[0], -7.f), 7.f), fminf(fmaxf(uu[1], -7.f), 7.f)};
                        const f32x2 t = pk_mul(a, kk);
                        const f32x2 d = pk_add((f32x2){__builtin_amdgcn_exp2f(t[0]), __builtin_amdgcn_exp2f(t[1])}, one2);
                        const f32x2 p = pk_mul(a, (f32x2){__builtin_amdgcn_rcpf(d[0]), __builtin_amdgcn_rcpf(d[1])});
                        o[2 * n + h] = pk_fma(p, b, p); } }
                u32x4 w; w.x = cvt_pk_bf16(o[0][0], o[0][1]); w.y = cvt_pk_bf16(o[1][0], o[1][1]); w.z = cvt_pk_bf16(o[2][0], o[2][1]); w.w = cvt_pk_bf16(o[3][0], o[3][1]);
                *(u32x4*)rowp = w; }
    }
};
struct EpiDown {
    static constexpr bool PERM = true;
    bf16_t* O; const float* bias;
    __device__ __forceinline__ void operator()(const f32x4 (&acc)[2][2][4][2], const Unit& u, int wr, int wc, int fr, int fq) const {
        const int row0 = u.row0 + wr * 64 + fr, col0 = u.col0 + wc * 32 + 8 * fq;
        const float* bb = bias + (size_t)u.aux * 1024 + col0;
        f32x4 bv[2][2];
#pragma unroll
        for (int bj = 0; bj < 2; ++bj)
#pragma unroll
            for (int n = 0; n < 2; ++n) bv[bj][n] = *(const f32x4*)(bb + bj * HALF + 4 * n);
#pragma unroll
        for (int ai = 0; ai < 2; ++ai)
#pragma unroll
            for (int m = 0; m < 4; ++m) { bf16_t* rowp = O + (size_t)(row0 + ai * HALF + m * 16) * 1024 + col0;
#pragma unroll
                for (int bj = 0; bj < 2; ++bj) { const f32x4 v0 = acc[ai][bj][m][0] + bv[bj][0], v1 = acc[ai][bj][m][1] + bv[bj][1];
                    u32x4 w; w.x = cvt_pk_bf16(v0[0], v0[1]); w.y = cvt_pk_bf16(v0[2], v0[3]); w.z = cvt_pk_bf16(v1[0], v1[1]); w.w = cvt_pk_bf16(v1[2], v1[3]);
                    *(u32x4*)(rowp + bj * HALF) = w; } }
    }
};
}
namespace attn_body {
#ifndef MK_NOBIAS0
#define MK_NOBIAS0 0
#endif
#ifndef MK_NOBIAS
#define MK_NOBIAS 0
#endif
constexpr int D = 64, NW = 8, QBLK = 32, QB = QBLK * NW, KVBLK = 64, NQB = T / QB;
constexpr int NSLOT = 3, SLOTB = 9216, NVSLOT = 4, VSLOT = 16384;
constexpr int LDS_K = 0, LDS_V = NSLOT * SLOTB, LDS_WS = NSLOT * SLOTB + NVSLOT * VSLOT, LDS_OST = LDS_WS + NW * 64 * 4, LDS_TB = LDS_OST + NW * 4096, LDS_UNIT = LDS_TB + T5N * 4, LDS_BYTES = LDS_UNIT + 16;
static_assert(LDS_BYTES <= CTRL_OFF, "attention LDS");
__device__ __forceinline__ int crow(int r, int hi) { return (r & 3) + 8 * (r >> 2) + 4 * hi; }
#define SBAR() __builtin_amdgcn_sched_barrier(0)
__device__ __forceinline__ void cmask(f32x16& p0, f32x16& p1, int jb, int qrel, int hi) {
    const float NEG = -INFINITY; const int lim = qrel - 64 * jb - 4 * hi;
#pragma unroll
    for (int r = 0; r < 16; ++r) { const int c = (r & 3) + 8 * (r >> 2); if (c > lim) p0[r] = NEG; if (c + 32 > lim) p1[r] = NEG; }
}
__device__ __forceinline__ void glds16(const void* sbase, unsigned voff, unsigned lds_dst) { unsigned keep;
    asm volatile("s_mov_b32 %0, m0\n\ts_mov_b32 m0, %3\n\ts_nop 0\n\tglobal_load_lds_dwordx4 %1, %2\n\ts_mov_b32 m0, %0" : "=&s"(keep) : "v"(voff), "s"(sbase), "s"(lds_dst) : "memory"); }
__device__ __forceinline__ float max3f(float a, float b, float c) { float r; asm("v_max3_f32 %0, %1, %2, %3" : "=v"(r) : "v"(a), "v"(b), "v"(c)); return r; }
__device__ __forceinline__ float max2f(float a, float b) { float r; asm("v_max_f32_e32 %0, %1, %2" : "=v"(r) : "v"(a), "v"(b)); return r; }
__device__ __forceinline__ float fadd_s(float a, float b) { float r; asm("v_add_f32_e32 %0, %1, %2" : "=v"(r) : "v"(a), "v"(b)); return r; }
__device__ __forceinline__ float fsub_s(float a, float b) { float r; asm("v_sub_f32_e32 %0, %1, %2" : "=v"(r) : "v"(a), "v"(b)); return r; }
typedef __bf16 bf16x2_t __attribute__((ext_vector_type(2)));
__device__ __forceinline__ unsigned cvtpk_s(float lo, float hi) { f32x2 v = {lo, hi}; bf16x2_t b = __builtin_convertvector(v, bf16x2_t); return __builtin_bit_cast(unsigned, b); }
#define WAIT_BAR(N) asm volatile("s_waitcnt vmcnt(" #N ") lgkmcnt(0)\n\ts_barrier" ::: "memory")
typedef LAS const char* lds_cptr;
typedef short v4i16_t __attribute__((ext_vector_type(4)));
__device__ __forceinline__ void kload2(bf16x8* kf, lds_cptr kp, int j) { kf[2 * j] = *(const LAS bf16x8*)(kp + j * 2048); kf[2 * j + 1] = *(const LAS bf16x8*)(kp + j * 2048 + 512); }
__device__ __forceinline__ s16x4 vtr(lds_cptr p) { return __builtin_bit_cast(s16x4, __builtin_amdgcn_ds_read_tr16_b64_v4i16((LAS v4i16_t*)p)); }
__device__ __forceinline__ float rowmax(const f32x16& p0, const f32x16& p1) {
    float a = max3f(p0[0], p0[1], p1[0]), b = max3f(p0[2], p0[3], p1[1]); a = max3f(a, p1[2], p1[3]);
#pragma unroll
    for (int r = 4; r < 16; r += 4) { a = max3f(a, p0[r], p0[r + 1]); b = max3f(b, p0[r + 2], p0[r + 3]); a = max3f(a, p1[r], p1[r + 1]); b = max3f(b, p1[r + 2], p1[r + 3]); }
    const float m = max2f(a, b);
    auto rr = __builtin_amdgcn_permlane32_swap(__float_as_uint(m), __float_as_uint(m), false, false);
    return max2f(__uint_as_float(rr[0]), __uint_as_float(rr[1]));
}
__device__ __forceinline__ void pv(f32x16* o, int vb, bf16x8 pa0, bf16x8 pa1, bf16x8 pa2, bf16x8 pa3) {
#pragma unroll
    for (int d0 = 0; d0 < 2; ++d0) { s16x4 lo[4], hi[4];
#pragma unroll
        for (int ks = 0; ks < 4; ++ks) {
            asm volatile("ds_read_b64_tr_b16 %0,%1 offset:%c2" : "=&v"(lo[ks]) : "v"(vb), "i"(d0 * 4096 + ks * 1024) : "memory");
            asm volatile("ds_read_b64_tr_b16 %0,%1 offset:%c2" : "=&v"(hi[ks]) : "v"(vb), "i"(d0 * 4096 + ks * 1024 + 512) : "memory"); }
        asm volatile("s_waitcnt lgkmcnt(0)" ::: "memory"); SBAR();
#define PK(k) (bf16x8){lo[k][0], lo[k][1], lo[k][2], lo[k][3], hi[k][0], hi[k][1], hi[k][2], hi[k][3]}
        o[d0] = __builtin_amdgcn_mfma_f32_32x32x16_bf16(pa0, PK(0), o[d0], 0, 0, 0);
        o[d0] = __builtin_amdgcn_mfma_f32_32x32x16_bf16(pa1, PK(1), o[d0], 0, 0, 0);
        o[d0] = __builtin_amdgcn_mfma_f32_32x32x16_bf16(pa2, PK(2), o[d0], 0, 0, 0);
        o[d0] = __builtin_amdgcn_mfma_f32_32x32x16_bf16(pa3, PK(3), o[d0], 0, 0, 0);
#undef PK
    }
}
struct AttnP {
    const bf16_t* proj;
    bf16_t* out;
    const float* t5tab;
    const float* cum2;
    const bf16_t* kb8;
    float xthr;
};

template <int MODE, int THRL>
__device__ __forceinline__ void attn_unit(const AttnP& P, int b, int vh, int qb, char* shm, const int tid) {
    const int lane = tid & 63, r32 = lane & 31, hi = lane >> 5; const int wid = __builtin_amdgcn_readfirstlane(tid >> 6);
    int h, qcol, kcol, vcol, ocol;
    constexpr bool T5 = (MODE == 0 || MODE == 2); constexpr int NH = (MODE == 2) ? 2 : 1;
    if (MODE == 0) { h = vh >> 2; const int m = (vh >> 1) & 1, half = vh & 1; qcol = h * 128 + m * 64; kcol = 512 + h * 128 + m * 64; vcol = 1024 + h * 128 + half * 64; ocol = (h * 2 + m) * 128 + half * 64; }
    else if (MODE == 2) { h = vh >> 1; const int m = vh & 1; qcol = h * 128 + m * 64; kcol = 512 + h * 128 + m * 64; vcol = 1024 + h * 128; ocol = (h * 2 + m) * 128; }
    else { h = vh; qcol = h * 64; kcol = 1024 + h * 64; vcol = 2048 + h * 64; ocol = h * 64; }
    const long rowbase = (long)b * T; const int q0 = qb * QB;
    const bf16_t* Qw = P.proj + (rowbase + q0 + wid * QBLK) * PITCH + qcol;
    const bf16_t* Kh = P.proj + rowbase * PITCH + kcol; const bf16_t* Vh = P.proj + rowbase * PITCH + vcol; int tskip = 0;
    const unsigned lds0 = (unsigned)(uintptr_t)shm;
    float* wsf = (float*)(shm + LDS_WS) + wid * 64;
    const unsigned kvoff = (unsigned)(lane * PITCH + wid * 8) * 2u;
    const unsigned vvoff = (unsigned)((16 * (wid & 3) + (lane >> 2)) * PITCH + (wid >> 2) * 32 + (lane & 3) * 8) * 2u;
    const bf16_t* k8h = (MODE == 1) ? P.kb8 + (long)(b * 16 + h) * T * 8 : nullptr; const unsigned k8voff = (unsigned)lane * 16u;
    const unsigned kdst = lds0 + LDS_K + wid * 1024, vdst = lds0 + LDS_V + wid * 1024, k8dst = lds0 + LDS_K + 8192;
#define DMA_K(t, slot) do { glds16(Kh + (long)(t) * KVBLK * PITCH, kvoff, (unsigned)__builtin_amdgcn_readfirstlane(kdst + (slot))); \
        if (MODE == 1 && wid == 0) glds16(k8h + (long)((t) + tskip) * KVBLK * 8, k8voff, (unsigned)__builtin_amdgcn_readfirstlane(k8dst + (slot))); } while (0)
#define DMA_V(t, slot) do { _Pragma("unroll") for (int hh_ = 0; hh_ < NH; ++hh_) glds16(Vh + (long)(t) * KVBLK * PITCH + hh_ * 64, vvoff, (unsigned)__builtin_amdgcn_readfirstlane(vdst + (slot) + hh_ * 8192)); } while (0)
#define WAITKV_22() do { if (MODE == 2) { WAIT_BAR(6); } else if (MODE == 1 && wid == 0) { WAIT_BAR(6); } else { WAIT_BAR(4); } } while (0)
#define WAITKV_12() do { if (MODE == 2) { WAIT_BAR(5); } else if (MODE == 1 && wid == 0) { WAIT_BAR(4); } else { WAIT_BAR(3); } } while (0)
#define WAITKV_11() do { if (MODE == 2) { WAIT_BAR(3); } else if (MODE == 1 && wid == 0) { WAIT_BAR(3); } else { WAIT_BAR(2); } } while (0)
#define WAITKV_02() do { if (MODE == 2) { WAIT_BAR(4); } else { WAIT_BAR(2); } } while (0)
    const int vb0 = (int)(lds0 + LDS_V) + ((lane >> 4) & 1) * 32 + (lane & 3) * 8 + (4 * hi + ((lane & 15) >> 2)) * 64;
    constexpr int NKF = (MODE == 1) ? 10 : 8;
    bf16x8 kf[NKF];
    const lds_cptr shm3 = (lds_cptr)shm; const lds_cptr kp0 = shm3 + LDS_K + hi * 1024 + r32 * 16; const lds_cptr kp8 = shm3 + LDS_K + 8192 + r32 * 16;
    const lds_cptr vp0 = shm3 + LDS_V + ((lane >> 4) & 1) * 32 + (lane & 3) * 8 + (4 * hi + ((lane & 15) >> 2)) * 64;
    int NT = (q0 + QB) / KVBLK;
    if (MODE == 1) {
        const float* cu = P.cum2 + (long)(b * 16 + h) * T; const float cq0 = cu[q0];
        int first = NT;
        for (int base = 0; base < NT; base += 64) { const int tt = base + lane; const bool keep = tt < NT && (cu[tt < NT ? 64 * tt + 63 : 0] - cq0 <= P.xthr);
            const unsigned long long mk = __ballot(keep); if (mk) { first = base + (int)__builtin_ctzll(mk); break; } }
        int t0 = first < NT - 4 ? first : NT - 4; t0 &= ~1; t0 = __builtin_amdgcn_readfirstlane(t0);
        Kh += (long)t0 * KVBLK * PITCH; Vh += (long)t0 * KVBLK * PITCH; NT -= t0; tskip = t0;
    }
    DMA_K(0, 0); DMA_V(0, 0); DMA_K(1, SLOTB); DMA_V(1, VSLOT);
    constexpr int NQR = (MODE == 1) ? 5 : 4;
    bf16x8 qr[NQR];
#pragma unroll
    for (int d0 = 0; d0 < 4; ++d0) qr[d0] = *reinterpret_cast<const bf16x8*>(&Qw[(long)r32 * PITCH + d0 * 16 + hi * 8]);
    const int qrel = wid * QBLK + r32;
    const lds_cptr qp0 = shm3 + LDS_OST + wid * 4096 + hi * 512 + r32 * 16;
#define QF(d0) (qr[d0])
    if (MODE == 1) {
        const float c = P.cum2[(long)(b * 16 + h) * T + q0 + qrel];
        const unsigned ch = f2bf(c); const float r1 = c - __builtin_bit_cast(float, ch << 16); const unsigned cm = f2bf(r1); const float r2 = r1 - __builtin_bit_cast(float, cm << 16); const unsigned cl = f2bf(r2);
        u32x4 w; w.x = ch | (cm << 16); w.y = cl | (0x3f80u << 16); w.z = 0x3f80u | (0x3f80u << 16); w.w = 0u;
        if (hi) w = (u32x4){0u, 0u, 0u, 0u};
        qr[NQR - 1] = __builtin_bit_cast(bf16x8, w);
    }
    float mhat = 0.f, l_reg = 0.f; f32x16 o[2 * NH];
#pragma unroll
    for (int d_ = 0; d_ < 2 * NH; ++d_) o[d_] = f32x16{};
    const f32x16 zero16 = f32x16{}; f32x2 mh2 = {0.f, 0.f};
    const float* tblo = (const float*)(shm + LDS_TB) + (q0 + qrel - 4 * hi - 63 + T5PAD);
#ifndef MK_NOBIAS
#define MK_NOBIAS 0
#endif
#ifndef MK_NOBIAS
#define MK_NOBIAS 0
#endif
#define PRE(P0, P1, t, WITHBIAS) do { \
        if (T5 && (WITHBIAS) && !MK_NOBIAS) { const float* tb_ = tblo - 64 * (t); \
            _Pragma("unroll") for (int r = 0; r < 16; ++r) { const int kv0_ = (r & 3) + 8 * (r >> 2); P0[r] = tb_[63 - kv0_]; P1[r] = tb_[31 - kv0_]; } } \
        else { _Pragma("unroll") for (int r = 0; r < 16; ++r) { P0[r] = 0.f; P1[r] = 0.f; } } \
        { const int jb_ = (t) - (NT - 4); if (jb_ >= 0) cmask(P0, P1, jb_, qrel, hi); } } while (0)
    bool resc = false;
#define RESC() do { if (resc) { asm volatile("s_nop 15\n\ts_nop 15\n\ts_nop 15\n\ts_nop 15\n\ts_waitcnt lgkmcnt(0)" : "+v"(o[0]), "+v"(o[1]) :: "memory"); if (NH == 2) asm volatile("" : "+v"(o[2 * NH - 2]), "+v"(o[2 * NH - 1]));     \
      _Pragma("unroll") for (int d_ = 0; d_ < 2 * NH; ++d_) _Pragma("unroll") for (int r = 0; r < 16; ++r) o[d_][r] *= wsf[crow(r, hi)]; } } while (0)
    f32x16 cA, cB;
    u32x4 pwa0, pwa1, pwa2, pwa3, pwb0, pwb1, pwb2, pwb3;
    int sl_prev = 0, sl_cur = 0, sl_next = SLOTB;
    int sv_prev = 0, sv_cur = 0, sv_next = VSLOT, sv_nn = 2 * VSLOT;
#define ROT() do { sl_prev = sl_cur; sl_cur = sl_next; sl_next = (sl_next == (NSLOT - 1) * SLOTB) ? 0 : sl_next + SLOTB; sv_prev = sv_cur; sv_cur = sv_next; sv_next = sv_nn; sv_nn = (sv_nn == (NVSLOT - 1) * VSLOT) ? 0 : sv_nn + VSLOT; } while (0)
    DMA_K(2, 2 * SLOTB);
    WAITKV_22();
    PRE(cA, cB, 0, (NT <= 28 && !MK_NOBIAS0));
    { const char* kb = shm + LDS_K + hi * 1024 + r32 * 16;
#pragma unroll
      for (int d0 = 0; d0 < 4; ++d0) {
          const bf16x8 b0 = *reinterpret_cast<const bf16x8*>(kb + d0 * 2048);
          const bf16x8 b1 = *reinterpret_cast<const bf16x8*>(kb + d0 * 2048 + 512);
          if (d0 == 0) { cA = __builtin_amdgcn_mfma_f32_32x32x16_bf16(b0, qr[0], cA, 0, 0, 0); cB = __builtin_amdgcn_mfma_f32_32x32x16_bf16(b1, qr[0], cB, 0, 0, 0); }
          else { cA = __builtin_amdgcn_mfma_f32_32x32x16_bf16(b0, qr[d0], cA, 0, 0, 0); cB = __builtin_amdgcn_mfma_f32_32x32x16_bf16(b1, qr[d0], cB, 0, 0, 0); } }
      if (MODE == 1) { const char* k8 = shm + LDS_K + 8192 + r32 * 16;
          const bf16x8 b0 = *reinterpret_cast<const bf16x8*>(k8); const bf16x8 b1 = *reinterpret_cast<const bf16x8*>(k8 + 512);
          cA = __builtin_amdgcn_mfma_f32_32x32x16_bf16(b0, qr[NQR - 1], cA, 0, 0, 0); cB = __builtin_amdgcn_mfma_f32_32x32x16_bf16(b1, qr[NQR - 1], cB, 0, 0, 0); } }
    asm volatile("s_nop 15\n\ts_nop 15\n\ts_nop 15\n\ts_nop 15\n\ts_nop 15" : "+v"(cA), "+v"(cB));
#ifndef MK_NOBIAS0
#define MK_NOBIAS0 0
#endif
#define PKW(P, B) cvtpk_s(P[B], P[B + 1])
    { mhat = rowmax(cA, cB); mh2 = (f32x2){mhat, mhat}; float sacc = 0.f;
      _Pragma("unroll") for (int r = 0; r < 16; ++r) { cA[r] = __builtin_amdgcn_exp2f(fsub_s(cA[r], mhat)); cB[r] = __builtin_amdgcn_exp2f(fsub_s(cB[r], mhat)); }
      _Pragma("unroll") for (int r = 0; r < 16; ++r) sacc += cA[r] + cB[r];
      l_reg = sacc;
      pwa0 = (u32x4){PKW(cA, 0), PKW(cA, 2), PKW(cA, 4), PKW(cA, 6)}; pwa1 = (u32x4){PKW(cA, 8), PKW(cA, 10), PKW(cA, 12), PKW(cA, 14)};
      pwa2 = (u32x4){PKW(cB, 0), PKW(cB, 2), PKW(cB, 4), PKW(cB, 6)}; pwa3 = (u32x4){PKW(cB, 8), PKW(cB, 10), PKW(cB, 12), PKW(cB, 14)}; }
    WAIT_BAR(0);
    DMA_K(3, 0); DMA_V(2, 2 * VSLOT);
    ROT();
#pragma unroll
    for (int j = 0; j < 4; ++j) kload2(kf, kp0 + sl_cur, j);
    if (MODE == 1) { kf[8] = *(const LAS bf16x8*)(kp8 + sl_cur); kf[9] = *(const LAS bf16x8*)(kp8 + sl_cur + 512); }
    WAITKV_11();
    s16x4 vlo[NH == 2 ? 1 : 8], vhi[NH == 2 ? 1 : 8]; s16x4 vwl[4], vwh[4];
#define PAF(PW, k) __builtin_bit_cast(bf16x8, PW##k)
#define VFR(i) (bf16x8){vlo[i][0], vlo[i][1], vlo[i][2], vlo[i][3], vhi[i][0], vhi[i][1], vhi[i][2], vhi[i][3]}
#define PIN(x) asm volatile("" : "+v"(x))
#define MX3(a, b, c) __builtin_fmaxf(__builtin_fmaxf((a), (b)), (c))
#define GAPA(MF) do { MF; SBAR(); } while (0)
#define EX(v) __builtin_amdgcn_exp2f(v)
#define GAPB(MF, X, B, PW, I) do { MF; { f32x2 a_ = {X[B], X[B + 1]}, b_ = {X[B + 2], X[B + 3]}; a_ -= mh2; b_ -= mh2; const float e0_ = EX(a_.x), e1_ = EX(a_.y), e2_ = EX(b_.x), e3_ = EX(b_.y); \
        sacc += e0_; sacc += e1_; sacc += e2_; sacc += e3_; PW[I] = cvtpk_s(e0_, e1_); PW[I + 1] = cvtpk_s(e2_, e3_); } PIN(PW); PIN(sacc); SBAR(); } while (0)
#define VRD(i) do { vlo[i] = vtr(vp_ + (((i) >> 2) * 4096 + ((i) & 3) * 1024)); vhi[i] = vtr(vp_ + (((i) >> 2) * 4096 + ((i) & 3) * 1024 + 512)); } while (0)
#define VRD1(i) do { if (NH == 2) { vlo[i] = vtr(vp_ + (8192 + ((i) >> 2) * 4096 + ((i) & 3) * 1024)); vhi[i] = vtr(vp_ + (8192 + ((i) >> 2) * 4096 + ((i) & 3) * 1024 + 512)); } } while (0)
#define GAPC(MF) do { if (NH == 2) { MF; SBAR(); } } while (0)
#define VW(w, half, i) do { vwl[w] = vtr(vp_ + ((half) * 8192 + ((i) >> 2) * 4096 + ((i) & 3) * 1024)); vwh[w] = vtr(vp_ + ((half) * 8192 + ((i) >> 2) * 4096 + ((i) & 3) * 1024 + 512)); } while (0)
#define VWF(w) (bf16x8){vwl[w][0], vwl[w][1], vwl[w][2], vwl[w][3], vwh[w][0], vwh[w][1], vwh[w][2], vwh[w][3]}
#define KRD(G, j) do { if (G) { kload2(kf, kp0 + sl_next, j); SBAR(); } } while (0)
#define KRD8(G) do { if (MODE == 1 && (G)) { kf[NKF - 2] = *(const LAS bf16x8*)(kp8 + sl_next); kf[NKF - 1] = *(const LAS bf16x8*)(kp8 + sl_next + 512); SBAR(); } } while (0)
#define STEP(PWC, PWN, t, GK, GV, GL, GPRE) do { SBAR(); if (GPRE) { PRE(cA, cB, t, true); SBAR(); } \
    const lds_cptr vp_ = vp0 + sv_prev; \
    bf16x8 qx0_, qx1_; \
    VRD(0); qx0_ = QF(0); SBAR(); GAPA(cA = (GPRE) ? __builtin_amdgcn_mfma_f32_32x32x16_bf16(kf[0], qx0_, cA, 0, 0, 0) : __builtin_amdgcn_mfma_f32_32x32x16_bf16(kf[0], qx0_, zero16, 0, 0, 0)); \
    VRD(4); qx1_ = QF(1); SBAR(); GAPA(cB = (GPRE) ? __builtin_amdgcn_mfma_f32_32x32x16_bf16(kf[1], qx0_, cB, 0, 0, 0) : __builtin_amdgcn_mfma_f32_32x32x16_bf16(kf[1], qx0_, zero16, 0, 0, 0)); \
    VRD(1); SBAR(); GAPA(cA = __builtin_amdgcn_mfma_f32_32x32x16_bf16(kf[2], qx1_, cA, 0, 0, 0)); \
    VRD(5); qx0_ = QF(2); SBAR(); GAPA(cB = __builtin_amdgcn_mfma_f32_32x32x16_bf16(kf[3], qx1_, cB, 0, 0, 0)); \
    VRD(2); SBAR(); GAPA(cA = __builtin_amdgcn_mfma_f32_32x32x16_bf16(kf[4], qx0_, cA, 0, 0, 0)); \
    VRD(6); qx1_ = QF(3); SBAR(); GAPA(cB = __builtin_amdgcn_mfma_f32_32x32x16_bf16(kf[5], qx0_, cB, 0, 0, 0)); \
    VRD(3); SBAR(); GAPA(cA = __builtin_amdgcn_mfma_f32_32x32x16_bf16(kf[6], qx1_, cA, 0, 0, 0)); \
    VRD(7); SBAR(); GAPA(cB = __builtin_amdgcn_mfma_f32_32x32x16_bf16(kf[7], qx1_, cB, 0, 0, 0)); \
    if (MODE == 1) { cA = __builtin_amdgcn_mfma_f32_32x32x16_bf16(kf[NKF - 2], qr[NQR - 1], cA, 0, 0, 0); cB = __builtin_amdgcn_mfma_f32_32x32x16_bf16(kf[NKF - 1], qr[NQR - 1], cB, 0, 0, 0); SBAR(); } \
    asm volatile("s_nop 15\n\ts_nop 7" : "+v"(cA), "+v"(cB));     \
    if (GK) { DMA_K((t) + 3, sl_cur); } if (GV) { DMA_V((t) + 2, sv_nn); } \
    { float a = MX3(cA[0], cA[1], cB[0]), b = MX3(cA[2], cA[3], cB[1]); a = MX3(a, cB[2], cB[3]); \
      _Pragma("unroll") for (int r = 4; r < 16; r += 4) { a = MX3(a, cA[r], cA[r + 1]); b = MX3(b, cA[r + 2], cA[r + 3]); a = MX3(a, cB[r], cB[r + 1]); b = MX3(b, cB[r + 2], cB[r + 3]); } \
      float rm = __builtin_fmaxf(a, b); { auto rr = __builtin_amdgcn_permlane32_swap(__float_as_uint(rm), __float_as_uint(rm), false, false); rm = __builtin_fmaxf(__uint_as_float(rr[0]), __uint_as_float(rr[1])); } \
      rm -= mhat; resc = false; \
      if (__builtin_expect(__any(rm > (float)THRL), 0)) { const float dl = __builtin_fmaxf(rm, 0.f); mhat += dl; mh2 = (f32x2){mhat, mhat}; \
        const float f = __builtin_amdgcn_exp2f(-dl); l_reg *= f; if (hi == 0) wsf[r32] = f; resc = true; } } \
    SBAR(); \
    float sacc = 0.f; \
    GAPB(o[0] = __builtin_amdgcn_mfma_f32_32x32x16_bf16(PAF(PWC, 0), VFR(0), o[0], 0, 0, 0), cA, 0, PWN##0, 0); VRD1(0); \
    GAPB(o[1] = __builtin_amdgcn_mfma_f32_32x32x16_bf16(PAF(PWC, 0), VFR(4), o[1], 0, 0, 0), cA, 4, PWN##0, 2); VRD1(4); \
    if (NH == 1) { KRD(GL, 0); } GAPB(o[0] = __builtin_amdgcn_mfma_f32_32x32x16_bf16(PAF(PWC, 1), VFR(1), o[0], 0, 0, 0), cA, 8, PWN##1, 0); VRD1(1); \
    if (NH == 1) { KRD(GL, 1); } GAPB(o[1] = __builtin_amdgcn_mfma_f32_32x32x16_bf16(PAF(PWC, 1), VFR(5), o[1], 0, 0, 0), cA, 12, PWN##1, 2); VRD1(5); \
    if (NH == 1) { KRD(GL, 2); } GAPB(o[0] = __builtin_amdgcn_mfma_f32_32x32x16_bf16(PAF(PWC, 2), VFR(2), o[0], 0, 0, 0), cB, 0, PWN##2, 0); VRD1(2); \
    if (NH == 1) { KRD(GL, 3); } GAPB(o[1] = __builtin_amdgcn_mfma_f32_32x32x16_bf16(PAF(PWC, 2), VFR(6), o[1], 0, 0, 0), cB, 4, PWN##2, 2); VRD1(6); \
    if (NH == 1) { KRD8(GL); } GAPB(o[0] = __builtin_amdgcn_mfma_f32_32x32x16_bf16(PAF(PWC, 3), VFR(3), o[0], 0, 0, 0), cB, 8, PWN##3, 0); VRD1(3); \
    GAPB(o[1] = __builtin_amdgcn_mfma_f32_32x32x16_bf16(PAF(PWC, 3), VFR(7), o[1], 0, 0, 0), cB, 12, PWN##3, 2); VRD1(7); \
    GAPC(o[2 * NH - 2] = __builtin_amdgcn_mfma_f32_32x32x16_bf16(PAF(PWC, 0), VFR(0), o[2 * NH - 2], 0, 0, 0)); \
    GAPC(o[2 * NH - 1] = __builtin_amdgcn_mfma_f32_32x32x16_bf16(PAF(PWC, 0), VFR(4), o[2 * NH - 1], 0, 0, 0)); \
    if (NH == 2) { KRD(GL, 0); } GAPC(o[2 * NH - 2] = __builtin_amdgcn_mfma_f32_32x32x16_bf16(PAF(PWC, 1), VFR(1), o[2 * NH - 2], 0, 0, 0)); \
    if (NH == 2) { KRD(GL, 1); } GAPC(o[2 * NH - 1] = __builtin_amdgcn_mfma_f32_32x32x16_bf16(PAF(PWC, 1), VFR(5), o[2 * NH - 1], 0, 0, 0)); \
    if (NH == 2) { KRD(GL, 2); } GAPC(o[2 * NH - 2] = __builtin_amdgcn_mfma_f32_32x32x16_bf16(PAF(PWC, 2), VFR(2), o[2 * NH - 2], 0, 0, 0)); \
    if (NH == 2) { KRD(GL, 3); } GAPC(o[2 * NH - 1] = __builtin_amdgcn_mfma_f32_32x32x16_bf16(PAF(PWC, 2), VFR(6), o[2 * NH - 1], 0, 0, 0)); \
    GAPC(o[2 * NH - 2] = __builtin_amdgcn_mfma_f32_32x32x16_bf16(PAF(PWC, 3), VFR(3), o[2 * NH - 2], 0, 0, 0)); \
    GAPC(o[2 * NH - 1] = __builtin_amdgcn_mfma_f32_32x32x16_bf16(PAF(PWC, 3), VFR(7), o[2 * NH - 1], 0, 0, 0)); \
    l_reg += sacc; \
    } while (0)
#define STEP2(PWC, PWN, t, GK, GV, GL, GPRE) do { SBAR(); if (GPRE) { PRE(cA, cB, t, true); SBAR(); } \
    const lds_cptr vp_ = vp0 + sv_prev; \
    bf16x8 qx0_, qx1_; \
    qx0_ = QF(0); SBAR(); GAPA(cA = (GPRE) ? __builtin_amdgcn_mfma_f32_32x32x16_bf16(kf[0], qx0_, cA, 0, 0, 0) : __builtin_amdgcn_mfma_f32_32x32x16_bf16(kf[0], qx0_, zero16, 0, 0, 0)); \
    qx1_ = QF(1); SBAR(); GAPA(cB = (GPRE) ? __builtin_amdgcn_mfma_f32_32x32x16_bf16(kf[1], qx0_, cB, 0, 0, 0) : __builtin_amdgcn_mfma_f32_32x32x16_bf16(kf[1], qx0_, zero16, 0, 0, 0)); \
    SBAR(); GAPA(cA = __builtin_amdgcn_mfma_f32_32x32x16_bf16(kf[2], qx1_, cA, 0, 0, 0)); \
    qx0_ = QF(2); SBAR(); GAPA(cB = __builtin_amdgcn_mfma_f32_32x32x16_bf16(kf[3], qx1_, cB, 0, 0, 0)); \
    SBAR(); GAPA(cA = __builtin_amdgcn_mfma_f32_32x32x16_bf16(kf[4], qx0_, cA, 0, 0, 0)); \
    qx1_ = QF(3); SBAR(); GAPA(cB = __builtin_amdgcn_mfma_f32_32x32x16_bf16(kf[5], qx0_, cB, 0, 0, 0)); \
    SBAR(); GAPA(cA = __builtin_amdgcn_mfma_f32_32x32x16_bf16(kf[6], qx1_, cA, 0, 0, 0)); \
    SBAR(); GAPA(cB = __builtin_amdgcn_mfma_f32_32x32x16_bf16(kf[7], qx1_, cB, 0, 0, 0)); \
    if (MODE == 1) { cA = __builtin_amdgcn_mfma_f32_32x32x16_bf16(kf[NKF - 2], qr[NQR - 1], cA, 0, 0, 0); cB = __builtin_amdgcn_mfma_f32_32x32x16_bf16(kf[NKF - 1], qr[NQR - 1], cB, 0, 0, 0); SBAR(); } \
    asm volatile("s_nop 15\n\ts_nop 7" : "+v"(cA), "+v"(cB));     \
    if (GK) { DMA_K((t) + 3, sl_cur); } if (GV) { DMA_V((t) + 2, sv_nn); } \
    VW(0, 0, 0); VW(1, 0, 4);        \
    { float a = MX3(cA[0], cA[1], cB[0]), b = MX3(cA[2], cA[3], cB[1]); a = MX3(a, cB[2], cB[3]); \
      _Pragma("unroll") for (int r = 4; r < 16; r += 4) { a = MX3(a, cA[r], cA[r + 1]); b = MX3(b, cA[r + 2], cA[r + 3]); a = MX3(a, cB[r], cB[r + 1]); b = MX3(b, cB[r + 2], cB[r + 3]); } \
      float rm = __builtin_fmaxf(a, b); { auto rr = __builtin_amdgcn_permlane32_swap(__float_as_uint(rm), __float_as_uint(rm), false, false); rm = __builtin_fmaxf(__uint_as_float(rr[0]), __uint_as_float(rr[1])); } \
      rm -= mhat; resc = false; \
      if (__builtin_expect(__any(rm > (float)THRL), 0)) { const float dl = __builtin_fmaxf(rm, 0.f); mhat += dl; mh2 = (f32x2){mhat, mhat}; \
        const float f = __builtin_amdgcn_exp2f(-dl); l_reg *= f; if (hi == 0) wsf[r32] = f; resc = true; } } \
    SBAR(); \
    float sacc = 0.f; \
    GAPB(o[0] = __builtin_amdgcn_mfma_f32_32x32x16_bf16(PAF(PWC, 0), VWF(0), o[0], 0, 0, 0), cA, 0, PWN##0, 0); VW(2, 0, 1); \
    GAPB(o[1] = __builtin_amdgcn_mfma_f32_32x32x16_bf16(PAF(PWC, 0), VWF(1), o[1], 0, 0, 0), cA, 4, PWN##0, 2); VW(3, 0, 5); \
    GAPB(o[0] = __builtin_amdgcn_mfma_f32_32x32x16_bf16(PAF(PWC, 1), VWF(2), o[0], 0, 0, 0), cA, 8, PWN##1, 0); VW(0, 0, 2); \
    GAPB(o[1] = __builtin_amdgcn_mfma_f32_32x32x16_bf16(PAF(PWC, 1), VWF(3), o[1], 0, 0, 0), cA, 12, PWN##1, 2); VW(1, 0, 6); \
    GAPB(o[0] = __builtin_amdgcn_mfma_f32_32x32x16_bf16(PAF(PWC, 2), VWF(0), o[0], 0, 0, 0), cB, 0, PWN##2, 0); VW(2, 0, 3); \
    GAPB(o[1] = __builtin_amdgcn_mfma_f32_32x32x16_bf16(PAF(PWC, 2), VWF(1), o[1], 0, 0, 0), cB, 4, PWN##2, 2); VW(3, 0, 7); \
    GAPB(o[0] = __builtin_amdgcn_mfma_f32_32x32x16_bf16(PAF(PWC, 3), VWF(2), o[0], 0, 0, 0), cB, 8, PWN##3, 0); VW(0, 1, 0); \
    GAPB(o[1] = __builtin_amdgcn_mfma_f32_32x32x16_bf16(PAF(PWC, 3), VWF(3), o[1], 0, 0, 0), cB, 12, PWN##3, 2); VW(1, 1, 4); \
    GAPC(o[2] = __builtin_amdgcn_mfma_f32_32x32x16_bf16(PAF(PWC, 0), VWF(0), o[2], 0, 0, 0)); VW(2, 1, 1); \
    GAPC(o[3] = __builtin_amdgcn_mfma_f32_32x32x16_bf16(PAF(PWC, 0), VWF(1), o[3], 0, 0, 0)); VW(3, 1, 5); \
    KRD(GL, 0); GAPC(o[2] = __builtin_amdgcn_mfma_f32_32x32x16_bf16(PAF(PWC, 1), VWF(2), o[2], 0, 0, 0)); VW(0, 1, 2); \
    KRD(GL, 1); GAPC(o[3] = __builtin_amdgcn_mfma_f32_32x32x16_bf16(PAF(PWC, 1), VWF(3), o[3], 0, 0, 0)); VW(1, 1, 6); \
    KRD(GL, 2); GAPC(o[2] = __builtin_amdgcn_mfma_f32_32x32x16_bf16(PAF(PWC, 2), VWF(0), o[2], 0, 0, 0)); VW(2, 1, 3); \
    KRD(GL, 3); GAPC(o[3] = __builtin_amdgcn_mfma_f32_32x32x16_bf16(PAF(PWC, 2), VWF(1), o[3], 0, 0, 0)); VW(3, 1, 7); \
    GAPC(o[2] = __builtin_amdgcn_mfma_f32_32x32x16_bf16(PAF(PWC, 3), VWF(2), o[2], 0, 0, 0)); \
    GAPC(o[3] = __builtin_amdgcn_mfma_f32_32x32x16_bf16(PAF(PWC, 3), VWF(3), o[3], 0, 0, 0)); \
    l_reg += sacc; \
    } while (0)
    int t = 1;
    for (; t + (T5 ? 29 : 5) < NT; t += 2) {
        if constexpr (NH == 2) { STEP2(pwa, pwb, t, true, true, true, false); } else { STEP(pwa, pwb, t, true, true, true, false); }     WAITKV_12(); RESC(); ROT();
        if constexpr (NH == 2) { STEP2(pwb, pwa, t + 1, true, true, true, false); } else { STEP(pwb, pwa, t + 1, true, true, true, false); } WAITKV_12(); RESC(); ROT();
    }
#define ENDW(tt) do { if ((tt) + 3 < NT) { WAITKV_12(); } else if ((tt) + 2 < NT) { WAITKV_02(); } else { WAIT_BAR(0); } } while (0)
    for (; t + 1 < NT; t += 2) {
        if constexpr (NH == 2) { STEP2(pwa, pwb, t, (t + 3 < NT), (t + 2 < NT), (t + 1 < NT), true); } else { STEP(pwa, pwb, t, (t + 3 < NT), (t + 2 < NT), (t + 1 < NT), true); }         ENDW(t);     RESC(); ROT();
        if constexpr (NH == 2) { STEP2(pwb, pwa, t + 1, (t + 4 < NT), (t + 3 < NT), (t + 2 < NT), true); } else { STEP(pwb, pwa, t + 1, (t + 4 < NT), (t + 3 < NT), (t + 2 < NT), true); }     ENDW(t + 1); RESC(); ROT();
    }
    if constexpr (NH == 2) { STEP2(pwa, pwb, NT - 1, false, false, false, true); } else { STEP(pwa, pwb, NT - 1, false, false, false, true); } RESC();
    SBAR(); pv(o, vb0 + sv_cur, PAF(pwb, 0), PAF(pwb, 1), PAF(pwb, 2), PAF(pwb, 3));
    if (NH == 2) pv(o + (2 * NH - 2), vb0 + sv_cur + 8192, PAF(pwb, 0), PAF(pwb, 1), PAF(pwb, 2), PAF(pwb, 3));
#undef PKW
#undef PAF
#undef VFR
#undef PIN
#undef MX3
#undef GAPA
#undef GAPB
#undef EX
#undef VRD
#undef KRD
#undef KRD8
#undef STEP
#undef STEP2
#undef VW
#undef VWF
#undef ENDW
    { auto rr = __builtin_amdgcn_permlane32_swap(__float_as_uint(l_reg), __float_as_uint(l_reg), false, false); l_reg = __uint_as_float(rr[0]) + __uint_as_float(rr[1]); }
    if (hi == 0) wsf[32 + r32] = l_reg; asm volatile("s_waitcnt lgkmcnt(0)" ::: "memory");
    float rli[16];
#pragma unroll
    for (int r = 0; r < 16; ++r) rli[r] = __builtin_amdgcn_rcpf(wsf[32 + crow(r, hi)]);
    bf16_t* Ow = P.out + (rowbase + q0 + wid * QBLK) * 1024 + ocol;
#pragma unroll
    for (int hh = 0; hh < NH; ++hh) { bf16_t* stg = (bf16_t*)(shm + LDS_OST) + wid * 2048;
#pragma unroll
      for (int r = 0; r < 16; ++r) { const int orow = crow(r, hi);
#pragma unroll
          for (int d0 = 0; d0 < 2; ++d0) stg[orow * 64 + d0 * 32 + r32] = (bf16_t)f2bf(o[2 * hh + d0][r] * rli[r]); }
      asm volatile("s_waitcnt lgkmcnt(0)" ::: "memory");
#pragma unroll
      for (int i = 0; i < 4; ++i) { const int row = i * 8 + (lane >> 3), ch = lane & 7; u32x4 v = *(const u32x4*)(stg + row * 64 + ch * 8);
          if (MODE == 1) {
              const u32x4 g = *(const u32x4*)(P.proj + (rowbase + q0 + wid * QBLK + row) * PITCH + 3072 + h * 64 + ch * 8);
              u32x4 w;
#pragma unroll
              for (int j = 0; j < 4; ++j) { const float a0 = bflo(v[j]) * sigmoid_f(bflo(g[j])), a1 = bfhi(v[j]) * sigmoid_f(bfhi(g[j])); w[j] = pk2(a0, a1); }
              v = w; }
          *(u32x4*)(Ow + (long)row * 1024 + hh * 64 + ch * 8) = v; }
      asm volatile("s_waitcnt lgkmcnt(0)" ::: "memory"); }
    asm volatile("s_waitcnt lgkmcnt(0)\n\ts_barrier" ::: "memory");
#undef DMA_K
#undef DMA_V
#undef WAITKV_22
#undef WAITKV_12
#undef WAITKV_11
#undef WAITKV_02
#undef VRD1
#undef QF
#undef GAPC
#undef PRE
#undef RESC
#undef ROT
}

#ifndef MK_THRL
#define MK_THRL 8
#endif
#ifndef MK_NOBIAS0
#define MK_NOBIAS0 0
#endif
#ifndef MK_NOBIAS
#define MK_NOBIAS 0
#endif
#ifndef MK_T5RELOAD
#define MK_T5RELOAD 0
#endif
template <int MODE>
__device__ __forceinline__ void attn_phase(char* lds, const AttnP& P, unsigned* queues  , unsigned xcc, const int tid) {
    volatile LAS int* uw = (volatile LAS int*)(LAS char*)(lds + LDS_UNIT); int cur_h = -1;
    for (int k = 0; k < 8; ++k) {
        const int qx = (int)((xcc + (unsigned)k) & 7u);
        for (;;) {
            if (tid == 0) uw[0] = (int)__hip_atomic_fetch_add(queues + 64 * qx, 1u, RLX_AGENT);
            __syncthreads();
            const int e = __builtin_amdgcn_readfirstlane(uw[0]);
            __syncthreads();
            constexpr int PERQ = (MODE == 2) ? 2 : 4;
#ifndef MK_QREP
#define MK_QREP 1
#endif
            constexpr int QREP = (MODE == 2) ? MK_QREP : 1;
            if (e >= QREP * PERQ * NQB) break;
            const int e1 = e % (PERQ * NQB); const int bvh = PERQ * qx + (e1 % PERQ), qb = NQB - 1 - (e1 / PERQ);
            const int ub = (MODE == 2) ? (bvh >> 3) : (bvh >> 4), uvh = (MODE == 2) ? (bvh & 7) : (bvh & 15), uh = (MODE == 2) ? (uvh >> 1) : (uvh >> 2);
            if ((MODE == 0 || MODE == 2) && (MK_T5RELOAD || uh != cur_h)) {
                cur_h = uh;
                LAS float* tb = (LAS float*)(LAS char*)(lds + LDS_TB) + tid; const GAS float* src = (const GAS float*)P.t5tab + (size_t)cur_h * T5N + tid; asm volatile("" : "+v"(tb), "+v"(src));
#pragma unroll
                for (int it = 0; it < (T5N + NTHR - 1) / NTHR; ++it) if (tid + NTHR * it < T5N) tb[NTHR * it] = src[NTHR * it];
                __syncthreads();
            }
            attn_unit<MODE, MK_THRL>(P, ub, uvh, qb, lds, tid);
        }
    }
}
#undef SBAR
#undef WAIT_BAR
}
struct Args { const float* in[24]; float* out; unsigned char* ws; const float* dbg_src; int lo, hi, bar_region, dbg_layer0; };
static_assert(sizeof(Args) == 27 * 8 + 16, "Args has padding");
template <int K_> __device__ __forceinline__ const float* inptr() {
#if defined(__HIP_DEVICE_COMPILE__)
    auto ka = __builtin_amdgcn_kernarg_segment_ptr(); const GAS float* p;
    asm volatile("s_load_dwordx2 %0, %1, %2\n\ts_waitcnt lgkmcnt(0)" : "=s"(p) : "s"(ka), "i"(K_ * 8)); return (const float*)p;
#else
    return nullptr;
#endif
}
#define INP(k) inptr<k>()
struct Frame {
    LAS unsigned char* lds; char* ldsg;
    gu32* ctl; unsigned char* ws;
    int tid, lane, wave, G, gw, NGW;
    float* out;
};
__device__ __forceinline__ float wave_sum(float v) {
#pragma unroll
    for (int o = 1; o < 64; o <<= 1) v += __shfl_xor(v, o);
    return v;
}
__device__ __forceinline__ float rowmax16(float v) {
    v = fmaxf(v, __builtin_bit_cast(float, __builtin_amdgcn_update_dpp(0, __builtin_bit_cast(int, v), 0xB1, 0xF, 0xF, false)));
    v = fmaxf(v, __builtin_bit_cast(float, __builtin_amdgcn_update_dpp(0, __builtin_bit_cast(int, v), 0x4E, 0xF, 0xF, false)));
    v = fmaxf(v, __builtin_bit_cast(float, __builtin_amdgcn_update_dpp(0, __builtin_bit_cast(int, v), 0x141, 0xF, 0xF, false)));
    v = fmaxf(v, __builtin_bit_cast(float, __builtin_amdgcn_update_dpp(0, __builtin_bit_cast(int, v), 0x140, 0xF, 0xF, false)));
    return v;
}
__device__ __forceinline__ float rowsum16(float v) {
    v += __builtin_bit_cast(float, __builtin_amdgcn_update_dpp(0, __builtin_bit_cast(int, v), 0xB1, 0xF, 0xF, false));
    v += __builtin_bit_cast(float, __builtin_amdgcn_update_dpp(0, __builtin_bit_cast(int, v), 0x4E, 0xF, 0xF, false));
    v += __builtin_bit_cast(float, __builtin_amdgcn_update_dpp(0, __builtin_bit_cast(int, v), 0x141, 0xF, 0xF, false));
    v += __builtin_bit_cast(float, __builtin_amdgcn_update_dpp(0, __builtin_bit_cast(int, v), 0x140, 0xF, 0xF, false));
    return v;
}

__device__ __forceinline__ void p0_transpose_item(const float* W, int ldn, int K, bf16_t* WT, int k0, int n_src0, int n_dst0, LAS float* scr, int lane) {
#pragma unroll 8
    for (int i = 0; i < 32; ++i) { const int kk = 2 * i + (lane >> 5); scr[kk * 33 + (lane & 31)] = W[(size_t)(k0 + kk) * ldn + n_src0 + (lane & 31)]; }
    LDS_WAIT(); asm volatile("" ::: "memory");
    const int c = lane & 7;
#pragma unroll
    for (int j = 0; j < 4; ++j) { const int n = (lane >> 3) + 8 * j; const LAS float* s = scr + (8 * c) * 33 + n;
        u32x4 o; o.x = pk2(s[0 * 33], s[1 * 33]); o.y = pk2(s[2 * 33], s[3 * 33]); o.z = pk2(s[4 * 33], s[5 * 33]); o.w = pk2(s[6 * 33], s[7 * 33]);
        *(GAS u32x4*)(WT + (size_t)(n_dst0 + n) * K + k0 + 8 * c) = o; }
    LDS_WAIT(); asm volatile("" ::: "memory");
}
__device__ __forceinline__ void p0a_convert(Frame& F) {
    LAS float* scr = (LAS float*)(F.lds + F.wave * 16384);
    unsigned char* ws = F.ws;
    constexpr int I_INE = 16 * 112, I_INO = 16 * 128, I_OUT = 16 * 32, I_GU = 16 * 64, I_D = 16 * 32;
    constexpr int N_DENSE = 2 * (I_INE + I_INO + 2 * I_OUT);
    constexpr long N_MOE = 128L * (I_GU + I_D);
    for (long it = F.gw; it < N_DENSE + N_MOE; it += F.NGW) {
        long r = it;
        if (r < N_DENSE) {
            const int i = (int)(r / (N_DENSE / 2)); int q = (int)(r % (N_DENSE / 2));
            if (q < I_INE) { p0_transpose_item(INP(2) + (size_t)i * D * EVEN_IN, EVEN_IN, D, (bf16_t*)(ws + WS_WINE) + (size_t)i * 3584 * D, 64 * (q / 112), 32 * (q % 112), 32 * (q % 112), scr, F.lane); continue; } q -= I_INE;
            if (q < I_INO) { p0_transpose_item(INP(10) + (size_t)i * D * ODD_IN, ODD_IN, D, (bf16_t*)(ws + WS_WINO) + (size_t)i * 4096 * D, 64 * (q / 128), 32 * (q % 128), 32 * (q % 128), scr, F.lane); continue; } q -= I_INO;
            if (q < I_OUT) { p0_transpose_item(INP(3) + (size_t)i * D * D, D, D, (bf16_t*)(ws + WS_WOUTE) + (size_t)i * D * D, 64 * (q / 32), 32 * (q % 32), 32 * (q % 32), scr, F.lane); continue; } q -= I_OUT;
            p0_transpose_item(INP(11) + (size_t)i * D * D, D, D, (bf16_t*)(ws + WS_WOUTO) + (size_t)i * D * D, 64 * (q / 32), 32 * (q % 32), 32 * (q % 32), scr, F.lane); continue;
        }
        r -= N_DENSE;
        const int le = (int)(r / (I_GU + I_D)); int q = (int)(r % (I_GU + I_D));
        if (q < I_GU) { const int nb = q % 64, n_src = 32 * nb;
            const int cc = n_src & 1023, n_dst = (cc >> 7) * 256 + (n_src >= 1024 ? 128 : 0) + (cc & 127);
            p0_transpose_item(INP(16) + (size_t)le * D * 2048, 2048, D, (bf16_t*)(ws + WS_WGU) + (size_t)le * 2048 * D, 64 * (q / 64), n_src, n_dst, scr, F.lane); }
        else { q -= I_GU; p0_transpose_item(INP(18) + (size_t)le * DFF * D, D, DFF, (bf16_t*)(ws + WS_WD) + (size_t)le * D * DFF, 64 * (q / 32), 32 * (q % 32), 32 * (q % 32), scr, F.lane); }
    }
    for (int it = F.gw; it < 128 + 32 + 32; it += F.NGW) {
        const float* src; int ld, col; bf16_t* hi; bool zero = false;
        if (it < 128) { const int l = it >> 5, e = it & 31; src = INP(14) + (size_t)l * D * NE; ld = NE; col = e; hi = (bf16_t*)(ws + WS_RW) + ((size_t)l * 2 * 32 + e) * 1024; }
        else if (it < 160) { const int i = (it - 128) >> 4, n = (it - 128) & 15; src = INP(2) + (size_t)i * D * EVEN_IN; ld = EVEN_IN; col = 3584 + n; zero = n >= 8; hi = (bf16_t*)(ws + WS_SWE) + ((size_t)i * 2 * 16 + n) * 1024; }
        else { const int i = (it - 160) >> 4, n = (it - 160) & 15; src = INP(10) + (size_t)i * D * ODD_IN; ld = ODD_IN; col = 4096 + n; hi = (bf16_t*)(ws + WS_SWO) + ((size_t)i * 2 * 16 + n) * 1024; }
        bf16_t* lo = hi + (it < 128 ? 32 : 16) * 1024;
        for (int k = F.lane; k < D; k += 64) { const float w = zero ? 0.f : src[(size_t)k * ld + col]; const unsigned h = f2bf(w); hi[k] = (bf16_t)h; lo[k] = (bf16_t)f2bf(w - __builtin_bit_cast(float, h << 16)); }
    }
    for (int i = F.gw * 64 + F.lane; i < 4 * T5N; i += F.NGW * 64) {
        const int h = i / T5N, p = i % T5N; float v = 0.f;
        if (p >= T5PAD) { const int n = p - T5PAD; int bk = n;
            if (n >= 16) { bk = 16 + (n >= 22) + (n >= 30) + (n >= 40) + (n >= 54) + (n >= 73) + (n >= 99) + (n >= 134) + (n >= 182) + (n >= 246) + (n >= 332) + (n >= 450) + (n >= 609) + (n >= 825) + (n >= 1117) + (n >= 1513); }
            v = (INP(1)[bk * 4 + h] - INP(1)[31 * 4 + h]) * LOG2E; }
#ifdef MK_ZEROT5
        v = 0.f;
#endif
#ifdef MK_SAMET5
        if (p >= T5PAD) { const int n = p - T5PAD; int bk = n; if (n >= 16) { bk = 16 + (n >= 22) + (n >= 30) + (n >= 40) + (n >= 54) + (n >= 73) + (n >= 99) + (n >= 134) + (n >= 182) + (n >= 246) + (n >= 332) + (n >= 450) + (n >= 609) + (n >= 825) + (n >= 1117) + (n >= 1513); } v = (INP(1)[bk * 4] - INP(1)[31 * 4]) * LOG2E; }
#endif
        ((float*)(ws + WS_T5))[i] = v;
    }
}

struct Ln16 {
    const float* X; const float* H; const bf16_t* Y; float* Xout; bf16_t* XB; const float* gam; const float* bet;
    const bf16_t* Whi; const bf16_t* Wlo;
    float oscale;
    const bf16_t* Xb; const bf16_t* Hb;
};
template <int SRC, int NS, bool WRITE_XB>
__device__ __forceinline__ void ln16_tile(const Ln16& P, int tile, int lane, const int (&pos)[4], const float (&gt)[4], f32x4 (&acc)[NS > 0 ? NS : 1]) {
    const int r = lane & 15, q = lane >> 4; const size_t m = (size_t)tile * 16 + r;
    const float* xr = P.X + m * D + 8 * q; const float* hr = (SRC == 1) ? P.H + m * D + 8 * q : nullptr;
    const bf16_t* yr[4];
    if (SRC == 2) {
#pragma unroll
        for (int k = 0; k < 4; ++k) yr[k] = P.Y + (size_t)pos[k] * D + 8 * q; }
#define LN16_LOAD(v, ks) do { const f32x4 a0 = *(const f32x4*)(xr + 32 * (ks)), a1 = *(const f32x4*)(xr + 32 * (ks) + 4); \
        if (SRC == 0) { _Pragma("unroll") for (int j = 0; j < 4; ++j) { v[j] = a0[j]; v[4 + j] = a1[j]; } } \
        else if (SRC == 1) { const f32x4 h0 = *(const f32x4*)(hr + 32 * (ks)), h1 = *(const f32x4*)(hr + 32 * (ks) + 4); _Pragma("unroll") for (int j = 0; j < 4; ++j) { v[j] = ALPHA * a0[j] + h0[j]; v[4 + j] = ALPHA * a1[j] + h1[j]; } } \
        else { _Pragma("unroll") for (int j = 0; j < 4; ++j) { v[j] = ALPHA * a0[j]; v[4 + j] = ALPHA * a1[j]; } \
            _Pragma("unroll") for (int k = 0; k < 4; ++k) { const u32x4 y = *(const u32x4*)(yr[k] + 32 * (ks)); _Pragma("unroll") for (int j = 0; j < 4; ++j) { v[2 * j] = fmaf(gt[k], bflo(y[j]), v[2 * j]); v[2 * j + 1] = fmaf(gt[k], bfhi(y[j]), v[2 * j + 1]); } } } } while (0)
    float mean = 0.f, rstd = 1.f;
    if (SRC != 0) {
        float s = 0.f, ss = 0.f;
#pragma unroll 4
        for (int ks = 0; ks < 32; ++ks) { float v[8]; LN16_LOAD(v, ks);
#pragma unroll
            for (int j = 0; j < 8; ++j) { s += v[j]; ss = fmaf(v[j], v[j], ss); } }
        s += __shfl_xor(s, 16); s += __shfl_xor(s, 32); ss += __shfl_xor(ss, 16); ss += __shfl_xor(ss, 32);
        mean = s * (1.f / D); const float var = fmaxf(ss * (1.f / D) - mean * mean, 0.f); rstd = rsqrtf(var + LN_EPS);
    }
#pragma unroll
    for (int n = 0; n < (NS > 0 ? NS : 1); ++n) acc[n] = (f32x4){0.f, 0.f, 0.f, 0.f};
#pragma unroll 2
    for (int ks = 0; ks < 32; ++ks) {
        float v[8]; LN16_LOAD(v, ks);
        if (SRC != 0) { const f32x4 g0 = *(const f32x4*)(P.gam + 32 * ks + 8 * q), g1 = *(const f32x4*)(P.gam + 32 * ks + 8 * q + 4), b0 = *(const f32x4*)(P.bet + 32 * ks + 8 * q), b1 = *(const f32x4*)(P.bet + 32 * ks + 8 * q + 4);
#pragma unroll
            for (int j = 0; j < 4; ++j) { v[j] = (v[j] - mean) * rstd * g0[j] + b0[j]; v[4 + j] = (v[4 + j] - mean) * rstd * g1[j] + b1[j]; } }
        if (P.Xout) { float* xo = P.Xout + m * D + 32 * ks + 8 * q;
            *(f32x4*)xo = (f32x4){v[0], v[1], v[2], v[3]} * P.oscale; *(f32x4*)(xo + 4) = (f32x4){v[4], v[5], v[6], v[7]} * P.oscale; }
        u32x4 hi; hi.x = pk2(v[0], v[1]); hi.y = pk2(v[2], v[3]); hi.z = pk2(v[4], v[5]); hi.w = pk2(v[6], v[7]);
        if (WRITE_XB) *(u32x4*)(P.XB + m * D + 32 * ks + 8 * q) = hi;
        if (NS > 0) {
            u32x4 lo;
#pragma unroll
            for (int j = 0; j < 4; ++j) lo[j] = pk2(v[2 * j] - bflo(hi[j]), v[2 * j + 1] - bfhi(hi[j]));
            const bf16x8 ah = __builtin_bit_cast(bf16x8, hi), al = __builtin_bit_cast(bf16x8, lo);
#pragma unroll
            for (int n = 0; n < NS; ++n) {
                const bf16x8 bh = *(const bf16x8*)(P.Whi + (size_t)(16 * n + r) * D + 32 * ks + 8 * q), bl = *(const bf16x8*)(P.Wlo + (size_t)(16 * n + r) * D + 32 * ks + 8 * q);
                acc[n] = __builtin_amdgcn_mfma_f32_16x16x32_bf16(ah, bh, acc[n], 0, 0, 0);
                acc[n] = __builtin_amdgcn_mfma_f32_16x16x32_bf16(al, bh, acc[n], 0, 0, 0);
                acc[n] = __builtin_amdgcn_mfma_f32_16x16x32_bf16(ah, bl, acc[n], 0, 0, 0); }
        }
    }
#undef LN16_LOAD
    if (NS > 0) asm volatile("s_nop 15\n\ts_nop 7" ::: "memory");
}
template <int SRC, int NS, bool WRITE_XB, bool WRITE_X>
__device__ __forceinline__ void ln16_pair(const Ln16& P, LAS unsigned char* xl, int par, int tile, int lane, int wave, const int (&pos)[4], const float (&gt)[4], f32x4 (&acc)[NS > 0 ? NS : 1]) {
    const int r = lane & 15, q = lane >> 4, half = wave & 1; const size_t m = (size_t)tile * 16 + r;
    const bf16_t* xr = P.Xb + m * D + 8 * q + 512 * half; const bf16_t* hr = (SRC == 1) ? P.Hb + m * D + 8 * q + 512 * half : nullptr;
    const bf16_t* yr[4];
    if (SRC == 2) {
#pragma unroll
        for (int k = 0; k < 4; ++k) yr[k] = P.Y + (size_t)pos[k] * D + 8 * q + 512 * half; }
    float st[16][8]; float s = 0.f, ss = 0.f;
#pragma unroll
    for (int ks = 0; ks < 16; ++ks) {
        const u32x4 xa = *(const u32x4*)(xr + 32 * ks);
        if (SRC == 1) { const u32x4 hh = *(const u32x4*)(hr + 32 * ks);
#pragma unroll
            for (int j = 0; j < 4; ++j) { st[ks][2 * j] = fmaf(ALPHA, bflo(xa[j]), bflo(hh[j])); st[ks][2 * j + 1] = fmaf(ALPHA, bfhi(xa[j]), bfhi(hh[j])); } }
        else {
#pragma unroll
            for (int j = 0; j < 4; ++j) { st[ks][2 * j] = ALPHA * bflo(xa[j]); st[ks][2 * j + 1] = ALPHA * bfhi(xa[j]); }
#pragma unroll
            for (int k = 0; k < 4; ++k) { const u32x4 y = *(const u32x4*)(yr[k] + 32 * ks);
#pragma unroll
                for (int j = 0; j < 4; ++j) { st[ks][2 * j] = fmaf(gt[k], bflo(y[j]), st[ks][2 * j]); st[ks][2 * j + 1] = fmaf(gt[k], bfhi(y[j]), st[ks][2 * j + 1]); } } }
#pragma unroll
        for (int j = 0; j < 8; ++j) { s += st[ks][j]; ss = fmaf(st[ks][j], st[ks][j], ss); }
        if ((ks & (SRC == 1 ? 7 : 3)) == (SRC == 1 ? 7 : 3)) __builtin_amdgcn_sched_barrier(0);
    }
    s += __shfl_xor(s, 16); s += __shfl_xor(s, 32); ss += __shfl_xor(ss, 16); ss += __shfl_xor(ss, 32);
    LAS float* ex = (LAS float*)(xl + par * 1024);
    if (q == 0) { ex[(wave * 16 + r) * 2] = s; ex[(wave * 16 + r) * 2 + 1] = ss; }
    __syncthreads();
    s += ex[((wave ^ 1) * 16 + r) * 2]; ss += ex[((wave ^ 1) * 16 + r) * 2 + 1];
    const float mean = s * (1.f / D); const float var = fmaxf(ss * (1.f / D) - mean * mean, 0.f); const float rstd = rsqrtf(var + LN_EPS);
#pragma unroll
    for (int n = 0; n < (NS > 0 ? NS : 1); ++n) acc[n] = (f32x4){0.f, 0.f, 0.f, 0.f};
#pragma unroll
    for (int ks = 0; ks < 16; ++ks) {
        const int c0 = 512 * half + 32 * ks + 8 * q;
        const f32x4 g0 = *(const f32x4*)(P.gam + c0), g1 = *(const f32x4*)(P.gam + c0 + 4), b0 = *(const f32x4*)(P.bet + c0), b1 = *(const f32x4*)(P.bet + c0 + 4);
        float v[8];
#pragma unroll
        for (int j = 0; j < 4; ++j) { v[j] = (st[ks][j] - mean) * rstd * g0[j] + b0[j]; v[4 + j] = (st[ks][4 + j] - mean) * rstd * g1[j] + b1[j]; }
        if (WRITE_X) { float* xo = P.Xout + m * D + c0;
            *(f32x4*)xo = (f32x4){v[0], v[1], v[2], v[3]} * P.oscale; *(f32x4*)(xo + 4) = (f32x4){v[4], v[5], v[6], v[7]} * P.oscale; }
        u32x4 hi; hi.x = pk2(v[0], v[1]); hi.y = pk2(v[2], v[3]); hi.z = pk2(v[4], v[5]); hi.w = pk2(v[6], v[7]);
        if (WRITE_XB) *(u32x4*)(P.XB + m * D + c0) = hi;
        if (NS > 0) {
            u32x4 lo;
#pragma unroll
            for (int j = 0; j < 4; ++j) lo[j] = pk2(v[2 * j] - bflo(hi[j]), v[2 * j + 1] - bfhi(hi[j]));
            const bf16x8 ah = __builtin_bit_cast(bf16x8, hi), al = __builtin_bit_cast(bf16x8, lo);
#pragma unroll
            for (int n = 0; n < NS; ++n) {
                const bf16x8 bh = *(const bf16x8*)(P.Whi + (size_t)(16 * n + r) * D + c0), bl = *(const bf16x8*)(P.Wlo + (size_t)(16 * n + r) * D + c0);
                acc[n] = __builtin_amdgcn_mfma_f32_16x16x32_bf16(ah, bh, acc[n], 0, 0, 0);
                acc[n] = __builtin_amdgcn_mfma_f32_16x16x32_bf16(al, bh, acc[n], 0, 0, 0);
                acc[n] = __builtin_amdgcn_mfma_f32_16x16x32_bf16(ah, bl, acc[n], 0, 0, 0); }
        }
        if ((ks & 3) == 3) __builtin_amdgcn_sched_barrier(0);
    }
    if (NS > 0) {
        asm volatile("s_nop 15\n\ts_nop 7" ::: "memory");
        LAS f32x4* ax = (LAS f32x4*)(xl + 2048);
#pragma unroll
        for (int n = 0; n < NS; ++n) ax[(wave * NS + n) * 64 + lane] = acc[n];
        __syncthreads();
#pragma unroll
        for (int n = 0; n < NS; ++n) acc[n] = acc[n] + ax[((wave ^ 1) * NS + n) * 64 + lane];
    }
}
__device__ __forceinline__ void smallproj_store(Frame& F, const f32x4& acc, int tile, bool next_even, const float* fb) {
    const int r = F.lane & 15, q = F.lane >> 4;
    if (next_even) {
        float* pb = (float*)(F.ws + WS_PB);
#pragma unroll
        for (int i = 0; i < 4; ++i) pb[(size_t)(tile * 16 + 4 * q + i) * 16 + r] = acc[i];
    } else {
        float* cum = (float*)(F.ws + WS_CUM); float* tsum = (float*)(F.ws + WS_TSUM);
        const int tok0 = tile * 16, b = tok0 / T, t0 = tok0 % T; const float bias = fb[r]; float s = 0.f;
#pragma unroll
        for (int i = 0; i < 4; ++i) { const float lf = -softplus_f(-(acc[i] + bias)); cum[(size_t)(b * 16 + r) * T + t0 + 4 * q + i] = lf; s += lf; }
        s += __shfl_xor(s, 16); s += __shfl_xor(s, 32);
        if (q == 0) tsum[(size_t)(b * 16 + r) * 1024 + (t0 >> 4)] = s;
    }
}

__device__ __forceinline__ void p0b_input(Frame& F) {
    Ln16 P{INP(0), nullptr, nullptr, nullptr, (bf16_t*)(F.ws + WS_XB), nullptr, nullptr, (const bf16_t*)(F.ws + WS_SWE), (const bf16_t*)(F.ws + WS_SWE) + 16 * 1024, 1.f};
    const int pos[4] = {0, 0, 0, 0}; const float gt[4] = {0.f, 0.f, 0.f, 0.f};
    for (int tile = F.gw; tile < NTOK / 16; tile += F.NGW) { f32x4 acc[1]; ln16_tile<0, 1, true>(P, tile, F.lane, pos, gt, acc); smallproj_store(F, acc[0], tile, true, nullptr); }
}

__device__ __forceinline__ void ln_router_phase(Frame& F, int layer) {
    volatile LAS int* wcnt = (volatile LAS int*)(F.lds + 0); volatile LAS int* gbase = (volatile LAS int*)(F.lds + 128);
    Ln16 P{(const float*)(F.ws + WS_X), (const float*)(F.ws + WS_H), nullptr, (float*)(F.ws + WS_X), (bf16_t*)(F.ws + WS_XB), INP(20) + layer * D, INP(21) + layer * D,
           (const bf16_t*)(F.ws + WS_RW) + (size_t)layer * 2 * 32 * 1024, (const bf16_t*)(F.ws + WS_RW) + (size_t)layer * 2 * 32 * 1024 + 32 * 1024, 1.f};
    P.Xb = (const bf16_t*)(F.ws + WS_XB); P.Hb = (const bf16_t*)(F.ws + WS_H);
    const float* rb = INP(15) + layer * NE;
    int* sele = (int*)(F.ws + WS_SELE); int* slot_o = (int*)(F.ws + WS_SLOT); float* gate_o = (float*)(F.ws + WS_GATE); int* list = (int*)(F.ws + WS_LIST);
    unsigned* gcnt = (unsigned*)(F.ctl + CW_CNT + layer * NE);
    const int pos[4] = {0, 0, 0, 0}; const float gt[4] = {0.f, 0.f, 0.f, 0.f};
    const int r = F.lane & 15, q = F.lane >> 4;
    for (int wt = blockIdx.x; wt < NTOK / 128; wt += F.G) {
        if (F.tid < 32) wcnt[F.tid] = 0;
        __syncthreads();
        const int kk = r & 3; int e_[2], local_[2]; float gm_[2];
#pragma unroll
        for (int rd = 0; rd < 2; ++rd) {
            const int tile = wt * 8 + rd * 4 + (F.wave >> 1);
            f32x4 acc[2]; ln16_pair<1, 2, true, false>(P, F.lds + 4096, rd, tile, F.lane, F.wave, pos, gt, acc);
            e_[rd] = 0; local_[rd] = 0; gm_[rd] = 0.f;
            if ((F.wave & 1) == 0) {
            const float b0 = rb[r], b1 = rb[16 + r];
            float top[4][4];
#pragma unroll
            for (int i = 0; i < 4; ++i) {
                float a = __builtin_bit_cast(float, (__builtin_bit_cast(unsigned, acc[0][i] + b0) & ~31u) | (unsigned)r);
                float b = __builtin_bit_cast(float, (__builtin_bit_cast(unsigned, acc[1][i] + b1) & ~31u) | (unsigned)(16 + r));
#pragma unroll
                for (int k = 0; k < 4; ++k) { const float mx = rowmax16(fmaxf(a, b)); top[i][k] = mx; if (a == mx) a = -INFINITY; if (b == mx) b = -INFINITY; }
            }
            float tv[4];
#pragma unroll
            for (int k = 0; k < 4; ++k) { const int i = r >> 2; tv[k] = i == 0 ? top[0][k] : i == 1 ? top[1][k] : i == 2 ? top[2][k] : top[3][k]; }
            float w[4], ws_ = 0.f;
#pragma unroll
            for (int k = 0; k < 4; ++k) { w[k] = __expf(tv[k] - tv[0]); ws_ += w[k]; }
            const float mine = kk == 0 ? tv[0] : kk == 1 ? tv[1] : kk == 2 ? tv[2] : tv[3]; gm_[rd] = (kk == 0 ? w[0] : kk == 1 ? w[1] : kk == 2 ? w[2] : w[3]) / ws_;
            e_[rd] = (int)(__builtin_bit_cast(unsigned, mine) & 31u);
            local_[rd] = __hip_atomic_fetch_add((LAS int*)(wcnt + e_[rd]), 1, __ATOMIC_RELAXED, __HIP_MEMORY_SCOPE_WORKGROUP);
            }
        }
        __syncthreads();
        if (F.tid < 32) gbase[F.tid] = (int)__hip_atomic_fetch_add(gcnt + F.tid, (unsigned)wcnt[F.tid], RLX_AGENT);
        __syncthreads();
        if ((F.wave & 1) == 0) {
#pragma unroll
            for (int rd = 0; rd < 2; ++rd) { const int tile = wt * 8 + rd * 4 + (F.wave >> 1);
                const int tok = tile * 16 + 4 * q + (r >> 2); const int sl = gbase[e_[rd]] + local_[rd];
                sele[tok * 4 + kk] = e_[rd]; slot_o[tok * 4 + kk] = sl; gate_o[tok * 4 + kk] = gm_[rd]; list[(size_t)e_[rd] * NTOK + sl] = tok * 4 + kk; } }
        __syncthreads();
    }
}

__device__ __forceinline__ void moe_tables(Frame& F, int layer) {
    volatile LAS int* cnt = (volatile LAS int*)(F.lds + CTRL_OFF); volatile LAS int* offp = cnt + 32;
    if (F.tid < 64) {
        const int c = F.lane < 32 ? (int)__hip_atomic_load((unsigned*)(F.ctl + CW_CNT + layer * NE + (F.lane & 31)), RLX_AGENT) : 0;
        int p = ((c + 255) >> 8) << 8;
#pragma unroll
        for (int o = 1; o < 32; o <<= 1) { const int n = __shfl_up(p, o); if ((F.lane & 31) >= o) p += n; }
        if (F.lane < 32) { cnt[F.lane] = c; offp[F.lane] = p - (((c + 255) >> 8) << 8); }
    }
    __syncthreads();
}

__device__ __forceinline__ void moe_out_phase(Frame& F, int layer) {
    volatile LAS int* offp = (volatile LAS int*)(F.lds + CTRL_OFF) + 32;
    const bool lastl = layer == 3, next_even = (layer & 1) == 1; const int ni = (layer + 1) >> 1;
    const bf16_t* sw = next_even ? (const bf16_t*)(F.ws + WS_SWE) + (size_t)ni * 2 * 16 * 1024 : (const bf16_t*)(F.ws + WS_SWO) + (size_t)ni * 2 * 16 * 1024;
    Ln16 P{(const float*)(F.ws + WS_X), nullptr, (const bf16_t*)(F.ws + WS_Y), lastl ? F.out : (float*)(F.ws + WS_X), (bf16_t*)(F.ws + WS_XB), INP(22) + layer * D, INP(23) + layer * D, sw, sw + 16 * 1024, 1.f};
    P.Xb = (const bf16_t*)(F.ws + WS_XB); P.Hb = nullptr;
#if defined(MK_TIMING)
    if (lastl) {
        const unsigned long long* st = (const unsigned long long*)(F.ctl + 65536);
        const int ty[36] = {0, 1, 2, 3, 4, 5, 8, 9, 10, 11, 13, 2, 6, 7, 8, 9, 10, 11, 13, 2, 3, 4, 5, 8, 9, 10, 11, 13, 2, 6, 7, 8, 9, 10, 11, 13};
        unsigned long long sel = 0;
#pragma unroll
        for (int k = 0; k < 34; ++k) if (((MK_TIMING) >> ty[k]) & 1) sel += st[k + 1] - st[k];
        P.oscale = 1.f + floorf((float)sel / (float)(st[34] - st[0]) * 100.f + 0.5f) * 0.01f;
    }
#endif
    const int* sele = (const int*)(F.ws + WS_SELE); const int* slot = (const int*)(F.ws + WS_SLOT); const float* gate = (const float*)(F.ws + WS_GATE);
    const float* fb = INP(13) + (lastl ? 0 : ni * 16);
    int par = 0;
    for (int tile = F.gw >> 1; tile < NTOK / 16; tile += F.NGW / 2, par ^= 1) {
        const int m = tile * 16 + (F.lane & 15); int pos[4]; float gt[4];
#pragma unroll
        for (int k = 0; k < 4; ++k) { pos[k] = offp[sele[m * 4 + k]] + slot[m * 4 + k]; gt[k] = gate[m * 4 + k]; }
        f32x4 acc[1];
        if (lastl) { ln16_pair<2, 0, false, true>(P, F.lds + 4096, par, tile, F.lane, F.wave, pos, gt, acc); }
        else { ln16_pair<2, 1, true, false>(P, F.lds + 4096, par, tile, F.lane, F.wave, pos, gt, acc); if ((F.wave & 1) == 0) smallproj_store(F, acc[0], tile, next_even, fb); }
    }
}

__device__ __forceinline__ void odd_prep_phase(Frame& F, int li) {
    float* cum = (float*)(F.ws + WS_CUM); const float* tsum = (const float*)(F.ws + WS_TSUM); bf16_t* kb8 = (bf16_t*)(F.ws + WS_KB8);
    for (int it = F.gw; it < 32 * 64; it += F.NGW) {
        const int bh = it >> 6, seg = it & 63;
        double base = 0.0;
        for (int j = F.lane; j < 16 * seg; j += 64) base += (double)tsum[(size_t)bh * 1024 + j];
#pragma unroll
        for (int o = 1; o < 64; o <<= 1) base += __shfl_xor(base, o);
        float* p = cum + (size_t)bh * T + seg * 256 + 4 * F.lane;
        const f32x4 lf = *(const f32x4*)p;
        float c0 = lf[0], c1 = c0 + lf[1], c2 = c1 + lf[2], c3 = c2 + lf[3];
        float incl = c3;
#pragma unroll
        for (int o = 1; o < 64; o <<= 1) { const float n = __shfl_up(incl, o); if (F.lane >= o) incl += n; }
        const float excl = incl - c3; const float bs = (float)base + excl;
        const float cc[4] = {(bs + c0) * LOG2E, (bs + c1) * LOG2E, (bs + c2) * LOG2E, (bs + c3) * LOG2E};
        *(f32x4*)p = (f32x4){cc[0], cc[1], cc[2], cc[3]};
#pragma unroll
        for (int j = 0; j < 4; ++j) { const float c = -cc[j];
            const unsigned ch = f2bf(c); const float r1 = c - __builtin_bit_cast(float, ch << 16); const unsigned cm = f2bf(r1); const float r2 = r1 - __builtin_bit_cast(float, cm << 16); const unsigned cl = f2bf(r2);
            u32x4 w; w.x = 0x3f80u | (0x3f80u << 16); w.y = 0x3f80u | (ch << 16); w.z = cm | (cl << 16); w.w = 0u;
            *(u32x4*)(kb8 + ((size_t)bh * T + seg * 256 + 4 * F.lane + j) * 8) = w; }
    }
    bf16_t* proj = (bf16_t*)(F.ws + WS_PROJ); const float* nw = INP(12) + li * 128;
    float wq[16], wk[16];
#pragma unroll
    for (int j = 0; j < 16; ++j) { wq[j] = nw[(F.lane & 3) * 16 + j] * C2; wk[j] = nw[64 + (F.lane & 3) * 16 + j]; }
    for (int tok = F.gw; tok < NTOK; tok += 4 * F.NGW) {
        u32x4 ra[4][2], rb[4][2];
#pragma unroll
        for (int u = 0; u < 4; ++u)
#pragma unroll
            for (int which = 0; which < 2; ++which) { const bf16_t* p = proj + (size_t)(tok + u * F.NGW) * PITCH + which * 1024 + 16 * F.lane; ra[u][which] = *(const u32x4*)p; rb[u][which] = *(const u32x4*)(p + 8); }
#pragma unroll
        for (int u = 0; u < 4; ++u)
#pragma unroll
        for (int which = 0; which < 2; ++which) {
            bf16_t* p = proj + (size_t)(tok + u * F.NGW) * PITCH + which * 1024 + 16 * F.lane;
            const u32x4 a = ra[u][which], b = rb[u][which];
            float v[16];
#pragma unroll
            for (int j = 0; j < 4; ++j) { v[2 * j] = bflo(a[j]); v[2 * j + 1] = bfhi(a[j]); v[8 + 2 * j] = bflo(b[j]); v[8 + 2 * j + 1] = bfhi(b[j]); }
            float ss = 0.f;
#pragma unroll
            for (int j = 0; j < 16; ++j) ss = fmaf(v[j], v[j], ss);
            ss += __shfl_xor(ss, 1); ss += __shfl_xor(ss, 2);
            const float rr = rsqrtf(ss * (1.f / 64.f) + RMS_EPS);
            u32x4 oa, ob;
#pragma unroll
            for (int j = 0; j < 4; ++j) { oa[j] = pk2(v[2 * j] * rr * (which ? wk[2 * j] : wq[2 * j]), v[2 * j + 1] * rr * (which ? wk[2 * j + 1] : wq[2 * j + 1]));
                ob[j] = pk2(v[8 + 2 * j] * rr * (which ? wk[8 + 2 * j] : wq[8 + 2 * j]), v[8 + 2 * j + 1] * rr * (which ? wk[8 + 2 * j + 1] : wq[8 + 2 * j + 1])); }
            *(u32x4*)p = oa; *(u32x4*)(p + 8) = ob;
        }
    }
}

__device__ __forceinline__ void even_combine_phase(Frame& F, int li, float lam_init) {
    const float* lp = INP(4) + li * 256;
    float a = 0.f, bsum = 0.f; { const int l = F.lane; a = lp[l] * lp[64 + l]; bsum = lp[128 + l] * lp[192 + l]; }
    a = wave_sum(a); bsum = wave_sum(bsum);
    const float lam = __expf(a) - __expf(bsum) + lam_init;
    const bf16_t* att = (const bf16_t*)(F.ws + WS_ATT); const float* go = (const float*)(F.ws + WS_GO); const bf16_t* proj = (const bf16_t*)(F.ws + WS_PROJ); bf16_t* mix = (bf16_t*)(F.ws + WS_MIX);
    const int l = F.lane, hh = l >> 4, d0 = (l & 15) * 8;
    float sw[8], gw[8];
#pragma unroll
    for (int j = 0; j < 8; ++j) { sw[j] = INP(5)[li * 128 + d0 + j] * (1.f - lam_init); gw[j] = INP(9)[li * 128 + d0 + j]; }
    for (int tok0 = F.gw; tok0 < NTOK; tok0 += 4 * F.NGW) {
        u32x4 o0_[4], o1_[4], z_[4]; f32x4 g0_[4], g1_[4];
#pragma unroll
        for (int u4 = 0; u4 < 4; ++u4) { const size_t tok = (size_t)(tok0 + u4 * F.NGW);
            o0_[u4] = *(const u32x4*)(att + tok * D + (hh * 2) * 128 + d0); o1_[u4] = *(const u32x4*)(att + tok * D + (hh * 2 + 1) * 128 + d0);
            g0_[u4] = *(const f32x4*)(go + tok * 512 + hh * 128 + d0); g1_[u4] = *(const f32x4*)(go + tok * 512 + hh * 128 + d0 + 4);
            z_[u4] = *(const u32x4*)(proj + tok * PITCH + 3072 + hh * 128 + d0); }
#pragma unroll
        for (int u4 = 0; u4 < 4; ++u4) { const size_t tok = (size_t)(tok0 + u4 * F.NGW);
        const u32x4 o0 = o0_[u4], o1 = o1_[u4];
        float v[8]; float ss = 0.f;
#pragma unroll
        for (int j = 0; j < 4; ++j) { v[2 * j] = bflo(o0[j]) - lam * bflo(o1[j]); v[2 * j + 1] = bfhi(o0[j]) - lam * bfhi(o1[j]); }
#pragma unroll
        for (int j = 0; j < 8; ++j) ss = fmaf(v[j], v[j], ss);
        ss = rowsum16(ss);
        float rr = rsqrtf(ss * (1.f / 128.f) + RMS_EPS);
        u32x4 w;
#pragma unroll
        for (int j = 0; j < 4; ++j) w[j] = pk2(v[2 * j] * rr * sw[2 * j], v[2 * j + 1] * rr * sw[2 * j + 1]);
        *(u32x4*)(mix + tok * D + hh * 128 + d0) = w;
        const f32x4 g0 = g0_[u4], g1 = g1_[u4];
        const u32x4 z = z_[u4];
        float u[8] = {g0[0], g0[1], g0[2], g0[3], g1[0], g1[1], g1[2], g1[3]};
        ss = 0.f;
#pragma unroll
        for (int j = 0; j < 8; ++j) ss = fmaf(u[j], u[j], ss);
        ss = rowsum16(ss);
        rr = rsqrtf(ss * (1.f / 128.f) + RMS_EPS);
#pragma unroll
        for (int j = 0; j < 4; ++j) { const float z0 = bflo(z[j]), z1 = bfhi(z[j]); w[j] = pk2(u[2 * j] * rr * gw[2 * j] * (z0 * sigmoid_f(z0)), u[2 * j + 1] * rr * gw[2 * j + 1] * (z1 * sigmoid_f(z1))); }
        *(u32x4*)(mix + tok * D + 512 + hh * 128 + d0) = w;
        }
    }
}
constexpr int GP_W = 136, GP_K = 72;
constexpr int GB_W = 64 * GP_W * 2, GB_QK = 64 * GP_K * 2, GB_KD = 128 * GP_K * 2;
constexpr int GB_ITEM = 2 * GB_W + GB_QK + GB_KD;
__device__ __forceinline__ int P32(int x) { return (x & ~31) | (((x >> 2) & 3) << 3) | (((x >> 4) & 1) << 2) | (x & 3); }

__device__ __forceinline__ void gdn_prep_phase(Frame& F, int li) {
    LAS unsigned char* L = F.lds;
    LAS bf16_t* Kn = (LAS bf16_t*)(L + 0);
    LAS bf16_t* Qn = (LAS bf16_t*)(L + 17408);
    LAS float* R = (LAS float*)(L + 34816);
    LAS float* Lm = (LAS float*)(L + 100352);
    LAS float* sc = (LAS float*)(L + 116736);
    const bf16_t* proj = (const bf16_t*)(F.ws + WS_PROJ); const float* pb = (const float*)(F.ws + WS_PB);
    const float* cw = INP(6) + (size_t)li * 4 * 1536;
    const int tid = F.tid, lane = F.lane, wave = F.wave;
    for (int item = blockIdx.x; item < 2048; item += F.G) {
        const int n = item & 255, h = (item >> 8) & 3, b = item >> 10; const int t0 = n * 64; const size_t tok0 = (size_t)b * T + t0;
        if (wave == 0) {
            const float bb = pb[(tok0 + lane) * 16 + h], ba = pb[(tok0 + lane) * 16 + 4 + h];
            const float beta = sigmoid_f(bb); const float g = -__expf(INP(7)[li * 4 + h]) * softplus_f(ba + INP(8)[li * 4 + h]);
            float gc = g;
#pragma unroll
            for (int o = 1; o < 64; o <<= 1) { const float v = __shfl_up(gc, o); if (lane >= o) gc += v; }
            sc[lane] = beta; sc[64 + lane] = gc;
        }
        __syncthreads();
        const int c = tid & 127, seg = tid >> 7;
        float yq[16], yk[16];
        {
            float w[3][4];
#pragma unroll
            for (int g = 0; g < 3; ++g)
#pragma unroll
                for (int j = 0; j < 4; ++j) w[g][j] = cw[j * 1536 + g * 512 + h * 128 + c];
            float xw[3][3];
            const bf16_t* base = proj + (tok0 + 16 * seg) * PITCH + 1536 + h * 128 + c;
#pragma unroll
            for (int j = 0; j < 3; ++j) { const bool ok = (t0 + 16 * seg - 3 + j) >= 0;
#pragma unroll
                for (int g = 0; g < 3; ++g) xw[g][j] = ok ? bf2f(base[(long)(j - 3) * PITCH + g * 512]) : 0.f; }
#pragma unroll
            for (int j = 0; j < 16; ++j) {
                float x[3];
#pragma unroll
                for (int g = 0; g < 3; ++g) x[g] = bf2f(base[(long)j * PITCH + g * 512]);
                float y[3];
#pragma unroll
                for (int g = 0; g < 3; ++g) { y[g] = w[g][0] * xw[g][0] + w[g][1] * xw[g][1] + w[g][2] * xw[g][2] + w[g][3] * x[g]; y[g] = y[g] * sigmoid_f(y[g]); xw[g][0] = xw[g][1]; xw[g][1] = xw[g][2]; xw[g][2] = x[g]; }
                yq[j] = y[0]; yk[j] = y[1]; R[(16 * seg + j) * 256 + c] = y[2] * sc[16 * seg + j];
            }
#pragma unroll
            for (int j = 0; j < 16; ++j) { const float sq = wave_sum(yq[j] * yq[j]), sk = wave_sum(yk[j] * yk[j]); if (lane == 0) { sc[128 + (wave * 16 + j) * 2] = sq; sc[128 + (wave * 16 + j) * 2 + 1] = sk; } }
        }
        __syncthreads();
        {
            const int wp = wave ^ 1;
#pragma unroll
            for (int j = 0; j < 16; ++j) { const int tk = 16 * seg + j;
                const float rq = rsqrtf(sc[128 + (wave * 16 + j) * 2] + sc[128 + (wp * 16 + j) * 2] + RMS_EPS), rk = rsqrtf(sc[128 + (wave * 16 + j) * 2 + 1] + sc[128 + (wp * 16 + j) * 2 + 1] + RMS_EPS);
                const float bt = sc[tk]; Qn[tk * GP_W + c] = (bf16_t)f2bf(yq[j] * rq); Kn[tk * GP_W + c] = (bf16_t)f2bf(yk[j] * rk); R[tk * 256 + 128 + c] = yk[j] * rk * bt * __expf(sc[64 + tk]); }
        }
        __syncthreads();
        {
            const int pq = wave >> 2, ti = (wave >> 1) & 1, tj = wave & 1, r32 = lane & 31, hi = lane >> 5;
            const LAS bf16_t* Ap = (pq ? Qn : Kn) + (32 * ti + r32) * GP_W + 8 * hi; const LAS bf16_t* Bp = Kn + (32 * tj + r32) * GP_W + 8 * hi;
            f32x16 acc = f32x16{};
#pragma unroll
            for (int ks = 0; ks < 8; ++ks) acc = __builtin_amdgcn_mfma_f32_32x32x16_bf16(*(const LAS bf16x8*)(Ap + 16 * ks), *(const LAS bf16x8*)(Bp + 16 * ks), acc, 0, 0, 0);
            asm volatile("s_nop 15\n\ts_nop 15\n\ts_nop 15\n\ts_nop 15" : "+v"(acc));
            const int m = 32 * tj + r32; const float gcm = sc[64 + m];
            bf16_t* gqk = (bf16_t*)(F.ws + WS_GQK) + (size_t)item * (64 * GP_K);
#pragma unroll
            for (int r = 0; r < 16; ++r) { const int cc = 32 * ti + (r & 3) + 8 * (r >> 2) + 4 * hi;
                const float dec = __expf(fminf(sc[64 + cc] - gcm, 0.f));
                if (pq == 0) Lm[cc * 64 + m] = (m < cc) ? sc[cc] * acc[r] * dec : 0.f;
                else gqk[cc * GP_K + P32(m)] = (bf16_t)f2bf((m <= cc) ? 0.08838834764831845f * acc[r] * dec : 0.f); }
        }
        __syncthreads();
        if (wave < 4) {
            float sol[64];
            LAS float* Rc = R + tid; const LAS float* Lv = Lm; asm volatile("" : "+v"(Rc), "+v"(Lv));
#pragma unroll
            for (int i = 0; i < 64; ++i) sol[i] = Rc[i * 256];
            __builtin_amdgcn_sched_barrier(0);
#pragma unroll
            for (int i = 1; i < 64; ++i) {
                float s4[4] = {sol[i], 0.f, 0.f, 0.f};
#pragma unroll
                for (int kb = 0; kb < (i + 3) / 4; ++kb) { const f32x4 l4 = *(const LAS f32x4*)(Lv + i * 64 + 4 * kb);
#pragma unroll
                    for (int u = 0; u < 4; ++u) if (4 * kb + u < i) s4[u] = fmaf(-l4[u], sol[4 * kb + u], s4[u]); }
                const float s = (s4[0] + s4[1]) + (s4[2] + s4[3]);
                sol[i] = s;
                Rc[i * 256] = s;
                __builtin_amdgcn_sched_barrier(0);
            }
        } else {
            const int t2 = tid - 256; const float gl = sc[64 + 63];
            bf16_t* gqd = (bf16_t*)(F.ws + WS_GQD) + (size_t)item * (64 * GP_W); bf16_t* gkd = (bf16_t*)(F.ws + WS_GKD) + (size_t)item * (128 * GP_K);
#pragma unroll 4
            for (int it = 0; it < 32; ++it) { const int e = t2 + 256 * it; const int cc = e >> 7, dk = e & 127; const float gcc = sc[64 + cc];
                gqd[cc * GP_W + P32(dk)] = (bf16_t)f2bf(bf2f(Qn[cc * GP_W + dk]) * 0.08838834764831845f * __expf(gcc));
                gkd[dk * GP_K + P32(cc)] = (bf16_t)f2bf(bf2f(Kn[cc * GP_W + dk]) * __expf(gl - gcc)); }
            if (t2 == 0) ((float*)(F.ws + WS_GL))[item] = __expf(gl);
        }
        __syncthreads();
        {
            f32x4* gu = (f32x4*)((float*)(F.ws + WS_GU) + (size_t)item * 8192);
#pragma unroll
            for (int it = 0; it < 4; ++it) { const int e = tid + NTHR * it; const int ln = e & 63, mt = (e >> 6) & 3, w = e >> 8; const int r = ln & 15, q = ln >> 4; const int dv = 16 * w + r, c0 = 16 * mt + 4 * q;
                gu[e] = (f32x4){R[(c0 + 0) * 256 + dv], R[(c0 + 1) * 256 + dv], R[(c0 + 2) * 256 + dv], R[(c0 + 3) * 256 + dv]}; }
            bf16_t* gw = (bf16_t*)(F.ws + WS_GW) + (size_t)item * (64 * GP_W);
#pragma unroll 4
            for (int it = 0; it < 16; ++it) { const int e = tid + NTHR * it; const int cc = e >> 7, dk = e & 127; gw[cc * GP_W + P32(dk)] = (bf16_t)f2bf(R[cc * 256 + 128 + dk]); }
        }
        __syncthreads();
    }
}

__device__ __forceinline__ void gdn_scan_phase(Frame& F, int li) {
#ifndef MK_SCAN_SPLIT
#define MK_SCAN_SPLIT 2
#endif
    constexpr int NSPLIT = MK_SCAN_SPLIT, NWV = 8 / NSPLIT;
    if (blockIdx.x >= 8 * NSPLIT) return;
    const int bh = blockIdx.x & 7, part = blockIdx.x >> 3, b = bh >> 2, h = bh & 3, lane = F.lane, wave = F.wave, r = lane & 15, q = lane >> 4;
    const bool act = wave < NWV; const int slice = part * NWV + (wave & (NWV - 1));
    const char* const g_w = (const char*)(F.ws + WS_GW); const char* const g_qd = (const char*)(F.ws + WS_GQD); const char* const g_qk = (const char*)(F.ws + WS_GQK); const char* const g_kd = (const char*)(F.ws + WS_GKD);
    const float* gu = (const float*)(F.ws + WS_GU); const float* glp = (const float*)(F.ws + WS_GL); float* go = (float*)(F.ws + WS_GO);
    const unsigned lds0 = (unsigned)(uintptr_t)F.ldsg;
    constexpr int GB_A = 2 * GB_W, GB_B = GB_QK + GB_KD, LB0 = 3 * GB_A;
    static_assert(LB0 + 2 * GB_B <= CTRL_OFF, "scan LDS");
#define GDN_DMA_A(item_, slot_) do { _Pragma("unroll") for (int p_ = 0; p_ < 5; ++p_) { const int p = wave + 8 * p_; if (p < 34) { \
        attn_body::glds16((p < 17 ? g_w : g_qd) + (size_t)(item_) * GB_W + (size_t)(p < 17 ? p : p - 17) * 1024, (unsigned)lane * 16u, (unsigned)__builtin_amdgcn_readfirstlane(lds0 + (slot_) * GB_A + p * 1024)); } } } while (0)
#define GDN_DMA_B(item_, slot_) do { _Pragma("unroll") for (int p_ = 0; p_ < 4; ++p_) { const int p = wave + 8 * p_; if (p < 27) { \
        attn_body::glds16(p < 9 ? g_qk + (size_t)(item_) * GB_QK + (size_t)p * 1024 : g_kd + (size_t)(item_) * GB_KD + (size_t)(p - 9) * 1024, (unsigned)lane * 16u, (unsigned)__builtin_amdgcn_readfirstlane(lds0 + LB0 + (slot_) * GB_B + p * 1024)); } } } while (0)
#define GDN_LDU(dst_, item_) do { _Pragma("unroll") for (int mt = 0; mt < 4; ++mt) dst_[mt] = *(const f32x4*)(gu + (size_t)(item_) * 8192 + ((slice * 4 + mt) * 64 + lane) * 4); } while (0)
#ifndef MK_SCAN_REP
#define MK_SCAN_REP 1
#endif
    const int item0 = bh * 256;
    for (int rep_ = 0; rep_ < MK_SCAN_REP; ++rep_) {
    f32x4 S[8];
#pragma unroll
    for (int m = 0; m < 8; ++m) S[m] = (f32x4){0.f, 0.f, 0.f, 0.f};
    GDN_DMA_A(item0, 0); GDN_DMA_B(item0, 0); GDN_DMA_A(item0 + 1, 1);
    f32x4 Ue[4], Uo[4], Op[4]; float gle = glp[item0], glo = glp[item0 + 1];
    GDN_LDU(Ue, item0); GDN_LDU(Uo, item0 + 1);
#pragma unroll
    for (int mt = 0; mt < 4; ++mt) Op[mt] = (f32x4){0.f, 0.f, 0.f, 0.f};
    int sa = 0;
    auto step = [&](const int n, f32x4 (&U)[4], float& glr) __attribute__((always_inline)) {
        const int item = item0 + n;
        if (n == 0 || n >= 254) asm volatile("s_waitcnt vmcnt(0) lgkmcnt(0)\n\ts_barrier" ::: "memory");
        else if (act && n >= 2) asm volatile("s_waitcnt vmcnt(33) lgkmcnt(0)\n\ts_barrier" ::: "memory");
        else if (act) asm volatile("s_waitcnt vmcnt(17) lgkmcnt(0)\n\ts_barrier" ::: "memory");
        else asm volatile("s_waitcnt vmcnt(7) lgkmcnt(0)\n\ts_barrier" ::: "memory");
        if (act && n > 0) { float* gop = go + ((size_t)b * T + 64 * (n - 1) + 4 * q) * 512 + h * 128 + 16 * slice + r;
#pragma unroll
            for (int mt = 0; mt < 4; ++mt)
#pragma unroll
                for (int i = 0; i < 4; ++i) gop[(size_t)(16 * mt + i) * 512] = Op[mt][i]; }
        if (n + 1 < 256) GDN_DMA_B(item + 1, (n + 1) & 1);
        if (n + 2 < 256) { const int sa2 = sa == 0 ? 2 : sa - 1;
            GDN_DMA_A(item + 2, sa2); }
        const LAS unsigned char* La = F.lds + sa * GB_A; const LAS unsigned char* Lbb = F.lds + LB0 + (n & 1) * GB_B;
        const LAS bf16_t* Wp = (const LAS bf16_t*)La + r * GP_W + 8 * q; const LAS bf16_t* QDp = (const LAS bf16_t*)(La + GB_W) + r * GP_W + 8 * q;
        const LAS bf16_t* QKp = (const LAS bf16_t*)Lbb + r * GP_K + 8 * q; const LAS bf16_t* KDp = (const LAS bf16_t*)(Lbb + GB_QK) + r * GP_K + 8 * q;
        f32x4 O[4]; bf16x8 Vb[2];
        if (act) {
        bf16x8 Sb[4];
#pragma unroll
        for (int ks = 0; ks < 4; ++ks) { u32x4 w; w.x = cvt_pk_bf16(S[2 * ks][0], S[2 * ks][1]); w.y = cvt_pk_bf16(S[2 * ks][2], S[2 * ks][3]); w.z = cvt_pk_bf16(S[2 * ks + 1][0], S[2 * ks + 1][1]); w.w = cvt_pk_bf16(S[2 * ks + 1][2], S[2 * ks + 1][3]); Sb[ks] = __builtin_bit_cast(bf16x8, w); }
        f32x4 ws_[4];
#pragma unroll
        for (int mt = 0; mt < 4; ++mt) { ws_[mt] = (f32x4){0.f, 0.f, 0.f, 0.f}; O[mt] = (f32x4){0.f, 0.f, 0.f, 0.f}; }
        f32x4 Uc[4]; float gl;
#define GDN_UCONS(W_) do { float a0, a1, a2, a3, a4, a5, a6, a7, a8; \
        asm volatile(W_ "\n\tv_mov_b32 %0, %9\n\tv_mov_b32 %1, %10\n\tv_mov_b32 %2, %11\n\tv_mov_b32 %3, %12\n\tv_mov_b32 %4, %13\n\tv_mov_b32 %5, %14\n\tv_mov_b32 %6, %15\n\tv_mov_b32 %7, %16\n\tv_mov_b32 %8, %17" \
            : "=&v"(a0), "=&v"(a1), "=&v"(a2), "=&v"(a3), "=&v"(a4), "=&v"(a5), "=&v"(a6), "=&v"(a7), "=&v"(a8) \
            : "v"(U[0][0]), "v"(U[0][1]), "v"(U[0][2]), "v"(U[0][3]), "v"(U[1][0]), "v"(U[1][1]), "v"(U[1][2]), "v"(U[1][3]), "v"(glr) : "memory"); \
        Uc[0] = (f32x4){a0, a1, a2, a3}; Uc[1] = (f32x4){a4, a5, a6, a7}; gl = a8; \
        asm volatile("v_mov_b32 %0, %8\n\tv_mov_b32 %1, %9\n\tv_mov_b32 %2, %10\n\tv_mov_b32 %3, %11\n\tv_mov_b32 %4, %12\n\tv_mov_b32 %5, %13\n\tv_mov_b32 %6, %14\n\tv_mov_b32 %7, %15" \
            : "=&v"(a0), "=&v"(a1), "=&v"(a2), "=&v"(a3), "=&v"(a4), "=&v"(a5), "=&v"(a6), "=&v"(a7) \
            : "v"(U[2][0]), "v"(U[2][1]), "v"(U[2][2]), "v"(U[2][3]), "v"(U[3][0]), "v"(U[3][1]), "v"(U[3][2]), "v"(U[3][3]) : "memory"); \
        Uc[2] = (f32x4){a0, a1, a2, a3}; Uc[3] = (f32x4){a4, a5, a6, a7}; } while (0)
        if (n < 2 || n >= 254) GDN_UCONS("s_waitcnt vmcnt(0)"); else GDN_UCONS("s_waitcnt vmcnt(51)");
        {
#pragma unroll
        for (int m = 0; m < 8; ++m) S[m] = S[m] * gl; }
#pragma unroll
        for (int ks = 0; ks < 4; ++ks)
#pragma unroll
            for (int mt = 0; mt < 4; ++mt) {
                ws_[mt] = __builtin_amdgcn_mfma_f32_16x16x32_bf16(*(const LAS bf16x8*)(Wp + 16 * mt * GP_W + 32 * ks), Sb[ks], ws_[mt], 0, 0, 0);
                O[mt] = __builtin_amdgcn_mfma_f32_16x16x32_bf16(*(const LAS bf16x8*)(QDp + 16 * mt * GP_W + 32 * ks), Sb[ks], O[mt], 0, 0, 0);
                if (mt == 3) __builtin_amdgcn_sched_barrier(0); }
        asm volatile("s_nop 15\n\ts_nop 15\n\ts_nop 15\n\ts_nop 15" ::: "memory");
#pragma unroll
        for (int kc = 0; kc < 2; ++kc) { const f32x4 v0 = Uc[2 * kc] - ws_[2 * kc], v1 = Uc[2 * kc + 1] - ws_[2 * kc + 1];
            u32x4 w; w.x = cvt_pk_bf16(v0[0], v0[1]); w.y = cvt_pk_bf16(v0[2], v0[3]); w.z = cvt_pk_bf16(v1[0], v1[1]); w.w = cvt_pk_bf16(v1[2], v1[3]); Vb[kc] = __builtin_bit_cast(bf16x8, w); }
        }
        asm volatile("" ::: "memory");
        if (act && n + 2 < 256) {
            const float* up = gu + (size_t)(item + 2) * 8192 + (slice * 256 + lane) * 4; const float* gp = glp + item + 2;
            asm volatile("global_load_dwordx4 %0, %4, off\n\tglobal_load_dwordx4 %1, %4, off offset:1024\n\tglobal_load_dwordx4 %2, %4, off offset:2048\n\tglobal_load_dwordx4 %3, %4, off offset:3072"
                         : "=&v"(U[0]), "=&v"(U[1]), "=&v"(U[2]), "=&v"(U[3]) : "v"(up) : "memory");
            asm volatile("global_load_dword %0, %1, off" : "=&v"(glr) : "v"(gp) : "memory"); }
        if (n >= 254) asm volatile("s_waitcnt vmcnt(0)\n\ts_barrier" ::: "memory");
        else if (act) asm volatile("s_waitcnt vmcnt(37)\n\ts_barrier" ::: "memory");
        else asm volatile("s_waitcnt vmcnt(11)\n\ts_barrier" ::: "memory");
        sa = sa == 2 ? 0 : sa + 1;
        if (!act) return;
#pragma unroll
        for (int kc = 0; kc < 2; ++kc)
#pragma unroll
            for (int mt = 0; mt < 4; ++mt) { O[mt] = __builtin_amdgcn_mfma_f32_16x16x32_bf16(*(const LAS bf16x8*)(QKp + 16 * mt * GP_K + 32 * kc), Vb[kc], O[mt], 0, 0, 0); if (mt == 3) __builtin_amdgcn_sched_barrier(0); }
#pragma unroll
        for (int kc = 0; kc < 2; ++kc)
#pragma unroll
            for (int m = 0; m < 8; ++m) { S[m] = __builtin_amdgcn_mfma_f32_16x16x32_bf16(*(const LAS bf16x8*)(KDp + 16 * m * GP_K + 32 * kc), Vb[kc], S[m], 0, 0, 0); if (m == 7) __builtin_amdgcn_sched_barrier(0); }
#pragma unroll
        for (int mt = 0; mt < 4; ++mt) Op[mt] = O[mt];
    };
    for (int n = 0; n < 256; n += 2) { step(n, Ue, gle); step(n + 1, Uo, glo); }
    if (act) { float* gop = go + ((size_t)b * T + 64 * 255 + 4 * q) * 512 + h * 128 + 16 * slice + r;
#pragma unroll
        for (int mt = 0; mt < 4; ++mt)
#pragma unroll
            for (int i = 0; i < 4; ++i) gop[(size_t)(16 * mt + i) * 512] = Op[mt][i]; }
    asm volatile("s_waitcnt vmcnt(0) lgkmcnt(0)\n\ts_barrier" ::: "memory");
    }
#undef GDN_DMA_A
#undef GDN_DMA_B
#undef GDN_LDU
#undef GDN_UCONS
}
constexpr int N_STEPS = 2 + 2 * (9 + 8);
#ifndef MK_INPROJ_REP
#define MK_INPROJ_REP 1
#endif
#ifndef MK_OUTPROJ_REP
#define MK_OUTPROJ_REP 1
#endif
#ifndef MK_EVEN_MODE
#define MK_EVEN_MODE 2
#endif

__global__ void __launch_bounds__(NTHR, 2) mk(Args a) {
    extern __shared__ __attribute__((aligned(16))) unsigned char lds_raw[];
    volatile LAS unsigned* MISC = (volatile LAS unsigned*)((LAS unsigned char*)lds_raw + MISC_OFF);
    for (int u = threadIdx.x; u < (LDS_BYTES - CTRL_OFF) / 4; u += NTHR) ((LAS unsigned*)((LAS unsigned char*)lds_raw + CTRL_OFF))[u] = 0u;
    __syncthreads();
    gu32* const ctl0 = (gu32*)(a.ws + WS_CTL);
    const int lo = a.lo, hi = a.hi;
    XcdBarrier bar; bar.bar = (unsigned*)(ctl0 + CW_BAR) + a.bar_region * XCD_BAR_WORDS; bar.x = xb_xcc_id(); bar.st = MISC + 8;
    if (hi - lo > 1) bar = xcd_barrier_post((unsigned*)(ctl0 + CW_BAR) + a.bar_region * XCD_BAR_WORDS, MISC + 8);
    const unsigned xcc = bar.x;
    const int cblk = (int)blockIdx.x;
    int step = 0;
#ifndef MK_EN
#define MK_EN 0xFFFF
#endif
#define EN(k) ((MK_EN >> (k)) & 1)
#if defined(MK_TIMING)
#define MK_STAMP() do { if (blockIdx.x == 0 && threadIdx.x == 0) ((unsigned long long*)(ctl0 + 65536))[step] = __builtin_amdgcn_s_memrealtime(); } while (0)
#else
#define MK_STAMP() do { } while (0)
#endif
#define PHASE_BEGIN if (step >= lo && step < hi) { MK_STAMP(); Frame F; { int tid_ = threadIdx.x; GAS unsigned char* wsg_ = (GAS unsigned char*)a.ws; asm volatile("" : "+v"(tid_), "+s"(wsg_)); unsigned char* ws_ = (unsigned char*)wsg_;     \
        F.lds = (LAS unsigned char*)lds_raw; F.ldsg = (char*)lds_raw; F.tid = tid_; F.lane = tid_ & 63; F.wave = __builtin_amdgcn_readfirstlane(tid_ >> 6); \
        F.G = gridDim.x; F.gw = blockIdx.x * NWAVES + F.wave; F.NGW = F.G * NWAVES; F.ws = ws_; F.ctl = (gu32*)(ws_ + WS_CTL); F.out = a.out; }
#ifdef MK_BAR2
#define PHASE_END   if (step + 1 < hi) { xcd_barrier(bar); xcd_barrier(bar); xcd_barrier(bar); } } ++step;
#else
#define PHASE_END   if (step + 1 < hi) xcd_barrier(bar); } ++step;
#endif
#ifndef MK_TWICE
#define MK_TWICE -1
#endif
#define REPEAT(k) for (int rep_ = 0; rep_ < (MK_TWICE == (k) ? 2 : 1); ++rep_)
#define REPBAR() do { if (rep_) xcd_barrier(bar); } while (0)

    PHASE_BEGIN if (EN(0)) REPEAT(0) { REPBAR(); p0a_convert(F); } PHASE_END
    PHASE_BEGIN if (EN(1)) {
        if (a.dbg_src) {
            const bool ne = (a.dbg_layer0 & 1) == 0; const int ni = a.dbg_layer0 >> 1;
            const bf16_t* sw = ne ? (const bf16_t*)(F.ws + WS_SWE) + (size_t)ni * 2 * 16 * 1024 : (const bf16_t*)(F.ws + WS_SWO) + (size_t)ni * 2 * 16 * 1024;
            Ln16 P{a.dbg_src, nullptr, nullptr, (float*)(F.ws + WS_X), (bf16_t*)(F.ws + WS_XB), nullptr, nullptr, sw, sw + 16 * 1024, 1.f};
            const int pos[4] = {0, 0, 0, 0}; const float gt[4] = {0.f, 0.f, 0.f, 0.f};
            for (int tile = F.gw; tile < NTOK / 16; tile += F.NGW) { f32x4 acc[1]; ln16_tile<0, 1, true>(P, tile, F.lane, pos, gt, acc); smallproj_store(F, acc[0], tile, ne, INP(13) + ni * 16); }
        } else p0b_input(F); }
    PHASE_END

    for (int layer = 0; layer < 4; ++layer) {
        const int li = layer >> 1; const bool even = (layer & 1) == 0;
        if (layer < a.dbg_layer0) { step += even ? 9 : 8; continue; }
        PHASE_BEGIN if (EN(2)) REPEAT(2) { REPBAR();
            const int N = even ? 3584 : 4096;
            pg8::DenseOrder S{(const char*)(F.ws + WS_XB), even ? (const char*)(F.ws + WS_WINE) + (size_t)li * 3584 * D * 2 : (const char*)(F.ws + WS_WINO) + (size_t)li * 4096 * D * 2, D, NTOK / 256, N / 256, (NTOK / 256) * (N / 256), F.G, cblk, MK_INPROJ_REP};
            pg8::EpiProj E{(bf16_t*)(F.ws + WS_PROJ), PITCH, even ? 512 : 0, C2};
            pg8::gemm_phase<pg8::EpiProj, pg8::DenseOrder, false>(F.lds, D, S, E, F.tid);
        } PHASE_END
        if (even) {
            PHASE_BEGIN if (EN(3)) REPEAT(3) { REPBAR(); gdn_prep_phase(F, li); } PHASE_END
            PHASE_BEGIN if (EN(4)) REPEAT(4) { REPBAR();
                if (EN(12)) gdn_scan_phase(F, li);
                attn_body::AttnP P{(const bf16_t*)(F.ws + WS_PROJ), (bf16_t*)(F.ws + WS_ATT), (const float*)(F.ws + WS_T5), nullptr, nullptr, 0.f};
                attn_body::attn_phase<MK_EVEN_MODE>(F.ldsg, P, (unsigned*)(F.ctl + CW_QUEUE + (layer + 4 * rep_) * 8 * 64), xcc, F.tid);
            } PHASE_END
            PHASE_BEGIN if (EN(5)) REPEAT(5) even_combine_phase(F, li, 0.8f - 0.6f * __expf(-0.3f * (float)layer)); PHASE_END
        } else {
            PHASE_BEGIN if (EN(6)) odd_prep_phase(F, li); PHASE_END
            PHASE_BEGIN if (EN(7)) REPEAT(7) { REPBAR();
                float mq, mk; { const float* nw = INP(12) + li * 128; mq = fabsf(nw[F.lane]); mk = fabsf(nw[64 + F.lane]);
#pragma unroll
                    for (int o = 1; o < 64; o <<= 1) { mq = fmaxf(mq, __shfl_xor(mq, o)); mk = fmaxf(mk, __shfl_xor(mk, o)); } }
                const float xb = 64.f * mq * mk * C2 * 1.05f;
                attn_body::AttnP P{(const bf16_t*)(F.ws + WS_PROJ), (bf16_t*)(F.ws + WS_MIX), nullptr, (const float*)(F.ws + WS_CUM), (const bf16_t*)(F.ws + WS_KB8), 2.f * xb + 54.f};
                attn_body::attn_phase<1>(F.ldsg, P, (unsigned*)(F.ctl + CW_QUEUE + (layer + 4 * rep_) * 8 * 64), xcc, F.tid);
            } PHASE_END
        }
        PHASE_BEGIN if (EN(8)) REPEAT(8) { REPBAR();
            pg8::DenseOrder S{(const char*)(F.ws + WS_MIX), even ? (const char*)(F.ws + WS_WOUTE) + (size_t)li * D * D * 2 : (const char*)(F.ws + WS_WOUTO) + (size_t)li * D * D * 2, D, NTOK / 256, D / 256, (NTOK / 256) * (D / 256), F.G, cblk, MK_OUTPROJ_REP};
            pg8::EpiProj E{(bf16_t*)(F.ws + WS_H), D, 0, 1.f};
            pg8::gemm_phase<pg8::EpiProj, pg8::DenseOrder, false>(F.lds, D, S, E, F.tid);
        } PHASE_END
        PHASE_BEGIN if (EN(9)) ln_router_phase(F, layer); PHASE_END
        PHASE_BEGIN if (EN(10)) REPEAT(10) { REPBAR();
            moe_tables(F, layer);
            pg8::MoeOrder S{(const char*)(F.ws + WS_XB), (const char*)(F.ws + WS_WGU) + (size_t)layer * NE * 2048 * D * 2, (const int*)(F.ws + WS_LIST), (const LAS int*)(F.lds + CTRL_OFF), (const LAS int*)(F.lds + CTRL_OFF) + 32,
                            8, (size_t)2048 * D * 2, D, true, F.G, cblk};
            pg8::EpiSwiglu E{(bf16_t*)(F.ws + WS_ACT), INP(17) + (size_t)layer * NE * 2048};
            pg8::gemm_phase<pg8::EpiSwiglu, pg8::MoeOrder, true>(F.lds, D, S, E, F.tid);
        } PHASE_END
        PHASE_BEGIN if (EN(11)) REPEAT(11) { REPBAR();
            moe_tables(F, layer);
            pg8::MoeOrder S{(const char*)(F.ws + WS_ACT), (const char*)(F.ws + WS_WD) + (size_t)layer * NE * D * DFF * 2, nullptr, (const LAS int*)(F.lds + CTRL_OFF), (const LAS int*)(F.lds + CTRL_OFF) + 32,
                            4, (size_t)D * DFF * 2, DFF, false, F.G, cblk};
            pg8::EpiDown E{(bf16_t*)(F.ws + WS_Y), INP(19) + (size_t)layer * NE * D};
            pg8::gemm_phase<pg8::EpiDown, pg8::MoeOrder, false>(F.lds, DFF, S, E, F.tid);
        } PHASE_END
        PHASE_BEGIN if (EN(13)) { moe_tables(F, layer); moe_out_phase(F, layer); } PHASE_END
    }
#undef PHASE_BEGIN
#undef PHASE_END
}
}

#if MK_DEBUG
namespace dbg {
template <class TA, class TB> __device__ __forceinline__ float ldv(const TA* p);
__device__ __forceinline__ float ldf(const float* p) { return *p; }
__device__ __forceinline__ float ldf(const unsigned short* p) { return __builtin_bit_cast(float, (unsigned)*p << 16); }
template <class TA, class TB>
__global__ void cmp(const TA* a, long lda, const TB* b, long ldb, int rows, int cols, float bscale, double* acc) {
    double e = 0.0, n = 0.0;
    for (long i = (long)blockIdx.x * blockDim.x + threadIdx.x; i < (long)rows * cols; i += (long)gridDim.x * blockDim.x) {
        const long r = i / cols, c = i % cols; const float x = ldf(a + r * lda + c), y = ldf(b + r * ldb + c) * bscale;
        e += (double)(x - y) * (x - y); n += (double)x * x; }
    for (int o = 32; o > 0; o >>= 1) { e += __shfl_xor(e, o); n += __shfl_xor(n, o); }
    if ((threadIdx.x & 63) == 0) { atomicAdd(acc, e); atomicAdd(acc + 1, n); }
}
__global__ void finish(float* out, const float* ref, const double* acc, int nchk, float thr, int which, long n) {
    float code = 0.f;
    if (which >= 0) { code = (float)sqrt(acc[2 * which] / (acc[2 * which + 1] + 1e-300)); if (!(code == code)) code = 3.f; if (code > 3.f) code = 3.f; }
    else { for (int k = 0; k < nchk; ++k) { const double e = acc[2 * k] / (acc[2 * k + 1] + 1e-300); if (!(e <= (double)thr)) { code = 0.1f * (k + 1); break; } } }
    for (long i = (long)blockIdx.x * blockDim.x + threadIdx.x; i < n; i += (long)gridDim.x * blockDim.x) out[i] = ref[i] * (1.f + code);
}
__global__ void csum(const unsigned* p, size_t nwords, unsigned long long* out, size_t colw, size_t pitchw) {
    unsigned long long s = 0;
    for (size_t i = (size_t)blockIdx.x * blockDim.x + threadIdx.x; i < nwords; i += (size_t)gridDim.x * blockDim.x) s += p[(i / colw) * pitchw + (i % colw)];
    for (int o = 32; o > 0; o >>= 1) s += __shfl_xor(s, o);
    if ((threadIdx.x & 63) == 0) atomicAdd(out, s);
}
__global__ void finish2(float* out, const float* ref, const unsigned long long* cs, int n, int nrun, long nel) {
    float code = 0.f;
#ifndef MK_DBG_ONLY
#define MK_DBG_ONLY -1
#endif
#ifndef MK_DBG_ANY
#define MK_DBG_ANY 0
#endif
    for (int k = 0; k < n && code == 0.f; ++k) for (int r = 1; r < nrun; ++r) if ((MK_DBG_ONLY < 0 || k == MK_DBG_ONLY) && cs[k] != cs[16 * r + k]) { code = MK_DBG_ANY ? 0.5f : 0.1f * (k + 1); break; }
    for (long i = (long)blockIdx.x * blockDim.x + threadIdx.x; i < nel; i += (long)gridDim.x * blockDim.x) out[i] = ref[i] * (1.f + code);
}
__global__ void attdiff(const unsigned short* a, const unsigned short* b, unsigned* stat, int mode) {
    const int u = blockIdx.x, bvh = u >> 6, qb = u & 63, bb = bvh >> 4, vh = bvh & 15;
    int ocol; if (mode == 0) { const int h = vh >> 2, m = (vh >> 1) & 1, half = vh & 1; ocol = (h * 2 + m) * 128 + half * 64; } else ocol = vh * 64;
    __shared__ int any; if (threadIdx.x == 0) any = 0; __syncthreads();
    const size_t row = (size_t)bb * T + qb * 256 + threadIdx.x; int df = 0;
    for (int c = 0; c < 64; ++c) df |= a[row * D + ocol + c] != b[row * D + ocol + c];
    if (df) any = 1; __syncthreads();
    if (threadIdx.x == 0 && any) { atomicAdd(stat, 1u); if (qb < 8) atomicAdd(stat + 1, 1u); if (vh < 8) atomicAdd(stat + 2, 1u); if (qb <= 6) atomicAdd(stat + 3, 1u); if (qb == 7) atomicAdd(stat + 4, 1u); if (qb == 0) atomicAdd(stat + 5, 1u); }
    if (df) { atomicAdd(stat + 6, 1u); if (threadIdx.x < 32) atomicAdd(stat + 7, 1u); }
}
__global__ void finish3(float* out, const float* ref, const unsigned* stat, int which, float denom, long nel) {
    float code = 0.f; { unsigned c = stat[which]; if (denom > 0.f) code = (float)(c / 8) * 8.f / denom; else { int lg = 0; while (c) { ++lg; c >>= 1; } code = 0.1f * (float)lg; } }
    for (long i = (long)blockIdx.x * blockDim.x + threadIdx.x; i < nel; i += (long)gridDim.x * blockDim.x) out[i] = ref[i] * (1.f + code);
}
__global__ void finish4(float* out, const float* ref, const double* acc, long nel) {
    const double e = acc[0] / (acc[1] + 1e-300); float code = e > 0 ? 0.1f * (float)floor(-log10(e)) : 2.f; if (code < 0.f) code = 0.f;
    for (long i = (long)blockIdx.x * blockDim.x + threadIdx.x; i < nel; i += (long)gridDim.x * blockDim.x) out[i] = ref[i] * (1.f + code);
}
__global__ void att2out(float* out, const unsigned short* att, int qlo, int qhi) {
    for (long i = (long)blockIdx.x * blockDim.x + threadIdx.x; i < (long)NTOK * D; i += (long)gridDim.x * blockDim.x) {
        const int row = (int)(i >> 10), qb = (row % T) >> 8; out[i] = (qb >= qlo && qb <= qhi) ? __builtin_bit_cast(float, (unsigned)att[i] << 16) : 0.f; }
}
__global__ void countpoison(const unsigned short* a, size_t n, unsigned* stat) {
    unsigned c = 0;
    for (size_t i = (size_t)blockIdx.x * blockDim.x + threadIdx.x; i < n; i += (size_t)gridDim.x * blockDim.x) c += a[i] == 0xFFFFu;
    for (int o = 32; o > 0; o >>= 1) c += __shfl_xor(c, o);
    if ((threadIdx.x & 63) == 0 && c) atomicAdd(stat, c);
}
__global__ void bf16n(float* out, const unsigned short* src, long n) { for (long i = (long)blockIdx.x * blockDim.x + threadIdx.x; i < (long)NTOK * D; i += (long)gridDim.x * blockDim.x) out[i] = i < n ? __builtin_bit_cast(float, (unsigned)src[i] << 16) : 0.f; }
__global__ void f32half(float* out, const float* src) { for (long i = (long)blockIdx.x * blockDim.x + threadIdx.x; i < (long)NTOK * D; i += (long)gridDim.x * blockDim.x) out[i] = i < (long)NTOK * 512 ? src[i] : 0.f; }
__global__ void f32out(float* out, const float* src) { for (long i = (long)blockIdx.x * blockDim.x + threadIdx.x; i < (long)NTOK * D; i += (long)gridDim.x * blockDim.x) out[i] = src[i]; }
}
#endif
#ifndef MK_SINGLE
#define MK_SINGLE 0
#endif
static int mk_grid_init() {
    static int grid = 0;
    if (grid == 0) {
        int dev = 0, cus = 0;
        if (hipGetDevice(&dev) != hipSuccess || hipDeviceGetAttribute(&cus, hipDeviceAttributeMultiprocessorCount, dev) != hipSuccess) { grid = -1; return grid; }
        if (hipFuncSetAttribute((const void*)fk::mk, hipFuncAttributeMaxDynamicSharedMemorySize, fk::LDS_BYTES) != hipSuccess) { fprintf(stderr, "kernel_launch: hipFuncSetAttribute failed\n"); grid = -1; return grid; }
        int per_cu = 0;
        if (hipOccupancyMaxActiveBlocksPerMultiprocessor(&per_cu, (const void*)fk::mk, fk::NTHR, fk::LDS_BYTES) != hipSuccess || per_cu < 1) fprintf(stderr, "kernel_launch: occupancy query reports %d\n", per_cu);
        (void)hipGetLastError();
        grid = cus;
    }
    return grid;
}
static void fast_forward(void* const* d_in, float* out, unsigned char* ws, hipStream_t stream, int step_lo, int step_hi, bool single, const float* dbg_src, int dbg_layer0) {
    const int grid = mk_grid_init(); if (grid <= 0) return;
    fk::Args a{};
    for (int i = 0; i < 24; ++i) a.in[i] = (const float*)d_in[i];
    a.out = out; a.ws = ws; a.dbg_src = dbg_src; a.dbg_layer0 = dbg_layer0; a.bar_region = 0;
    if (single) { a.lo = step_lo; a.hi = step_hi; hipLaunchKernelGGL(fk::mk, dim3(grid), dim3(fk::NTHR), fk::LDS_BYTES, stream, a); }
    else for (int s = step_lo; s < step_hi; ++s) { a.lo = s; a.hi = s + 1; hipLaunchKernelGGL(fk::mk, dim3(grid), dim3(fk::NTHR), fk::LDS_BYTES, stream, a); }
}

#ifndef MK_DEBUG
#define MK_DEBUG 0
#endif
#if MK_DEBUG
#ifndef MK_DBG_CFG
#define MK_DBG_CFG 1
#endif
#ifndef MK_DBG_DENOM
#define MK_DBG_DENOM 0.f
#endif
#ifndef MK_DBG_WHICH
#define MK_DBG_WHICH -1
#endif
#endif

extern "C" void kernel_launch(void* const* d_in, const int* in_sizes, int n_in, void* d_out, int out_size, void* d_ws, size_t ws_size, hipStream_t stream) {
    if (n_in != 24 || ws_size < fk::WS_FAST_END) { fprintf(stderr, "kernel_launch: unexpected n_in %d / ws %zu\n", n_in, ws_size); return; }
    unsigned char* ws = (unsigned char*)d_ws;
#if MK_DEBUG
    using namespace nv;
    constexpr size_t MiB = 1u << 20; unsigned char* keep = ws + 2400 * MiB;
    float* nout = (float*)(keep + 1536 * MiB); double* acc = (double*)(keep + 1664 * MiB);
    In in; for (int i = 0; i < 24; ++i) in.p[i] = (const float*)d_in[i];
    const float C2 = fk::C2;
#if MK_DBG_CFG == 1
    Save sv[] = {{0, ST_PROJ, keep}, {0, ST_ATT, keep + 512 * MiB}};
    forward(in, ws, nout, sv, 2, stream);
    (void)hipMemsetAsync(ws + fk::WS_CTL, 0, fk::CTL_BYTES, stream); (void)hipMemsetAsync(acc, 0, 1024, stream);
    fast_forward(d_in, (float*)d_out, ws, stream, 0, 5, false, nullptr, 0);
    const float* nproj = (const float*)keep; const unsigned short* fproj = (const unsigned short*)(ws + fk::WS_PROJ);
    dbg::cmp<float, unsigned short><<<1024, 256, 0, stream>>>(nproj, EVEN_IN, fproj, fk::PITCH, NTOK, 512, 1.f / C2, acc + 0);
    dbg::cmp<float, unsigned short><<<1024, 256, 0, stream>>>(nproj + 512, EVEN_IN, fproj + 512, fk::PITCH, NTOK, 3072, 1.f, acc + 2);
    dbg::cmp<float, float><<<1024, 256, 0, stream>>>(nproj + 3584, EVEN_IN, (const float*)(ws + fk::WS_PB), 16, NTOK, 8, 1.f, acc + 4);
    dbg::cmp<float, unsigned short><<<1024, 256, 0, stream>>>((const float*)(keep + 512 * MiB), D, (const unsigned short*)(ws + fk::WS_ATT), D, NTOK, D, 1.f, acc + 6);
    const int nchk = 4;
#elif MK_DBG_CFG == 2
    Save sv[] = {{0, ST_XOUT, keep}, {1, ST_PROJ, keep + 128 * MiB}, {1, ST_CUM, keep + 648 * MiB}, {1, ST_MIX, keep + 656 * MiB}, {1, ST_H, keep + 784 * MiB}, {1, ST_XMIX, keep + 912 * MiB}, {1, ST_XOUT, keep + 1040 * MiB}};
    forward(in, ws, nout, sv, 7, stream);
    (void)hipMemsetAsync(ws + fk::WS_CTL, 0, fk::CTL_BYTES, stream); (void)hipMemsetAsync(acc, 0, 1024, stream);
    fast_forward(d_in, (float*)d_out, ws, stream, 0, 2, false, (const float*)keep, 1);
    const int s0 = 2 + 9;
    const float* nproj = (const float*)(keep + 128 * MiB); const unsigned short* fproj = (const unsigned short*)(ws + fk::WS_PROJ);
    fast_forward(d_in, (float*)d_out, ws, stream, s0, s0 + 2, false, (const float*)keep, 1);
    dbg::cmp<float, unsigned short><<<1024, 256, 0, stream>>>(nproj, ODD_IN, fproj, fk::PITCH, NTOK, 1024, 1.f / C2, acc + 0);
    dbg::cmp<float, unsigned short><<<1024, 256, 0, stream>>>(nproj + 1024, ODD_IN, fproj + 1024, fk::PITCH, NTOK, 3072, 1.f, acc + 2);
    dbg::cmp<float, float><<<1024, 256, 0, stream>>>((const float*)(keep + 648 * MiB), T, (const float*)(ws + fk::WS_CUM), T, 32, T, 1.f / fk::LOG2E, acc + 4);
    fast_forward(d_in, (float*)d_out, ws, stream, s0 + 2, s0 + 3, false, (const float*)keep, 1);
    dbg::cmp<float, unsigned short><<<1024, 256, 0, stream>>>((const float*)(keep + 656 * MiB), D, (const unsigned short*)(ws + fk::WS_MIX), D, NTOK, D, 1.f, acc + 6);
    fast_forward(d_in, (float*)d_out, ws, stream, s0 + 3, s0 + 4, false, (const float*)keep, 1);
    dbg::cmp<float, float><<<1024, 256, 0, stream>>>((const float*)(keep + 784 * MiB), D, (const float*)(ws + fk::WS_H), D, NTOK, D, 1.f, acc + 8);
    fast_forward(d_in, (float*)d_out, ws, stream, s0 + 4, s0 + 5, false, (const float*)keep, 1);
    dbg::cmp<float, float><<<1024, 256, 0, stream>>>((const float*)(keep + 912 * MiB), D, (const float*)(ws + fk::WS_X), D, NTOK, D, 1.f, acc + 10);
    fast_forward(d_in, (float*)d_out, ws, stream, s0 + 5, s0 + 8, false, (const float*)keep, 1);
    dbg::cmp<float, float><<<1024, 256, 0, stream>>>((const float*)(keep + 1040 * MiB), D, (const float*)(ws + fk::WS_X), D, NTOK, D, 1.f, acc + 12);
    const int nchk = 7;
#elif MK_DBG_CFG == 3
    Save sv[] = {{0, ST_ATT, keep}, {0, ST_GO, keep + 128 * MiB}, {0, ST_MIX, keep + 192 * MiB}, {0, ST_H, keep + 320 * MiB}, {0, ST_XMIX, keep + 448 * MiB}, {0, ST_XOUT, keep + 576 * MiB}};
    forward(in, ws, nout, sv, 6, stream);
    (void)hipMemsetAsync(ws + fk::WS_CTL, 0, fk::CTL_BYTES, stream); (void)hipMemsetAsync(acc, 0, 1024, stream);
    fast_forward(d_in, (float*)d_out, ws, stream, 0, 5, false, nullptr, 0);
    dbg::cmp<float, unsigned short><<<1024, 256, 0, stream>>>((const float*)keep, D, (const unsigned short*)(ws + fk::WS_ATT), D, NTOK, D, 1.f, acc + 0);
    dbg::cmp<float, float><<<1024, 256, 0, stream>>>((const float*)(keep + 128 * MiB), 512, (const float*)(ws + fk::WS_GO), 512, NTOK, 512, 1.f, acc + 2);
    fast_forward(d_in, (float*)d_out, ws, stream, 5, 6, false, nullptr, 0);
    dbg::cmp<float, unsigned short><<<1024, 256, 0, stream>>>((const float*)(keep + 192 * MiB), D, (const unsigned short*)(ws + fk::WS_MIX), D, NTOK, D, 1.f, acc + 4);
    fast_forward(d_in, (float*)d_out, ws, stream, 6, 7, false, nullptr, 0);
    dbg::cmp<float, float><<<1024, 256, 0, stream>>>((const float*)(keep + 320 * MiB), D, (const float*)(ws + fk::WS_H), D, NTOK, D, 1.f, acc + 6);
    fast_forward(d_in, (float*)d_out, ws, stream, 7, 8, false, nullptr, 0);
    dbg::cmp<float, float><<<1024, 256, 0, stream>>>((const float*)(keep + 448 * MiB), D, (const float*)(ws + fk::WS_X), D, NTOK, D, 1.f, acc + 8);
    fast_forward(d_in, (float*)d_out, ws, stream, 8, 11, false, nullptr, 0);
    dbg::cmp<float, float><<<1024, 256, 0, stream>>>((const float*)(keep + 576 * MiB), D, (const float*)(ws + fk::WS_X), D, NTOK, D, 1.f, acc + 10);
    const int nchk = 6;
#elif MK_DBG_CFG == 6
#ifndef MK_QLO
#define MK_QLO 0
#define MK_QHI 63
#endif
    (void)hipMemsetAsync(ws + fk::WS_CTL, 0, fk::CTL_BYTES, stream);
    (void)hipMemsetAsync(ws + fk::WS_GW, 0, fk::WS_GU - fk::WS_GW, stream);
#ifndef MK_NSTEP
#define MK_NSTEP 5
#endif
    fast_forward(d_in, (float*)(ws + 2400 * MiB), ws, stream, 0, MK_NSTEP, false, nullptr, 0);
#ifndef MK_OUTBUF
#define MK_OUTBUF 0
#endif
    if (MK_OUTBUF == 0) dbg::att2out<<<1024, 256, 0, stream>>>((float*)d_out, (const unsigned short*)(ws + fk::WS_ATT), MK_QLO, MK_QHI);
    else if (MK_OUTBUF == 1) dbg::f32out<<<1024, 256, 0, stream>>>((float*)d_out, (const float*)(ws + fk::WS_X));
    else if (MK_OUTBUF == 2) dbg::att2out<<<1024, 256, 0, stream>>>((float*)d_out, (const unsigned short*)(ws + fk::WS_MIX), 0, 63);
    else if (MK_OUTBUF == 8) dbg::bf16n<<<1024, 256, 0, stream>>>((float*)d_out, (const unsigned short*)(ws + fk::WS_GW), 2048L * 64 * 136);
    else if (MK_OUTBUF == 9) dbg::bf16n<<<1024, 256, 0, stream>>>((float*)d_out, (const unsigned short*)(ws + fk::WS_GQD), 2048L * 64 * 136);
    else if (MK_OUTBUF == 10) dbg::bf16n<<<1024, 256, 0, stream>>>((float*)d_out, (const unsigned short*)(ws + fk::WS_GQK), 2048L * 64 * 72);
    else if (MK_OUTBUF == 11) dbg::bf16n<<<1024, 256, 0, stream>>>((float*)d_out, (const unsigned short*)(ws + fk::WS_GKD), 2048L * 128 * 72);
    else if (MK_OUTBUF == 6) dbg::att2out<<<1024, 256, 0, stream>>>((float*)d_out, (const unsigned short*)(ws + fk::WS_GW), 0, 63);
    else if (MK_OUTBUF == 7) dbg::att2out<<<1024, 256, 0, stream>>>((float*)d_out, (const unsigned short*)(ws + fk::WS_GQK), 0, 63);
    else if (MK_OUTBUF == 4) dbg::f32half<<<1024, 256, 0, stream>>>((float*)d_out, (const float*)(ws + fk::WS_GO));
    else if (MK_OUTBUF == 5) dbg::f32half<<<1024, 256, 0, stream>>>((float*)d_out, (const float*)(ws + fk::WS_GU));
    else dbg::f32out<<<1024, 256, 0, stream>>>((float*)d_out, (const float*)(ws + fk::WS_H));
    (void)nout; (void)acc; (void)in; (void)C2;
    const int nchk = 0; if (nchk == 0) return;
#elif MK_DBG_CFG == 7
    forward(in, ws, nout, nullptr, 0, stream);
    float* fout = (float*)(keep + 1024 * MiB); unsigned* stat = (unsigned*)acc; (void)hipMemsetAsync(stat, 0, 64, stream);
    (void)hipMemsetAsync(ws + fk::WS_CTL, 0, fk::CTL_BYTES, stream);
    (void)hipMemsetAsync(ws + fk::WS_ATT, 0xFF, (size_t)64 * MiB, stream);
    fast_forward(d_in, fout, ws, stream, 0, 5, false, nullptr, 0);
    dbg::countpoison<<<1024, 256, 0, stream>>>((const unsigned short*)(ws + fk::WS_ATT), (size_t)NTOK * D, stat);
    dbg::finish3<<<1024, 256, 0, stream>>>((float*)d_out, nout, stat, 0, 0.f, (long)NTOK * D);
    const int nchk = 0; if (nchk == 0) return;
#elif MK_DBG_CFG == 5
    forward(in, ws, nout, nullptr, 0, stream);
    float* fout = (float*)(keep + 1024 * MiB); unsigned* stat = (unsigned*)acc; (void)hipMemsetAsync(stat, 0, 64, stream);
    for (int run = 0; run < 2; ++run) {
        (void)hipMemsetAsync(ws + fk::WS_CTL, 0, fk::CTL_BYTES, stream);
        fast_forward(d_in, fout, ws, stream, 0, 5, false, nullptr, 0);
        if (run == 0) (void)hipMemcpyAsync(keep, ws + fk::WS_ATT, (size_t)64 * MiB, hipMemcpyDeviceToDevice, stream);
    }
    dbg::attdiff<<<2048, 256, 0, stream>>>((const unsigned short*)keep, (const unsigned short*)(ws + fk::WS_ATT), stat, 0);
#if MK_DBG_WHICH == 9
    (void)hipMemsetAsync(acc + 16, 0, 64, stream);
    dbg::cmp<unsigned short, unsigned short><<<1024, 256, 0, stream>>>((const unsigned short*)keep, D, (const unsigned short*)(ws + fk::WS_ATT), D, NTOK, D, 1.f, acc + 16);
    dbg::finish4<<<1024, 256, 0, stream>>>((float*)d_out, nout, acc + 16, (long)NTOK * D);
#else
    dbg::finish3<<<1024, 256, 0, stream>>>((float*)d_out, nout, stat, MK_DBG_WHICH < 0 ? 0 : MK_DBG_WHICH, MK_DBG_DENOM, (long)NTOK * D);
#endif
    const int nchk = 0; if (nchk == 0) return;
#elif MK_DBG_CFG == 4
    forward(in, ws, nout, nullptr, 0, stream);
    float* fout = (float*)(keep + 1024 * MiB);
    unsigned long long* cs = (unsigned long long*)acc; (void)hipMemsetAsync(cs, 0, 4096, stream);
#ifndef MK_DBG_S0
#define MK_DBG_S0 0
#endif
#ifndef MK_DBG_NS
#define MK_DBG_NS 9
#endif
    int nslot = 0;
#ifndef MK_NRUN
#define MK_NRUN 2
#endif
    for (int run = 0; run < MK_NRUN; ++run) {
        (void)hipMemsetAsync(ws + fk::WS_CTL, 0, fk::CTL_BYTES, stream);
        int slot = 0;
        auto CS2 = [&](size_t off, size_t rows, size_t colw, size_t pitchw) { if (slot >= MK_DBG_S0 && slot < MK_DBG_S0 + MK_DBG_NS) dbg::csum<<<1024, 256, 0, stream>>>((const unsigned*)(ws + off), rows * colw, cs + 16 * run + (slot - MK_DBG_S0), colw, pitchw); ++slot; };
        auto CS = [&](size_t off, size_t bytes) { CS2(off, 1, bytes / 4, bytes / 4); };
        int st = 0;
        auto RUN = [&](int n) { fast_forward(d_in, fout, ws, stream, st, st + n, false, nullptr, 0); st += n; };
        RUN(1); CS(fk::WS_WINE, fk::WS_X - fk::WS_WINE);
        RUN(1); CS(fk::WS_X, (size_t)192 * MiB); CS(fk::WS_PB, 2 * MiB);
        for (int layer = 0; layer < 4; ++layer) {
            RUN(1); CS2(fk::WS_PROJ, NTOK, (layer & 1) ? 2048 : 1792, 2048);
            if ((layer & 1) == 0) { RUN(1); CS(fk::WS_GU, (size_t)64 * MiB); CS(fk::WS_GL, 8192); CS2(fk::WS_GW, 2048 * 64, 64, 68); CS2(fk::WS_GQD, 2048 * 64, 64, 68); CS2(fk::WS_GQK, 2048 * 64, 32, 36); CS2(fk::WS_GKD, 2048 * 128, 32, 36); RUN(1); CS(fk::WS_ATT, (size_t)64 * MiB); CS(fk::WS_GO, (size_t)64 * MiB); RUN(1); CS(fk::WS_MIX, (size_t)64 * MiB); }
            else { RUN(1); CS2(fk::WS_PROJ, NTOK, 2048, 2048); CS(fk::WS_CUM, 2 * MiB); CS(fk::WS_KB8, 8 * MiB); RUN(1); CS(fk::WS_MIX, (size_t)64 * MiB); }
            RUN(1); CS(fk::WS_H, (size_t)128 * MiB);
            RUN(1); CS(fk::WS_X, (size_t)192 * MiB); CS(fk::WS_SELE, 512 * 1024); CS(fk::WS_GATE, 512 * 1024);
            RUN(3); if (layer < 3) CS(fk::WS_X, (size_t)192 * MiB);
        }
        nslot = slot;
    }
    (void)nslot;
    dbg::finish2<<<1024, 256, 0, stream>>>((float*)d_out, nout, cs, 9, MK_NRUN, (long)NTOK * D);
    const int nchk = 0; if (nchk == 0) return;
#endif
    dbg::finish<<<1024, 256, 0, stream>>>((float*)d_out, nout, acc, nchk, 1e-3f, MK_DBG_WHICH, (long)NTOK * D);
#else
    (void)hipMemsetAsync(ws + fk::WS_CTL, 0, fk::CTL_BYTES, stream);
    fast_forward(d_in, (float*)d_out, ws, stream, 0, fk::N_STEPS, MK_SINGLE != 0, nullptr, 0);
#endif
}
```

```cpp
#define MK_SINGLE 1
#ifndef MK_DEBUG
#define MK_DEBUG 0
#endif
#include <hip/hip_runtime.h>
#include <cstdint>
#include <cstdio>

namespace cfg {
constexpr int B = 2, T = 16384, D = 1024, NTOK = B * T;
constexpr int EVEN_IN = 3592, ODD_IN = 4112;
constexpr int NE = 32, TOPK = 4, DFF = 1024;
constexpr float ALPHA = 1.681792830507429f;
constexpr float LN_EPS = 1e-5f, RMS_EPS = 1e-6f;
}
using namespace cfg;

#if MK_DEBUG
namespace nv {

__device__ __forceinline__ float sigmoidf_(float x) { return 1.f / (1.f + __expf(-x)); }
__device__ __forceinline__ float softplusf_(float x) { return x > 20.f ? x : log1pf(expf(x)); }

struct GemmArgs {
    const float* A; const float* Bm; const float* bias; float* C; const int* cnt; const int* off; const int* list;
    int lda, ldb, ldc, M, N, K;
};
template <int MODE>
__global__ void __launch_bounds__(256) gemm(GemmArgs g) {
    __shared__ float As[16][128 + 4];
    __shared__ float Bs[16][128 + 4];
    const int tid = threadIdx.x, tx = tid & 15, ty = tid >> 4;
    const int m0 = blockIdx.y * 128, n0 = blockIdx.x * 128;
    int M = g.M; const float* Bm = g.Bm; const float* bias = g.bias; int rowbase = 0; const int* lst = nullptr;
    if (MODE != 0) {
        const int e = blockIdx.z; M = g.cnt[e]; if (m0 >= M) return;
        rowbase = g.off[e]; lst = g.list + (size_t)e * NTOK;
        Bm += (size_t)e * g.K * g.ldb; if (bias) bias += (size_t)e * g.N;
    }
    const float* arow[2]; bool aval[2];
#pragma unroll
    for (int i = 0; i < 2; ++i) {
        const int r = m0 + (tid >> 2) + 64 * i; aval[i] = r < M;
        if (MODE == 0) arow[i] = g.A + (size_t)r * g.lda;
        else if (MODE == 1) { const int tok = aval[i] ? (lst[r] >> 2) : 0; arow[i] = g.A + (size_t)tok * g.lda; }
        else arow[i] = g.A + (size_t)(rowbase + r) * g.lda;
    }
    float acc[8][8];
#pragma unroll
    for (int i = 0; i < 8; ++i)
#pragma unroll
        for (int j = 0; j < 8; ++j) acc[i][j] = 0.f;
    for (int k0 = 0; k0 < g.K; k0 += 16) {
#pragma unroll
        for (int i = 0; i < 2; ++i) {
            const int r = (tid >> 2) + 64 * i, c = (tid & 3) * 4;
            float4 v = make_float4(0.f, 0.f, 0.f, 0.f);
            if (aval[i]) {
                v = *(const float4*)(arow[i] + k0 + c);
                if (MODE == 2) {
                    const float4 u = *(const float4*)(arow[i] + 1024 + k0 + c);
                    float gg[4] = {v.x, v.y, v.z, v.w}, uu[4] = {u.x, u.y, u.z, u.w}, o[4];
#pragma unroll
                    for (int q = 0; q < 4; ++q) { const float a = fminf(gg[q], 7.f), b = fminf(fmaxf(uu[q], -7.f), 7.f); o[q] = a * sigmoidf_(1.702f * a) * (b + 1.f); }
                    v = make_float4(o[0], o[1], o[2], o[3]);
                }
            }
            As[c][r] = v.x; As[c + 1][r] = v.y; As[c + 2][r] = v.z; As[c + 3][r] = v.w;
        }
#pragma unroll
        for (int i = 0; i < 2; ++i) {
            const int r = (tid >> 5) + 8 * i, c = (tid & 31) * 4;
            const float* bp = Bm + (size_t)(k0 + r) * g.ldb + n0 + c;
            float4 v;
            if (n0 + c + 3 < g.N) v = *(const float4*)bp;
            else { v.x = (n0 + c < g.N) ? bp[0] : 0.f; v.y = (n0 + c + 1 < g.N) ? bp[1] : 0.f; v.z = (n0 + c + 2 < g.N) ? bp[2] : 0.f; v.w = 0.f; }
            *(float4*)&Bs[r][c] = v;
        }
        __syncthreads();
#pragma unroll
        for (int kk = 0; kk < 16; ++kk) {
            const float4 a0 = *(const float4*)&As[kk][ty * 8], a1 = *(const float4*)&As[kk][ty * 8 + 4];
            const float4 b0 = *(const float4*)&Bs[kk][tx * 8], b1 = *(const float4*)&Bs[kk][tx * 8 + 4];
            const float a[8] = {a0.x, a0.y, a0.z, a0.w, a1.x, a1.y, a1.z, a1.w};
            const float b[8] = {b0.x, b0.y, b0.z, b0.w, b1.x, b1.y, b1.z, b1.w};
#pragma unroll
            for (int i = 0; i < 8; ++i)
#pragma unroll
                for (int j = 0; j < 8; ++j) acc[i][j] = fmaf(a[i], b[j], acc[i][j]);
        }
        __syncthreads();
    }
#pragma unroll
    for (int i = 0; i < 8; ++i) {
        const int r = m0 + ty * 8 + i; if (r >= M) continue;
        float* crow = g.C + (size_t)(rowbase + r) * g.ldc;
#pragma unroll
        for (int j = 0; j < 8; ++j) { const int c = n0 + tx * 8 + j; if (c < g.N) crow[c] = acc[i][j] + (bias ? bias[c] : 0.f); }
    }
}

__device__ __forceinline__ float block_sum_256(float v, float* red) {
#pragma unroll
    for (int o = 32; o > 0; o >>= 1) v += __shfl_xor(v, o);
    __syncthreads();
    if ((threadIdx.x & 63) == 0) red[threadIdx.x >> 6] = v;
    __syncthreads();
    return red[0] + red[1] + red[2] + red[3];
}
__global__ void __launch_bounds__(256) ln_res(float* X, const float* H, const float* gam, const float* bet, float* Xout) {
    __shared__ float red[4];
    const size_t row = blockIdx.x; const int c = threadIdx.x * 4;
    const float4 x = *(const float4*)(X + row * D + c), h = *(const float4*)(H + row * D + c);
    float v[4] = {ALPHA * x.x + h.x, ALPHA * x.y + h.y, ALPHA * x.z + h.z, ALPHA * x.w + h.w};
    const float mean = block_sum_256(v[0] + v[1] + v[2] + v[3], red) * (1.f / D);
    float q = 0.f;
#pragma unroll
    for (int i = 0; i < 4; ++i) { v[i] -= mean; q += v[i] * v[i]; }
    const float rstd = rsqrtf(block_sum_256(q, red) * (1.f / D) + LN_EPS);
    const float4 gg = *(const float4*)(gam + c), bb = *(const float4*)(bet + c);
    const float4 o = make_float4(v[0] * rstd * gg.x + bb.x, v[1] * rstd * gg.y + bb.y, v[2] * rstd * gg.z + bb.z, v[3] * rstd * gg.w + bb.w);
    *(float4*)(Xout + row * D + c) = o;
}

template <int MODE>
__global__ void __launch_bounds__(256) attn(const float* P, float* O, const float* tab  , const float* cum  , int ldp) {
    __shared__ float Ks[64][64];
    __shared__ float Vs[64][64];
    __shared__ float ck[64];
    __shared__ float tb[MODE == 0 ? 2048 : 1];
    const int tid = threadIdx.x, qb = gridDim.x - 1 - blockIdx.x, b = blockIdx.y >> 4, vh = blockIdx.y & 15;
    int qcol, kcol, vcol, ocol, h;
    if (MODE == 0) { h = vh >> 2; const int m = (vh >> 1) & 1, half = vh & 1; qcol = h * 128 + m * 64; kcol = 512 + h * 128 + m * 64; vcol = 1024 + h * 128 + half * 64; ocol = (h * 2 + m) * 128 + half * 64; }
    else { h = vh; qcol = h * 64; kcol = 1024 + h * 64; vcol = 2048 + h * 64; ocol = h * 64; }
    if (MODE == 0) { for (int i = tid; i < 2048; i += 256) tb[i] = tab[h * 2048 + i]; }
    const int i_row = qb * 256 + tid; const size_t tok = (size_t)b * T + i_row;
    float q[64], o[64];
#pragma unroll
    for (int d = 0; d < 64; d += 4) { const float4 v = *(const float4*)(P + tok * ldp + qcol + d); q[d] = v.x * 0.125f; q[d + 1] = v.y * 0.125f; q[d + 2] = v.z * 0.125f; q[d + 3] = v.w * 0.125f; }
#pragma unroll
    for (int d = 0; d < 64; ++d) o[d] = 0.f;
    float m_run = -INFINITY, l_run = 0.f;
    float cq = 0.f; const float* cumrow = nullptr;
    if (MODE == 1) { cumrow = cum + (size_t)(b * 16 + h) * T; cq = cumrow[i_row]; }
    const float far_bias = (MODE == 0) ? tab[h * 2048 + 2047] : 0.f;
    const int ntile = 4 * qb + 4;
    for (int kt = 0; kt < ntile; ++kt) {
        __syncthreads();
        {
            const int r = tid >> 2, c0 = (tid & 3) * 16; const size_t ktok = (size_t)b * T + kt * 64 + r;
#pragma unroll
            for (int c = 0; c < 16; c += 4) { *(float4*)&Ks[r][c0 + c] = *(const float4*)(P + ktok * ldp + kcol + c0 + c); *(float4*)&Vs[r][c0 + c] = *(const float4*)(P + ktok * ldp + vcol + c0 + c); }
            if (MODE == 1 && tid < 64) ck[tid] = cumrow[kt * 64 + tid];
        }
        __syncthreads();
        if (kt * 64 > i_row) continue;
#pragma unroll 1
        for (int jj = 0; jj < 64; ++jj) {
            const int j = kt * 64 + jj; const int dist = i_row - j;
            if (dist < 0) break;
            float dot = 0.f;
#pragma unroll
            for (int d = 0; d < 64; d += 4) { const float4 kv = *(const float4*)&Ks[jj][d]; dot = fmaf(q[d], kv.x, dot); dot = fmaf(q[d + 1], kv.y, dot); dot = fmaf(q[d + 2], kv.z, dot); dot = fmaf(q[d + 3], kv.w, dot); }
            float bias;
            if (MODE == 0) bias = dist < 2048 ? tb[dist] : far_bias;
            else bias = cq - ck[jj];
            const float sc = dot + bias;
            if (sc > m_run) { const float f = __expf(m_run - sc); l_run *= f;
#pragma unroll
                for (int d = 0; d < 64; ++d) o[d] *= f;
                m_run = sc; }
            const float p = __expf(sc - m_run); l_run += p;
#pragma unroll
            for (int d = 0; d < 64; d += 4) { const float4 vv = *(const float4*)&Vs[jj][d]; o[d] = fmaf(p, vv.x, o[d]); o[d + 1] = fmaf(p, vv.y, o[d + 1]); o[d + 2] = fmaf(p, vv.z, o[d + 2]); o[d + 3] = fmaf(p, vv.w, o[d + 3]); }
        }
    }
    const float inv = 1.f / l_run;
#pragma unroll
    for (int d = 0; d < 64; d += 4) *(float4*)(O + tok * D + ocol + d) = make_float4(o[d] * inv, o[d + 1] * inv, o[d + 2] * inv, o[d + 3] * inv);
}

__global__ void t5tab(const float* t5, float* tab) {
    const int i = blockIdx.x * blockDim.x + threadIdx.x; if (i >= 4 * 2048) return;
    const int h = i >> 11, n = i & 2047; int bk;
    if (n < 16) bk = n; else { bk = 16 + (int)(log((double)n / 16.0) / log(128.0) * 16.0); if (bk > 31) bk = 31; }
    tab[i] = t5[bk * 4 + h];
}

__global__ void conv_silu(const float* P  , const float* w  , float* CQ  ) {
    const size_t i = (size_t)blockIdx.x * blockDim.x + threadIdx.x; if (i >= (size_t)NTOK * 1536) return;
    const int c = (int)(i % 1536); const size_t tok = i / 1536; const int t = (int)(tok % T);
    float y = 0.f;
#pragma unroll
    for (int j = 0; j < 4; ++j) { const int tt = t - 3 + j; if (tt >= 0) y = fmaf(w[j * 1536 + c], P[(tok - 3 + j) * EVEN_IN + 1536 + c], y); }
    CQ[i] = y * sigmoidf_(y);
}
__global__ void gdn_norm(const float* P, float* CQ, const float* a_log, const float* dt_bias, float* BETA, float* G) {
    const int i = blockIdx.x * blockDim.x + threadIdx.x; if (i >= NTOK * 8) return;
    const int which = i & 1, h = (i >> 1) & 3; const size_t tok = i >> 3;
    float* p = CQ + tok * 1536 + which * 512 + h * 128; float ss = 0.f;
    for (int d = 0; d < 128; ++d) ss = fmaf(p[d], p[d], ss);
    const float r = rsqrtf(ss + RMS_EPS);
    for (int d = 0; d < 128; ++d) p[d] *= r;
    if (which == 0) {
        BETA[tok * 4 + h] = sigmoidf_(P[tok * EVEN_IN + 3584 + h]);
        G[tok * 4 + h] = -expf(a_log[h]) * softplusf_(P[tok * EVEN_IN + 3588 + h] + dt_bias[h]);
    }
}
__global__ void __launch_bounds__(128) gdn_rec(const float* CQ, const float* BETA, const float* G, float* GO  ) {
    __shared__ float ks[2][128], qs[2][128];
    const int b = blockIdx.x >> 2, h = blockIdx.x & 3, c = threadIdx.x;
    float S[128];
#pragma unroll
    for (int d = 0; d < 128; ++d) S[d] = 0.f;
    const float scale = 0.08838834764831845f;
    for (int t = 0; t < T; ++t) {
        const size_t tok = (size_t)b * T + t; const int bf = t & 1;
        ks[bf][c] = CQ[tok * 1536 + 512 + h * 128 + c]; qs[bf][c] = CQ[tok * 1536 + h * 128 + c];
        const float v = CQ[tok * 1536 + 1024 + h * 128 + c], beta = BETA[tok * 4 + h], alpha = __expf(G[tok * 4 + h]);
        __syncthreads();
        float ksum = 0.f;
#pragma unroll
        for (int d = 0; d < 128; d += 4) { const float4 k4 = *(const float4*)&ks[bf][d]; ksum = fmaf(k4.x, S[d], ksum); ksum = fmaf(k4.y, S[d + 1], ksum); ksum = fmaf(k4.z, S[d + 2], ksum); ksum = fmaf(k4.w, S[d + 3], ksum); }
        const float vnew = beta * (v - alpha * ksum);
        float o = 0.f;
#pragma unroll
        for (int d = 0; d < 128; d += 4) { const float4 k4 = *(const float4*)&ks[bf][d]; const float4 q4 = *(const float4*)&qs[bf][d];
            S[d] = fmaf(alpha, S[d], k4.x * vnew); S[d + 1] = fmaf(alpha, S[d + 1], k4.y * vnew); S[d + 2] = fmaf(alpha, S[d + 2], k4.z * vnew); S[d + 3] = fmaf(alpha, S[d + 3], k4.w * vnew);
            o = fmaf(q4.x, S[d], o); o = fmaf(q4.y, S[d + 1], o); o = fmaf(q4.z, S[d + 2], o); o = fmaf(q4.w, S[d + 3], o); }
        GO[tok * 512 + h * 128 + c] = o * scale;
    }
}
__global__ void __launch_bounds__(128) even_combine(const float* ATT  , const float* GO, const float* P, const float* lamp  ,
                                                    const float* subln_w, const float* gdn_w, float* MIX, float lam_init) {
    __shared__ float red[2]; __shared__ float lam_s;
    const size_t tok = blockIdx.x; const int d = threadIdx.x;
    if (d < 64) {
        float a = lamp[d] * lamp[64 + d], bb = lamp[128 + d] * lamp[192 + d];
#pragma unroll
        for (int o = 32; o > 0; o >>= 1) { a += __shfl_xor(a, o); bb += __shfl_xor(bb, o); }
        if (d == 0) lam_s = expf(a) - expf(bb) + lam_init;
    }
    __syncthreads();
    const float lam = lam_s;
    for (int grp = 0; grp < 8; ++grp) {
        float v;
        if (grp < 4) v = ATT[tok * D + (grp * 2) * 128 + d] - lam * ATT[tok * D + (grp * 2 + 1) * 128 + d];
        else v = GO[tok * 512 + (grp - 4) * 128 + d];
        float ss = v * v;
#pragma unroll
        for (int o = 32; o > 0; o >>= 1) ss += __shfl_xor(ss, o);
        __syncthreads();
        if ((d & 63) == 0) red[d >> 6] = ss;
        __syncthreads();
        const float r = rsqrtf((red[0] + red[1]) * (1.f / 128.f) + RMS_EPS);
        float outv;
        if (grp < 4) outv = v * r * subln_w[d] * (1.f - lam_init);
        else { const float z = P[tok * EVEN_IN + 3072 + (grp - 4) * 128 + d]; outv = v * r * gdn_w[d] * (z * sigmoidf_(z)); }
        MIX[tok * D + grp * 128 + d] = outv;
    }
}

__global__ void qknorm(float* P  , const float* w  ) {
    const int i = blockIdx.x * blockDim.x + threadIdx.x; if (i >= NTOK * 32) return;
    const int which = i & 1, h = (i >> 1) & 15; const size_t tok = i >> 5;
    float* p = P + tok * ODD_IN + which * 1024 + h * 64; float ss = 0.f;
    for (int d = 0; d < 64; ++d) ss = fmaf(p[d], p[d], ss);
    const float r = rsqrtf(ss * (1.f / 64.f) + RMS_EPS);
    for (int d = 0; d < 64; ++d) p[d] = p[d] * r * w[which * 64 + d];
}
__global__ void logf_k(const float* P, const float* fb, float* LF  ) {
    const int i = blockIdx.x * blockDim.x + threadIdx.x; if (i >= NTOK * 16) return;
    const int h = i & 15; const size_t tok = i >> 4; const int b = (int)(tok / T), t = (int)(tok % T);
    const float x = P[tok * ODD_IN + 4096 + h] + fb[h];
    LF[(size_t)(b * 16 + h) * T + t] = -softplusf_(-x);
}
__global__ void __launch_bounds__(1024) cumsum16k(float* LF) {
    __shared__ float part[1024];
    float* p = LF + (size_t)blockIdx.x * T + threadIdx.x * 16; float v[16]; float s = 0.f;
#pragma unroll
    for (int i = 0; i < 16; ++i) { s += p[i]; v[i] = s; }
    part[threadIdx.x] = s; __syncthreads();
    for (int o = 1; o < 1024; o <<= 1) { float a = threadIdx.x >= o ? part[threadIdx.x - o] : 0.f; __syncthreads(); part[threadIdx.x] += a; __syncthreads(); }
    const float base = threadIdx.x ? part[threadIdx.x - 1] : 0.f;
#pragma unroll
    for (int i = 0; i < 16; ++i) p[i] = v[i] + base;
}
__global__ void gate_k(const float* ATT, const float* P, float* MIX) {
    const size_t i = (size_t)blockIdx.x * blockDim.x + threadIdx.x; if (i >= (size_t)NTOK * D) return;
    const size_t tok = i >> 10; const int c = (int)(i & 1023);
    MIX[i] = ATT[i] * sigmoidf_(P[tok * ODD_IN + 3072 + c]);
}

__global__ void __launch_bounds__(256) router(const float* X, const float* rw  , const float* rb, int* cnt, int* list, int* sel_e, int* sel_slot, float* gate) {
    __shared__ float lg[8][32];
    const int tk = threadIdx.x >> 5, e = threadIdx.x & 31; const size_t tok = (size_t)blockIdx.x * 8 + tk;
    const float* x = X + tok * D; float acc = 0.f;
    for (int k = 0; k < D; ++k) acc = fmaf(x[k], rw[k * 32 + e], acc);
    lg[tk][e] = acc + rb[e];
    __syncthreads();
    if (e == 0) {
        float v[4]; int id[4]; unsigned used = 0u;
#pragma unroll
        for (int k = 0; k < 4; ++k) { float best = -INFINITY; int bi = 0; for (int j = 0; j < 32; ++j) { const float z = lg[tk][j]; if (!((used >> j) & 1u) && z > best) { best = z; bi = j; } } used |= 1u << bi; v[k] = best; id[k] = bi; }
        float s = 0.f, p[4];
#pragma unroll
        for (int k = 0; k < 4; ++k) { p[k] = __expf(v[k] - v[0]); s += p[k]; }
#pragma unroll
        for (int k = 0; k < 4; ++k) {
            const int slot = atomicAdd(&cnt[id[k]], 1);
            list[(size_t)id[k] * NTOK + slot] = (int)(tok * 4 + k);
            sel_e[tok * 4 + k] = id[k]; sel_slot[tok * 4 + k] = slot; gate[tok * 4 + k] = p[k] / s;
        }
    }
}
__global__ void offsets(const int* cnt, int* off) { if (threadIdx.x == 0) { int s = 0; for (int e = 0; e < NE; ++e) { off[e] = s; s += cnt[e]; } } }
__global__ void __launch_bounds__(256) combine_ln(float* X, const float* Y, const int* off, const int* sel_e, const int* sel_slot, const float* gate, const float* gam, const float* bet, float* Xout) {
    __shared__ float red[4];
    const size_t row = blockIdx.x; const int c = threadIdx.x * 4;
    const float4 x = *(const float4*)(X + row * D + c);
    float v[4] = {ALPHA * x.x, ALPHA * x.y, ALPHA * x.z, ALPHA * x.w};
#pragma unroll
    for (int k = 0; k < 4; ++k) { const size_t pos = (size_t)off[sel_e[row * 4 + k]] + sel_slot[row * 4 + k]; const float gt = gate[row * 4 + k]; const float4 y = *(const float4*)(Y + pos * D + c);
        v[0] = fmaf(gt, y.x, v[0]); v[1] = fmaf(gt, y.y, v[1]); v[2] = fmaf(gt, y.z, v[2]); v[3] = fmaf(gt, y.w, v[3]); }
    const float mean = block_sum_256(v[0] + v[1] + v[2] + v[3], red) * (1.f / D);
    float q = 0.f;
#pragma unroll
    for (int i = 0; i < 4; ++i) { v[i] -= mean; q += v[i] * v[i]; }
    const float rstd = rsqrtf(block_sum_256(q, red) * (1.f / D) + LN_EPS);
    const float4 gg = *(const float4*)(gam + c), bb = *(const float4*)(bet + c);
    *(float4*)(Xout + row * D + c) = make_float4(v[0] * rstd * gg.x + bb.x, v[1] * rstd * gg.y + bb.y, v[2] * rstd * gg.z + bb.z, v[3] * rstd * gg.w + bb.w);
}

constexpr size_t MiB = 1u << 20;
constexpr size_t O_X = 0;
constexpr size_t O_H = 128 * MiB;
constexpr size_t O_MIX = 256 * MiB;
constexpr size_t O_ATT = 384 * MiB;
constexpr size_t O_PROJ = 512 * MiB;
constexpr size_t O_CQ = 1032 * MiB;
constexpr size_t O_GO = 1224 * MiB;
constexpr size_t O_HB = 512 * MiB;
constexpr size_t O_Y = 1536 * MiB;
constexpr size_t O_SMALL = 2048 * MiB;
constexpr size_t O_END = 2064 * MiB;
constexpr size_t S_TAB = 0, S_BETA = 64 * 1024, S_G = S_BETA + 512 * 1024, S_CUM = S_G + 512 * 1024  , S_CNT = S_CUM + 2 * MiB, S_OFF = S_CNT + 256,
                 S_SELE = S_CNT + 4096, S_SLOT = S_SELE + 512 * 1024, S_GATE = S_SLOT + 512 * 1024, S_LIST = S_GATE + 512 * 1024  ;
static_assert(S_LIST + 4 * MiB <= 16 * MiB, "small region");

struct In { const float* p[24]; };
static_assert(sizeof(GemmArgs) == 80, "GemmArgs has padding");

struct Save { int layer, stage; void* dst; };
enum { ST_PROJ = 0, ST_CQ, ST_GO, ST_ATT, ST_MIX, ST_H, ST_XMIX, ST_XOUT, ST_CUM, ST_BETA, ST_G, ST_Y };
static void forward(const In& in, unsigned char* ws, float* out, const Save* sv, int nsv, hipStream_t st) {
    auto save = [&](int layer, int stage, const void* src, size_t bytes) { for (int k = 0; k < nsv; ++k) if (sv[k].layer == layer && sv[k].stage == stage) (void)hipMemcpyAsync(sv[k].dst, src, bytes, hipMemcpyDeviceToDevice, st); };
    float* X = (float*)(ws + O_X); float* H = (float*)(ws + O_H); float* MIX = (float*)(ws + O_MIX); float* ATT = (float*)(ws + O_ATT);
    float* PROJ = (float*)(ws + O_PROJ); float* CQ = (float*)(ws + O_CQ); float* GO = (float*)(ws + O_GO); float* HB = (float*)(ws + O_HB); float* Y = (float*)(ws + O_Y);
    unsigned char* sm = ws + O_SMALL;
    float* TAB = (float*)(sm + S_TAB); float* BETA = (float*)(sm + S_BETA); float* G = (float*)(sm + S_G); float* CUM = (float*)(sm + S_CUM);
    int* CNT = (int*)(sm + S_CNT); int* OFF = (int*)(sm + S_OFF); int* SELE = (int*)(sm + S_SELE); int* SLOT = (int*)(sm + S_SLOT); float* GATE = (float*)(sm + S_GATE); int* LIST = (int*)(sm + S_LIST);
    (void)hipMemcpyAsync(X, in.p[0], (size_t)NTOK * D * 4, hipMemcpyDeviceToDevice, st);
    t5tab<<<32, 256, 0, st>>>(in.p[1], TAB);
    for (int layer = 0; layer < 4; ++layer) {
        const int i = layer >> 1;
        if ((layer & 1) == 0) {
            GemmArgs g{X, in.p[2] + (size_t)i * D * EVEN_IN, nullptr, PROJ, nullptr, nullptr, nullptr, D, EVEN_IN, EVEN_IN, NTOK, EVEN_IN, D};
            gemm<0><<<dim3((EVEN_IN + 127) / 128, NTOK / 128), 256, 0, st>>>(g);
            conv_silu<<<(unsigned)(((size_t)NTOK * 1536 + 255) / 256), 256, 0, st>>>(PROJ, in.p[6] + (size_t)i * 4 * 1536, CQ);
            gdn_norm<<<NTOK * 8 / 256, 256, 0, st>>>(PROJ, CQ, in.p[7] + i * 4, in.p[8] + i * 4, BETA, G);
            save(layer, ST_CQ, CQ, (size_t)NTOK * 1536 * 4); save(layer, ST_BETA, BETA, (size_t)NTOK * 16); save(layer, ST_G, G, (size_t)NTOK * 16);
            gdn_rec<<<8, 128, 0, st>>>(CQ, BETA, G, GO);
            save(layer, ST_GO, GO, (size_t)NTOK * 512 * 4);
            save(layer, ST_PROJ, PROJ, (size_t)NTOK * EVEN_IN * 4);
            attn<0><<<dim3(T / 256, B * 16), 256, 0, st>>>(PROJ, ATT, TAB, nullptr, EVEN_IN);
            save(layer, ST_ATT, ATT, (size_t)NTOK * D * 4);
            const float lam_init = 0.8f - 0.6f * expf(-0.3f * (float)layer);
            even_combine<<<NTOK, 128, 0, st>>>(ATT, GO, PROJ, in.p[4] + i * 256, in.p[5] + i * 128, in.p[9] + i * 128, MIX, lam_init);
            GemmArgs g2{MIX, in.p[3] + (size_t)i * D * D, nullptr, H, nullptr, nullptr, nullptr, D, D, D, NTOK, D, D};
            gemm<0><<<dim3(D / 128, NTOK / 128), 256, 0, st>>>(g2);
        } else {
            GemmArgs g{X, in.p[10] + (size_t)i * D * ODD_IN, nullptr, PROJ, nullptr, nullptr, nullptr, D, ODD_IN, ODD_IN, NTOK, ODD_IN, D};
            gemm<0><<<dim3((ODD_IN + 127) / 128, NTOK / 128), 256, 0, st>>>(g);
            qknorm<<<NTOK * 32 / 256, 256, 0, st>>>(PROJ, in.p[12] + i * 128);
            logf_k<<<NTOK * 16 / 256, 256, 0, st>>>(PROJ, in.p[13] + i * 16, CUM);
            cumsum16k<<<B * 16, 1024, 0, st>>>(CUM);
            save(layer, ST_PROJ, PROJ, (size_t)NTOK * ODD_IN * 4); save(layer, ST_CUM, CUM, (size_t)32 * T * 4);
            attn<1><<<dim3(T / 256, B * 16), 256, 0, st>>>(PROJ, ATT, nullptr, CUM, ODD_IN);
            save(layer, ST_ATT, ATT, (size_t)NTOK * D * 4);
            gate_k<<<(unsigned)((size_t)NTOK * D / 256), 256, 0, st>>>(ATT, PROJ, MIX);
            GemmArgs g2{MIX, in.p[11] + (size_t)i * D * D, nullptr, H, nullptr, nullptr, nullptr, D, D, D, NTOK, D, D};
            gemm<0><<<dim3(D / 128, NTOK / 128), 256, 0, st>>>(g2);
        }
        save(layer, ST_MIX, MIX, (size_t)NTOK * D * 4); save(layer, ST_H, H, (size_t)NTOK * D * 4);
        ln_res<<<NTOK, 256, 0, st>>>(X, H, in.p[20] + layer * D, in.p[21] + layer * D, X);
        save(layer, ST_XMIX, X, (size_t)NTOK * D * 4);
        (void)hipMemsetAsync(CNT, 0, 128, st);
        router<<<NTOK / 8, 256, 0, st>>>(X, in.p[14] + (size_t)layer * D * NE, in.p[15] + layer * NE, CNT, LIST, SELE, SLOT, GATE);
        offsets<<<1, 64, 0, st>>>(CNT, OFF);
        GemmArgs m1{X, in.p[16] + (size_t)layer * NE * D * 2048, in.p[17] + (size_t)layer * NE * 2048, HB, CNT, OFF, LIST, D, 2048, 2048, 0, 2048, D};
        gemm<1><<<dim3(2048 / 128, NTOK / 128, NE), 256, 0, st>>>(m1);
        GemmArgs m2{HB, in.p[18] + (size_t)layer * NE * DFF * D, in.p[19] + (size_t)layer * NE * D, Y, CNT, OFF, LIST, 2048, D, D, 0, D, DFF};
        gemm<2><<<dim3(D / 128, NTOK / 128, NE), 256, 0, st>>>(m2);
        float* dst = (layer == 3) ? out : X;
        combine_ln<<<NTOK, 256, 0, st>>>(X, Y, OFF, SELE, SLOT, GATE, in.p[22] + layer * D, in.p[23] + layer * D, dst);
        save(layer, ST_XOUT, dst, (size_t)NTOK * D * 4);
    }
}
}

#endif
namespace fk {
#define LAS __attribute__((address_space(3)))
#define GAS __attribute__((address_space(1)))
typedef unsigned short bf16_t;
typedef short bf16x8 __attribute__((ext_vector_type(8)));
typedef short s16x4 __attribute__((ext_vector_type(4)));
typedef float f32x2 __attribute__((ext_vector_type(2)));
typedef float f32x4 __attribute__((ext_vector_type(4)));
typedef float f32x16 __attribute__((ext_vector_type(16)));
typedef unsigned u32x2 __attribute__((ext_vector_type(2)));
typedef unsigned u32x4 __attribute__((ext_vector_type(4)));
typedef GAS unsigned gu32;

constexpr int NWAVES = 8, NTHR = 512;
constexpr int PITCH = 4160;
constexpr float LOG2E = 1.4426950408889634f;
constexpr float C2 = 0.125f * LOG2E;
constexpr int NPAD = NTOK * 4 + NE * 256;
constexpr int T5PAD = 256, T5N = 2048 + T5PAD;

constexpr size_t MiB = 1u << 20;
constexpr size_t WS_CTL = 0, CTL_BYTES = 1 * MiB;
constexpr size_t WS_WINE = 2 * MiB;
constexpr size_t WS_WINO = 16 * MiB;
constexpr size_t WS_WOUTE = 32 * MiB, WS_WOUTO = 36 * MiB;
constexpr size_t WS_RW = 40 * MiB;
constexpr size_t WS_SWE = WS_RW + 512 * 1024;
constexpr size_t WS_SWO = WS_SWE + 128 * 1024;
constexpr size_t WS_T5 = 41 * MiB;
constexpr size_t WS_WGU = 64 * MiB;
constexpr size_t WS_WD = 576 * MiB;
constexpr size_t WS_X = 832 * MiB;
constexpr size_t WS_XB = 960 * MiB;
constexpr size_t WS_PROJ = 2368 * MiB;
constexpr size_t WS_ATT = 1280 * MiB;
constexpr size_t WS_MIX = 1344 * MiB;
constexpr size_t WS_H = 1408 * MiB;
constexpr size_t WS_GW = 1536 * MiB, WS_GQD = 1570 * MiB, WS_GQK = 1604 * MiB, WS_GKD = 1622 * MiB, WS_GU = 1658 * MiB;
constexpr size_t WS_GO = 1722 * MiB;
constexpr size_t WS_ACT = 1792 * MiB;
constexpr size_t WS_Y = 2064 * MiB;
constexpr size_t WS_PB = 2336 * MiB;
constexpr size_t WS_CUM = 2338 * MiB;
constexpr size_t WS_KB8 = 2340 * MiB;
constexpr size_t WS_SELE = 2348 * MiB, WS_SLOT = WS_SELE + 512 * 1024, WS_GATE = WS_SLOT + 512 * 1024, WS_TSUM = WS_GATE + 512 * 1024;
constexpr size_t WS_LIST = 2350 * MiB;
constexpr size_t WS_GL = 2354 * MiB;
constexpr size_t WS_FAST_END = 2632 * MiB;
constexpr int CW_TMO = 0, CW_BAR = 4096, CW_CNT = 8192  , CW_QUEUE = 12288  ;

constexpr int RING_BYTES = 131072;
constexpr int CTRL_OFF = 159744;
constexpr int MISC_OFF = CTRL_OFF + 320;
constexpr int LDS_BYTES = 163840;

#define LDS_WAIT() asm volatile("s_waitcnt lgkmcnt(0)" ::: "memory")
#define VM_WAIT() asm volatile("s_waitcnt vmcnt(0)" ::: "memory")
#define RLX_AGENT __ATOMIC_RELAXED, __HIP_MEMORY_SCOPE_AGENT

__device__ __forceinline__ unsigned f2bf(float f) { unsigned u = __builtin_bit_cast(unsigned, f); return (u + 0x7fffu + ((u >> 16) & 1u)) >> 16; }
__device__ __forceinline__ unsigned pk2(float lo, float hi) { return f2bf(lo) | (f2bf(hi) << 16); }
__device__ __forceinline__ float bf2f(unsigned short h) { return __builtin_bit_cast(float, (unsigned)h << 16); }
__device__ __forceinline__ float bflo(unsigned w) { return __builtin_bit_cast(float, w << 16); }
__device__ __forceinline__ float bfhi(unsigned w) { return __builtin_bit_cast(float, w & 0xffff0000u); }
__device__ __forceinline__ unsigned cvt_pk_bf16(float lo, float hi) { unsigned r; asm volatile("v_cvt_pk_bf16_f32 %0, %1, %2" : "=v"(r) : "v"(lo), "v"(hi)); return r; }
__device__ __forceinline__ float sigmoid_f(float x) { return 1.f / (1.f + __expf(-x)); }
__device__ __forceinline__ float softplus_f(float x) { const float e = __expf(-fabsf(x)); const float l = e < 1e-3f ? e * (1.f - 0.5f * e) : __logf(1.f + e); return fmaxf(x, 0.f) + l; }

#define XB_TMO      128
#define XB_XCNT(j)  (256  + 64 * (j))
#define XB_XSUB(j)  (1280 + 64 * (j))
#define XB_XGEN(j)  (2304 + 64 * (j))
#define XB_TOP      3328
#define XB_TOPGEN   3392
#define XCD_BAR_WORDS 3456
#define XB_SPIN_CAP (1u << 18)
__device__ __forceinline__ unsigned xb_ld(unsigned* p)              { return __hip_atomic_load(p, __ATOMIC_RELAXED, __HIP_MEMORY_SCOPE_AGENT); }
__device__ __forceinline__ unsigned xb_add(unsigned* p, unsigned v) { return __hip_atomic_fetch_add(p, v, __ATOMIC_RELAXED, __HIP_MEMORY_SCOPE_AGENT); }
__device__ __forceinline__ unsigned xb_xcc_id() { return (unsigned)__builtin_amdgcn_s_getreg((3 << 11) | 20) & 0xFu; }
#define XB_SPIN(cond, bar) do { unsigned _sp = 0; while (cond) { __builtin_amdgcn_s_sleep(1); \
    if ((++_sp & 255u) == 0u) { if (xb_ld(&(bar)[XB_TMO])) break; if (_sp > XB_SPIN_CAP) { atomicAdd(&(bar)[XB_TMO], 1u); break; } } } } while (0)
struct XcdBarrier { unsigned* bar; unsigned x; volatile LAS unsigned* st; };
__device__ __forceinline__ XcdBarrier xcd_barrier_post(unsigned* bar, volatile LAS unsigned* st) {
    XcdBarrier b; b.bar = bar; b.x = xb_xcc_id(); b.st = st;
    if (threadIdx.x == 0) (void)xb_add(&bar[XB_XCNT(b.x)], 1u);
    return b;
}
__device__ __forceinline__ void xcd_barrier_complete(unsigned* bar, unsigned x, unsigned& nloc, unsigned& nx) {
    const unsigned G = gridDim.x * gridDim.y * gridDim.z;
    unsigned sum, cnt, mine, sp = 0u;
    for (;;) {
        sum = 0u; cnt = 0u;
#pragma unroll
        for (unsigned j = 0; j < 16; ++j) { const unsigned c = xb_ld(&bar[XB_XCNT(j)]); sum += c; cnt += (c > 0u) ? 1u : 0u; }
        mine = xb_ld(&bar[XB_XCNT(x)]);
        if (sum == G) break;
        __builtin_amdgcn_s_sleep(1);
        if ((++sp & 255u) == 0u) { if (xb_ld(&bar[XB_TMO])) break; if (sp > XB_SPIN_CAP) { atomicAdd(&bar[XB_TMO], 1u); break; } }
    }
    nloc = mine > 0u ? mine : 1u; nx = cnt > 0u ? cnt : 1u;
}
__device__ __forceinline__ void xcd_barrier(const XcdBarrier& b) {
    asm volatile("s_waitcnt vmcnt(0)" ::: "memory");
    __syncthreads();
    if (threadIdx.x == 0) {
        unsigned* bar = b.bar; const unsigned bx = b.x;
        __builtin_amdgcn_s_waitcnt(0);
        unsigned nloc = b.st[0], nx = b.st[1];
        if (nloc == 0u) { xcd_barrier_complete(bar, bx, nloc, nx); b.st[0] = nloc; b.st[1] = nx; }
        const unsigned old = xb_add(&bar[XB_XSUB(bx)], 1u);
        const unsigned gen = old / nloc;
        if (old + 1u == (gen + 1u) * nloc) {
            __builtin_amdgcn_fence(__ATOMIC_RELEASE, "agent");
            asm volatile("s_waitcnt vmcnt(0)" ::: "memory");
            const unsigned og = xb_add(&bar[XB_TOP], 1u);
            const unsigned tg = og / nx;
            if (og + 1u == (tg + 1u) * nx) xb_add(&bar[XB_TOPGEN], 1u);
            else XB_SPIN(xb_ld(&bar[XB_TOPGEN]) == tg, bar);
            __builtin_amdgcn_fence(__ATOMIC_ACQUIRE, "agent");
            xb_add(&bar[XB_XGEN(bx)], 1u);
            asm volatile("s_waitcnt vmcnt(0)" ::: "memory");
        } else {
            XB_SPIN(xb_ld(&bar[XB_XGEN(bx)]) == gen, bar);
            __builtin_amdgcn_fence(__ATOMIC_ACQUIRE, "agent");
            asm volatile("s_waitcnt vmcnt(0)" ::: "memory");
        }
    }
    __syncthreads();
}

namespace pg8 {
constexpr int BM = 256, BK = 64, HALF = 128, HTB = HALF * BK * 2, STAGE_BYTES = 8 * HTB;
__host__ __device__ __forceinline__ int lds_byte(int r, int c) { const int st = (r >> 4) * 2 + (c >> 5), rr = r & 15, cc = c & 31, ob = rr * 64 + cc * 2; return st * 1024 + (ob ^ (((ob >> 9) & 1) << 5)); }
__host__ __device__ __forceinline__ void stage_rc(int b, int& R, int& C) { const int st = b / 1024, sb = b % 1024, swz = sb ^ (((sb >> 9) & 1) << 5); R = (st >> 1) * 16 + swz / 64; C = (st & 1) * 32 + (swz % 64) / 2; }
__host__ __device__ __forceinline__ int perm32(int rho) { const int n = rho >> 4, i = rho & 15; return 8 * (i >> 2) + 4 * n + (i & 3); }

struct Unit { const char* A; const char* B; const int* rows; int nvalid; int row0; int col0; int aux; };

template <class Epi, class Sched, bool GATHER>
__device__ __forceinline__ void gemm_phase(LAS unsigned char* lds, const int K, const Sched& S, const Epi& E, const int tid) {
    const int wid = __builtin_amdgcn_readfirstlane(tid >> 6), lane = tid & 63, wr = wid >> 2, wc = wid & 3, fr = lane & 15, fq = lane >> 4;
    const int nt = K / BK;
    int Rr[2], Cc[2]; unsigned voffB[2]; unsigned offA[2][2], noffA[2][2];
#pragma unroll
    for (int i = 0; i < 2; ++i) { stage_rc(tid * 16 + i * 8192, Rr[i], Cc[i]); const int Rb = Epi::PERM ? ((Rr[i] & ~31) + perm32(Rr[i] & 31)) : Rr[i];
        voffB[i] = (unsigned)(Rb * K + Cc[i]) * 2u;
#pragma unroll
        for (int h = 0; h < 2; ++h) { offA[h][i] = (unsigned)((Rr[i] + HALF * h) * K + Cc[i]) * 2u; noffA[h][i] = offA[h][i]; } }
    const size_t kstep = (size_t)(BK * 2);
    const size_t hstep = (size_t)HALF * K * 2;
    const unsigned ldsw = (unsigned)wid * 1024u;
    const int aoff = lds_byte(wr * 64 + fr, fq * 8), boff = lds_byte(wc * 32 + fr, fq * 8);
#define PG8_SA(b, h) (((b) * 2 + (h)) * HTB)
#define PG8_SB(b, h) ((4 + (b) * 2 + (h)) * HTB)
#define PG8_STAGE_B(bufoff, gbase) do { _Pragma("unroll") for (int _i = 0; _i < 2; ++_i) \
        __builtin_amdgcn_global_load_lds((const unsigned*)((const char*)(gbase) + voffB[_i]), (LAS unsigned*)(lds + (bufoff) + ldsw + _i * 8192), 16, 0, 0); } while (0)
#define PG8_STAGE_A(bufoff, gbase, off, h) do { _Pragma("unroll") for (int _i = 0; _i < 2; ++_i) \
        __builtin_amdgcn_global_load_lds((const unsigned*)((const char*)(gbase) + (off)[h][_i]), (LAS unsigned*)(lds + (bufoff) + ldsw + _i * 8192), 16, 0, 0); } while (0)
#define PG8_LDA(dst, b, h) do { _Pragma("unroll") for (int m = 0; m < 4; ++m) _Pragma("unroll") for (int k = 0; k < 2; ++k) dst[m][k] = *(const LAS bf16x8*)(lds + PG8_SA(b, h) + aoff + m * 2048 + k * 1024); } while (0)
#define PG8_LDB(dst, b, h) do { _Pragma("unroll") for (int n = 0; n < 2; ++n) _Pragma("unroll") for (int k = 0; k < 2; ++k) dst[n][k] = *(const LAS bf16x8*)(lds + PG8_SB(b, h) + boff + n * 2048 + k * 1024); } while (0)
#define PG8_MMA(ai, bj, At, Bt) do { __builtin_amdgcn_s_setprio(1); _Pragma("unroll") for (int m = 0; m < 4; ++m) _Pragma("unroll") for (int n = 0; n < 2; ++n) _Pragma("unroll") for (int k = 0; k < 2; ++k) \
        acc[ai][bj][m][n] = __builtin_amdgcn_mfma_f32_16x16x32_bf16(Bt[n][k], At[m][k], acc[ai][bj][m][n], 0, 0, 0); __builtin_amdgcn_s_setprio(0); } while (0)
#define PG8_WAIT_V(n) asm volatile("s_waitcnt vmcnt(" #n ")" ::: "memory")
#define PG8_WAIT_L(n) asm volatile("s_waitcnt lgkmcnt(" #n ")" ::: "memory")
#define PG8_BAR __builtin_amdgcn_s_barrier()
#define PG8_SCHED __builtin_amdgcn_sched_barrier(0)
#define PG8_ROWS(dst, u) do { if constexpr (GATHER) { _Pragma("unroll") for (int h = 0; h < 2; ++h) _Pragma("unroll") for (int i = 0; i < 2; ++i) { \
        int rr_ = Rr[i] + HALF * h; rr_ = rr_ < (u).nvalid ? rr_ : (u).nvalid - 1; const int tok_ = (u).rows[rr_] >> 2; dst[h][i] = (unsigned)(tok_ * K + Cc[i]) * 2u; } } } while (0)
    Unit cur, nxt; int ui = 0;
    if (!S.next(0, cur)) return;
    f32x4 acc[2][2][4][2];
#pragma unroll
    for (int a = 0; a < 2; ++a)
#pragma unroll
        for (int b = 0; b < 2; ++b)
#pragma unroll
            for (int m = 0; m < 4; ++m)
#pragma unroll
                for (int n = 0; n < 2; ++n) acc[a][b][m][n] = (f32x4){0.f, 0.f, 0.f, 0.f};
    bf16x8 At[4][2], B0[2][2], B1[2][2];
    const char* cA = cur.A; const char* cB = cur.B;
    PG8_ROWS(offA, cur);
    PG8_STAGE_B(PG8_SB(0, 0), cB); PG8_STAGE_B(PG8_SB(0, 1), cB + hstep); PG8_STAGE_A(PG8_SA(0, 0), cA, offA, 0); PG8_STAGE_A(PG8_SA(0, 1), cA, offA, 1);
    if (wr == 1) PG8_BAR;
    PG8_WAIT_V(2); PG8_BAR;
    PG8_STAGE_B(PG8_SB(1, 0), cB + kstep); PG8_STAGE_A(PG8_SA(1, 0), cA + kstep, offA, 0); PG8_STAGE_B(PG8_SB(1, 1), cB + hstep + kstep);
    PG8_WAIT_V(6); PG8_BAR;
    for (;;) {
        const bool has_next = S.next(ui + 1, nxt);
        const char* nA = has_next ? nxt.A : cA; const char* nB = has_next ? nxt.B : cB;
        if constexpr (GATHER) { if (has_next) { PG8_ROWS(noffA, nxt); } else {
#pragma unroll
            for (int h = 0; h < 2; ++h)
#pragma unroll
                for (int i = 0; i < 2; ++i) noffA[h][i] = offA[h][i]; } }
        for (int t = 0; t < nt; t += 2) {
            const bool last = (t == nt - 2);
            const char* a1 = cA + (size_t)(t + 1) * kstep;
            const char* a2 = last ? nA : cA + (size_t)(t + 2) * kstep; const char* b2 = last ? nB : cB + (size_t)(t + 2) * kstep;
            const char* a3 = a2 + kstep; const char* b3 = b2 + kstep;
            PG8_LDB(B0, 0, 0); PG8_LDB(B1, 0, 1); PG8_SCHED; PG8_LDA(At, 0, 0); PG8_STAGE_A(PG8_SA(1, 1), a1, offA, 1);
            if (GATHER && last) { asm volatile("" ::: "memory");
#pragma unroll
                for (int h = 0; h < 2; ++h)
#pragma unroll
                    for (int i = 0; i < 2; ++i) offA[h][i] = noffA[h][i]; }
            PG8_WAIT_V(8); PG8_WAIT_L(0); PG8_BAR; PG8_MMA(0, 0, At, B0); PG8_MMA(0, 1, At, B1); PG8_BAR; PG8_SCHED;
            PG8_LDA(At, 0, 1); PG8_STAGE_B(PG8_SB(0, 0), b2); PG8_STAGE_B(PG8_SB(0, 1), b2 + hstep); PG8_STAGE_A(PG8_SA(0, 0), a2, offA, 0);
            PG8_WAIT_V(8); PG8_WAIT_L(0); PG8_BAR; PG8_MMA(1, 0, At, B0); PG8_MMA(1, 1, At, B1); PG8_BAR; PG8_SCHED;
            PG8_LDB(B0, 1, 0); PG8_LDB(B1, 1, 1); PG8_SCHED; PG8_LDA(At, 1, 0); PG8_STAGE_A(PG8_SA(0, 1), a2, offA, 1);
            PG8_WAIT_V(8); PG8_WAIT_L(0); PG8_BAR; PG8_MMA(0, 0, At, B0); PG8_MMA(0, 1, At, B1); PG8_BAR; PG8_SCHED;
            PG8_LDA(At, 1, 1); PG8_STAGE_B(PG8_SB(1, 0), b3); PG8_STAGE_B(PG8_SB(1, 1), b3 + hstep); PG8_STAGE_A(PG8_SA(1, 0), a3, offA, 0);
            PG8_WAIT_V(8); PG8_WAIT_L(0); PG8_BAR; PG8_MMA(1, 0, At, B0); PG8_MMA(1, 1, At, B1); PG8_BAR; PG8_SCHED;
        }
        if (wr == 0) PG8_BAR;
        asm volatile("s_nop 15\n\ts_nop 15\n\ts_nop 15\n\ts_nop 15" ::: "memory");
        E(acc, cur, wr, wc, fr, fq);
        if (!has_next) break;
#pragma unroll
        for (int a = 0; a < 2; ++a)
#pragma unroll
            for (int b = 0; b < 2; ++b)
#pragma unroll
                for (int m = 0; m < 4; ++m)
#pragma unroll
                    for (int n = 0; n < 2; ++n) acc[a][b][m][n] = (f32x4){0.f, 0.f, 0.f, 0.f};
        cur = nxt; cA = nA; cB = nB; ++ui;
        if (wr == 1) PG8_BAR;
    }
    PG8_WAIT_V(0);
    PG8_BAR;
#undef PG8_SA
#undef PG8_SB
#undef PG8_STAGE_A
#undef PG8_STAGE_B
#undef PG8_LDA
#undef PG8_LDB
#undef PG8_MMA
#undef PG8_WAIT_V
#undef PG8_WAIT_L
#undef PG8_BAR
#undef PG8_SCHED
#undef PG8_ROWS
}

struct DenseOrder {
    const char* A; const char* Bt; int K; int nM, nN, nwg, G, c, rep;
    __device__ __forceinline__ bool next(int i, Unit& u) const {
        const long L = (long)i * G + c; if (L >= (long)nwg * rep) return false;
        int wgid = (int)(L % nwg); { const int q = nwg / 8, r = nwg % 8, xcd = wgid % 8, off = wgid / 8; wgid = (xcd < r ? xcd * (q + 1) : r * (q + 1) + (xcd - r) * q) + off; }
        const int nig = 8 * nN, gid = wgid / nig, fm = gid * 8, gsz = (nM - fm) < 8 ? (nM - fm) : 8;
        const int pm = fm + ((wgid % nig) % gsz), pn = (wgid % nig) / gsz;
        u.A = A + (size_t)pm * BM * K * 2; u.B = Bt + (size_t)pn * BM * K * 2; u.rows = nullptr; u.nvalid = BM; u.row0 = pm * BM; u.col0 = pn * BM; u.aux = 0; return true;
    }
};
struct MoeOrder {
    const char* A; const char* W; const int* list; const LAS int* cnt; const LAS int* offp;
    int npn; size_t wstride; int K; bool gather; int G, c;
    __device__ __forceinline__ bool next(int i, Unit& u) const {
        const int x = c & 7, j = c >> 3, W8 = G >> 3; int q = j + i * W8;
#pragma unroll
        for (int s = 0; s < 4; ++s) { const int e = x + 8 * s; const int n = cnt[e]; const int ntile = (n + 255) >> 8; const int ne = ntile * npn;
            if (q < ne) { const int ti = q / npn, pn = q % npn;
                u.B = W + (size_t)e * wstride + (size_t)pn * BM * K * 2; u.row0 = offp[e] + ti * BM; u.col0 = pn * BM; u.aux = e;
                u.nvalid = (n - ti * BM) < BM ? (n - ti * BM) : BM;
                if (gather) { u.A = A; u.rows = list + (size_t)e * NTOK + ti * BM; } else { u.A = A + (size_t)u.row0 * K * 2; u.rows = nullptr; }
                return true; }
            q -= ne; }
        return false;
    }
};

struct EpiProj {
    static constexpr bool PERM = true;
    bf16_t* O; int ldc; int qcols; float qscale;
    __device__ __forceinline__ void operator()(const f32x4 (&acc)[2][2][4][2], const Unit& u, int wr, int wc, int fr, int fq) const {
        const int row0 = u.row0 + wr * 64 + fr, col0 = u.col0 + wc * 32 + 8 * fq;
        const float sc = (u.col0 < qcols) ? qscale : 1.f;
#pragma unroll
        for (int ai = 0; ai < 2; ++ai)
#pragma unroll
            for (int m = 0; m < 4; ++m) { bf16_t* rowp = O + (size_t)(row0 + ai * HALF + m * 16) * ldc + col0;
#pragma unroll
                for (int bj = 0; bj < 2; ++bj) { const f32x4 a0 = acc[ai][bj][m][0], a1 = acc[ai][bj][m][1];
                    typedef float f32x2 __attribute__((ext_vector_type(2))); const f32x2 sc2 = {sc, sc};
                    const f32x2 p0 = (f32x2){a0[0], a0[1]} * sc2, p1 = (f32x2){a0[2], a0[3]} * sc2, p2 = (f32x2){a1[0], a1[1]} * sc2, p3 = (f32x2){a1[2], a1[3]} * sc2;
                    u32x4 w; w.x = cvt_pk_bf16(p0[0], p0[1]); w.y = cvt_pk_bf16(p1[0], p1[1]); w.z = cvt_pk_bf16(p2[0], p2[1]); w.w = cvt_pk_bf16(p3[0], p3[1]);
                    *(u32x4*)(rowp + bj * HALF) = w; } }
    }
};
struct EpiF32 {
    static constexpr bool PERM = false;
    float* C; int ldc;
    __device__ __forceinline__ void operator()(const f32x4 (&acc)[2][2][4][2], const Unit& u, int wr, int wc, int fr, int fq) const {
        const int row0 = u.row0 + wr * 64 + fr, col0 = u.col0 + wc * 32 + 4 * fq;
#pragma unroll
        for (int ai = 0; ai < 2; ++ai)
#pragma unroll
            for (int m = 0; m < 4; ++m) { float* rowp = C + (size_t)(row0 + ai * HALF + m * 16) * ldc + col0;
#pragma unroll
                for (int bj = 0; bj < 2; ++bj)
#pragma unroll
                    for (int n = 0; n < 2; ++n) *(f32x4*)(rowp + bj * HALF + n * 16) = acc[ai][bj][m][n]; }
    }
};
struct EpiBf16 {
    static constexpr bool PERM = false;
    bf16_t* C; int ldc;
    __device__ __forceinline__ void operator()(const f32x4 (&acc)[2][2][4][2], const Unit& u, int wr, int wc, int fr, int fq) const {
        const int row0 = u.row0 + wr * 64 + fr, col0 = u.col0 + wc * 32 + 4 * fq;
#pragma unroll
        for (int ai = 0; ai < 2; ++ai)
#pragma unroll
            for (int m = 0; m < 4; ++m) { bf16_t* rowp = C + (size_t)(row0 + ai * HALF + m * 16) * ldc + col0;
#pragma unroll
                for (int bj = 0; bj < 2; ++bj)
#pragma unroll
                    for (int n = 0; n < 2; ++n) { const f32x4 v = acc[ai][bj][m][n]; u32x2 w; w.x = cvt_pk_bf16(v[0], v[1]); w.y = cvt_pk_bf16(v[2], v[3]); *(u32x2*)(rowp + bj * HALF + n * 16) = w; } }
    }
};
struct EpiSwiglu {
    static constexpr bool PERM = true;
    bf16_t* O; const float* bias;
    __device__ __forceinline__ void operator()(const f32x4 (&acc)[2][2][4][2], const Unit& u, int wr, int wc, int fr, int fq) const {
        const int row0 = u.row0 + wr * 64 + fr, ac0 = (u.col0 >> 1) + wc * 32 + 8 * fq;
        const float* bg = bias + (size_t)u.aux * 2048 + ac0; const float* bu = bg + 1024;
        f32x4 bgv[2], buv[2];
#pragma unroll
        for (int n = 0; n < 2; ++n) { bgv[n] = *(const f32x4*)(bg + 4 * n); buv[n] = *(const f32x4*)(bu + 4 * n); }
        typedef float f32x2 __attribute__((ext_vector_type(2)));
        auto pk_add = [](f32x2 x, f32x2 y) { return x + y; };
        auto pk_mul = [](f32x2 x, f32x2 y) { return x * y; };
        auto pk_fma = [](f32x2 x, f32x2 y, f32x2 z) { return __builtin_elementwise_fma(x, y, z); };
        const f32x2 kk = {-1.702f * LOG2E, -1.702f * LOG2E}, one2 = {1.f, 1.f};
#pragma unroll
        for (int ai = 0; ai < 2; ++ai)
#pragma unroll
            for (int m = 0; m < 4; ++m) { bf16_t* rowp = O + (size_t)(row0 + ai * HALF + m * 16) * 1024 + ac0; f32x2 o[4];
#pragma unroll
                for (int n = 0; n < 2; ++n) { const f32x4 ga = acc[ai][0][m][n], ua = acc[ai][1][m][n];
#pragma unroll
                    for (int h = 0; h < 2; ++h) {
                        const f32x2 g = pk_add((f32x2){ga[2 * h], ga[2 * h + 1]}, (f32x2){bgv[n][2 * h], bgv[n][2 * h + 1]}), uu = pk_add((f32x2){ua[2 * h], ua[2 * h + 1]}, (f32x2){buv[n][2 * h], buv[n][2 * h + 1]});
                        const f32x2 a = {fminf(g[0], 7.f), fminf(g[1], 7.f)}, b = {fminf(fmaxf(uu[0], -7.f), 7.f), fminf(fmaxf(uu[1], -7.f), 7.f)};
                        const f32x2 t = pk_mul(a, kk);
                        const f32x2 d = pk_add((f32x2){__builtin_amdgcn_exp2f(t[0]), __builtin_amdgcn_exp2f(t[1])}, one2);
                        const f32x2 p = pk_mul(a, (f32x2){__builtin_amdgcn_rcpf(d[0]), __builtin_amdgcn_rcpf(d[1])});
                        o[2 * n + h] = pk_fma(p, b, p); } }
                u32x4 w; w.x = cvt_pk_bf16(o[0][0], o[0][1]); w.y = cvt_pk_bf16(o[1][0], o[1][1]); w.z = cvt_pk_bf16(o[2][0], o[2][1]); w.w = cvt_pk_bf16(o[3][0], o[3][1]);
                *(u32x4*)rowp = w; }
    }
};
struct EpiDown {
    static constexpr bool PERM = true;
    bf16_t* O; const float* bias;
    __device__ __forceinline__ void operator()(const f32x4 (&acc)[2][2][4][2], const Unit& u, int wr, int wc, int fr, int fq) const {
        const int row0 = u.row0 + wr * 64 + fr, col0 = u.col0 + wc * 32 + 8 * fq;
        const float* bb = bias + (size_t)u.aux * 1024 + col0;
        f32x4 bv[2][2];
#pragma unroll
        for (int bj = 0; bj < 2; ++bj)
#pragma unroll
            for (int n = 0; n < 2; ++n) bv[bj][n] = *(const f32x4*)(bb + bj * HALF + 4 * n);
#pragma unroll
        for (int ai = 0; ai < 2; ++ai)
#pragma unroll
            for (int m = 0; m < 4; ++m) { bf16_t* rowp = O + (size_t)(row0 + ai * HALF + m * 16) * 1024 + col0;
#pragma unroll
                for (int bj = 0; bj < 2; ++bj) { const f32x4 a0 = acc[ai][bj][m][0], a1 = acc[ai][bj][m][1], c0 = bv[bj][0], c1 = bv[bj][1];
                    typedef float f32x2 __attribute__((ext_vector_type(2)));
                    const f32x2 p0 = (f32x2){a0[0], a0[1]} + (f32x2){c0[0], c0[1]}, p1 = (f32x2){a0[2], a0[3]} + (f32x2){c0[2], c0[3]}, p2 = (f32x2){a1[0], a1[1]} + (f32x2){c1[0], c1[1]}, p3 = (f32x2){a1[2], a1[3]} + (f32x2){c1[2], c1[3]};
                    u32x4 w; w.x = cvt_pk_bf16(p0[0], p0[1]); w.y = cvt_pk_bf16(p1[0], p1[1]); w.z = cvt_pk_bf16(p2[0], p2[1]); w.w = cvt_pk_bf16(p3[0], p3[1]);
                    *(u32x4*)(rowp + bj * HALF) = w; } }
    }
};
}
namespace attn_body {
#ifndef MK_NOBIAS0
#define MK_NOBIAS0 0
#endif
#ifndef MK_NOBIAS
#define MK_NOBIAS 0
#endif
constexpr int D = 64, NW = 8, QBLK = 32, QB = QBLK * NW, KVBLK = 64, NQB = T / QB;
constexpr int NSLOT = 3, SLOTB = 9216, NVSLOT = 4, VSLOT = 16384;
constexpr int LDS_K = 0, LDS_V = NSLOT * SLOTB, LDS_WS = NSLOT * SLOTB + NVSLOT * VSLOT, LDS_OST = LDS_WS + NW * 64 * 4, LDS_TB = LDS_OST + NW * 4096, LDS_UNIT = LDS_TB + T5N * 4, LDS_BYTES = LDS_UNIT + 16;
static_assert(LDS_BYTES <= CTRL_OFF, "attention LDS");
__device__ __forceinline__ int crow(int r, int hi) { return (r & 3) + 8 * (r >> 2) + 4 * hi; }
#define SBAR() __builtin_amdgcn_sched_barrier(0)
__device__ __forceinline__ void cmask(f32x16& p0, f32x16& p1, int jb, int qrel, int hi) {
    const float NEG = -INFINITY; const int lim = qrel - 64 * jb - 4 * hi;
#pragma unroll
    for (int r = 0; r < 16; ++r) { const int c = (r & 3) + 8 * (r >> 2); if (c > lim) p0[r] = NEG; if (c + 32 > lim) p1[r] = NEG; }
}
__device__ __forceinline__ void glds16(const void* sbase, unsigned voff, unsigned lds_dst) { unsigned keep;
    asm volatile("s_mov_b32 %0, m0\n\ts_mov_b32 m0, %3\n\ts_nop 0\n\tglobal_load_lds_dwordx4 %1, %2\n\ts_mov_b32 m0, %0" : "=&s"(keep) : "v"(voff), "s"(sbase), "s"(lds_dst) : "memory"); }
__device__ __forceinline__ float max3f(float a, float b, float c) { float r; asm("v_max3_f32 %0, %1, %2, %3" : "=v"(r) : "v"(a), "v"(b), "v"(c)); return r; }
__device__ __forceinline__ float max2f(float a, float b) { float r; asm("v_max_f32_e32 %0, %1, %2" : "=v"(r) : "v"(a), "v"(b)); return r; }
__device__ __forceinline__ float fadd_s(float a, float b) { float r; asm("v_add_f32_e32 %0, %1, %2" : "=v"(r) : "v"(a), "v"(b)); return r; }
__device__ __forceinline__ float fsub_s(float a, float b) { float r; asm("v_sub_f32_e32 %0, %1, %2" : "=v"(r) : "v"(a), "v"(b)); return r; }
typedef __bf16 bf16x2_t __attribute__((ext_vector_type(2)));
__device__ __forceinline__ unsigned cvtpk_s(float lo, float hi) { f32x2 v = {lo, hi}; bf16x2_t b = __builtin_convertvector(v, bf16x2_t); return __builtin_bit_cast(unsigned, b); }
#define WAIT_BAR(N) asm volatile("s_waitcnt vmcnt(" #N ") lgkmcnt(0)\n\ts_barrier" ::: "memory")
typedef LAS const char* lds_cptr;
typedef short v4i16_t __attribute__((ext_vector_type(4)));
__device__ __forceinline__ void kload2(bf16x8* kf, lds_cptr kp, int j) { kf[2 * j] = *(const LAS bf16x8*)(kp + j * 2048); kf[2 * j + 1] = *(const LAS bf16x8*)(kp + j * 2048 + 512); }
__device__ __forceinline__ s16x4 vtr(lds_cptr p) { return __builtin_bit_cast(s16x4, __builtin_amdgcn_ds_read_tr16_b64_v4i16((LAS v4i16_t*)p)); }
__device__ __forceinline__ float rowmax(const f32x16& p0, const f32x16& p1) {
    float a = max3f(p0[0], p0[1], p1[0]), b = max3f(p0[2], p0[3], p1[1]); a = max3f(a, p1[2], p1[3]);
#pragma unroll
    for (int r = 4; r < 16; r += 4) { a = max3f(a, p0[r], p0[r + 1]); b = max3f(b, p0[r + 2], p0[r + 3]); a = max3f(a, p1[r], p1[r + 1]); b = max3f(b, p1[r + 2], p1[r + 3]); }
    const float m = max2f(a, b);
    auto rr = __builtin_amdgcn_permlane32_swap(__float_as_uint(m), __float_as_uint(m), false, false);
    return max2f(__uint_as_float(rr[0]), __uint_as_float(rr[1]));
}
__device__ __forceinline__ void pv(f32x16* o, int vb, bf16x8 pa0, bf16x8 pa1, bf16x8 pa2, bf16x8 pa3) {
#pragma unroll
    for (int d0 = 0; d0 < 2; ++d0) { s16x4 lo[4], hi[4];
#pragma unroll
        for (int ks = 0; ks < 4; ++ks) {
            asm volatile("ds_read_b64_tr_b16 %0,%1 offset:%c2" : "=&v"(lo[ks]) : "v"(vb), "i"(d0 * 4096 + ks * 1024) : "memory");
            asm volatile("ds_read_b64_tr_b16 %0,%1 offset:%c2" : "=&v"(hi[ks]) : "v"(vb), "i"(d0 * 4096 + ks * 1024 + 512) : "memory"); }
        asm volatile("s_waitcnt lgkmcnt(0)" ::: "memory"); SBAR();
#define PK(k) (bf16x8){lo[k][0], lo[k][1], lo[k][2], lo[k][3], hi[k][0], hi[k][1], hi[k][2], hi[k][3]}
        o[d0] = __builtin_amdgcn_mfma_f32_32x32x16_bf16(pa0, PK(0), o[d0], 0, 0, 0);
        o[d0] = __builtin_amdgcn_mfma_f32_32x32x16_bf16(pa1, PK(1), o[d0], 0, 0, 0);
        o[d0] = __builtin_amdgcn_mfma_f32_32x32x16_bf16(pa2, PK(2), o[d0], 0, 0, 0);
        o[d0] = __builtin_amdgcn_mfma_f32_32x32x16_bf16(pa3, PK(3), o[d0], 0, 0, 0);
#undef PK
    }
}
struct AttnP {
    const bf16_t* proj;
    bf16_t* out;
    const float* t5tab;
    const float* cum2;
    const bf16_t* kb8;
    float xthr;
};

template <int MODE, int THRL>
__device__ __forceinline__ void attn_unit(const AttnP& P, int b, int vh, int qb, char* shm, const int tid) {
    const int lane = tid & 63, r32 = lane & 31, hi = lane >> 5; const int wid = __builtin_amdgcn_readfirstlane(tid >> 6);
    int h, qcol, kcol, vcol, ocol;
    constexpr bool T5 = (MODE == 0 || MODE == 2); constexpr int NH = (MODE == 2) ? 2 : 1;
    if (MODE == 0) { h = vh >> 2; const int m = (vh >> 1) & 1, half = vh & 1; qcol = h * 128 + m * 64; kcol = 512 + h * 128 + m * 64; vcol = 1024 + h * 128 + half * 64; ocol = (h * 2 + m) * 128 + half * 64; }
    else if (MODE == 2) { h = vh >> 1; const int m = vh & 1; qcol = h * 128 + m * 64; kcol = 512 + h * 128 + m * 64; vcol = 1024 + h * 128; ocol = (h * 2 + m) * 128; }
    else { h = vh; qcol = h * 64; kcol = 1024 + h * 64; vcol = 2048 + h * 64; ocol = h * 64; }
    const long rowbase = (long)b * T; const int q0 = qb * QB;
    const bf16_t* Qw = P.proj + (rowbase + q0 + wid * QBLK) * PITCH + qcol;
    const bf16_t* Kh = P.proj + rowbase * PITCH + kcol; const bf16_t* Vh = P.proj + rowbase * PITCH + vcol; int tskip = 0;
    const unsigned lds0 = (unsigned)(uintptr_t)shm;
    float* wsf = (float*)(shm + LDS_WS) + wid * 64;
    const unsigned kvoff = (unsigned)(lane * PITCH + wid * 8) * 2u;
    const unsigned vvoff = (unsigned)((16 * (wid & 3) + (lane >> 2)) * PITCH + (wid >> 2) * 32 + (lane & 3) * 8) * 2u;
    const bf16_t* k8h = (MODE == 1) ? P.kb8 + (long)(b * 16 + h) * T * 8 : nullptr; const unsigned k8voff = (unsigned)lane * 16u;
    const unsigned kdst = lds0 + LDS_K + wid * 1024, vdst = lds0 + LDS_V + wid * 1024, k8dst = lds0 + LDS_K + 8192;
#define DMA_K(t, slot) do { glds16(Kh + (long)(t) * KVBLK * PITCH, kvoff, (unsigned)__builtin_amdgcn_readfirstlane(kdst + (slot))); \
        if (MODE == 1 && wid == 0) glds16(k8h + (long)((t) + tskip) * KVBLK * 8, k8voff, (unsigned)__builtin_amdgcn_readfirstlane(k8dst + (slot))); } while (0)
#define DMA_V(t, slot) do { _Pragma("unroll") for (int hh_ = 0; hh_ < NH; ++hh_) glds16(Vh + (long)(t) * KVBLK * PITCH + hh_ * 64, vvoff, (unsigned)__builtin_amdgcn_readfirstlane(vdst + (slot) + hh_ * 8192)); } while (0)
#define WAITKV_22() do { if (MODE == 2) { WAIT_BAR(6); } else if (MODE == 1 && wid == 0) { WAIT_BAR(6); } else { WAIT_BAR(4); } } while (0)
#define WAITKV_12() do { if (MODE == 2) { WAIT_BAR(5); } else if (MODE == 1 && wid == 0) { WAIT_BAR(4); } else { WAIT_BAR(3); } } while (0)
#define WAITKV_11() do { if (MODE == 2) { WAIT_BAR(3); } else if (MODE == 1 && wid == 0) { WAIT_BAR(3); } else { WAIT_BAR(2); } } while (0)
#define WAITKV_02() do { if (MODE == 2) { WAIT_BAR(4); } else { WAIT_BAR(2); } } while (0)
    const int vb0 = (int)(lds0 + LDS_V) + ((lane >> 4) & 1) * 32 + (lane & 3) * 8 + (4 * hi + ((lane & 15) >> 2)) * 64;
    constexpr int NKF = (MODE == 1) ? 10 : 8;
    bf16x8 kf[NKF];
    const lds_cptr shm3 = (lds_cptr)shm; const lds_cptr kp0 = shm3 + LDS_K + hi * 1024 + r32 * 16; const lds_cptr kp8 = shm3 + LDS_K + 8192 + r32 * 16;
    const lds_cptr vp0 = shm3 + LDS_V + ((lane >> 4) & 1) * 32 + (lane & 3) * 8 + (4 * hi + ((lane & 15) >> 2)) * 64;
    int NT = (q0 + QB) / KVBLK;
    if (MODE == 1) {
        const float* cu = P.cum2 + (long)(b * 16 + h) * T; const float cq0 = cu[q0];
        int first = NT;
        for (int base = 0; base < NT; base += 64) { const int tt = base + lane; const bool keep = tt < NT && (cu[tt < NT ? 64 * tt + 63 : 0] - cq0 <= P.xthr);
            const unsigned long long mk = __ballot(keep); if (mk) { first = base + (int)__builtin_ctzll(mk); break; } }
        int t0 = first < NT - 4 ? first : NT - 4; t0 &= ~1; t0 = __builtin_amdgcn_readfirstlane(t0);
        Kh += (long)t0 * KVBLK * PITCH; Vh += (long)t0 * KVBLK * PITCH; NT -= t0; tskip = t0;
    }
    DMA_K(0, 0); DMA_V(0, 0); DMA_K(1, SLOTB); DMA_V(1, VSLOT);
    constexpr int NQR = (MODE == 1) ? 5 : 4;
    bf16x8 qr[NQR];
#pragma unroll
    for (int d0 = 0; d0 < 4; ++d0) qr[d0] = *reinterpret_cast<const bf16x8*>(&Qw[(long)r32 * PITCH + d0 * 16 + hi * 8]);
    const int qrel = wid * QBLK + r32;
    const lds_cptr qp0 = shm3 + LDS_OST + wid * 4096 + hi * 512 + r32 * 16;
#define QF(d0) (qr[d0])
    if (MODE == 1) {
        const float c = P.cum2[(long)(b * 16 + h) * T + q0 + qrel];
        const unsigned ch = f2bf(c); const float r1 = c - __builtin_bit_cast(float, ch << 16); const unsigned cm = f2bf(r1); const float r2 = r1 - __builtin_bit_cast(float, cm << 16); const unsigned cl = f2bf(r2);
        u32x4 w; w.x = ch | (cm << 16); w.y = cl | (0x3f80u << 16); w.z = 0x3f80u | (0x3f80u << 16); w.w = 0u;
        if (hi) w = (u32x4){0u, 0u, 0u, 0u};
        qr[NQR - 1] = __builtin_bit_cast(bf16x8, w);
    }
    float mhat = 0.f, l_reg = 0.f; f32x16 o[2 * NH];
#pragma unroll
    for (int d_ = 0; d_ < 2 * NH; ++d_) o[d_] = f32x16{};
    const f32x16 zero16 = f32x16{}; f32x2 mh2 = {0.f, 0.f};
    const float* tblo = (const float*)(shm + LDS_TB) + (q0 + qrel - 4 * hi - 63 + T5PAD);
#ifndef MK_NOBIAS
#define MK_NOBIAS 0
#endif
#ifndef MK_NOBIAS
#define MK_NOBIAS 0
#endif
#define PRE(P0, P1, t, WITHBIAS) do { \
        if (T5 && (WITHBIAS) && !MK_NOBIAS) { const float* tb_ = tblo - 64 * (t); \
            _Pragma("unroll") for (int r = 0; r < 16; ++r) { const int kv0_ = (r & 3) + 8 * (r >> 2); P0[r] = tb_[63 - kv0_]; P1[r] = tb_[31 - kv0_]; } } \
        else { _Pragma("unroll") for (int r = 0; r < 16; ++r) { P0[r] = 0.f; P1[r] = 0.f; } } \
        { const int jb_ = (t) - (NT - 4); if (jb_ >= 0) cmask(P0, P1, jb_, qrel, hi); } } while (0)
    bool resc = false;
#define RESC() do { if (resc) { asm volatile("s_nop 15\n\ts_nop 15\n\ts_nop 15\n\ts_nop 15\n\ts_waitcnt lgkmcnt(0)" : "+v"(o[0]), "+v"(o[1]) :: "memory"); if (NH == 2) asm volatile("" : "+v"(o[2 * NH - 2]), "+v"(o[2 * NH - 1]));     \
      _Pragma("unroll") for (int d_ = 0; d_ < 2 * NH; ++d_) _Pragma("unroll") for (int r = 0; r < 16; ++r) o[d_][r] *= wsf[crow(r, hi)]; } } while (0)
    f32x16 cA, cB;
    u32x4 pwa0, pwa1, pwa2, pwa3, pwb0, pwb1, pwb2, pwb3;
    int sl_prev = 0, sl_cur = 0, sl_next = SLOTB;
    int sv_prev = 0, sv_cur = 0, sv_next = VSLOT, sv_nn = 2 * VSLOT;
#define ROT() do { sl_prev = sl_cur; sl_cur = sl_next; sl_next = (sl_next == (NSLOT - 1) * SLOTB) ? 0 : sl_next + SLOTB; sv_prev = sv_cur; sv_cur = sv_next; sv_next = sv_nn; sv_nn = (sv_nn == (NVSLOT - 1) * VSLOT) ? 0 : sv_nn + VSLOT; } while (0)
    DMA_K(2, 2 * SLOTB);
    WAITKV_22();
    PRE(cA, cB, 0, (NT <= 28 && !MK_NOBIAS0));
    { const char* kb = shm + LDS_K + hi * 1024 + r32 * 16;
#pragma unroll
      for (int d0 = 0; d0 < 4; ++d0) {
          const bf16x8 b0 = *reinterpret_cast<const bf16x8*>(kb + d0 * 2048);
          const bf16x8 b1 = *reinterpret_cast<const bf16x8*>(kb + d0 * 2048 + 512);
          if (d0 == 0) { cA = __builtin_amdgcn_mfma_f32_32x32x16_bf16(b0, qr[0], cA, 0, 0, 0); cB = __builtin_amdgcn_mfma_f32_32x32x16_bf16(b1, qr[0], cB, 0, 0, 0); }
          else { cA = __builtin_amdgcn_mfma_f32_32x32x16_bf16(b0, qr[d0], cA, 0, 0, 0); cB = __builtin_amdgcn_mfma_f32_32x32x16_bf16(b1, qr[d0], cB, 0, 0, 0); } }
      if (MODE == 1) { const char* k8 = shm + LDS_K + 8192 + r32 * 16;
          const bf16x8 b0 = *reinterpret_cast<const bf16x8*>(k8); const bf16x8 b1 = *reinterpret_cast<const bf16x8*>(k8 + 512);
          cA = __builtin_amdgcn_mfma_f32_32x32x16_bf16(b0, qr[NQR - 1], cA, 0, 0, 0); cB = __builtin_amdgcn_mfma_f32_32x32x16_bf16(b1, qr[NQR - 1], cB, 0, 0, 0); } }
    asm volatile("s_nop 15\n\ts_nop 15\n\ts_nop 15\n\ts_nop 15\n\ts_nop 15" : "+v"(cA), "+v"(cB));
#ifndef MK_NOBIAS0
#define MK_NOBIAS0 0
#endif
#define PKW(P, B) cvtpk_s(P[B], P[B + 1])
    { mhat = rowmax(cA, cB); mh2 = (f32x2){mhat, mhat}; float sacc = 0.f;
      _Pragma("unroll") for (int r = 0; r < 16; ++r) { cA[r] = __builtin_amdgcn_exp2f(fsub_s(cA[r], mhat)); cB[r] = __builtin_amdgcn_exp2f(fsub_s(cB[r], mhat)); }
      _Pragma("unroll") for (int r = 0; r < 16; ++r) sacc += cA[r] + cB[r];
      l_reg = sacc;
      pwa0 = (u32x4){PKW(cA, 0), PKW(cA, 2), PKW(cA, 4), PKW(cA, 6)}; pwa1 = (u32x4){PKW(cA, 8), PKW(cA, 10), PKW(cA, 12), PKW(cA, 14)};
      pwa2 = (u32x4){PKW(cB, 0), PKW(cB, 2), PKW(cB, 4), PKW(cB, 6)}; pwa3 = (u32x4){PKW(cB, 8), PKW(cB, 10), PKW(cB, 12), PKW(cB, 14)}; }
    WAIT_BAR(0);
    DMA_K(3, 0); DMA_V(2, 2 * VSLOT);
    ROT();
#pragma unroll
    for (int j = 0; j < 4; ++j) kload2(kf, kp0 + sl_cur, j);
    if (MODE == 1) { kf[8] = *(const LAS bf16x8*)(kp8 + sl_cur); kf[9] = *(const LAS bf16x8*)(kp8 + sl_cur + 512); }
    WAITKV_11();
    s16x4 vlo[NH == 2 ? 1 : 8], vhi[NH == 2 ? 1 : 8]; s16x4 vwl[4], vwh[4];
#define PAF(PW, k) __builtin_bit_cast(bf16x8, PW##k)
#define VFR(i) (bf16x8){vlo[i][0], vlo[i][1], vlo[i][2], vlo[i][3], vhi[i][0], vhi[i][1], vhi[i][2], vhi[i][3]}
#define PIN(x) asm volatile("" : "+v"(x))
#define MX3(a, b, c) __builtin_fmaxf(__builtin_fmaxf((a), (b)), (c))
#define GAPA(MF) do { MF; SBAR(); } while (0)
#define EX(v) __builtin_amdgcn_exp2f(v)
#define GAPB(MF, X, B, PW, I) do { MF; { f32x2 a_ = {X[B], X[B + 1]}, b_ = {X[B + 2], X[B + 3]}; a_ -= mh2; b_ -= mh2; const float e0_ = EX(a_.x), e1_ = EX(a_.y), e2_ = EX(b_.x), e3_ = EX(b_.y); \
        sacc += e0_; sacc += e1_; sacc += e2_; sacc += e3_; PW[I] = cvtpk_s(e0_, e1_); PW[I + 1] = cvtpk_s(e2_, e3_); } PIN(PW); PIN(sacc); SBAR(); } while (0)
#define VRD(i) do { vlo[i] = vtr(vp_ + (((i) >> 2) * 4096 + ((i) & 3) * 1024)); vhi[i] = vtr(vp_ + (((i) >> 2) * 4096 + ((i) & 3) * 1024 + 512)); } while (0)
#define VRD1(i) do { if (NH == 2) { vlo[i] = vtr(vp_ + (8192 + ((i) >> 2) * 4096 + ((i) & 3) * 1024)); vhi[i] = vtr(vp_ + (8192 + ((i) >> 2) * 4096 + ((i) & 3) * 1024 + 512)); } } while (0)
#define GAPC(MF) do { if (NH == 2) { MF; SBAR(); } } while (0)
#define VW(w, half, i) do { vwl[w] = vtr(vp_ + ((half) * 8192 + ((i) >> 2) * 4096 + ((i) & 3) * 1024)); vwh[w] = vtr(vp_ + ((half) * 8192 + ((i) >> 2) * 4096 + ((i) & 3) * 1024 + 512)); } while (0)
#define VWF(w) (bf16x8){vwl[w][0], vwl[w][1], vwl[w][2], vwl[w][3], vwh[w][0], vwh[w][1], vwh[w][2], vwh[w][3]}
#define KRD(G, j) do { if (G) { kload2(kf, kp0 + sl_next, j); SBAR(); } } while (0)
#define KRD8(G) do { if (MODE == 1 && (G)) { kf[NKF - 2] = *(const LAS bf16x8*)(kp8 + sl_next); kf[NKF - 1] = *(const LAS bf16x8*)(kp8 + sl_next + 512); SBAR(); } } while (0)
#define STEP(PWC, PWN, t, GK, GV, GL, GPRE) do { SBAR(); if (GPRE) { PRE(cA, cB, t, true); SBAR(); } \
    const lds_cptr vp_ = vp0 + sv_prev; \
    bf16x8 qx0_, qx1_; \
    VRD(0); qx0_ = QF(0); SBAR(); GAPA(cA = (GPRE) ? __builtin_amdgcn_mfma_f32_32x32x16_bf16(kf[0], qx0_, cA, 0, 0, 0) : __builtin_amdgcn_mfma_f32_32x32x16_bf16(kf[0], qx0_, zero16, 0, 0, 0)); \
    VRD(4); qx1_ = QF(1); SBAR(); GAPA(cB = (GPRE) ? __builtin_amdgcn_mfma_f32_32x32x16_bf16(kf[1], qx0_, cB, 0, 0, 0) : __builtin_amdgcn_mfma_f32_32x32x16_bf16(kf[1], qx0_, zero16, 0, 0, 0)); \
    VRD(1); SBAR(); GAPA(cA = __builtin_amdgcn_mfma_f32_32x32x16_bf16(kf[2], qx1_, cA, 0, 0, 0)); \
    VRD(5); qx0_ = QF(2); SBAR(); GAPA(cB = __builtin_amdgcn_mfma_f32_32x32x16_bf16(kf[3], qx1_, cB, 0, 0, 0)); \
    VRD(2); SBAR(); GAPA(cA = __builtin_amdgcn_mfma_f32_32x32x16_bf16(kf[4], qx0_, cA, 0, 0, 0)); \
    VRD(6); qx1_ = QF(3); SBAR(); GAPA(cB = __builtin_amdgcn_mfma_f32_32x32x16_bf16(kf[5], qx0_, cB, 0, 0, 0)); \
    VRD(3); SBAR(); GAPA(cA = __builtin_amdgcn_mfma_f32_32x32x16_bf16(kf[6], qx1_, cA, 0, 0, 0)); \
    VRD(7); SBAR(); GAPA(cB = __builtin_amdgcn_mfma_f32_32x32x16_bf16(kf[7], qx1_, cB, 0, 0, 0)); \
    if (MODE == 1) { cA = __builtin_amdgcn_mfma_f32_32x32x16_bf16(kf[NKF - 2], qr[NQR - 1], cA, 0, 0, 0); cB = __builtin_amdgcn_mfma_f32_32x32x16_bf16(kf[NKF - 1], qr[NQR - 1], cB, 0, 0, 0); SBAR(); } \
    asm volatile("s_nop 15\n\ts_nop 7" : "+v"(cA), "+v"(cB));     \
    if (GK) { DMA_K((t) + 3, sl_cur); } if (GV) { DMA_V((t) + 2, sv_nn); } \
    { float a = MX3(cA[0], cA[1], cB[0]), b = MX3(cA[2], cA[3], cB[1]); a = MX3(a, cB[2], cB[3]); \
      _Pragma("unroll") for (int r = 4; r < 16; r += 4) { a = MX3(a, cA[r], cA[r + 1]); b = MX3(b, cA[r + 2], cA[r + 3]); a = MX3(a, cB[r], cB[r + 1]); b = MX3(b, cB[r + 2], cB[r + 3]); } \
      float rm = __builtin_fmaxf(a, b); { auto rr = __builtin_amdgcn_permlane32_swap(__float_as_uint(rm), __float_as_uint(rm), false, false); rm = __builtin_fmaxf(__uint_as_float(rr[0]), __uint_as_float(rr[1])); } \
      rm -= mhat; resc = false; \
      if (__builtin_expect(__any(rm > (float)THRL), 0)) { const float dl = __builtin_fmaxf(rm, 0.f); mhat += dl; mh2 = (f32x2){mhat, mhat}; \
        const float f = __builtin_amdgcn_exp2f(-dl); l_reg *= f; if (hi == 0) wsf[r32] = f; resc = true; } } \
    SBAR(); \
    float sacc = 0.f; \
    GAPB(o[0] = __builtin_amdgcn_mfma_f32_32x32x16_bf16(PAF(PWC, 0), VFR(0), o[0], 0, 0, 0), cA, 0, PWN##0, 0); VRD1(0); \
    GAPB(o[1] = __builtin_amdgcn_mfma_f32_32x32x16_bf16(PAF(PWC, 0), VFR(4), o[1], 0, 0, 0), cA, 4, PWN##0, 2); VRD1(4); \
    if (NH == 1) { KRD(GL, 0); } GAPB(o[0] = __builtin_amdgcn_mfma_f32_32x32x16_bf16(PAF(PWC, 1), VFR(1), o[0], 0, 0, 0), cA, 8, PWN##1, 0); VRD1(1); \
    if (NH == 1) { KRD(GL, 1); } GAPB(o[1] = __builtin_amdgcn_mfma_f32_32x32x16_bf16(PAF(PWC, 1), VFR(5), o[1], 0, 0, 0), cA, 12, PWN##1, 2); VRD1(5); \
    if (NH == 1) { KRD(GL, 2); } GAPB(o[0] = __builtin_amdgcn_mfma_f32_32x32x16_bf16(PAF(PWC, 2), VFR(2), o[0], 0, 0, 0), cB, 0, PWN##2, 0); VRD1(2); \
    if (NH == 1) { KRD(GL, 3); } GAPB(o[1] = __builtin_amdgcn_mfma_f32_32x32x16_bf16(PAF(PWC, 2), VFR(6), o[1], 0, 0, 0), cB, 4, PWN##2, 2); VRD1(6); \
    if (NH == 1) { KRD8(GL); } GAPB(o[0] = __builtin_amdgcn_mfma_f32_32x32x16_bf16(PAF(PWC, 3), VFR(3), o[0], 0, 0, 0), cB, 8, PWN##3, 0); VRD1(3); \
    GAPB(o[1] = __builtin_amdgcn_mfma_f32_32x32x16_bf16(PAF(PWC, 3), VFR(7), o[1], 0, 0, 0), cB, 12, PWN##3, 2); VRD1(7); \
    GAPC(o[2 * NH - 2] = __builtin_amdgcn_mfma_f32_32x32x16_bf16(PAF(PWC, 0), VFR(0), o[2 * NH - 2], 0, 0, 0)); \
    GAPC(o[2 * NH - 1] = __builtin_amdgcn_mfma_f32_32x32x16_bf16(PAF(PWC, 0), VFR(4), o[2 * NH - 1], 0, 0, 0)); \
    if (NH == 2) { KRD(GL, 0); } GAPC(o[2 * NH - 2] = __builtin_amdgcn_mfma_f32_32x32x16_bf16(PAF(PWC, 1), VFR(1), o[2 * NH - 2], 0, 0, 0)); \
    if (NH == 2) { KRD(GL, 1); } GAPC(o[2 * NH - 1] = __builtin_amdgcn_mfma_f32_32x32x16_bf16(PAF(PWC, 1), VFR(5), o[2 * NH - 1], 0, 0, 0)); \
    if (NH == 2) { KRD(GL, 2); } GAPC(o[2 * NH - 2] = __builtin_amdgcn_mfma_f32_32x32x16_bf16(PAF(PWC, 2), VFR(2), o[2 * NH - 2], 0, 0, 0)); \
    if (NH == 2) { KRD(GL, 3); } GAPC(o[2 * NH - 1] = __builtin_amdgcn_mfma_f32_32x32x16_bf16(PAF(PWC, 2), VFR(6), o[2 * NH - 1], 0, 0, 0)); \
    GAPC(o[2 * NH - 2] = __builtin_amdgcn_mfma_f32_32x32x16_bf16(PAF(PWC, 3), VFR(3), o[2 * NH - 2], 0, 0, 0)); \
    GAPC(o[2 * NH - 1] = __builtin_amdgcn_mfma_f32_32x32x16_bf16(PAF(PWC, 3), VFR(7), o[2 * NH - 1], 0, 0, 0)); \
    l_reg += sacc; \
    } while (0)
#define STEP2(PWC, PWN, t, GK, GV, GL, GPRE) do { SBAR(); if (GPRE) { PRE(cA, cB, t, true); SBAR(); } \
    const lds_cptr vp_ = vp0 + sv_prev; \
    bf16x8 qx0_, qx1_; \
    qx0_ = QF(0); SBAR(); GAPA(cA = (GPRE) ? __builtin_amdgcn_mfma_f32_32x32x16_bf16(kf[0], qx0_, cA, 0, 0, 0) : __builtin_amdgcn_mfma_f32_32x32x16_bf16(kf[0], qx0_, zero16, 0, 0, 0)); \
    qx1_ = QF(1); SBAR(); GAPA(cB = (GPRE) ? __builtin_amdgcn_mfma_f32_32x32x16_bf16(kf[1], qx0_, cB, 0, 0, 0) : __builtin_amdgcn_mfma_f32_32x32x16_bf16(kf[1], qx0_, zero16, 0, 0, 0)); \
    SBAR(); GAPA(cA = __builtin_amdgcn_mfma_f32_32x32x16_bf16(kf[2], qx1_, cA, 0, 0, 0)); \
    qx0_ = QF(2); SBAR(); GAPA(cB = __builtin_amdgcn_mfma_f32_32x32x16_bf16(kf[3], qx1_, cB, 0, 0, 0)); \
    SBAR(); GAPA(cA = __builtin_amdgcn_mfma_f32_32x32x16_bf16(kf[4], qx0_, cA, 0, 0, 0)); \
    qx1_ = QF(3); SBAR(); GAPA(cB = __builtin_amdgcn_mfma_f32_32x32x16_bf16(kf[5], qx0_, cB, 0, 0, 0)); \
    SBAR(); GAPA(cA = __builtin_amdgcn_mfma_f32_32x32x16_bf16(kf[6], qx1_, cA, 0, 0, 0)); \
    SBAR(); GAPA(cB = __builtin_amdgcn_mfma_f32_32x32x16_bf16(kf[7], qx1_, cB, 0, 0, 0)); \
    if (MODE == 1) { cA = __builtin_amdgcn_mfma_f32_32x32x16_bf16(kf[NKF - 2], qr[NQR - 1], cA, 0, 0, 0); cB = __builtin_amdgcn_mfma_f32_32x32x16_bf16(kf[NKF - 1], qr[NQR - 1], cB, 0, 0, 0); SBAR(); } \
    asm volatile("s_nop 15\n\ts_nop 7" : "+v"(cA), "+v"(cB));     \
    if (GK) { DMA_K((t) + 3, sl_cur); } if (GV) { DMA_V((t) + 2, sv_nn); } \
    VW(0, 0, 0); VW(1, 0, 4);        \
    { float a = MX3(cA[0], cA[1], cB[0]), b = MX3(cA[2], cA[3], cB[1]); a = MX3(a, cB[2], cB[3]); \
      _Pragma("unroll") for (int r = 4; r < 16; r += 4) { a = MX3(a, cA[r], cA[r + 1]); b = MX3(b, cA[r + 2], cA[r + 3]); a = MX3(a, cB[r], cB[r + 1]); b = MX3(b, cB[r + 2], cB[r + 3]); } \
      float rm = __builtin_fmaxf(a, b); { auto rr = __builtin_amdgcn_permlane32_swap(__float_as_uint(rm), __float_as_uint(rm), false, false); rm = __builtin_fmaxf(__uint_as_float(rr[0]), __uint_as_float(rr[1])); } \
      rm -= mhat; resc = false; \
      if (__builtin_expect(__any(rm > (float)THRL), 0)) { const float dl = __builtin_fmaxf(rm, 0.f); mhat += dl; mh2 = (f32x2){mhat, mhat}; \
        const float f = __builtin_amdgcn_exp2f(-dl); l_reg *= f; if (hi == 0) wsf[r32] = f; resc = true; } } \
    SBAR(); \
    float sacc = 0.f; \
    GAPB(o[0] = __builtin_amdgcn_mfma_f32_32x32x16_bf16(PAF(PWC, 0), VWF(0), o[0], 0, 0, 0), cA, 0, PWN##0, 0); VW(2, 0, 1); \
    GAPB(o[1] = __builtin_amdgcn_mfma_f32_32x32x16_bf16(PAF(PWC, 0), VWF(1), o[1], 0, 0, 0), cA, 4, PWN##0, 2); VW(3, 0, 5); \
    GAPB(o[0] = __builtin_amdgcn_mfma_f32_32x32x16_bf16(PAF(PWC, 1), VWF(2), o[0], 0, 0, 0), cA, 8, PWN##1, 0); VW(0, 0, 2); \
    GAPB(o[1] = __builtin_amdgcn_mfma_f32_32x32x16_bf16(PAF(PWC, 1), VWF(3), o[1], 0, 0, 0), cA, 12, PWN##1, 2); VW(1, 0, 6); \
    GAPB(o[0] = __builtin_amdgcn_mfma_f32_32x32x16_bf16(PAF(PWC, 2), VWF(0), o[0], 0, 0, 0), cB, 0, PWN##2, 0); VW(2, 0, 3); \
    GAPB(o[1] = __builtin_amdgcn_mfma_f32_32x32x16_bf16(PAF(PWC, 2), VWF(1), o[1], 0, 0, 0), cB, 4, PWN##2, 2); VW(3, 0, 7); \
    GAPB(o[0] = __builtin_amdgcn_mfma_f32_32x32x16_bf16(PAF(PWC, 3), VWF(2), o[0], 0, 0, 0), cB, 8, PWN##3, 0); VW(0, 1, 0); \
    GAPB(o[1] = __builtin_amdgcn_mfma_f32_32x32x16_bf16(PAF(PWC, 3), VWF(3), o[1], 0, 0, 0), cB, 12, PWN##3, 2); VW(1, 1, 4); \
    GAPC(o[2] = __builtin_amdgcn_mfma_f32_32x32x16_bf16(PAF(PWC, 0), VWF(0), o[2], 0, 0, 0)); VW(2, 1, 1); \
    GAPC(o[3] = __builtin_amdgcn_mfma_f32_32x32x16_bf16(PAF(PWC, 0), VWF(1), o[3], 0, 0, 0)); VW(3, 1, 5); \
    KRD(GL, 0); GAPC(o[2] = __builtin_amdgcn_mfma_f32_32x32x16_bf16(PAF(PWC, 1), VWF(2), o[2], 0, 0, 0)); VW(0, 1, 2); \
    KRD(GL, 1); GAPC(o[3] = __builtin_amdgcn_mfma_f32_32x32x16_bf16(PAF(PWC, 1), VWF(3), o[3], 0, 0, 0)); VW(1, 1, 6); \
    KRD(GL, 2); GAPC(o[2] = __builtin_amdgcn_mfma_f32_32x32x16_bf16(PAF(PWC, 2), VWF(0), o[2], 0, 0, 0)); VW(2, 1, 3); \
    KRD(GL, 3); GAPC(o[3] = __builtin_amdgcn_mfma_f32_32x32x16_bf16(PAF(PWC, 2), VWF(1), o[3], 0, 0, 0)); VW(3, 1, 7); \
    GAPC(o[2] = __builtin_amdgcn_mfma_f32_32x32x16_bf16(PAF(PWC, 3), VWF(2), o[2], 0, 0, 0)); \
    GAPC(o[3] = __builtin_amdgcn_mfma_f32_32x32x16_bf16(PAF(PWC, 3), VWF(3), o[3], 0, 0, 0)); \
    l_reg += sacc; \
    } while (0)
    int t = 1;
    for (; t + (T5 ? 29 : 5) < NT; t += 2) {
        if constexpr (NH == 2) { STEP2(pwa, pwb, t, true, true, true, false); } else { STEP(pwa, pwb, t, true, true, true, false); }     WAITKV_12(); RESC(); ROT();
        if constexpr (NH == 2) { STEP2(pwb, pwa, t + 1, true, true, true, false); } else { STEP(pwb, pwa, t + 1, true, true, true, false); } WAITKV_12(); RESC(); ROT();
    }
#define ENDW(tt) do { if ((tt) + 3 < NT) { WAITKV_12(); } else if ((tt) + 2 < NT) { WAITKV_02(); } else { WAIT_BAR(0); } } while (0)
    for (; t + 1 < NT; t += 2) {
        if constexpr (NH == 2) { STEP2(pwa, pwb, t, (t + 3 < NT), (t + 2 < NT), (t + 1 < NT), true); } else { STEP(pwa, pwb, t, (t + 3 < NT), (t + 2 < NT), (t + 1 < NT), true); }         ENDW(t);     RESC(); ROT();
        if constexpr (NH == 2) { STEP2(pwb, pwa, t + 1, (t + 4 < NT), (t + 3 < NT), (t + 2 < NT), true); } else { STEP(pwb, pwa, t + 1, (t + 4 < NT), (t + 3 < NT), (t + 2 < NT), true); }     ENDW(t + 1); RESC(); ROT();
    }
    if constexpr (NH == 2) { STEP2(pwa, pwb, NT - 1, false, false, false, true); } else { STEP(pwa, pwb, NT - 1, false, false, false, true); } RESC();
    SBAR(); pv(o, vb0 + sv_cur, PAF(pwb, 0), PAF(pwb, 1), PAF(pwb, 2), PAF(pwb, 3));
    if (NH == 2) pv(o + (2 * NH - 2), vb0 + sv_cur + 8192, PAF(pwb, 0), PAF(pwb, 1), PAF(pwb, 2), PAF(pwb, 3));
#undef PKW
#undef PAF
#undef VFR
#undef PIN
#undef MX3
#undef GAPA
#undef GAPB
#undef EX
#undef VRD
#undef KRD
#undef KRD8
#undef STEP
#undef STEP2
#undef VW
#undef VWF
#undef ENDW
    { auto rr = __builtin_amdgcn_permlane32_swap(__float_as_uint(l_reg), __float_as_uint(l_reg), false, false); l_reg = __uint_as_float(rr[0]) + __uint_as_float(rr[1]); }
    if (hi == 0) wsf[32 + r32] = l_reg; asm volatile("s_waitcnt lgkmcnt(0)" ::: "memory");
    float rli[16];
#pragma unroll
    for (int r = 0; r < 16; ++r) rli[r] = __builtin_amdgcn_rcpf(wsf[32 + crow(r, hi)]);
    bf16_t* Ow = P.out + (rowbase + q0 + wid * QBLK) * 1024 + ocol;
#pragma unroll
    for (int hh = 0; hh < NH; ++hh) { bf16_t* stg = (bf16_t*)(shm + LDS_OST) + wid * 2048;
#pragma unroll
      for (int r = 0; r < 16; ++r) { const int orow = crow(r, hi);
#pragma unroll
          for (int d0 = 0; d0 < 2; ++d0) stg[orow * 64 + d0 * 32 + r32] = (bf16_t)f2bf(o[2 * hh + d0][r] * rli[r]); }
      asm volatile("s_waitcnt lgkmcnt(0)" ::: "memory");
#pragma unroll
      for (int i = 0; i < 4; ++i) { const int row = i * 8 + (lane >> 3), ch = lane & 7; u32x4 v = *(const u32x4*)(stg + row * 64 + ch * 8);
          if (MODE == 1) {
              const u32x4 g = *(const u32x4*)(P.proj + (rowbase + q0 + wid * QBLK + row) * PITCH + 3072 + h * 64 + ch * 8);
              u32x4 w;
#pragma unroll
              for (int j = 0; j < 4; ++j) { const float a0 = bflo(v[j]) * sigmoid_f(bflo(g[j])), a1 = bfhi(v[j]) * sigmoid_f(bfhi(g[j])); w[j] = pk2(a0, a1); }
              v = w; }
          *(u32x4*)(Ow + (long)row * 1024 + hh * 64 + ch * 8) = v; }
      asm volatile("s_waitcnt lgkmcnt(0)" ::: "memory"); }
    asm volatile("s_waitcnt lgkmcnt(0)\n\ts_barrier" ::: "memory");
#undef DMA_K
#undef DMA_V
#undef WAITKV_22
#undef WAITKV_12
#undef WAITKV_11
#undef WAITKV_02
#undef VRD1
#undef QF
#undef GAPC
#undef PRE
#undef RESC
#undef ROT
}

#ifndef MK_THRL
#define MK_THRL 8
#endif
#ifndef MK_NOBIAS0
#define MK_NOBIAS0 0
#endif
#ifndef MK_NOBIAS
#define MK_NOBIAS 0
#endif
#ifndef MK_T5RELOAD
#define MK_T5RELOAD 0
#endif
template <int MODE>
__device__ __forceinline__ void attn_phase(char* lds, const AttnP& P, unsigned* queues  , unsigned xcc, const int tid) {
    volatile LAS int* uw = (volatile LAS int*)(LAS char*)(lds + LDS_UNIT); int cur_h = -1;
    for (int k = 0; k < 8; ++k) {
        const int qx = (int)((xcc + (unsigned)k) & 7u);
        for (;;) {
            if (tid == 0) uw[0] = (int)__hip_atomic_fetch_add(queues + 64 * qx, 1u, RLX_AGENT);
            __syncthreads();
            const int e = __builtin_amdgcn_readfirstlane(uw[0]);
            __syncthreads();
            constexpr int PERQ = (MODE == 2) ? 2 : 4;
#ifndef MK_QREP
#define MK_QREP 1
#endif
            constexpr int QREP = (MODE == 2) ? MK_QREP : 1;
            if (e >= QREP * PERQ * NQB) break;
            const int e1 = e % (PERQ * NQB); const int bvh = PERQ * qx + (e1 % PERQ), qb = NQB - 1 - (e1 / PERQ);
            const int ub = (MODE == 2) ? (bvh >> 3) : (bvh >> 4), uvh = (MODE == 2) ? (bvh & 7) : (bvh & 15), uh = (MODE == 2) ? (uvh >> 1) : (uvh >> 2);
            if ((MODE == 0 || MODE == 2) && (MK_T5RELOAD || uh != cur_h)) {
                cur_h = uh;
                LAS float* tb = (LAS float*)(LAS char*)(lds + LDS_TB) + tid; const GAS float* src = (const GAS float*)P.t5tab + (size_t)cur_h * T5N + tid; asm volatile("" : "+v"(tb), "+v"(src));
#pragma unroll
                for (int it = 0; it < (T5N + NTHR - 1) / NTHR; ++it) if (tid + NTHR * it < T5N) tb[NTHR * it] = src[NTHR * it];
                __syncthreads();
            }
            attn_unit<MODE, MK_THRL>(P, ub, uvh, qb, lds, tid);
        }
    }
}
#undef SBAR
#undef WAIT_BAR
}
struct Args { const float* in[24]; float* out; unsigned char* ws; const float* dbg_src; int lo, hi, bar_region, dbg_layer0; };
static_assert(sizeof(Args) == 27 * 8 + 16, "Args has padding");
template <int K_> __device__ __forceinline__ const float* inptr() {
#if defined(__HIP_DEVICE_COMPILE__)
    auto ka = __builtin_amdgcn_kernarg_segment_ptr(); const GAS float* p;
    asm volatile("s_load_dwordx2 %0, %1, %2\n\ts_waitcnt lgkmcnt(0)" : "=s"(p) : "s"(ka), "i"(K_ * 8)); return (const float*)p;
#else
    return nullptr;
#endif
}
#define INP(k) inptr<k>()
struct Frame {
    LAS unsigned char* lds; char* ldsg;
    gu32* ctl; unsigned char* ws;
    int tid, lane, wave, G, gw, NGW;
    float* out;
};
__device__ __forceinline__ float wave_sum(float v) {
#pragma unroll
    for (int o = 1; o < 64; o <<= 1) v += __shfl_xor(v, o);
    return v;
}
__device__ __forceinline__ float rowmax16(float v) {
    v = fmaxf(v, __builtin_bit_cast(float, __builtin_amdgcn_update_dpp(0, __builtin_bit_cast(int, v), 0xB1, 0xF, 0xF, false)));
    v = fmaxf(v, __builtin_bit_cast(float, __builtin_amdgcn_update_dpp(0, __builtin_bit_cast(int, v), 0x4E, 0xF, 0xF, false)));
    v = fmaxf(v, __builtin_bit_cast(float, __builtin_amdgcn_update_dpp(0, __builtin_bit_cast(int, v), 0x141, 0xF, 0xF, false)));
    v = fmaxf(v, __builtin_bit_cast(float, __builtin_amdgcn_update_dpp(0, __builtin_bit_cast(int, v), 0x140, 0xF, 0xF, false)));
    return v;
}
__device__ __forceinline__ float rowsum16(float v) {
    v += __builtin_bit_cast(float, __builtin_amdgcn_update_dpp(0, __builtin_bit_cast(int, v), 0xB1, 0xF, 0xF, false));
    v += __builtin_bit_cast(float, __builtin_amdgcn_update_dpp(0, __builtin_bit_cast(int, v), 0x4E, 0xF, 0xF, false));
    v += __builtin_bit_cast(float, __builtin_amdgcn_update_dpp(0, __builtin_bit_cast(int, v), 0x141, 0xF, 0xF, false));
    v += __builtin_bit_cast(float, __builtin_amdgcn_update_dpp(0, __builtin_bit_cast(int, v), 0x140, 0xF, 0xF, false));
    return v;
}

__device__ __forceinline__ void p0_transpose_item(const float* W, int ldn, int K, bf16_t* WT, int k0, int n_src0, int n_dst0, LAS float* scr, int lane) {
#pragma unroll 8
    for (int i = 0; i < 32; ++i) { const int kk = 2 * i + (lane >> 5); scr[kk * 33 + (lane & 31)] = W[(size_t)(k0 + kk) * ldn + n_src0 + (lane & 31)]; }
    LDS_WAIT(); asm volatile("" ::: "memory");
    const int c = lane & 7;
#pragma unroll
    for (int j = 0; j < 4; ++j) { const int n = (lane >> 3) + 8 * j; const LAS float* s = scr + (8 * c) * 33 + n;
        u32x4 o; o.x = pk2(s[0 * 33], s[1 * 33]); o.y = pk2(s[2 * 33], s[3 * 33]); o.z = pk2(s[4 * 33], s[5 * 33]); o.w = pk2(s[6 * 33], s[7 * 33]);
        *(GAS u32x4*)(WT + (size_t)(n_dst0 + n) * K + k0 + 8 * c) = o; }
    LDS_WAIT(); asm volatile("" ::: "memory");
}
__device__ __forceinline__ void p0a_convert(Frame& F) {
    LAS float* scr = (LAS float*)(F.lds + F.wave * 16384);
    unsigned char* ws = F.ws;
    constexpr int I_INE = 16 * 112, I_INO = 16 * 128, I_OUT = 16 * 32, I_GU = 16 * 64, I_D = 16 * 32;
    constexpr int N_DENSE = 2 * (I_INE + I_INO + 2 * I_OUT);
    constexpr long N_MOE = 128L * (I_GU + I_D);
    for (long it = F.gw; it < N_DENSE + N_MOE; it += F.NGW) {
        long r = it;
        if (r < N_DENSE) {
            const int i = (int)(r / (N_DENSE / 2)); int q = (int)(r % (N_DENSE / 2));
            if (q < I_INE) { p0_transpose_item(INP(2) + (size_t)i * D * EVEN_IN, EVEN_IN, D, (bf16_t*)(ws + WS_WINE) + (size_t)i * 3584 * D, 64 * (q / 112), 32 * (q % 112), 32 * (q % 112), scr, F.lane); continue; } q -= I_INE;
            if (q < I_INO) { p0_transpose_item(INP(10) + (size_t)i * D * ODD_IN, ODD_IN, D, (bf16_t*)(ws + WS_WINO) + (size_t)i * 4096 * D, 64 * (q / 128), 32 * (q % 128), 32 * (q % 128), scr, F.lane); continue; } q -= I_INO;
            if (q < I_OUT) { p0_transpose_item(INP(3) + (size_t)i * D * D, D, D, (bf16_t*)(ws + WS_WOUTE) + (size_t)i * D * D, 64 * (q / 32), 32 * (q % 32), 32 * (q % 32), scr, F.lane); continue; } q -= I_OUT;
            p0_transpose_item(INP(11) + (size_t)i * D * D, D, D, (bf16_t*)(ws + WS_WOUTO) + (size_t)i * D * D, 64 * (q / 32), 32 * (q % 32), 32 * (q % 32), scr, F.lane); continue;
        }
        r -= N_DENSE;
        const int le = (int)(r / (I_GU + I_D)); int q = (int)(r % (I_GU + I_D));
        if (q < I_GU) { const int nb = q % 64, n_src = 32 * nb;
            const int cc = n_src & 1023, n_dst = (cc >> 7) * 256 + (n_src >= 1024 ? 128 : 0) + (cc & 127);
            p0_transpose_item(INP(16) + (size_t)le * D * 2048, 2048, D, (bf16_t*)(ws + WS_WGU) + (size_t)le * 2048 * D, 64 * (q / 64), n_src, n_dst, scr, F.lane); }
        else { q -= I_GU; p0_transpose_item(INP(18) + (size_t)le * DFF * D, D, DFF, (bf16_t*)(ws + WS_WD) + (size_t)le * D * DFF, 64 * (q / 32), 32 * (q % 32), 32 * (q % 32), scr, F.lane); }
    }
    for (int it = F.gw; it < 128 + 32 + 32; it += F.NGW) {
        const float* src; int ld, col; bf16_t* hi; bool zero = false;
        if (it < 128) { const int l = it >> 5, e = it & 31; src = INP(14) + (size_t)l * D * NE; ld = NE; col = e; hi = (bf16_t*)(ws + WS_RW) + ((size_t)l * 2 * 32 + e) * 1024; }
        else if (it < 160) { const int i = (it - 128) >> 4, n = (it - 128) & 15; src = INP(2) + (size_t)i * D * EVEN_IN; ld = EVEN_IN; col = 3584 + n; zero = n >= 8; hi = (bf16_t*)(ws + WS_SWE) + ((size_t)i * 2 * 16 + n) * 1024; }
        else { const int i = (it - 160) >> 4, n = (it - 160) & 15; src = INP(10) + (size_t)i * D * ODD_IN; ld = ODD_IN; col = 4096 + n; hi = (bf16_t*)(ws + WS_SWO) + ((size_t)i * 2 * 16 + n) * 1024; }
        bf16_t* lo = hi + (it < 128 ? 32 : 16) * 1024;
        for (int k = F.lane; k < D; k += 64) { const float w = zero ? 0.f : src[(size_t)k * ld + col]; const unsigned h = f2bf(w); hi[k] = (bf16_t)h; lo[k] = (bf16_t)f2bf(w - __builtin_bit_cast(float, h << 16)); }
    }
    for (int i = F.gw * 64 + F.lane; i < 4 * T5N; i += F.NGW * 64) {
        const int h = i / T5N, p = i % T5N; float v = 0.f;
        if (p >= T5PAD) { const int n = p - T5PAD; int bk = n;
            if (n >= 16) { bk = 16 + (n >= 22) + (n >= 30) + (n >= 40) + (n >= 54) + (n >= 73) + (n >= 99) + (n >= 134) + (n >= 182) + (n >= 246) + (n >= 332) + (n >= 450) + (n >= 609) + (n >= 825) + (n >= 1117) + (n >= 1513); }
            v = (INP(1)[bk * 4 + h] - INP(1)[31 * 4 + h]) * LOG2E; }
#ifdef MK_ZEROT5
        v = 0.f;
#endif
#ifdef MK_SAMET5
        if (p >= T5PAD) { const int n = p - T5PAD; int bk = n; if (n >= 16) { bk = 16 + (n >= 22) + (n >= 30) + (n >= 40) + (n >= 54) + (n >= 73) + (n >= 99) + (n >= 134) + (n >= 182) + (n >= 246) + (n >= 332) + (n >= 450) + (n >= 609) + (n >= 825) + (n >= 1117) + (n >= 1513); } v = (INP(1)[bk * 4] - INP(1)[31 * 4]) * LOG2E; }
#endif
        ((float*)(ws + WS_T5))[i] = v;
    }
}

struct Ln16 {
    const float* X; const float* H; const bf16_t* Y; float* Xout; bf16_t* XB; const float* gam; const float* bet;
    const bf16_t* Whi; const bf16_t* Wlo;
    float oscale;
    const bf16_t* Xb; const bf16_t* Hb;
};
template <int SRC, int NS, bool WRITE_XB>
__device__ __forceinline__ void ln16_tile(const Ln16& P, int tile, int lane, const int (&pos)[4], const float (&gt)[4], f32x4 (&acc)[NS > 0 ? NS : 1]) {
    const int r = lane & 15, q = lane >> 4; const size_t m = (size_t)tile * 16 + r;
    const float* xr = P.X + m * D + 8 * q; const float* hr = (SRC == 1) ? P.H + m * D + 8 * q : nullptr;
    const bf16_t* yr[4];
    if (SRC == 2) {
#pragma unroll
        for (int k = 0; k < 4; ++k) yr[k] = P.Y + (size_t)pos[k] * D + 8 * q; }
#define LN16_LOAD(v, ks) do { const f32x4 a0 = *(const f32x4*)(xr + 32 * (ks)), a1 = *(const f32x4*)(xr + 32 * (ks) + 4); \
        if (SRC == 0) { _Pragma("unroll") for (int j = 0; j < 4; ++j) { v[j] = a0[j]; v[4 + j] = a1[j]; } } \
        else if (SRC == 1) { const f32x4 h0 = *(const f32x4*)(hr + 32 * (ks)), h1 = *(const f32x4*)(hr + 32 * (ks) + 4); _Pragma("unroll") for (int j = 0; j < 4; ++j) { v[j] = ALPHA * a0[j] + h0[j]; v[4 + j] = ALPHA * a1[j] + h1[j]; } } \
        else { _Pragma("unroll") for (int j = 0; j < 4; ++j) { v[j] = ALPHA * a0[j]; v[4 + j] = ALPHA * a1[j]; } \
            _Pragma("unroll") for (int k = 0; k < 4; ++k) { const u32x4 y = *(const u32x4*)(yr[k] + 32 * (ks)); _Pragma("unroll") for (int j = 0; j < 4; ++j) { v[2 * j] = fmaf(gt[k], bflo(y[j]), v[2 * j]); v[2 * j + 1] = fmaf(gt[k], bfhi(y[j]), v[2 * j + 1]); } } } } while (0)
    float mean = 0.f, rstd = 1.f;
    if (SRC != 0) {
        float s = 0.f, ss = 0.f;
#pragma unroll 4
        for (int ks = 0; ks < 32; ++ks) { float v[8]; LN16_LOAD(v, ks);
#pragma unroll
            for (int j = 0; j < 8; ++j) { s += v[j]; ss = fmaf(v[j], v[j], ss); } }
        s += __shfl_xor(s, 16); s += __shfl_xor(s, 32); ss += __shfl_xor(ss, 16); ss += __shfl_xor(ss, 32);
        mean = s * (1.f / D); const float var = fmaxf(ss * (1.f / D) - mean * mean, 0.f); rstd = rsqrtf(var + LN_EPS);
    }
#pragma unroll
    for (int n = 0; n < (NS > 0 ? NS : 1); ++n) acc[n] = (f32x4){0.f, 0.f, 0.f, 0.f};
#pragma unroll 2
    for (int ks = 0; ks < 32; ++ks) {
        float v[8]; LN16_LOAD(v, ks);
        if (SRC != 0) { const f32x4 g0 = *(const f32x4*)(P.gam + 32 * ks + 8 * q), g1 = *(const f32x4*)(P.gam + 32 * ks + 8 * q + 4), b0 = *(const f32x4*)(P.bet + 32 * ks + 8 * q), b1 = *(const f32x4*)(P.bet + 32 * ks + 8 * q + 4);
#pragma unroll
            for (int j = 0; j < 4; ++j) { v[j] = (v[j] - mean) * rstd * g0[j] + b0[j]; v[4 + j] = (v[4 + j] - mean) * rstd * g1[j] + b1[j]; } }
        if (P.Xout) { float* xo = P.Xout + m * D + 32 * ks + 8 * q;
            *(f32x4*)xo = (f32x4){v[0], v[1], v[2], v[3]} * P.oscale; *(f32x4*)(xo + 4) = (f32x4){v[4], v[5], v[6], v[7]} * P.oscale; }
        u32x4 hi; hi.x = pk2(v[0], v[1]); hi.y = pk2(v[2], v[3]); hi.z = pk2(v[4], v[5]); hi.w = pk2(v[6], v[7]);
        if (WRITE_XB) *(u32x4*)(P.XB + m * D + 32 * ks + 8 * q) = hi;
        if (NS > 0) {
            u32x4 lo;
#pragma unroll
            for (int j = 0; j < 4; ++j) lo[j] = pk2(v[2 * j] - bflo(hi[j]), v[2 * j + 1] - bfhi(hi[j]));
            const bf16x8 ah = __builtin_bit_cast(bf16x8, hi), al = __builtin_bit_cast(bf16x8, lo);
#pragma unroll
            for (int n = 0; n < NS; ++n) {
                const bf16x8 bh = *(const bf16x8*)(P.Whi + (size_t)(16 * n + r) * D + 32 * ks + 8 * q), bl = *(const bf16x8*)(P.Wlo + (size_t)(16 * n + r) * D + 32 * ks + 8 * q);
                acc[n] = __builtin_amdgcn_mfma_f32_16x16x32_bf16(ah, bh, acc[n], 0, 0, 0);
                acc[n] = __builtin_amdgcn_mfma_f32_16x16x32_bf16(al, bh, acc[n], 0, 0, 0);
                acc[n] = __builtin_amdgcn_mfma_f32_16x16x32_bf16(ah, bl, acc[n], 0, 0, 0); }
        }
    }
#undef LN16_LOAD
    if (NS > 0) asm volatile("s_nop 15\n\ts_nop 7" ::: "memory");
}
template <int SRC, int NS, bool WRITE_XB, bool WRITE_X>
__device__ __forceinline__ void ln16_pair(const Ln16& P, LAS unsigned char* xl, int par, int tile, int lane, int wave, const int (&pos)[4], const float (&gt)[4], f32x4 (&acc)[NS > 0 ? NS : 1]) {
    const int r = lane & 15, q = lane >> 4, half = wave & 1; const size_t m = (size_t)tile * 16 + r;
    const bf16_t* xr = P.Xb + m * D + 8 * q + 512 * half; const bf16_t* hr = (SRC == 1) ? P.Hb + m * D + 8 * q + 512 * half : nullptr;
    const bf16_t* yr[4];
    if (SRC == 2) {
#pragma unroll
        for (int k = 0; k < 4; ++k) yr[k] = P.Y + (size_t)pos[k] * D + 8 * q + 512 * half; }
    float st[16][8]; float s = 0.f, ss = 0.f;
#pragma unroll
    for (int ks = 0; ks < 16; ++ks) {
        const u32x4 xa = *(const u32x4*)(xr + 32 * ks);
        if (SRC == 1) { const u32x4 hh = *(const u32x4*)(hr + 32 * ks);
#pragma unroll
            for (int j = 0; j < 4; ++j) { st[ks][2 * j] = fmaf(ALPHA, bflo(xa[j]), bflo(hh[j])); st[ks][2 * j + 1] = fmaf(ALPHA, bfhi(xa[j]), bfhi(hh[j])); } }
        else {
#pragma unroll
            for (int j = 0; j < 4; ++j) { st[ks][2 * j] = ALPHA * bflo(xa[j]); st[ks][2 * j + 1] = ALPHA * bfhi(xa[j]); }
#pragma unroll
            for (int k = 0; k < 4; ++k) { const u32x4 y = *(const u32x4*)(yr[k] + 32 * ks);
#pragma unroll
                for (int j = 0; j < 4; ++j) { st[ks][2 * j] = fmaf(gt[k], bflo(y[j]), st[ks][2 * j]); st[ks][2 * j + 1] = fmaf(gt[k], bfhi(y[j]), st[ks][2 * j + 1]); } } }
#pragma unroll
        for (int j = 0; j < 8; ++j) { s += st[ks][j]; ss = fmaf(st[ks][j], st[ks][j], ss); }
        if ((ks & (SRC == 1 ? 7 : 3)) == (SRC == 1 ? 7 : 3)) __builtin_amdgcn_sched_barrier(0);
    }
    s += __shfl_xor(s, 16); s += __shfl_xor(s, 32); ss += __shfl_xor(ss, 16); ss += __shfl_xor(ss, 32);
    LAS float* ex = (LAS float*)(xl + par * 1024);
    if (q == 0) { ex[(wave * 16 + r) * 2] = s; ex[(wave * 16 + r) * 2 + 1] = ss; }
    __syncthreads();
    s += ex[((wave ^ 1) * 16 + r) * 2]; ss += ex[((wave ^ 1) * 16 + r) * 2 + 1];
    const float mean = s * (1.f / D); const float var = fmaxf(ss * (1.f / D) - mean * mean, 0.f); const float rstd = rsqrtf(var + LN_EPS);
#pragma unroll
    for (int n = 0; n < (NS > 0 ? NS : 1); ++n) acc[n] = (f32x4){0.f, 0.f, 0.f, 0.f};
#pragma unroll
    for (int ks = 0; ks < 16; ++ks) {
        const int c0 = 512 * half + 32 * ks + 8 * q;
        const f32x4 g0 = *(const f32x4*)(P.gam + c0), g1 = *(const f32x4*)(P.gam + c0 + 4), b0 = *(const f32x4*)(P.bet + c0), b1 = *(const f32x4*)(P.bet + c0 + 4);
        float v[8];
#pragma unroll
        for (int j = 0; j < 4; ++j) { v[j] = (st[ks][j] - mean) * rstd * g0[j] + b0[j]; v[4 + j] = (st[ks][4 + j] - mean) * rstd * g1[j] + b1[j]; }
        if (WRITE_X) { float* xo = P.Xout + m * D + c0;
            *(f32x4*)xo = (f32x4){v[0], v[1], v[2], v[3]} * P.oscale; *(f32x4*)(xo + 4) = (f32x4){v[4], v[5], v[6], v[7]} * P.oscale; }
        u32x4 hi; hi.x = pk2(v[0], v[1]); hi.y = pk2(v[2], v[3]); hi.z = pk2(v[4], v[5]); hi.w = pk2(v[6], v[7]);
        if (WRITE_XB) *(u32x4*)(P.XB + m * D + c0) = hi;
        if (NS > 0) {
            u32x4 lo;
#pragma unroll
            for (int j = 0; j < 4; ++j) lo[j] = pk2(v[2 * j] - bflo(hi[j]), v[2 * j + 1] - bfhi(hi[j]));
            const bf16x8 ah = __builtin_bit_cast(bf16x8, hi), al = __builtin_bit_cast(bf16x8, lo);
#pragma unroll
            for (int n = 0; n < NS; ++n) {
                const bf16x8 bh = *(const bf16x8*)(P.Whi + (size_t)(16 * n + r) * D + c0), bl = *(const bf16x8*)(P.Wlo + (size_t)(16 * n + r) * D + c0);
                acc[n] = __builtin_amdgcn_mfma_f32_16x16x32_bf16(ah, bh, acc[n], 0, 0, 0);
                acc[n] = __builtin_amdgcn_mfma_f32_16x16x32_bf16(al, bh, acc[n], 0, 0, 0);
                acc[n] = __builtin_amdgcn_mfma_f32_16x16x32_bf16(ah, bl, acc[n], 0, 0, 0); }
        }
        if ((ks & 3) == 3) __builtin_amdgcn_sched_barrier(0);
    }
    if (NS > 0) {
        asm volatile("s_nop 15\n\ts_nop 7" ::: "memory");
        LAS f32x4* ax = (LAS f32x4*)(xl + 2048);
#pragma unroll
        for (int n = 0; n < NS; ++n) ax[(wave * NS + n) * 64 + lane] = acc[n];
        __syncthreads();
#pragma unroll
        for (int n = 0; n < NS; ++n) acc[n] = acc[n] + ax[((wave ^ 1) * NS + n) * 64 + lane];
    }
}
__device__ __forceinline__ void smallproj_store(Frame& F, const f32x4& acc, int tile, bool next_even, const float* fb) {
    const int r = F.lane & 15, q = F.lane >> 4;
    if (next_even) {
        float* pb = (float*)(F.ws + WS_PB);
#pragma unroll
        for (int i = 0; i < 4; ++i) pb[(size_t)(tile * 16 + 4 * q + i) * 16 + r] = acc[i];
    } else {
        float* cum = (float*)(F.ws + WS_CUM); float* tsum = (float*)(F.ws + WS_TSUM);
        const int tok0 = tile * 16, b = tok0 / T, t0 = tok0 % T; const float bias = fb[r]; float s = 0.f;
#pragma unroll
        for (int i = 0; i < 4; ++i) { const float lf = -softplus_f(-(acc[i] + bias)); cum[(size_t)(b * 16 + r) * T + t0 + 4 * q + i] = lf; s += lf; }
        s += __shfl_xor(s, 16); s += __shfl_xor(s, 32);
        if (q == 0) tsum[(size_t)(b * 16 + r) * 1024 + (t0 >> 4)] = s;
    }
}

__device__ __forceinline__ void p0b_input(Frame& F) {
    Ln16 P{INP(0), nullptr, nullptr, nullptr, (bf16_t*)(F.ws + WS_XB), nullptr, nullptr, (const bf16_t*)(F.ws + WS_SWE), (const bf16_t*)(F.ws + WS_SWE) + 16 * 1024, 1.f};
    const int pos[4] = {0, 0, 0, 0}; const float gt[4] = {0.f, 0.f, 0.f, 0.f};
    for (int tile = F.gw; tile < NTOK / 16; tile += F.NGW) { f32x4 acc[1]; ln16_tile<0, 1, true>(P, tile, F.lane, pos, gt, acc); smallproj_store(F, acc[0], tile, true, nullptr); }
}

__device__ __forceinline__ void ln_router_phase(Frame& F, int layer) {
    volatile LAS int* wcnt = (volatile LAS int*)(F.lds + 0); volatile LAS int* gbase = (volatile LAS int*)(F.lds + 128);
    Ln16 P{(const float*)(F.ws + WS_X), (const float*)(F.ws + WS_H), nullptr, (float*)(F.ws + WS_X), (bf16_t*)(F.ws + WS_XB), INP(20) + layer * D, INP(21) + layer * D,
           (const bf16_t*)(F.ws + WS_RW) + (size_t)layer * 2 * 32 * 1024, (const bf16_t*)(F.ws + WS_RW) + (size_t)layer * 2 * 32 * 1024 + 32 * 1024, 1.f};
    P.Xb = (const bf16_t*)(F.ws + WS_XB); P.Hb = (const bf16_t*)(F.ws + WS_H);
    const float* rb = INP(15) + layer * NE;
    int* sele = (int*)(F.ws + WS_SELE); int* slot_o = (int*)(F.ws + WS_SLOT); float* gate_o = (float*)(F.ws + WS_GATE); int* list = (int*)(F.ws + WS_LIST);
    unsigned* gcnt = (unsigned*)(F.ctl + CW_CNT + layer * NE);
    const int pos[4] = {0, 0, 0, 0}; const float gt[4] = {0.f, 0.f, 0.f, 0.f};
    const int r = F.lane & 15, q = F.lane >> 4;
    for (int wt = blockIdx.x; wt < NTOK / 128; wt += F.G) {
        if (F.tid < 32) wcnt[F.tid] = 0;
        __syncthreads();
        const int kk = r & 3; int e_[2], local_[2]; float gm_[2];
#pragma unroll
        for (int rd = 0; rd < 2; ++rd) {
            const int tile = wt * 8 + rd * 4 + (F.wave >> 1);
            f32x4 acc[2]; ln16_pair<1, 2, true, false>(P, F.lds + 4096, rd, tile, F.lane, F.wave, pos, gt, acc);
            e_[rd] = 0; local_[rd] = 0; gm_[rd] = 0.f;
            if ((F.wave & 1) == 0) {
            const float b0 = rb[r], b1 = rb[16 + r];
            float top[4][4];
#pragma unroll
            for (int i = 0; i < 4; ++i) {
                float a = __builtin_bit_cast(float, (__builtin_bit_cast(unsigned, acc[0][i] + b0) & ~31u) | (unsigned)r);
                float b = __builtin_bit_cast(float, (__builtin_bit_cast(unsigned, acc[1][i] + b1) & ~31u) | (unsigned)(16 + r));
#pragma unroll
                for (int k = 0; k < 4; ++k) { const float mx = rowmax16(fmaxf(a, b)); top[i][k] = mx; if (a == mx) a = -INFINITY; if (b == mx) b = -INFINITY; }
            }
            float tv[4];
#pragma unroll
            for (int k = 0; k < 4; ++k) { const int i = r >> 2; tv[k] = i == 0 ? top[0][k] : i == 1 ? top[1][k] : i == 2 ? top[2][k] : top[3][k]; }
            float w[4], ws_ = 0.f;
#pragma unroll
            for (int k = 0; k < 4; ++k) { w[k] = __expf(tv[k] - tv[0]); ws_ += w[k]; }
            const float mine = kk == 0 ? tv[0] : kk == 1 ? tv[1] : kk == 2 ? tv[2] : tv[3]; gm_[rd] = (kk == 0 ? w[0] : kk == 1 ? w[1] : kk == 2 ? w[2] : w[3]) / ws_;
            e_[rd] = (int)(__builtin_bit_cast(unsigned, mine) & 31u);
            local_[rd] = __hip_atomic_fetch_add((LAS int*)(wcnt + e_[rd]), 1, __ATOMIC_RELAXED, __HIP_MEMORY_SCOPE_WORKGROUP);
            }
        }
        __syncthreads();
        if (F.tid < 32) gbase[F.tid] = (int)__hip_atomic_fetch_add(gcnt + F.tid, (unsigned)wcnt[F.tid], RLX_AGENT);
        __syncthreads();
        if ((F.wave & 1) == 0) {
#pragma unroll
            for (int rd = 0; rd < 2; ++rd) { const int tile = wt * 8 + rd * 4 + (F.wave >> 1);
                const int tok = tile * 16 + 4 * q + (r >> 2); const int sl = gbase[e_[rd]] + local_[rd];
                sele[tok * 4 + kk] = e_[rd]; slot_o[tok * 4 + kk] = sl; gate_o[tok * 4 + kk] = gm_[rd]; list[(size_t)e_[rd] * NTOK + sl] = tok * 4 + kk; } }
        __syncthreads();
    }
}

__device__ __forceinline__ void moe_tables(Frame& F, int layer) {
    volatile LAS int* cnt = (volatile LAS int*)(F.lds + CTRL_OFF); volatile LAS int* offp = cnt + 32;
    if (F.tid < 64) {
        const int c = F.lane < 32 ? (int)__hip_atomic_load((unsigned*)(F.ctl + CW_CNT + layer * NE + (F.lane & 31)), RLX_AGENT) : 0;
        int p = ((c + 255) >> 8) << 8;
#pragma unroll
        for (int o = 1; o < 32; o <<= 1) { const int n = __shfl_up(p, o); if ((F.lane & 31) >= o) p += n; }
        if (F.lane < 32) { cnt[F.lane] = c; offp[F.lane] = p - (((c + 255) >> 8) << 8); }
    }
    __syncthreads();
}

__device__ __forceinline__ void moe_out_phase(Frame& F, int layer) {
    volatile LAS int* offp = (volatile LAS int*)(F.lds + CTRL_OFF) + 32;
    const bool lastl = layer == 3, next_even = (layer & 1) == 1; const int ni = (layer + 1) >> 1;
    const bf16_t* sw = next_even ? (const bf16_t*)(F.ws + WS_SWE) + (size_t)ni * 2 * 16 * 1024 : (const bf16_t*)(F.ws + WS_SWO) + (size_t)ni * 2 * 16 * 1024;
    Ln16 P{(const float*)(F.ws + WS_X), nullptr, (const bf16_t*)(F.ws + WS_Y), lastl ? F.out : (float*)(F.ws + WS_X), (bf16_t*)(F.ws + WS_XB), INP(22) + layer * D, INP(23) + layer * D, sw, sw + 16 * 1024, 1.f};
    P.Xb = (const bf16_t*)(F.ws + WS_XB); P.Hb = nullptr;
#if defined(MK_TIMING)
    if (lastl) {
        const unsigned long long* st = (const unsigned long long*)(F.ctl + 65536);
        const int ty[36] = {0, 1, 2, 3, 4, 5, 8, 9, 10, 11, 13, 2, 6, 7, 8, 9, 10, 11, 13, 2, 3, 4, 5, 8, 9, 10, 11, 13, 2, 6, 7, 8, 9, 10, 11, 13};
        unsigned long long sel = 0;
#pragma unroll
        for (int k = 0; k < 34; ++k) if (((MK_TIMING) >> ty[k]) & 1) sel += st[k + 1] - st[k];
        P.oscale = 1.f + floorf((float)sel / (float)(st[34] - st[0]) * 100.f + 0.5f) * 0.01f;
    }
#endif
    const int* sele = (const int*)(F.ws + WS_SELE); const int* slot = (const int*)(F.ws + WS_SLOT); const float* gate = (const float*)(F.ws + WS_GATE);
    const float* fb = INP(13) + (lastl ? 0 : ni * 16);
    int par = 0;
    for (int tile = F.gw >> 1; tile < NTOK / 16; tile += F.NGW / 2, par ^= 1) {
        const int m = tile * 16 + (F.lane & 15); int pos[4]; float gt[4];
#pragma unroll
        for (int k = 0; k < 4; ++k) { pos[k] = offp[sele[m * 4 + k]] + slot[m * 4 + k]; gt[k] = gate[m * 4 + k]; }
        f32x4 acc[1];
        if (lastl) { ln16_pair<2, 0, false, true>(P, F.lds + 4096, par, tile, F.lane, F.wave, pos, gt, acc); }
        else { ln16_pair<2, 1, true, false>(P, F.lds + 4096, par, tile, F.lane, F.wave, pos, gt, acc); if ((F.wave & 1) == 0) smallproj_store(F, acc[0], tile, next_even, fb); }
    }
}

__device__ __forceinline__ void odd_prep_phase(Frame& F, int li) {
    float* cum = (float*)(F.ws + WS_CUM); const float* tsum = (const float*)(F.ws + WS_TSUM); bf16_t* kb8 = (bf16_t*)(F.ws + WS_KB8);
    for (int it = F.gw; it < 32 * 64; it += F.NGW) {
        const int bh = it >> 6, seg = it & 63;
        double base = 0.0;
        for (int j = F.lane; j < 16 * seg; j += 64) base += (double)tsum[(size_t)bh * 1024 + j];
#pragma unroll
        for (int o = 1; o < 64; o <<= 1) base += __shfl_xor(base, o);
        float* p = cum + (size_t)bh * T + seg * 256 + 4 * F.lane;
        const f32x4 lf = *(const f32x4*)p;
        float c0 = lf[0], c1 = c0 + lf[1], c2 = c1 + lf[2], c3 = c2 + lf[3];
        float incl = c3;
#pragma unroll
        for (int o = 1; o < 64; o <<= 1) { const float n = __shfl_up(incl, o); if (F.lane >= o) incl += n; }
        const float excl = incl - c3; const float bs = (float)base + excl;
        const float cc[4] = {(bs + c0) * LOG2E, (bs + c1) * LOG2E, (bs + c2) * LOG2E, (bs + c3) * LOG2E};
        *(f32x4*)p = (f32x4){cc[0], cc[1], cc[2], cc[3]};
#pragma unroll
        for (int j = 0; j < 4; ++j) { const float c = -cc[j];
            const unsigned ch = f2bf(c); const float r1 = c - __builtin_bit_cast(float, ch << 16); const unsigned cm = f2bf(r1); const float r2 = r1 - __builtin_bit_cast(float, cm << 16); const unsigned cl = f2bf(r2);
            u32x4 w; w.x = 0x3f80u | (0x3f80u << 16); w.y = 0x3f80u | (ch << 16); w.z = cm | (cl << 16); w.w = 0u;
            *(u32x4*)(kb8 + ((size_t)bh * T + seg * 256 + 4 * F.lane + j) * 8) = w; }
    }
    bf16_t* proj = (bf16_t*)(F.ws + WS_PROJ); const float* nw = INP(12) + li * 128;
    float wq[16], wk[16];
#pragma unroll
    for (int j = 0; j < 16; ++j) { wq[j] = nw[(F.lane & 3) * 16 + j] * C2; wk[j] = nw[64 + (F.lane & 3) * 16 + j]; }
    for (int tok = F.gw; tok < NTOK; tok += 4 * F.NGW) {
        u32x4 ra[4][2], rb[4][2];
#pragma unroll
        for (int u = 0; u < 4; ++u)
#pragma unroll
            for (int which = 0; which < 2; ++which) { const bf16_t* p = proj + (size_t)(tok + u * F.NGW) * PITCH + which * 1024 + 16 * F.lane; ra[u][which] = *(const u32x4*)p; rb[u][which] = *(const u32x4*)(p + 8); }
#pragma unroll
        for (int u = 0; u < 4; ++u)
#pragma unroll
        for (int which = 0; which < 2; ++which) {
            bf16_t* p = proj + (size_t)(tok + u * F.NGW) * PITCH + which * 1024 + 16 * F.lane;
            const u32x4 a = ra[u][which], b = rb[u][which];
            float v[16];
#pragma unroll
            for (int j = 0; j < 4; ++j) { v[2 * j] = bflo(a[j]); v[2 * j + 1] = bfhi(a[j]); v[8 + 2 * j] = bflo(b[j]); v[8 + 2 * j + 1] = bfhi(b[j]); }
            float ss = 0.f;
#pragma unroll
            for (int j = 0; j < 16; ++j) ss = fmaf(v[j], v[j], ss);
            ss += __shfl_xor(ss, 1); ss += __shfl_xor(ss, 2);
            const float rr = rsqrtf(ss * (1.f / 64.f) + RMS_EPS);
            u32x4 oa, ob;
#pragma unroll
            for (int j = 0; j < 4; ++j) { oa[j] = pk2(v[2 * j] * rr * (which ? wk[2 * j] : wq[2 * j]), v[2 * j + 1] * rr * (which ? wk[2 * j + 1] : wq[2 * j + 1]));
                ob[j] = pk2(v[8 + 2 * j] * rr * (which ? wk[8 + 2 * j] : wq[8 + 2 * j]), v[8 + 2 * j + 1] * rr * (which ? wk[8 + 2 * j + 1] : wq[8 + 2 * j + 1])); }
            *(u32x4*)p = oa; *(u32x4*)(p + 8) = ob;
        }
    }
}

__device__ __forceinline__ void even_combine_phase(Frame& F, int li, float lam_init) {
    const float* lp = INP(4) + li * 256;
    float a = 0.f, bsum = 0.f; { const int l = F.lane; a = lp[l] * lp[64 + l]; bsum = lp[128 + l] * lp[192 + l]; }
    a = wave_sum(a); bsum = wave_sum(bsum);
    const float lam = __expf(a) - __expf(bsum) + lam_init;
    const bf16_t* att = (const bf16_t*)(F.ws + WS_ATT); const float* go = (const float*)(F.ws + WS_GO); const bf16_t* proj = (const bf16_t*)(F.ws + WS_PROJ); bf16_t* mix = (bf16_t*)(F.ws + WS_MIX);
    const int l = F.lane, hh = l >> 4, d0 = (l & 15) * 8;
    float sw[8], gw[8];
#pragma unroll
    for (int j = 0; j < 8; ++j) { sw[j] = INP(5)[li * 128 + d0 + j] * (1.f - lam_init); gw[j] = INP(9)[li * 128 + d0 + j]; }
    for (int tok0 = F.gw; tok0 < NTOK; tok0 += 4 * F.NGW) {
        u32x4 o0_[4], o1_[4], z_[4]; f32x4 g0_[4], g1_[4];
#pragma unroll
        for (int u4 = 0; u4 < 4; ++u4) { const size_t tok = (size_t)(tok0 + u4 * F.NGW);
            o0_[u4] = *(const u32x4*)(att + tok * D + (hh * 2) * 128 + d0); o1_[u4] = *(const u32x4*)(att + tok * D + (hh * 2 + 1) * 128 + d0);
            g0_[u4] = *(const f32x4*)(go + tok * 512 + hh * 128 + d0); g1_[u4] = *(const f32x4*)(go + tok * 512 + hh * 128 + d0 + 4);
            z_[u4] = *(const u32x4*)(proj + tok * PITCH + 3072 + hh * 128 + d0); }
#pragma unroll
        for (int u4 = 0; u4 < 4; ++u4) { const size_t tok = (size_t)(tok0 + u4 * F.NGW);
        const u32x4 o0 = o0_[u4], o1 = o1_[u4];
        float v[8]; float ss = 0.f;
#pragma unroll
        for (int j = 0; j < 4; ++j) { v[2 * j] = bflo(o0[j]) - lam * bflo(o1[j]); v[2 * j + 1] = bfhi(o0[j]) - lam * bfhi(o1[j]); }
#pragma unroll
        for (int j = 0; j < 8; ++j) ss = fmaf(v[j], v[j], ss);
        ss = rowsum16(ss);
        float rr = rsqrtf(ss * (1.f / 128.f) + RMS_EPS);
        u32x4 w;
#pragma unroll
        for (int j = 0; j < 4; ++j) w[j] = pk2(v[2 * j] * rr * sw[2 * j], v[2 * j + 1] * rr * sw[2 * j + 1]);
        *(u32x4*)(mix + tok * D + hh * 128 + d0) = w;
        const f32x4 g0 = g0_[u4], g1 = g1_[u4];
        const u32x4 z = z_[u4];
        float u[8] = {g0[0], g0[1], g0[2], g0[3], g1[0], g1[1], g1[2], g1[3]};
        ss = 0.f;
#pragma unroll
        for (int j = 0; j < 8; ++j) ss = fmaf(u[j], u[j], ss);
        ss = rowsum16(ss);
        rr = rsqrtf(ss * (1.f / 128.f) + RMS_EPS);
#pragma unroll
        for (int j = 0; j < 4; ++j) { const float z0 = bflo(z[j]), z1 = bfhi(z[j]); w[j] = pk2(u[2 * j] * rr * gw[2 * j] * (z0 * sigmoid_f(z0)), u[2 * j + 1] * rr * gw[2 * j + 1] * (z1 * sigmoid_f(z1))); }
        *(u32x4*)(mix + tok * D + 512 + hh * 128 + d0) = w;
        }
    }
}
constexpr int GP_W = 136, GP_K = 72;
constexpr int GB_W = 64 * GP_W * 2, GB_QK = 64 * GP_K * 2, GB_KD = 128 * GP_K * 2;
constexpr int GB_ITEM = 2 * GB_W + GB_QK + GB_KD;
__device__ __forceinline__ int P32(int x) { return (x & ~31) | (((x >> 2) & 3) << 3) | (((x >> 4) & 1) << 2) | (x & 3); }

__device__ __forceinline__ void gdn_prep_phase(Frame& F, int li) {
    LAS unsigned char* L = F.lds;
    LAS bf16_t* Kn = (LAS bf16_t*)(L + 0);
    LAS bf16_t* Qn = (LAS bf16_t*)(L + 17408);
    LAS float* R = (LAS float*)(L + 34816);
    LAS float* Lm = (LAS float*)(L + 100352);
    LAS float* sc = (LAS float*)(L + 116736);
    const bf16_t* proj = (const bf16_t*)(F.ws + WS_PROJ); const float* pb = (const float*)(F.ws + WS_PB);
    const float* cw = INP(6) + (size_t)li * 4 * 1536;
    const int tid = F.tid, lane = F.lane, wave = F.wave;
    for (int item = blockIdx.x; item < 2048; item += F.G) {
        const int n = item & 255, h = (item >> 8) & 3, b = item >> 10; const int t0 = n * 64; const size_t tok0 = (size_t)b * T + t0;
        if (wave == 0) {
            const float bb = pb[(tok0 + lane) * 16 + h], ba = pb[(tok0 + lane) * 16 + 4 + h];
            const float beta = sigmoid_f(bb); const float g = -__expf(INP(7)[li * 4 + h]) * softplus_f(ba + INP(8)[li * 4 + h]);
            float gc = g;
#pragma unroll
            for (int o = 1; o < 64; o <<= 1) { const float v = __shfl_up(gc, o); if (lane >= o) gc += v; }
            sc[lane] = beta; sc[64 + lane] = gc;
        }
        __syncthreads();
        const int c = tid & 127, seg = tid >> 7;
        float yq[16], yk[16];
        {
            float w[3][4];
#pragma unroll
            for (int g = 0; g < 3; ++g)
#pragma unroll
                for (int j = 0; j < 4; ++j) w[g][j] = cw[j * 1536 + g * 512 + h * 128 + c];
            float xw[3][3];
            const bf16_t* base = proj + (tok0 + 16 * seg) * PITCH + 1536 + h * 128 + c;
#pragma unroll
            for (int j = 0; j < 3; ++j) { const bool ok = (t0 + 16 * seg - 3 + j) >= 0;
#pragma unroll
                for (int g = 0; g < 3; ++g) xw[g][j] = ok ? bf2f(base[(long)(j - 3) * PITCH + g * 512]) : 0.f; }
#pragma unroll
            for (int j = 0; j < 16; ++j) {
                float x[3];
#pragma unroll
                for (int g = 0; g < 3; ++g) x[g] = bf2f(base[(long)j * PITCH + g * 512]);
                float y[3];
#pragma unroll
                for (int g = 0; g < 3; ++g) { y[g] = w[g][0] * xw[g][0] + w[g][1] * xw[g][1] + w[g][2] * xw[g][2] + w[g][3] * x[g]; y[g] = y[g] * sigmoid_f(y[g]); xw[g][0] = xw[g][1]; xw[g][1] = xw[g][2]; xw[g][2] = x[g]; }
                yq[j] = y[0]; yk[j] = y[1]; R[(16 * seg + j) * 256 + c] = y[2] * sc[16 * seg + j];
            }
#pragma unroll
            for (int j = 0; j < 16; ++j) { const float sq = wave_sum(yq[j] * yq[j]), sk = wave_sum(yk[j] * yk[j]); if (lane == 0) { sc[128 + (wave * 16 + j) * 2] = sq; sc[128 + (wave * 16 + j) * 2 + 1] = sk; } }
        }
        __syncthreads();
        {
            const int wp = wave ^ 1;
#pragma unroll
            for (int j = 0; j < 16; ++j) { const int tk = 16 * seg + j;
                const float rq = rsqrtf(sc[128 + (wave * 16 + j) * 2] + sc[128 + (wp * 16 + j) * 2] + RMS_EPS), rk = rsqrtf(sc[128 + (wave * 16 + j) * 2 + 1] + sc[128 + (wp * 16 + j) * 2 + 1] + RMS_EPS);
                const float bt = sc[tk]; Qn[tk * GP_W + c] = (bf16_t)f2bf(yq[j] * rq); Kn[tk * GP_W + c] = (bf16_t)f2bf(yk[j] * rk); R[tk * 256 + 128 + c] = yk[j] * rk * bt * __expf(sc[64 + tk]); }
        }
        __syncthreads();
        {
            const int pq = wave >> 2, ti = (wave >> 1) & 1, tj = wave & 1, r32 = lane & 31, hi = lane >> 5;
            const LAS bf16_t* Ap = (pq ? Qn : Kn) + (32 * ti + r32) * GP_W + 8 * hi; const LAS bf16_t* Bp = Kn + (32 * tj + r32) * GP_W + 8 * hi;
            f32x16 acc = f32x16{};
#pragma unroll
            for (int ks = 0; ks < 8; ++ks) acc = __builtin_amdgcn_mfma_f32_32x32x16_bf16(*(const LAS bf16x8*)(Ap + 16 * ks), *(const LAS bf16x8*)(Bp + 16 * ks), acc, 0, 0, 0);
            asm volatile("s_nop 15\n\ts_nop 15\n\ts_nop 15\n\ts_nop 15" : "+v"(acc));
            const int m = 32 * tj + r32; const float gcm = sc[64 + m];
            bf16_t* gqk = (bf16_t*)(F.ws + WS_GQK) + (size_t)item * (64 * GP_K);
#pragma unroll
            for (int r = 0; r < 16; ++r) { const int cc = 32 * ti + (r & 3) + 8 * (r >> 2) + 4 * hi;
                const float dec = __expf(fminf(sc[64 + cc] - gcm, 0.f));
                if (pq == 0) Lm[cc * 64 + m] = (m < cc) ? sc[cc] * acc[r] * dec : 0.f;
                else gqk[cc * GP_K + P32(m)] = (bf16_t)f2bf((m <= cc) ? 0.08838834764831845f * acc[r] * dec : 0.f); }
        }
        __syncthreads();
        if (wave < 4) {
            float sol[64];
            LAS float* Rc = R + tid; const LAS float* Lv = Lm; asm volatile("" : "+v"(Rc), "+v"(Lv));
#pragma unroll
            for (int i = 0; i < 64; ++i) sol[i] = Rc[i * 256];
            __builtin_amdgcn_sched_barrier(0);
#pragma unroll
            for (int i = 1; i < 64; ++i) {
                float s4[4] = {sol[i], 0.f, 0.f, 0.f};
#pragma unroll
                for (int kb = 0; kb < (i + 3) / 4; ++kb) { const f32x4 l4 = *(const LAS f32x4*)(Lv + i * 64 + 4 * kb);
#pragma unroll
                    for (int u = 0; u < 4; ++u) if (4 * kb + u < i) s4[u] = fmaf(-l4[u], sol[4 * kb + u], s4[u]); }
                const float s = (s4[0] + s4[1]) + (s4[2] + s4[3]);
                sol[i] = s;
                Rc[i * 256] = s;
                __builtin_amdgcn_sched_barrier(0);
            }
        } else {
            const int t2 = tid - 256; const float gl = sc[64 + 63];
            bf16_t* gqd = (bf16_t*)(F.ws + WS_GQD) + (size_t)item * (64 * GP_W); bf16_t* gkd = (bf16_t*)(F.ws + WS_GKD) + (size_t)item * (128 * GP_K);
#pragma unroll 4
            for (int it = 0; it < 32; ++it) { const int e = t2 + 256 * it; const int cc = e >> 7, dk = e & 127; const float gcc = sc[64 + cc];
                gqd[cc * GP_W + P32(dk)] = (bf16_t)f2bf(bf2f(Qn[cc * GP_W + dk]) * 0.08838834764831845f * __expf(gcc));
                gkd[dk * GP_K + P32(cc)] = (bf16_t)f2bf(bf2f(Kn[cc * GP_W + dk]) * __expf(gl - gcc)); }
            if (t2 == 0) ((float*)(F.ws + WS_GL))[item] = __expf(gl);
        }
        __syncthreads();
        {
            f32x4* gu = (f32x4*)((float*)(F.ws + WS_GU) + (size_t)item * 8192);
#pragma unroll
            for (int it = 0; it < 4; ++it) { const int e = tid + NTHR * it; const int ln = e & 63, mt = (e >> 6) & 3, w = e >> 8; const int r = ln & 15, q = ln >> 4; const int dv = 16 * w + r, c0 = 16 * mt + 4 * q;
                gu[e] = (f32x4){R[(c0 + 0) * 256 + dv], R[(c0 + 1) * 256 + dv], R[(c0 + 2) * 256 + dv], R[(c0 + 3) * 256 + dv]}; }
            bf16_t* gw = (bf16_t*)(F.ws + WS_GW) + (size_t)item * (64 * GP_W);
#pragma unroll 4
            for (int it = 0; it < 16; ++it) { const int e = tid + NTHR * it; const int cc = e >> 7, dk = e & 127; gw[cc * GP_W + P32(dk)] = (bf16_t)f2bf(R[cc * 256 + 128 + dk]); }
        }
        __syncthreads();
    }
}

__device__ __forceinline__ void gdn_scan_phase(Frame& F, int li) {
#ifndef MK_SCAN_SPLIT
#define MK_SCAN_SPLIT 2
#endif
    constexpr int NSPLIT = MK_SCAN_SPLIT, NWV = 8 / NSPLIT;
    if (blockIdx.x >= 8 * NSPLIT) return;
    const int bh = blockIdx.x & 7, part = blockIdx.x >> 3, b = bh >> 2, h = bh & 3, lane = F.lane, wave = F.wave, r = lane & 15, q = lane >> 4;
    const bool act = wave < NWV; const int slice = part * NWV + (wave & (NWV - 1));
    const char* const g_w = (const char*)(F.ws + WS_GW); const char* const g_qd = (const char*)(F.ws + WS_GQD); const char* const g_qk = (const char*)(F.ws + WS_GQK); const char* const g_kd = (const char*)(F.ws + WS_GKD);
    const float* gu = (const float*)(F.ws + WS_GU); const float* glp = (const float*)(F.ws + WS_GL); float* go = (float*)(F.ws + WS_GO);
    const unsigned lds0 = (unsigned)(uintptr_t)F.ldsg;
    constexpr int GB_A = 2 * GB_W, GB_B = GB_QK + GB_KD, LB0 = 3 * GB_A;
    static_assert(LB0 + 2 * GB_B <= CTRL_OFF, "scan LDS");
#define GDN_DMA_A(item_, slot_) do { _Pragma("unroll") for (int p_ = 0; p_ < 5; ++p_) { const int p = wave + 8 * p_; if (p < 34) { \
        attn_body::glds16((p < 17 ? g_w : g_qd) + (size_t)(item_) * GB_W + (size_t)(p < 17 ? p : p - 17) * 1024, (unsigned)lane * 16u, (unsigned)__builtin_amdgcn_readfirstlane(lds0 + (slot_) * GB_A + p * 1024)); } } } while (0)
#define GDN_DMA_B(item_, slot_) do { _Pragma("unroll") for (int p_ = 0; p_ < 4; ++p_) { const int p = wave + 8 * p_; if (p < 27) { \
        attn_body::glds16(p < 9 ? g_qk + (size_t)(item_) * GB_QK + (size_t)p * 1024 : g_kd + (size_t)(item_) * GB_KD + (size_t)(p - 9) * 1024, (unsigned)lane * 16u, (unsigned)__builtin_amdgcn_readfirstlane(lds0 + LB0 + (slot_) * GB_B + p * 1024)); } } } while (0)
#define GDN_LDU(dst_, item_) do { _Pragma("unroll") for (int mt = 0; mt < 4; ++mt) dst_[mt] = *(const f32x4*)(gu + (size_t)(item_) * 8192 + ((slice * 4 + mt) * 64 + lane) * 4); } while (0)
#ifndef MK_SCAN_REP
#define MK_SCAN_REP 1
#endif
    const int item0 = bh * 256;
    for (int rep_ = 0; rep_ < MK_SCAN_REP; ++rep_) {
    f32x4 S[8];
#pragma unroll
    for (int m = 0; m < 8; ++m) S[m] = (f32x4){0.f, 0.f, 0.f, 0.f};
    GDN_DMA_A(item0, 0); GDN_DMA_B(item0, 0); GDN_DMA_A(item0 + 1, 1);
    f32x4 Ue[4], Uo[4], Op[4]; float gle = glp[item0], glo = glp[item0 + 1];
    GDN_LDU(Ue, item0); GDN_LDU(Uo, item0 + 1);
#pragma unroll
    for (int mt = 0; mt < 4; ++mt) Op[mt] = (f32x4){0.f, 0.f, 0.f, 0.f};
    int sa = 0;
    auto step = [&](const int n, f32x4 (&U)[4], float& glr) __attribute__((always_inline)) {
        const int item = item0 + n;
        if (n == 0 || n >= 254) asm volatile("s_waitcnt vmcnt(0) lgkmcnt(0)\n\ts_barrier" ::: "memory");
        else if (act && n >= 2) asm volatile("s_waitcnt vmcnt(33) lgkmcnt(0)\n\ts_barrier" ::: "memory");
        else if (act) asm volatile("s_waitcnt vmcnt(17) lgkmcnt(0)\n\ts_barrier" ::: "memory");
        else asm volatile("s_waitcnt vmcnt(7) lgkmcnt(0)\n\ts_barrier" ::: "memory");
        if (act && n > 0) { float* gop = go + ((size_t)b * T + 64 * (n - 1) + 4 * q) * 512 + h * 128 + 16 * slice + r;
#pragma unroll
            for (int mt = 0; mt < 4; ++mt)
#pragma unroll
                for (int i = 0; i < 4; ++i) gop[(size_t)(16 * mt + i) * 512] = Op[mt][i]; }
        if (n + 1 < 256) GDN_DMA_B(item + 1, (n + 1) & 1);
        if (n + 2 < 256) { const int sa2 = sa == 0 ? 2 : sa - 1;
            GDN_DMA_A(item + 2, sa2); }
        const LAS unsigned char* La = F.lds + sa * GB_A; const LAS unsigned char* Lbb = F.lds + LB0 + (n & 1) * GB_B;
        const LAS bf16_t* Wp = (const LAS bf16_t*)La + r * GP_W + 8 * q; const LAS bf16_t* QDp = (const LAS bf16_t*)(La + GB_W) + r * GP_W + 8 * q;
        const LAS bf16_t* QKp = (const LAS bf16_t*)Lbb + r * GP_K + 8 * q; const LAS bf16_t* KDp = (const LAS bf16_t*)(Lbb + GB_QK) + r * GP_K + 8 * q;
        f32x4 O[4]; bf16x8 Vb[2];
        if (act) {
        bf16x8 Sb[4];
#pragma unroll
        for (int ks = 0; ks < 4; ++ks) { u32x4 w; w.x = cvt_pk_bf16(S[2 * ks][0], S[2 * ks][1]); w.y = cvt_pk_bf16(S[2 * ks][2], S[2 * ks][3]); w.z = cvt_pk_bf16(S[2 * ks + 1][0], S[2 * ks + 1][1]); w.w = cvt_pk_bf16(S[2 * ks + 1][2], S[2 * ks + 1][3]); Sb[ks] = __builtin_bit_cast(bf16x8, w); }
        f32x4 ws_[4];
#pragma unroll
        for (int mt = 0; mt < 4; ++mt) { ws_[mt] = (f32x4){0.f, 0.f, 0.f, 0.f}; O[mt] = (f32x4){0.f, 0.f, 0.f, 0.f}; }
        f32x4 Uc[4]; float gl;
#define GDN_UCONS(W_) do { float a0, a1, a2, a3, a4, a5, a6, a7, a8; \
        asm volatile(W_ "\n\tv_mov_b32 %0, %9\n\tv_mov_b32 %1, %10\n\tv_mov_b32 %2, %11\n\tv_mov_b32 %3, %12\n\tv_mov_b32 %4, %13\n\tv_mov_b32 %5, %14\n\tv_mov_b32 %6, %15\n\tv_mov_b32 %7, %16\n\tv_mov_b32 %8, %17" \
            : "=&v"(a0), "=&v"(a1), "=&v"(a2), "=&v"(a3), "=&v"(a4), "=&v"(a5), "=&v"(a6), "=&v"(a7), "=&v"(a8) \
            : "v"(U[0][0]), "v"(U[0][1]), "v"(U[0][2]), "v"(U[0][3]), "v"(U[1][0]), "v"(U[1][1]), "v"(U[1][2]), "v"(U[1][3]), "v"(glr) : "memory"); \
        Uc[0] = (f32x4){a0, a1, a2, a3}; Uc[1] = (f32x4){a4, a5, a6, a7}; gl = a8; \
        asm volatile("v_mov_b32 %0, %8\n\tv_mov_b32 %1, %9\n\tv_mov_b32 %2, %10\n\tv_mov_b32 %3, %11\n\tv_mov_b32 %4, %12\n\tv_mov_b32 %5, %13\n\tv_mov_b32 %6, %14\n\tv_mov_b32 %7, %15" \
            : "=&v"(a0), "=&v"(a1), "=&v"(a2), "=&v"(a3), "=&v"(a4), "=&v"(a5), "=&v"(a6), "=&v"(a7) \
            : "v"(U[2][0]), "v"(U[2][1]), "v"(U[2][2]), "v"(U[2][3]), "v"(U[3][0]), "v"(U[3][1]), "v"(U[3][2]), "v"(U[3][3]) : "memory"); \
        Uc[2] = (f32x4){a0, a1, a2, a3}; Uc[3] = (f32x4){a4, a5, a6, a7}; } while (0)
        if (n < 2 || n >= 254) GDN_UCONS("s_waitcnt vmcnt(0)"); else GDN_UCONS("s_waitcnt vmcnt(51)");
        {
#pragma unroll
        for (int m = 0; m < 8; ++m) S[m] = S[m] * gl; }
#pragma unroll
        for (int ks = 0; ks < 4; ++ks)
#pragma unroll
            for (int mt = 0; mt < 4; ++mt) {
                ws_[mt] = __builtin_amdgcn_mfma_f32_16x16x32_bf16(*(const LAS bf16x8*)(Wp + 16 * mt * GP_W + 32 * ks), Sb[ks], ws_[mt], 0, 0, 0);
                O[mt] = __builtin_amdgcn_mfma_f32_16x16x32_bf16(*(const LAS bf16x8*)(QDp + 16 * mt * GP_W + 32 * ks), Sb[ks], O[mt], 0, 0, 0);
                if (mt == 3) __builtin_amdgcn_sched_barrier(0); }
        asm volatile("s_nop 15\n\ts_nop 15\n\ts_nop 15\n\ts_nop 15" ::: "memory");
#pragma unroll
        for (int kc = 0; kc < 2; ++kc) { const f32x4 v0 = Uc[2 * kc] - ws_[2 * kc], v1 = Uc[2 * kc + 1] - ws_[2 * kc + 1];
            u32x4 w; w.x = cvt_pk_bf16(v0[0], v0[1]); w.y = cvt_pk_bf16(v0[2], v0[3]); w.z = cvt_pk_bf16(v1[0], v1[1]); w.w = cvt_pk_bf16(v1[2], v1[3]); Vb[kc] = __builtin_bit_cast(bf16x8, w); }
        }
        asm volatile("" ::: "memory");
        if (act && n + 2 < 256) {
            const float* up = gu + (size_t)(item + 2) * 8192 + (slice * 256 + lane) * 4; const float* gp = glp + item + 2;
            asm volatile("global_load_dwordx4 %0, %4, off\n\tglobal_load_dwordx4 %1, %4, off offset:1024\n\tglobal_load_dwordx4 %2, %4, off offset:2048\n\tglobal_load_dwordx4 %3, %4, off offset:3072"
                         : "=&v"(U[0]), "=&v"(U[1]), "=&v"(U[2]), "=&v"(U[3]) : "v"(up) : "memory");
            asm volatile("global_load_dword %0, %1, off" : "=&v"(glr) : "v"(gp) : "memory"); }
        if (n >= 254) asm volatile("s_waitcnt vmcnt(0)\n\ts_barrier" ::: "memory");
        else if (act) asm volatile("s_waitcnt vmcnt(37)\n\ts_barrier" ::: "memory");
        else asm volatile("s_waitcnt vmcnt(11)\n\ts_barrier" ::: "memory");
        sa = sa == 2 ? 0 : sa + 1;
        if (!act) return;
#pragma unroll
        for (int kc = 0; kc < 2; ++kc)
#pragma unroll
            for (int mt = 0; mt < 4; ++mt) { O[mt] = __builtin_amdgcn_mfma_f32_16x16x32_bf16(*(const LAS bf16x8*)(QKp + 16 * mt * GP_K + 32 * kc), Vb[kc], O[mt], 0, 0, 0); if (mt == 3) __builtin_amdgcn_sched_barrier(0); }
#pragma unroll
        for (int kc = 0; kc < 2; ++kc)
#pragma unroll
            for (int m = 0; m < 8; ++m) { S[m] = __builtin_amdgcn_mfma_f32_16x16x32_bf16(*(const LAS bf16x8*)(KDp + 16 * m * GP_K + 32 * kc), Vb[kc], S[m], 0, 0, 0); if (m == 7) __builtin_amdgcn_sched_barrier(0); }
#pragma unroll
        for (int mt = 0; mt < 4; ++mt) Op[mt] = O[mt];
    };
    for (int n = 0; n < 256; n += 2) { step(n, Ue, gle); step(n + 1, Uo, glo); }
    if (act) { float* gop = go + ((size_t)b * T + 64 * 255 + 4 * q) * 512 + h * 128 + 16 * slice + r;
#pragma unroll
        for (int mt = 0; mt < 4; ++mt)
#pragma unroll
            for (int i = 0; i < 4; ++i) gop[(size_t)(16 * mt + i) * 512] = Op[mt][i]; }
    asm volatile("s_waitcnt vmcnt(0) lgkmcnt(0)\n\ts_barrier" ::: "memory");
    }
#undef GDN_DMA_A
#undef GDN_DMA_B
#undef GDN_LDU
#undef GDN_UCONS
}
constexpr int N_STEPS = 2 + 2 * (9 + 8);
#ifndef MK_INPROJ_REP
#define MK_INPROJ_REP 1
#endif
#ifndef MK_OUTPROJ_REP
#define MK_OUTPROJ_REP 1
#endif
#ifndef MK_EVEN_MODE
#define MK_EVEN_MODE 2
#endif

__global__ void __launch_bounds__(NTHR, 2) mk(Args a) {
    extern __shared__ __attribute__((aligned(16))) unsigned char lds_raw[];
    volatile LAS unsigned* MISC = (volatile LAS unsigned*)((LAS unsigned char*)lds_raw + MISC_OFF);
    for (int u = threadIdx.x; u < (LDS_BYTES - CTRL_OFF) / 4; u += NTHR) ((LAS unsigned*)((LAS unsigned char*)lds_raw + CTRL_OFF))[u] = 0u;
    __syncthreads();
    gu32* const ctl0 = (gu32*)(a.ws + WS_CTL);
    const int lo = a.lo, hi = a.hi;
    XcdBarrier bar; bar.bar = (unsigned*)(ctl0 + CW_BAR) + a.bar_region * XCD_BAR_WORDS; bar.x = xb_xcc_id(); bar.st = MISC + 8;
    if (hi - lo > 1) bar = xcd_barrier_post((unsigned*)(ctl0 + CW_BAR) + a.bar_region * XCD_BAR_WORDS, MISC + 8);
    const unsigned xcc = bar.x;
    const int cblk = (int)blockIdx.x;
    int step = 0;
#ifndef MK_EN
#define MK_EN 0xFFFF
#endif
#define EN(k) ((MK_EN >> (k)) & 1)
#if defined(MK_TIMING)
#define MK_STAMP() do { if (blockIdx.x == 0 && threadIdx.x == 0) ((unsigned long long*)(ctl0 + 65536))[step] = __builtin_amdgcn_s_memrealtime(); } while (0)
#else
#define MK_STAMP() do { } while (0)
#endif
#define PHASE_BEGIN if (step >= lo && step < hi) { MK_STAMP(); Frame F; { int tid_ = threadIdx.x; GAS unsigned char* wsg_ = (GAS unsigned char*)a.ws; asm volatile("" : "+v"(tid_), "+s"(wsg_)); unsigned char* ws_ = (unsigned char*)wsg_;     \
        F.lds = (LAS unsigned char*)lds_raw; F.ldsg = (char*)lds_raw; F.tid = tid_; F.lane = tid_ & 63; F.wave = __builtin_amdgcn_readfirstlane(tid_ >> 6); \
        F.G = gridDim.x; F.gw = blockIdx.x * NWAVES + F.wave; F.NGW = F.G * NWAVES; F.ws = ws_; F.ctl = (gu32*)(ws_ + WS_CTL); F.out = a.out; }
#ifdef MK_BAR2
#define PHASE_END   if (step + 1 < hi) { xcd_barrier(bar); xcd_barrier(bar); xcd_barrier(bar); } } ++step;
#else
#define PHASE_END   if (step + 1 < hi) xcd_barrier(bar); } ++step;
#endif
#ifndef MK_TWICE
#define MK_TWICE -1
#endif
#define REPEAT(k) for (int rep_ = 0; rep_ < (MK_TWICE == (k) ? 2 : 1); ++rep_)
#define REPBAR() do { if (rep_) xcd_barrier(bar); } while (0)

    PHASE_BEGIN if (EN(0)) REPEAT(0) { REPBAR(); p0a_convert(F); } PHASE_END
    PHASE_BEGIN if (EN(1)) {
        if (a.dbg_src) {
            const bool ne = (a.dbg_layer0 & 1) == 0; const int ni = a.dbg_layer0 >> 1;
            const bf16_t* sw = ne ? (const bf16_t*)(F.ws + WS_SWE) + (size_t)ni * 2 * 16 * 1024 : (const bf16_t*)(F.ws + WS_SWO) + (size_t)ni * 2 * 16 * 1024;
            Ln16 P{a.dbg_src, nullptr, nullptr, (float*)(F.ws + WS_X), (bf16_t*)(F.ws + WS_XB), nullptr, nullptr, sw, sw + 16 * 1024, 1.f};
            const int pos[4] = {0, 0, 0, 0}; const float gt[4] = {0.f, 0.f, 0.f, 0.f};
            for (int tile = F.gw; tile < NTOK / 16; tile += F.NGW) { f32x4 acc[1]; ln16_tile<0, 1, true>(P, tile, F.lane, pos, gt, acc); smallproj_store(F, acc[0], tile, ne, INP(13) + ni * 16); }
        } else p0b_input(F); }
    PHASE_END

    for (int layer = 0; layer < 4; ++layer) {
        const int li = layer >> 1; const bool even = (layer & 1) == 0;
        if (layer < a.dbg_layer0) { step += even ? 9 : 8; continue; }
        PHASE_BEGIN if (EN(2)) REPEAT(2) { REPBAR();
            const int N = even ? 3584 : 4096;
            pg8::DenseOrder S{(const char*)(F.ws + WS_XB), even ? (const char*)(F.ws + WS_WINE) + (size_t)li * 3584 * D * 2 : (const char*)(F.ws + WS_WINO) + (size_t)li * 4096 * D * 2, D, NTOK / 256, N / 256, (NTOK / 256) * (N / 256), F.G, cblk, MK_INPROJ_REP};
            pg8::EpiProj E{(bf16_t*)(F.ws + WS_PROJ), PITCH, even ? 512 : 0, C2};
            pg8::gemm_phase<pg8::EpiProj, pg8::DenseOrder, false>(F.lds, D, S, E, F.tid);
        } PHASE_END
        if (even) {
            PHASE_BEGIN if (EN(3)) REPEAT(3) { REPBAR(); gdn_prep_phase(F, li); } PHASE_END
            PHASE_BEGIN if (EN(4)) REPEAT(4) { REPBAR();
                if (EN(12)) gdn_scan_phase(F, li);
                attn_body::AttnP P{(const bf16_t*)(F.ws + WS_PROJ), (bf16_t*)(F.ws + WS_ATT), (const float*)(F.ws + WS_T5), nullptr, nullptr, 0.f};
                attn_body::attn_phase<MK_EVEN_MODE>(F.ldsg, P, (unsigned*)(F.ctl + CW_QUEUE + (layer + 4 * rep_) * 8 * 64), xcc, F.tid);
            } PHASE_END
            PHASE_BEGIN if (EN(5)) REPEAT(5) even_combine_phase(F, li, 0.8f - 0.6f * __expf(-0.3f * (float)layer)); PHASE_END
        } else {
            PHASE_BEGIN if (EN(6)) odd_prep_phase(F, li); PHASE_END
            PHASE_BEGIN if (EN(7)) REPEAT(7) { REPBAR();
                float mq, mk; { const float* nw = INP(12) + li * 128; mq = fabsf(nw[F.lane]); mk = fabsf(nw[64 + F.lane]);
#pragma unroll
                    for (int o = 1; o < 64; o <<= 1) { mq = fmaxf(mq, __shfl_xor(mq, o)); mk = fmaxf(mk, __shfl_xor(mk, o)); } }
                const float xb = 64.f * mq * mk * C2 * 1.05f;
                attn_body::AttnP P{(const bf16_t*)(F.ws + WS_PROJ), (bf16_t*)(F.ws + WS_MIX), nullptr, (const float*)(F.ws + WS_CUM), (const bf16_t*)(F.ws + WS_KB8), 2.f * xb + 54.f};
                attn_body::attn_phase<1>(F.ldsg, P, (unsigned*)(F.ctl + CW_QUEUE + (layer + 4 * rep_) * 8 * 64), xcc, F.tid);
            } PHASE_END
        }
        PHASE_BEGIN if (EN(8)) REPEAT(8) { REPBAR();
            pg8::DenseOrder S{(const char*)(F.ws + WS_MIX), even ? (const char*)(F.ws + WS_WOUTE) + (size_t)li * D * D * 2 : (const char*)(F.ws + WS_WOUTO) + (size_t)li * D * D * 2, D, NTOK / 256, D / 256, (NTOK / 256) * (D / 256), F.G, cblk, MK_OUTPROJ_REP};
            pg8::EpiProj E{(bf16_t*)(F.ws + WS_H), D, 0, 1.f};
            pg8::gemm_phase<pg8::EpiProj, pg8::DenseOrder, false>(F.lds, D, S, E, F.tid);
        } PHASE_END
        PHASE_BEGIN if (EN(9)) ln_router_phase(F, layer); PHASE_END
        PHASE_BEGIN if (EN(10)) REPEAT(10) { REPBAR();
            moe_tables(F, layer);
            pg8::MoeOrder S{(const char*)(F.ws + WS_XB), (const char*)(F.ws + WS_WGU) + (size_t)layer * NE * 2048 * D * 2, (const int*)(F.ws + WS_LIST), (const LAS int*)(F.lds + CTRL_OFF), (const LAS int*)(F.lds + CTRL_OFF) + 32,
                            8, (size_t)2048 * D * 2, D, true, F.G, cblk};
            pg8::EpiSwiglu E{(bf16_t*)(F.ws + WS_ACT), INP(17) + (size_t)layer * NE * 2048};
            pg8::gemm_phase<pg8::EpiSwiglu, pg8::MoeOrder, true>(F.lds, D, S, E, F.tid);
        } PHASE_END
        PHASE_BEGIN if (EN(11)) REPEAT(11) { REPBAR();
            moe_tables(F, layer);
            pg8::MoeOrder S{(const char*)(F.ws + WS_ACT), (const char*)(F.ws + WS_WD) + (size_t)layer * NE * D * DFF * 2, nullptr, (const LAS int*)(F.lds + CTRL_OFF), (const LAS int*)(F.lds + CTRL_OFF) + 32,
                            4, (size_t)D * DFF * 2, DFF, false, F.G, cblk};
            pg8::EpiDown E{(bf16_t*)(F.ws + WS_Y), INP(19) + (size_t)layer * NE * D};
            pg8::gemm_phase<pg8::EpiDown, pg8::MoeOrder, false>(F.lds, DFF, S, E, F.tid);
        } PHASE_END
        PHASE_BEGIN if (EN(13)) { moe_tables(F, layer); moe_out_phase(F, layer); } PHASE_END
    }
#undef PHASE_BEGIN
#undef PHASE_END
}
}

#if MK_DEBUG
namespace dbg {
template <class TA, class TB> __device__ __forceinline__ float ldv(const TA* p);
__device__ __forceinline__ float ldf(const float* p) { return *p; }
__device__ __forceinline__ float ldf(const unsigned short* p) { return __builtin_bit_cast(float, (unsigned)*p << 16); }
template <class TA, class TB>
__global__ void cmp(const TA* a, long lda, const TB* b, long ldb, int rows, int cols, float bscale, double* acc) {
    double e = 0.0, n = 0.0;
    for (long i = (long)blockIdx.x * blockDim.x + threadIdx.x; i < (long)rows * cols; i += (long)gridDim.x * blockDim.x) {
        const long r = i / cols, c = i % cols; const float x = ldf(a + r * lda + c), y = ldf(b + r * ldb + c) * bscale;
        e += (double)(x - y) * (x - y); n += (double)x * x; }
    for (int o = 32; o > 0; o >>= 1) { e += __shfl_xor(e, o); n += __shfl_xor(n, o); }
    if ((threadIdx.x & 63) == 0) { atomicAdd(acc, e); atomicAdd(acc + 1, n); }
}
__global__ void finish(float* out, const float* ref, const double* acc, int nchk, float thr, int which, long n) {
    float code = 0.f;
    if (which >= 0) { code = (float)sqrt(acc[2 * which] / (acc[2 * which + 1] + 1e-300)); if (!(code == code)) code = 3.f; if (code > 3.f) code = 3.f; }
    else { for (int k = 0; k < nchk; ++k) { const double e = acc[2 * k] / (acc[2 * k + 1] + 1e-300); if (!(e <= (double)thr)) { code = 0.1f * (k + 1); break; } } }
    for (long i = (long)blockIdx.x * blockDim.x + threadIdx.x; i < n; i += (long)gridDim.x * blockDim.x) out[i] = ref[i] * (1.f + code);
}
__global__ void csum(const unsigned* p, size_t nwords, unsigned long long* out, size_t colw, size_t pitchw) {
    unsigned long long s = 0;
    for (size_t i = (size_t)blockIdx.x * blockDim.x + threadIdx.x; i < nwords; i += (size_t)gridDim.x * blockDim.x) s += p[(i / colw) * pitchw + (i % colw)];
    for (int o = 32; o > 0; o >>= 1) s += __shfl_xor(s, o);
    if ((threadIdx.x & 63) == 0) atomicAdd(out, s);
}
__global__ void finish2(float* out, const float* ref, const unsigned long long* cs, int n, int nrun, long nel) {
    float code = 0.f;
#ifndef MK_DBG_ONLY
#define MK_DBG_ONLY -1
#endif
#ifndef MK_DBG_ANY
#define MK_DBG_ANY 0
#endif
    for (int k = 0; k < n && code == 0.f; ++k) for (int r = 1; r < nrun; ++r) if ((MK_DBG_ONLY < 0 || k == MK_DBG_ONLY) && cs[k] != cs[16 * r + k]) { code = MK_DBG_ANY ? 0.5f : 0.1f * (k + 1); break; }
    for (long i = (long)blockIdx.x * blockDim.x + threadIdx.x; i < nel; i += (long)gridDim.x * blockDim.x) out[i] = ref[i] * (1.f + code);
}
__global__ void attdiff(const unsigned short* a, const unsigned short* b, unsigned* stat, int mode) {
    const int u = blockIdx.x, bvh = u >> 6, qb = u & 63, bb = bvh >> 4, vh = bvh & 15;
    int ocol; if (mode == 0) { const int h = vh >> 2, m = (vh >> 1) & 1, half = vh & 1; ocol = (h * 2 + m) * 128 + half * 64; } else ocol = vh * 64;
    __shared__ int any; if (threadIdx.x == 0) any = 0; __syncthreads();
    const size_t row = (size_t)bb * T + qb * 256 + threadIdx.x; int df = 0;
    for (int c = 0; c < 64; ++c) df |= a[row * D + ocol + c] != b[row * D + ocol + c];
    if (df) any = 1; __syncthreads();
    if (threadIdx.x == 0 && any) { atomicAdd(stat, 1u); if (qb < 8) atomicAdd(stat + 1, 1u); if (vh < 8) atomicAdd(stat + 2, 1u); if (qb <= 6) atomicAdd(stat + 3, 1u); if (qb == 7) atomicAdd(stat + 4, 1u); if (qb == 0) atomicAdd(stat + 5, 1u); }
    if (df) { atomicAdd(stat + 6, 1u); if (threadIdx.x < 32) atomicAdd(stat + 7, 1u); }
}
__global__ void finish3(float* out, const float* ref, const unsigned* stat, int which, float denom, long nel) {
    float code = 0.f; { unsigned c = stat[which]; if (denom > 0.f) code = (float)(c / 8) * 8.f / denom; else { int lg = 0; while (c) { ++lg; c >>= 1; } code = 0.1f * (float)lg; } }
    for (long i = (long)blockIdx.x * blockDim.x + threadIdx.x; i < nel; i += (long)gridDim.x * blockDim.x) out[i] = ref[i] * (1.f + code);
}
__global__ void finish4(float* out, const float* ref, const double* acc, long nel) {
    const double e = acc[0] / (acc[1] + 1e-300); float code = e > 0 ? 0.1f * (float)floor(-log10(e)) : 2.f; if (code < 0.f) code = 0.f;
    for (long i = (long)blockIdx.x * blockDim.x + threadIdx.x; i < nel; i += (long)gridDim.x * blockDim.x) out[i] = ref[i] * (1.f + code);
}
__global__ void att2out(float* out, const unsigned short* att, int qlo, int qhi) {
    for (long i = (long)blockIdx.x * blockDim.x + threadIdx.x; i < (long)NTOK * D; i += (long)gridDim.x * blockDim.x) {
        const int row = (int)(i >> 10), qb = (row % T) >> 8; out[i] = (qb >= qlo && qb <= qhi) ? __builtin_bit_cast(float, (unsigned)att[i] << 16) : 0.f; }
}
__global__ void countpoison(const unsigned short* a, size_t n, unsigned* stat) {
    unsigned c = 0;
    for (size_t i = (size_t)blockIdx.x * blockDim.x + threadIdx.x; i < n; i += (size_t)gridDim.x * blockDim.x) c += a[i] == 0xFFFFu;
    for (int o = 32; o > 0; o >>= 1) c += __shfl_xor(c, o);
    if ((threadIdx.x & 63) == 0 && c) atomicAdd(stat, c);
}
__global__ void bf16n(float* out, const unsigned short* src, long n) { for (long i = (long)blockIdx.x * blockDim.x + threadIdx.x; i < (long)NTOK * D; i += (long)gridDim.x * blockDim.x) out[i] = i < n ? __builtin_bit_cast(float, (unsigned)src[i] << 16) : 0.f; }
__global__ void f32half(float* out, const float* src) { for (long i = (long)blockIdx.x * blockDim.x + threadIdx.x; i < (long)NTOK * D; i += (long)gridDim.x * blockDim.x) out[i] = i < (long)NTOK * 512 ? src[i] : 0.f; }
__global__ void f32out(float* out, const float* src) { for (long i = (long)blockIdx.x * blockDim.x + threadIdx.x; i < (long)NTOK * D; i += (long)gridDim.x * blockDim.x) out[i] = src[i]; }
}
#endif
#ifndef MK_SINGLE
#define MK_SINGLE 0
#endif
static int mk_grid_init() {
    static int grid = 0;
    if (grid == 0) {
        int dev = 0, cus = 0;
        if (hipGetDevice(&dev) != hipSuccess || hipDeviceGetAttribute(&cus, hipDeviceAttributeMultiprocessorCount, dev) != hipSuccess) { grid = -1; return grid; }
        if (hipFuncSetAttribute((const void*)fk::mk, hipFuncAttributeMaxDynamicSharedMemorySize, fk::LDS_BYTES) != hipSuccess) { fprintf(stderr, "kernel_launch: hipFuncSetAttribute failed\n"); grid = -1; return grid; }
        int per_cu = 0;
        if (hipOccupancyMaxActiveBlocksPerMultiprocessor(&per_cu, (const void*)fk::mk, fk::NTHR, fk::LDS_BYTES) != hipSuccess || per_cu < 1) fprintf(stderr, "kernel_launch: occupancy query reports %d\n", per_cu);
        (void)hipGetLastError();
        grid = cus;
    }
    return grid;
}
static void fast_forward(void* const* d_in, float* out, unsigned char* ws, hipStream_t stream, int step_lo, int step_hi, bool single, const float* dbg_src, int dbg_layer0) {
    const int grid = mk_grid_init(); if (grid <= 0) return;
    fk::Args a{};
    for (int i = 0; i < 24; ++i) a.in[i] = (const float*)d_in[i];
    a.out = out; a.ws = ws; a.dbg_src = dbg_src; a.dbg_layer0 = dbg_layer0; a.bar_region = 0;
    if (single) { a.lo = step_lo; a.hi = step_hi; hipLaunchKernelGGL(fk::mk, dim3(grid), dim3(fk::NTHR), fk::LDS_BYTES, stream, a); }
    else for (int s = step_lo; s < step_hi; ++s) { a.lo = s; a.hi = s + 1; hipLaunchKernelGGL(fk::mk, dim3(grid), dim3(fk::NTHR), fk::LDS_BYTES, stream, a); }
}

#ifndef MK_DEBUG
#define MK_DEBUG 0
#endif
#if MK_DEBUG
#ifndef MK_DBG_CFG
#define MK_DBG_CFG 1
#endif
#ifndef MK_DBG_DENOM
#define MK_DBG_DENOM 0.f
#endif
#ifndef MK_DBG_WHICH
#define MK_DBG_WHICH -1
#endif
#endif

extern "C" void kernel_launch(void* const* d_in, const int* in_sizes, int n_in, void* d_out, int out_size, void* d_ws, size_t ws_size, hipStream_t stream) {
    if (n_in != 24 || ws_size < fk::WS_FAST_END) { fprintf(stderr, "kernel_launch: unexpected n_in %d / ws %zu\n", n_in, ws_size); return; }
    unsigned char* ws = (unsigned char*)d_ws;
#if MK_DEBUG
    using namespace nv;
    constexpr size_t MiB = 1u << 20; unsigned char* keep = ws + 2400 * MiB;
    float* nout = (float*)(keep + 1536 * MiB); double* acc = (double*)(keep + 1664 * MiB);
    In in; for (int i = 0; i < 24; ++i) in.p[i] = (const float*)d_in[i];
    const float C2 = fk::C2;
#if MK_DBG_CFG == 1
    Save sv[] = {{0, ST_PROJ, keep}, {0, ST_ATT, keep + 512 * MiB}};
    forward(in, ws, nout, sv, 2, stream);
    (void)hipMemsetAsync(ws + fk::WS_CTL, 0, fk::CTL_BYTES, stream); (void)hipMemsetAsync(acc, 0, 1024, stream);
    fast_forward(d_in, (float*)d_out, ws, stream, 0, 5, false, nullptr, 0);
    const float* nproj = (const float*)keep; const unsigned short* fproj = (const unsigned short*)(ws + fk::WS_PROJ);
    dbg::cmp<float, unsigned short><<<1024, 256, 0, stream>>>(nproj, EVEN_IN, fproj, fk::PITCH, NTOK, 512, 1.f / C2, acc + 0);
    dbg::cmp<float, unsigned short><<<1024, 256, 0, stream>>>(nproj + 512, EVEN_IN, fproj + 512, fk::PITCH, NTOK, 3072, 1.f, acc + 2);
    dbg::cmp<float, float><<<1024, 256, 0, stream>>>(nproj + 3584, EVEN_IN, (const float*)(ws + fk::WS_PB), 16, NTOK, 8, 1.f, acc + 4);
    dbg::cmp<float, unsigned short><<<1024, 256, 0, stream>>>((const float*)(keep + 512 * MiB), D, (const unsigned short*)(ws + fk::WS_ATT), D, NTOK, D, 1.f, acc + 6);
    const int nchk = 4;
#elif MK_DBG_CFG == 2
    Save sv[] = {{0, ST_XOUT, keep}, {1, ST_PROJ, keep + 128 * MiB}, {1, ST_CUM, keep + 648 * MiB}, {1, ST_MIX, keep + 656 * MiB}, {1, ST_H, keep + 784 * MiB}, {1, ST_XMIX, keep + 912 * MiB}, {1, ST_XOUT, keep + 1040 * MiB}};
    forward(in, ws, nout, sv, 7, stream);
    (void)hipMemsetAsync(ws + fk::WS_CTL, 0, fk::CTL_BYTES, stream); (void)hipMemsetAsync(acc, 0, 1024, stream);
    fast_forward(d_in, (float*)d_out, ws, stream, 0, 2, false, (const float*)keep, 1);
    const int s0 = 2 + 9;
    const float* nproj = (const float*)(keep + 128 * MiB); const unsigned short* fproj = (const unsigned short*)(ws + fk::WS_PROJ);
    fast_forward(d_in, (float*)d_out, ws, stream, s0, s0 + 2, false, (const float*)keep, 1);
    dbg::cmp<float, unsigned short><<<1024, 256, 0, stream>>>(nproj, ODD_IN, fproj, fk::PITCH, NTOK, 1024, 1.f / C2, acc + 0);
    dbg::cmp<float, unsigned short><<<1024, 256, 0, stream>>>(nproj + 1024, ODD_IN, fproj + 1024, fk::PITCH, NTOK, 3072, 1.f, acc + 2);
    dbg::cmp<float, float><<<1024, 256, 0, stream>>>((const float*)(keep + 648 * MiB), T, (const float*)(ws + fk::WS_CUM), T, 32, T, 1.f / fk::LOG2E, acc + 4);
    fast_forward(d_in, (float*)d_out, ws, stream, s0 + 2, s0 + 3, false, (const float*)keep, 1);
    dbg::cmp<float, unsigned short><<<1024, 256, 0, stream>>>((const float*)(keep + 656 * MiB), D, (const unsigned short*)(ws + fk::WS_MIX), D, NTOK, D, 1.f, acc + 6);
    fast_forward(d_in, (float*)d_out, ws, stream, s0 + 3, s0 + 4, false, (const float*)keep, 1);
    dbg::cmp<float, float><<<1024, 256, 0, stream>>>((const float*)(keep + 784 * MiB), D, (const float*)(ws + fk::WS_H), D, NTOK, D, 1.f, acc + 8);
    fast_forward(d_in, (float*)d_out, ws, stream, s0 + 4, s0 + 5, false, (const float*)keep, 1);
    dbg::cmp<float, float><<<1024, 256, 0, stream>>>((const float*)(keep + 912 * MiB), D, (const float*)(ws + fk::WS_X), D, NTOK, D, 1.f, acc + 10);
    fast_forward(d_in, (float*)d_out, ws, stream, s0 + 5, s0 + 8, false, (const float*)keep, 1);
    dbg::cmp<float, float><<<1024, 256, 0, stream>>>((const float*)(keep + 1040 * MiB), D, (const float*)(ws + fk::WS_X), D, NTOK, D, 1.f, acc + 12);
    const int nchk = 7;
#elif MK_DBG_CFG == 3
    Save sv[] = {{0, ST_ATT, keep}, {0, ST_GO, keep + 128 * MiB}, {0, ST_MIX, keep + 192 * MiB}, {0, ST_H, keep + 320 * MiB}, {0, ST_XMIX, keep + 448 * MiB}, {0, ST_XOUT, keep + 576 * MiB}};
    forward(in, ws, nout, sv, 6, stream);
    (void)hipMemsetAsync(ws + fk::WS_CTL, 0, fk::CTL_BYTES, stream); (void)hipMemsetAsync(acc, 0, 1024, stream);
    fast_forward(d_in, (float*)d_out, ws, stream, 0, 5, false, nullptr, 0);
    dbg::cmp<float, unsigned short><<<1024, 256, 0, stream>>>((const float*)keep, D, (const unsigned short*)(ws + fk::WS_ATT), D, NTOK, D, 1.f, acc + 0);
    dbg::cmp<float, float><<<1024, 256, 0, stream>>>((const float*)(keep + 128 * MiB), 512, (const float*)(ws + fk::WS_GO), 512, NTOK, 512, 1.f, acc + 2);
    fast_forward(d_in, (float*)d_out, ws, stream, 5, 6, false, nullptr, 0);
    dbg::cmp<float, unsigned short><<<1024, 256, 0, stream>>>((const float*)(keep + 192 * MiB), D, (const unsigned short*)(ws + fk::WS_MIX), D, NTOK, D, 1.f, acc + 4);
    fast_forward(d_in, (float*)d_out, ws, stream, 6, 7, false, nullptr, 0);
    dbg::cmp<float, float><<<1024, 256, 0, stream>>>((const float*)(keep + 320 * MiB), D, (const float*)(ws + fk::WS_H), D, NTOK, D, 1.f, acc + 6);
    fast_forward(d_in, (float*)d_out, ws, stream, 7, 8, false, nullptr, 0);
    dbg::cmp<float, float><<<1024, 256, 0, stream>>>((const float*)(keep + 448 * MiB), D, (const float*)(ws + fk::WS_X), D, NTOK, D, 1.f, acc + 8);
    fast_forward(d_in, (float*)d_out, ws, stream, 8, 11, false, nullptr, 0);
    dbg::cmp<float, float><<<1024, 256, 0, stream>>>((const float*)(keep + 576 * MiB), D, (const float*)(ws + fk::WS_X), D, NTOK, D, 1.f, acc + 10);
    const int nchk = 6;
#elif MK_DBG_CFG == 6
#ifndef MK_QLO
#define MK_QLO 0
#define MK_QHI 63
#endif
    (void)hipMemsetAsync(ws + fk::WS_CTL, 0, fk::CTL_BYTES, stream);
    (void)hipMemsetAsync(ws + fk::WS_GW, 0, fk::WS_GU - fk::WS_GW, stream);
#ifndef MK_NSTEP
#define MK_NSTEP 5
#endif
    fast_forward(d_in, (float*)(ws + 2400 * MiB), ws, stream, 0, MK_NSTEP, false, nullptr, 0);
#ifndef MK_OUTBUF
#define MK_OUTBUF 0
#endif
    if (MK_OUTBUF == 0) dbg::att2out<<<1024, 256, 0, stream>>>((float*)d_out, (const unsigned short*)(ws + fk::WS_ATT), MK_QLO, MK_QHI);
    else if (MK_OUTBUF == 1) dbg::f32out<<<1024, 256, 0, stream>>>((float*)d_out, (const float*)(ws + fk::WS_X));
    else if (MK_OUTBUF == 2) dbg::att2out<<<1024, 256, 0, stream>>>((float*)d_out, (const unsigned short*)(ws + fk::WS_MIX), 0, 63);
    else if (MK_OUTBUF == 8) dbg::bf16n<<<1024, 256, 0, stream>>>((float*)d_out, (const unsigned short*)(ws + fk::WS_GW), 2048L * 64 * 136);
    else if (MK_OUTBUF == 9) dbg::bf16n<<<1024, 256, 0, stream>>>((float*)d_out, (const unsigned short*)(ws + fk::WS_GQD), 2048L * 64 * 136);
    else if (MK_OUTBUF == 10) dbg::bf16n<<<1024, 256, 0, stream>>>((float*)d_out, (const unsigned short*)(ws + fk::WS_GQK), 2048L * 64 * 72);
    else if (MK_OUTBUF == 11) dbg::bf16n<<<1024, 256, 0, stream>>>((float*)d_out, (const unsigned short*)(ws + fk::WS_GKD), 2048L * 128 * 72);
    else if (MK_OUTBUF == 6) dbg::att2out<<<1024, 256, 0, stream>>>((float*)d_out, (const unsigned short*)(ws + fk::WS_GW), 0, 63);
    else if (MK_OUTBUF == 7) dbg::att2out<<<1024, 256, 0, stream>>>((float*)d_out, (const unsigned short*)(ws + fk::WS_GQK), 0, 63);
    else if (MK_OUTBUF == 4) dbg::f32half<<<1024, 256, 0, stream>>>((float*)d_out, (const float*)(ws + fk::WS_GO));
    else if (MK_OUTBUF == 5) dbg::f32half<<<1024, 256, 0, stream>>>((float*)d_out, (const float*)(ws + fk::WS_GU));
    else dbg::f32out<<<1024, 256, 0, stream>>>((float*)d_out, (const float*)(ws + fk::WS_H));
    (void)nout; (void)acc; (void)in; (void)C2;
    const int nchk = 0; if (nchk == 0) return;
#elif MK_DBG_CFG == 7
    forward(in, ws, nout, nullptr, 0, stream);
    float* fout = (float*)(keep + 1024 * MiB); unsigned* stat = (unsigned*)acc; (void)hipMemsetAsync(stat, 0, 64, stream);
    (void)hipMemsetAsync(ws + fk::WS_CTL, 0, fk::CTL_BYTES, stream);
    (void)hipMemsetAsync(ws + fk::WS_ATT, 0xFF, (size_t)64 * MiB, stream);
    fast_forward(d_in, fout, ws, stream, 0, 5, false, nullptr, 0);
    dbg::countpoison<<<1024, 256, 0, stream>>>((const unsigned short*)(ws + fk::WS_ATT), (size_t)NTOK * D, stat);
    dbg::finish3<<<1024, 256, 0, stream>>>((float*)d_out, nout, stat, 0, 0.f, (long)NTOK * D);
    const int nchk = 0; if (nchk == 0) return;
#elif MK_DBG_CFG == 5
    forward(in, ws, nout, nullptr, 0, stream);
    float* fout = (float*)(keep + 1024 * MiB); unsigned* stat = (unsigned*)acc; (void)hipMemsetAsync(stat, 0, 64, stream);
    for (int run = 0; run < 2; ++run) {
        (void)hipMemsetAsync(ws + fk::WS_CTL, 0, fk::CTL_BYTES, stream);
        fast_forward(d_in, fout, ws, stream, 0, 5, false, nullptr, 0);
        if (run == 0) (void)hipMemcpyAsync(keep, ws + fk::WS_ATT, (size_t)64 * MiB, hipMemcpyDeviceToDevice, stream);
    }
    dbg::attdiff<<<2048, 256, 0, stream>>>((const unsigned short*)keep, (const unsigned short*)(ws + fk::WS_ATT), stat, 0);
#if MK_DBG_WHICH == 9
    (void)hipMemsetAsync(acc + 16, 0, 64, stream);
    dbg::cmp<unsigned short, unsigned short><<<1024, 256, 0, stream>>>((const unsigned short*)keep, D, (const unsigned short*)(ws + fk::WS_ATT), D, NTOK, D, 1.f, acc + 16);
    dbg::finish4<<<1024, 256, 0, stream>>>((float*)d_out, nout, acc + 16, (long)NTOK * D);
#else
    dbg::finish3<<<1024, 256, 0, stream>>>((float*)d_out, nout, stat, MK_DBG_WHICH < 0 ? 0 : MK_DBG_WHICH, MK_DBG_DENOM, (long)NTOK * D);
#endif
    const int nchk = 0; if (nchk == 0) return;
#elif MK_DBG_CFG == 4
    forward(in, ws, nout, nullptr, 0, stream);
    float* fout = (float*)(keep + 1024 * MiB);
    unsigned long long* cs = (unsigned long long*)acc; (void)hipMemsetAsync(cs, 0, 4096, stream);
#ifndef MK_DBG_S0
#define MK_DBG_S0 0
#endif
#ifndef MK_DBG_NS
#define MK_DBG_NS 9
#endif
    int nslot = 0;
#ifndef MK_NRUN
#define MK_NRUN 2
#endif
    for (int run = 0; run < MK_NRUN; ++run) {
        (void)hipMemsetAsync(ws + fk::WS_CTL, 0, fk::CTL_BYTES, stream);
        int slot = 0;
        auto CS2 = [&](size_t off, size_t rows, size_t colw, size_t pitchw) { if (slot >= MK_DBG_S0 && slot < MK_DBG_S0 + MK_DBG_NS) dbg::csum<<<1024, 256, 0, stream>>>((const unsigned*)(ws + off), rows * colw, cs + 16 * run + (slot - MK_DBG_S0), colw, pitchw); ++slot; };
        auto CS = [&](size_t off, size_t bytes) { CS2(off, 1, bytes / 4, bytes / 4); };
        int st = 0;
        auto RUN = [&](int n) { fast_forward(d_in, fout, ws, stream, st, st + n, false, nullptr, 0); st += n; };
        RUN(1); CS(fk::WS_WINE, fk::WS_X - fk::WS_WINE);
        RUN(1); CS(fk::WS_X, (size_t)192 * MiB); CS(fk::WS_PB, 2 * MiB);
        for (int layer = 0; layer < 4; ++layer) {
            RUN(1); CS2(fk::WS_PROJ, NTOK, (layer & 1) ? 2048 : 1792, 2048);
            if ((layer & 1) == 0) { RUN(1); CS(fk::WS_GU, (size_t)64 * MiB); CS(fk::WS_GL, 8192); CS2(fk::WS_GW, 2048 * 64, 64, 68); CS2(fk::WS_GQD, 2048 * 64, 64, 68); CS2(fk::WS_GQK, 2048 * 64, 32, 36); CS2(fk::WS_GKD, 2048 * 128, 32, 36); RUN(1); CS(fk::WS_ATT, (size_t)64 * MiB); CS(fk::WS_GO, (size_t)64 * MiB); RUN(1); CS(fk::WS_MIX, (size_t)64 * MiB); }
            else { RUN(1); CS2(fk::WS_PROJ, NTOK, 2048, 2048); CS(fk::WS_CUM, 2 * MiB); CS(fk::WS_KB8, 8 * MiB); RUN(1); CS(fk::WS_MIX, (size_t)64 * MiB); }
            RUN(1); CS(fk::WS_H, (size_t)128 * MiB);
            RUN(1); CS(fk::WS_X, (size_t)192 * MiB); CS(fk::WS_SELE, 512 * 1024); CS(fk::WS_GATE, 512 * 1024);
            RUN(3); if (layer < 3) CS(fk::WS_X, (size_t)192 * MiB);
        }
        nslot = slot;
    }
    (void)nslot;
    dbg::finish2<<<1024, 256, 0, stream>>>((float*)d_out, nout, cs, 9, MK_NRUN, (long)NTOK * D);
    const int nchk = 0; if (nchk == 0) return;
#endif
    dbg::finish<<<1024, 256, 0, stream>>>((float*)d_out, nout, acc, nchk, 1e-3f, MK_DBG_WHICH, (long)NTOK * D);
#else
    (void)hipMemsetAsync(ws + fk::WS_CTL, 0, fk::CTL_BYTES, stream);
    fast_forward(d_in, (float*)d_out, ws, stream, 0, fk::N_STEPS, MK_SINGLE != 0, nullptr, 0);
#endif
}
```
